# Optimizing an MI355X kernel written in HIP

```python
import math
import jax, jax.numpy as jnp
from jax import lax
import numpy as np

D_MODEL = 1024
BATCH = 2
SEQ = 8192
DEPTH = 4

CTX_LEN = 256
GRID_W = 64
GDN_H = 4
GDN_DK = 128
GDN_DV = 128
GDN_CHUNK = 64
CONV_K = 3
DIFF_H = 4
DIFF_D = 64
Q_BLOCK = 128
ROPE_BASE = 10000.0
NA_H = 8
NA_D = 64
WIN_H = 8
WIN_W = 16
NA_QB_W = 16
NA_KB_W = 32
N_BRANCH = 3
BRANCH_W = 512
GDN_QK = GDN_H * GDN_DK
GDN_V = GDN_H * GDN_DV
DIFF_W = 2 * DIFF_H * DIFF_D
NA_W = NA_H * NA_D
IN_SPLITS = (GDN_QK, GDN_QK, GDN_V, GDN_V, GDN_H, GDN_H, GDN_H, GDN_H,
             DIFF_W, DIFF_W, DIFF_W, NA_W, NA_W, NA_W, N_BRANCH * D_MODEL)
D_IN = sum(IN_SPLITS)
N_EXPERTS = 32
TOP_K = 4
D_EXPERT = 1024
SWIGLU_LIMIT = 7.0
SWIGLU_ALPHA = 1.702
MOE_BLOCK = 128
DN_ALPHA = (2 * DEPTH) ** 0.25
DN_BETA = (8 * DEPTH) ** -0.25
LN_EPS = 1e-5
RMS_EPS = 1e-6
NEG_INF = -1e30

kernel_name = 'hybrid_gdn_diffattn_natten_moe_dit'

F32 = jnp.float32


def _layernorm(x):
    xf = x.astype(F32)
    mu = jnp.mean(xf, -1, keepdims=True)
    var = jnp.mean(jnp.square(xf - mu), -1, keepdims=True)
    return ((xf - mu) * lax.rsqrt(var + LN_EPS)).astype(x.dtype)


def _rmsnorm(x, w):
    xf = x.astype(F32)
    return xf * lax.rsqrt(jnp.mean(jnp.square(xf), -1, keepdims=True) + RMS_EPS) * w.astype(F32)


def _l2norm(x):
    return x * lax.rsqrt(jnp.sum(jnp.square(x), -1, keepdims=True) + RMS_EPS)


def _modulate(x, shift, scale):
    return _layernorm(x) * (1 + scale) + shift


def _post_norm(x, y, g, b):
    return _layernorm(DN_ALPHA * x + y) * g + b


def _split_cols(p):
    return jnp.split(p, np.cumsum(IN_SPLITS)[:-1].tolist(), axis=-1)


def _axial_rope(n_tok, dtype):
    t = jnp.arange(n_tok)
    row = (t // GRID_W).astype(F32)
    col = (t % GRID_W).astype(F32)
    n_freq = DIFF_D // 4
    inv = ROPE_BASE ** (-jnp.arange(n_freq, dtype=F32) / n_freq)
    ang = jnp.concatenate([row[:, None] * inv, col[:, None] * inv], -1)
    ang = jnp.concatenate([ang, ang], -1)
    return jnp.cos(ang).astype(dtype), jnp.sin(ang).astype(dtype)


def _apply_rope(x, cos, sin):
    x1, x2 = jnp.split(x, 2, axis=-1)
    return x * cos + jnp.concatenate([-x2, x1], -1) * sin


def _short_conv(x, w):
    return lax.conv_general_dilated(x, w[:, None, :], window_strides=(1,),
                                    padding=[(CONV_K // 2, CONV_K // 2)],
                                    dimension_numbers=('NWC', 'WIO', 'NWC'),
                                    feature_group_count=x.shape[-1])


def _gdn_qkv(q, k, v, conv_w):
    b, L, _ = q.shape
    qkv = jax.nn.silu(_short_conv(jnp.concatenate([q, k, v], -1), conv_w)).astype(F32)
    q, k, v = jnp.split(qkv, [GDN_QK, 2 * GDN_QK], axis=-1)
    q = _l2norm(q.reshape(b, L, GDN_H, GDN_DK)) * GDN_DK ** -0.5
    k = _l2norm(k.reshape(b, L, GDN_H, GDN_DK))
    return q, k, v.reshape(b, L, GDN_H, GDN_DV)


def _gdn_decay(a, bb, a_log, dt_bias):
    g = -jnp.exp(a_log.astype(F32)) * jax.nn.softplus(a.astype(F32) + dt_bias.astype(F32))
    return g, jax.nn.sigmoid(bb.astype(F32))


def _gdn_chunk_scan(q, k, v, g, beta, s0, with_out):
    b, L, h, _ = q.shape
    dv = v.shape[-1]
    cs = GDN_CHUNK
    n = L // cs

    def blk(t):
        return t.reshape(b, n, cs, h, -1).transpose(0, 3, 1, 2, 4)

    q, k, v = blk(q), blk(k), blk(v)
    g = g.reshape(b, n, cs, h).transpose(0, 3, 1, 2)
    beta = beta.reshape(b, n, cs, h).transpose(0, 3, 1, 2)
    gc = jnp.cumsum(g, axis=-1)
    i = jnp.arange(cs)
    incl = i[:, None] >= i[None, :]
    strict = i[:, None] > i[None, :]
    decay = jnp.where(incl, jnp.exp(jnp.where(incl, gc[..., :, None] - gc[..., None, :], 0.0)), 0.0)
    kb = k * beta[..., None]
    low = jnp.where(strict, jnp.einsum('bhnid,bhnjd->bhnij', kb, k) * decay, 0.0)
    rhs = jnp.concatenate([v * beta[..., None], kb * jnp.exp(gc)[..., None]], axis=-1)
    sol = lax.linalg.triangular_solve(low + jnp.eye(cs, dtype=F32), rhs, left_side=True, lower=True)
    u, w = sol[..., :dv], sol[..., dv:]
    g_last = gc[..., -1]
    k_tail = k * jnp.exp(g_last[..., None] - gc)[..., None]

    def seq(t):
        return jnp.moveaxis(t, 2, 0)

    def state_update(S, u_i, w_i, kt_i, gl_i):
        v_new = u_i - jnp.einsum('bhck,bhkv->bhcv', w_i, S)
        S_new = S * jnp.exp(gl_i)[..., None, None] + jnp.einsum('bhck,bhcv->bhkv', kt_i, v_new)
        return S_new, v_new

    if not with_out:
        def step(S, xs):
            S_new, _ = state_update(S, *xs)
            return S_new, None
        s_fin, _ = lax.scan(step, s0, (seq(u), seq(w), seq(k_tail), seq(g_last)))
        return s_fin, None

    qk = jnp.where(incl, jnp.einsum('bhnid,bhnjd->bhnij', q, k) * decay, 0.0)
    qg = q * jnp.exp(gc)[..., None]

    def step_out(S, xs):
        u_i, w_i, kt_i, gl_i, qk_i, qg_i = xs
        S_new, v_new = state_update(S, u_i, w_i, kt_i, gl_i)
        o_i = jnp.einsum('bhck,bhkv->bhcv', qg_i, S) + jnp.einsum('bhcj,bhjv->bhcv', qk_i, v_new)
        return S_new, o_i

    s_fin, o = lax.scan(step_out, s0, tuple(seq(t) for t in (u, w, k_tail, g_last, qk, qg)))
    o = jnp.moveaxis(o, 0, 2).transpose(0, 2, 3, 1, 4).reshape(b, L, h, dv)
    return s_fin, o


def _gated_rms(o, z, w):
    b, L, h, dv = o.shape
    zf = z.reshape(b, L, h, dv).astype(F32)
    return (_rmsnorm(o, w) * jax.nn.silu(zf)).reshape(b, L, h * dv).astype(z.dtype)


def _gdn_branch(lat, ctx, conv_w, a_log, dt_bias, norm_w, with_ctx_out):
    qx, kx, vx = _gdn_qkv(lat[0], lat[1], lat[2], conv_w)
    qc, kc, vc = _gdn_qkv(ctx[0], ctx[1], ctx[2], conv_w)
    s0 = jnp.zeros((qx.shape[0], GDN_H, GDN_DK, GDN_DV), F32)
    outs_x, outs_c = [], []
    for d in range(2):
        fl = (lambda t: t[:, ::-1]) if d else (lambda t: t)
        gx, bx = _gdn_decay(lat[4 + 2 * d], lat[5 + 2 * d], a_log[d], dt_bias[d])
        gcc, bcc = _gdn_decay(ctx[4 + 2 * d], ctx[5 + 2 * d], a_log[d], dt_bias[d])
        s_ctx, oc = _gdn_chunk_scan(fl(qc), fl(kc), fl(vc), fl(gcc), fl(bcc), s0, with_ctx_out)
        _, ox = _gdn_chunk_scan(fl(qx), fl(kx), fl(vx), fl(gx), fl(bx), s_ctx, True)
        outs_x.append(fl(ox))
        if with_ctx_out:
            outs_c.append(fl(oc))
    yx = _gated_rms(outs_x[0] + outs_x[1], lat[3], norm_w)
    yc = _gated_rms(outs_c[0] + outs_c[1], ctx[3], norm_w) if with_ctx_out else None
    return yx, yc


def _diff_attend(q, k, v, lam):
    s = jnp.einsum('bhmqd,bhmkd->bhmqk', q, k).astype(F32) * DIFF_D ** -0.5
    p = jax.nn.softmax(s, axis=-1)
    a = p[:, :, 0] - lam * p[:, :, 1]
    return jnp.einsum('bhqk,bhke->bhqe', a.astype(v.dtype), v)


def _diff_out(o, norm_w, lam_init, dtype):
    b, h, L, e = o.shape
    y = _rmsnorm(o, norm_w) * (1.0 - lam_init)
    return y.transpose(0, 2, 1, 3).reshape(b, L, h * e).astype(dtype)


def _diff_branch(lat, ctx, lam_vec, lam_init, norm_w, cos, sin, with_ctx_out):
    qx, kx, vx = lat
    qc, kc, vc = ctx
    b, S, _ = qx.shape

    def qk_heads(t):
        return t.reshape(b, t.shape[1], DIFF_H, 2, DIFF_D).transpose(0, 2, 3, 1, 4)

    def v_heads(t):
        return t.reshape(b, t.shape[1], DIFF_H, 2 * DIFF_D).transpose(0, 2, 1, 3)

    lv = lam_vec.astype(F32)
    lam = jnp.exp(jnp.sum(lv[0] * lv[1])) - jnp.exp(jnp.sum(lv[2] * lv[3])) + lam_init
    qx_h = _apply_rope(qk_heads(qx), cos, sin)
    kx_h = _apply_rope(qk_heads(kx), cos, sin)
    kc_h, vc_h = qk_heads(kc), v_heads(vc)
    k_all = jnp.concatenate([kx_h, kc_h], axis=3)
    v_all = jnp.concatenate([v_heads(vx), vc_h], axis=2)
    nb = S // Q_BLOCK
    q_blocks = jnp.moveaxis(qx_h.reshape(b, DIFF_H, 2, nb, Q_BLOCK, DIFF_D), 3, 0)
    o = lax.map(lambda qb: _diff_attend(qb, k_all, v_all, lam), q_blocks)
    o = jnp.moveaxis(o, 0, 2).reshape(b, DIFF_H, S, 2 * DIFF_D)
    yx = _diff_out(o, norm_w, lam_init, qx.dtype)
    yc = _diff_out(_diff_attend(qk_heads(qc), kc_h, vc_h, lam), norm_w, lam_init, qc.dtype) if with_ctx_out else None
    return yx, yc


def _na_branch(lat, ctx, rpb, with_ctx_out):
    qx, kx, vx = lat
    qc, kc, vc = ctx
    b, S, _ = qx.shape
    dt = qx.dtype
    rows = S // GRID_W
    kh = min(WIN_H, rows)
    n_cb = GRID_W // NA_QB_W
    scale = NA_D ** -0.5

    def heads(t):
        return t.reshape(b, t.shape[1], NA_H, NA_D).transpose(0, 2, 1, 3)

    qg = heads(qx).reshape(b, NA_H, rows, GRID_W, NA_D)
    kg = heads(kx).reshape(b, NA_H, rows, GRID_W, NA_D)
    vg = heads(vx).reshape(b, NA_H, rows, GRID_W, NA_D)
    kch, vch = heads(kc), heads(vc)
    q_cols = np.arange(GRID_W).reshape(n_cb, NA_QB_W)
    win_c0 = np.clip(q_cols - WIN_W // 2, 0, GRID_W - WIN_W)
    k_c0 = np.clip(np.arange(n_cb) * NA_QB_W - WIN_W // 2, 0, GRID_W - NA_KB_W)
    k_cols = k_c0[:, None] + np.arange(NA_KB_W)
    col_ok = (k_cols[:, None, :] >= win_c0[:, :, None]) & (k_cols[:, None, :] < win_c0[:, :, None] + WIN_W)
    col_idx = np.clip(k_cols[:, None, :] - q_cols[:, :, None] + WIN_W - 1, 0, 2 * WIN_W - 2)
    n_loc = kh * NA_KB_W
    mask = np.broadcast_to(col_ok[:, :, None, :], (n_cb, NA_QB_W, kh, NA_KB_W)).reshape(n_cb, NA_QB_W, n_loc)

    def gather_band(t, r0):
        band = lax.dynamic_slice_in_dim(t, r0, kh, axis=2)[:, :, :, k_cols]
        return band.transpose(0, 1, 3, 2, 4, 5).reshape(b, NA_H, n_cb, n_loc, NA_D)

    def row_fn(r):
        r0 = jnp.clip(r - kh // 2, 0, rows - kh)
        k_blk, v_blk = gather_band(kg, r0), gather_band(vg, r0)
        q_r = lax.dynamic_index_in_dim(qg, r, axis=2, keepdims=False).reshape(b, NA_H, n_cb, NA_QB_W, NA_D)
        bias = rpb[:, r0 + jnp.arange(kh) - r + WIN_H - 1][:, :, col_idx]
        bias = bias.transpose(0, 2, 3, 1, 4).reshape(NA_H, n_cb, NA_QB_W, n_loc).astype(F32)
        s_loc = jnp.einsum('bhnqd,bhnkd->bhnqk', q_r, k_blk).astype(F32) * scale + bias
        s_loc = jnp.where(mask, s_loc, NEG_INF)
        s_ctx = jnp.einsum('bhnqd,bhkd->bhnqk', q_r, kch).astype(F32) * scale
        p = jax.nn.softmax(jnp.concatenate([s_loc, s_ctx], -1), axis=-1).astype(dt)
        o = (jnp.einsum('bhnqk,bhnkd->bhnqd', p[..., :n_loc], v_blk)
             + jnp.einsum('bhnqk,bhkd->bhnqd', p[..., n_loc:], vch))
        return o.reshape(b, NA_H, GRID_W, NA_D)

    o = lax.map(row_fn, jnp.arange(rows))
    yx = o.transpose(1, 0, 3, 2, 4).reshape(b, S, NA_H * NA_D)
    yc = None
    if with_ctx_out:
        qch = heads(qc)
        s = jnp.einsum('bhqd,bhkd->bhqk', qch, kch).astype(F32) * scale
        p = jax.nn.softmax(s, axis=-1).astype(dt)
        yc = jnp.einsum('bhqk,bhkd->bhqd', p, vch).transpose(0, 2, 1, 3).reshape(b, qc.shape[1], NA_H * NA_D)
    return yx, yc


def _merge(ya, yb, yc, gate_logits, w_branch, w_out):
    ga, gb, gcg = jnp.split(jax.nn.sigmoid(gate_logits.astype(F32)).astype(ya.dtype), N_BRANCH, axis=-1)
    m = ga * (ya @ w_branch[0]) + gb * (yb @ w_branch[1]) + gcg * (yc @ w_branch[2])
    return m @ w_out


def _token_mixer(hx, hc, w_in, conv_w, a_log, dt_bias, gdn_norm_w, lam_vec, lam_init, diff_norm_w,
                 rpb, w_branch, w_out, cos, sin, with_ctx_out):
    px = _split_cols(hx @ w_in)
    pc = _split_cols(hc @ w_in)
    ya_x, ya_c = _gdn_branch(px[:8], pc[:8], conv_w, a_log, dt_bias, gdn_norm_w, with_ctx_out)
    yb_x, yb_c = _diff_branch(px[8:11], pc[8:11], lam_vec, lam_init, diff_norm_w, cos, sin, with_ctx_out)
    yc_x, yc_c = _na_branch(px[11:14], pc[11:14], rpb, with_ctx_out)
    out_x = _merge(ya_x, yb_x, yc_x, px[14], w_branch, w_out)
    out_c = _merge(ya_c, yb_c, yc_c, pc[14], w_branch, w_out) if with_ctx_out else None
    return out_x, out_c


def _moe(h, w_router, b_router, w1, b1, w2, b2):
    T, D = h.shape
    logits = (h @ w_router).astype(F32) + b_router.astype(F32)
    top_v, top_e = lax.top_k(logits, TOP_K)
    gate = jax.nn.softmax(top_v, axis=-1)
    n_asg = T * TOP_K
    flat_e = top_e.reshape(-1)
    flat_tok = jnp.arange(n_asg, dtype=jnp.int32) // TOP_K
    order = jnp.argsort(flat_e)
    e_sorted = flat_e[order]
    counts = jnp.bincount(flat_e, length=N_EXPERTS)
    padded = (counts + MOE_BLOCK - 1) // MOE_BLOCK * MOE_BLOCK
    pad_end = jnp.cumsum(padded)
    pad_start = pad_end - padded
    start = jnp.cumsum(counts) - counts
    dest = pad_start[e_sorted] + jnp.arange(n_asg) - start[e_sorted]
    n_blk = -(-(n_asg + N_EXPERTS * (MOE_BLOCK - 1)) // MOE_BLOCK)
    n_rows = n_blk * MOE_BLOCK
    row_tok = jnp.full((n_rows,), T, jnp.int32).at[dest].set(flat_tok[order])
    row_gate = jnp.zeros((n_rows,), h.dtype).at[dest].set(gate.reshape(-1)[order].astype(h.dtype))
    blk_e = jnp.minimum(jnp.searchsorted(pad_end, jnp.arange(n_blk) * MOE_BLOCK, side='right'), N_EXPERTS - 1)
    h_pad = jnp.concatenate([h, jnp.zeros((1, D), h.dtype)], 0)

    def expert_block(args):
        rows, e = args
        hu = h_pad[rows] @ w1[e] + b1[e]
        x_glu = jnp.minimum(hu[:, :D_EXPERT], SWIGLU_LIMIT)
        x_lin = jnp.clip(hu[:, D_EXPERT:], -SWIGLU_LIMIT, SWIGLU_LIMIT)
        act = x_glu * jax.nn.sigmoid(SWIGLU_ALPHA * x_glu) * (x_lin + 1)
        return act @ w2[e] + b2[e]

    y = lax.map(expert_block, (row_tok.reshape(n_blk, MOE_BLOCK), blk_e))
    y = y.reshape(n_rows, D) * row_gate[:, None]
    return jax.ops.segment_sum(y, row_tok, num_segments=T + 1)[:T]


def setup_inputs(seed: int = 0) -> dict:
    key = jax.random.key(seed)
    ks = jax.random.split(key, 24)

    def nrm(k, shape, s):
        return jax.random.normal(k, shape, F32) * s

    dt = jnp.exp(jax.random.uniform(ks[9], (DEPTH, 2, GDN_H), F32, math.log(1e-3), math.log(1e-1)))
    return {
        'x': nrm(ks[0], (BATCH, SEQ, D_MODEL), 1.0),
        'c': nrm(ks[1], (BATCH, D_MODEL), 1.0),
        'ctx': nrm(ks[2], (BATCH, CTX_LEN, D_MODEL), 1.0),
        'c_ctx': nrm(ks[3], (D_MODEL,), 1.0),
        'w_ada': nrm(ks[4], (DEPTH, D_MODEL, 6 * D_MODEL), D_MODEL ** -0.5),
        'b_ada': nrm(ks[5], (DEPTH, 6 * D_MODEL), 0.02),
        'w_in': nrm(ks[6], (DEPTH, D_MODEL, D_IN), D_MODEL ** -0.5),
        'conv_w': nrm(ks[7], (DEPTH, CONV_K, 2 * GDN_QK + GDN_V), CONV_K ** -0.5),
        'gdn_a_log': jnp.log(jax.random.uniform(ks[8], (DEPTH, 2, GDN_H), F32, 1.0, 16.0)),
        'gdn_dt_bias': dt + jnp.log(-jnp.expm1(-dt)),
        'gdn_norm_w': 1.0 + nrm(ks[10], (DEPTH, GDN_DV), 0.02),
        'diff_lambda': nrm(ks[11], (DEPTH, 4, DIFF_D), 0.1),
        'diff_norm_w': 1.0 + nrm(ks[12], (DEPTH, 2 * DIFF_D), 0.02),
        'na_rpb': nrm(ks[13], (DEPTH, NA_H, 2 * WIN_H - 1, 2 * WIN_W - 1), 0.02),
        'w_branch': nrm(ks[14], (DEPTH, N_BRANCH, BRANCH_W, D_MODEL), BRANCH_W ** -0.5),
        'w_out': nrm(ks[15], (DEPTH, D_MODEL, D_MODEL), D_MODEL ** -0.5 * DN_BETA),
        'ln_g': 1.0 + nrm(ks[16], (DEPTH, 2, D_MODEL), 0.02),
        'ln_b': nrm(ks[17], (DEPTH, 2, D_MODEL), 0.02),
        'w_router': nrm(ks[18], (DEPTH, D_MODEL, N_EXPERTS), D_MODEL ** -0.5),
        'b_router': nrm(ks[19], (DEPTH, N_EXPERTS), 0.01),
        'w_exp1': nrm(ks[20], (DEPTH, N_EXPERTS, D_MODEL, 2 * D_EXPERT), D_MODEL ** -0.5),
        'b_exp1': nrm(ks[21], (DEPTH, N_EXPERTS, 2 * D_EXPERT), 0.01),
        'w_exp2': nrm(ks[22], (DEPTH, N_EXPERTS, D_EXPERT, D_MODEL), D_EXPERT ** -0.5 * DN_BETA),
        'b_exp2': nrm(ks[23], (DEPTH, N_EXPERTS, D_MODEL), 0.01),
    }


def reference(x, c, ctx, c_ctx, w_ada, b_ada, w_in, conv_w, gdn_a_log, gdn_dt_bias, gdn_norm_w,
              diff_lambda, diff_norm_w, na_rpb, w_branch, w_out, ln_g, ln_b, w_router, b_router,
              w_exp1, b_exp1, w_exp2, b_exp2):
    b, S, D = x.shape
    Lc = ctx.shape[1]
    cos, sin = _axial_rope(S, x.dtype)
    for l in range(DEPTH):
        last = l == DEPTH - 1
        lam_init = 0.8 - 0.6 * math.exp(-0.3 * l)
        mod_x = (jax.nn.silu(c) @ w_ada[l] + b_ada[l])[:, None, :]
        mod_c = jax.nn.silu(c_ctx) @ w_ada[l] + b_ada[l]
        sh1, sc1, g1, sh2, sc2, g2 = jnp.split(mod_x, 6, axis=-1)
        csh1, csc1, cg1, csh2, csc2, cg2 = jnp.split(mod_c, 6, axis=-1)
        hx = _modulate(x, sh1, sc1)
        hc = _modulate(ctx, csh1, csc1)
        mx, mc = _token_mixer(hx, hc, w_in[l], conv_w[l], gdn_a_log[l], gdn_dt_bias[l], gdn_norm_w[l],
                              diff_lambda[l], lam_init, diff_norm_w[l], na_rpb[l], w_branch[l], w_out[l],
                              cos, sin, not last)
        x = _post_norm(x, g1 * mx, ln_g[l, 0], ln_b[l, 0])
        hx = _modulate(x, sh2, sc2)
        if last:
            fx = _moe(hx.reshape(-1, D), w_router[l], b_router[l], w_exp1[l], b_exp1[l],
                      w_exp2[l], b_exp2[l]).reshape(b, S, D)
        else:
            ctx = _post_norm(ctx, cg1 * mc, ln_g[l, 0], ln_b[l, 0])
            hc = _modulate(ctx, csh2, csc2)
            f = _moe(jnp.concatenate([hx.reshape(-1, D), hc.reshape(-1, D)], 0), w_router[l], b_router[l],
                     w_exp1[l], b_exp1[l], w_exp2[l], b_exp2[l])
            fx = f[:b * S].reshape(b, S, D)
            ctx = _post_norm(ctx, cg2 * f[b * S:].reshape(b, Lc, D), ln_g[l, 1], ln_b[l, 1])
        x = _post_norm(x, g2 * fx, ln_g[l, 1], ln_b[l, 1])
    return x
```

```cpp
#include <hip/hip_runtime.h>
#include <cstdio>
#include <cstdint>
#include <cmath>

#define GAS __attribute__((address_space(1)))
#define LAS __attribute__((address_space(3)))
typedef unsigned short bf16;
typedef float f32x4 __attribute__((ext_vector_type(4)));
typedef float f32x2 __attribute__((ext_vector_type(2)));
typedef unsigned u32x4 __attribute__((ext_vector_type(4)));
typedef unsigned u32x2 __attribute__((ext_vector_type(2)));
typedef short bf16x8 __attribute__((ext_vector_type(8)));

namespace pg8 {
#define PG8_LAS __attribute__((address_space(3)))
constexpr int BM = 256, BK = 64, HALF = 128, HTB = HALF * BK * 2, STAGE_BYTES = 8 * HTB, NXCD = 8, WGM = 8;
__host__ __device__ __forceinline__ int lds_byte(int r, int c) { const int st = (r >> 4) * 2 + (c >> 5), rr = r & 15, cc = c & 31, ob = rr * 64 + cc * 2; return st * 1024 + (ob ^ (((ob >> 9) & 1) << 5)); }
__host__ __device__ __forceinline__ void stage_rc(int b, int& R, int& C) { const int st = b / 1024, sb = b % 1024, swz = sb ^ (((sb >> 9) & 1) << 5); R = (st >> 1) * 16 + swz / 64; C = (st & 1) * 32 + (swz % 64) / 2; }
__host__ __device__ __forceinline__ int perm32(int rho) { const int n = rho >> 4, i = rho & 15; return 8 * (i >> 2) + 4 * n + (i & 3); }

struct Unit { int pm, pn, aux; unsigned aoff, boff; };

__device__ __forceinline__ unsigned cvt_pk_bf16(float lo, float hi) { unsigned r; asm volatile("v_cvt_pk_bf16_f32 %0, %1, %2" : "=v"(r) : "v"(lo), "v"(hi)); return r; }

template <class Epi, class Sched, bool ALIGN_EPI = true, bool SP2 = true>
__device__ __forceinline__ void gemm_phase(PG8_LAS unsigned char* lds, const int K, const char* Abase, const char* Bbase, const Sched& S, const Epi& E, const int wv) {
    int lane_; asm volatile("v_mbcnt_lo_u32_b32 %0, -1, 0\n\tv_mbcnt_hi_u32_b32 %0, -1, %0" : "=v"(lane_));
    const int wid = wv, lane = lane_, tid = wv * 64 + lane_, wr = wid >> 2, wc = wid & 3, fr = lane & 15, fq = lane >> 4;
    const int nt = K / BK;
    unsigned voffA[2], voffB[2];
#pragma unroll
    for (int i = 0; i < 2; ++i) { int R, C; stage_rc(tid * 16 + i * 8192, R, C); const int Rb = ((R & ~31) + perm32(R & 31));
        voffA[i] = (unsigned)(R * K + C) * 2u; voffB[i] = (unsigned)(Rb * K + C) * 2u; }
    const size_t kstep = (size_t)(BK * 2);
    const size_t hstep = (size_t)HALF * K * 2;
    const unsigned ldsw = (unsigned)wid * 1024u;
    const int aoff = lds_byte(wr * 64 + fr, fq * 8), boff = lds_byte(wc * 32 + fr, fq * 8);
#define PG8_SA(b, h) (((b) * 2 + (h)) * HTB)
#define PG8_SB(b, h) ((4 + (b) * 2 + (h)) * HTB)
#define PG8_STAGE(bufoff, gbase, voff) do { _Pragma("unroll") for (int _i = 0; _i < 2; ++_i) \
        __builtin_amdgcn_global_load_lds((const GAS unsigned*)((const char*)(gbase) + (voff)[_i]), (PG8_LAS unsigned*)(lds + (bufoff) + ldsw + _i * 8192), 16, 0, 0); } while (0)
#define PG8_LDA(dst, b, h) do { _Pragma("unroll") for (int m = 0; m < 4; ++m) _Pragma("unroll") for (int k = 0; k < 2; ++k) dst[m][k] = *(const PG8_LAS bf16x8*)(lds + PG8_SA(b, h) + aoff + m * 2048 + k * 1024); } while (0)
#define PG8_LDB(dst, b, h) do { _Pragma("unroll") for (int n = 0; n < 2; ++n) _Pragma("unroll") for (int k = 0; k < 2; ++k) dst[n][k] = *(const PG8_LAS bf16x8*)(lds + PG8_SB(b, h) + boff + n * 2048 + k * 1024); } while (0)
#define PG8_MMA(ai, bj, At, Bt) do { __builtin_amdgcn_s_setprio(1); _Pragma("unroll") for (int m = 0; m < 4; ++m) _Pragma("unroll") for (int n = 0; n < 2; ++n) _Pragma("unroll") for (int k = 0; k < 2; ++k) \
        acc[ai][bj][m][n] = __builtin_amdgcn_mfma_f32_16x16x32_bf16(Bt[n][k], At[m][k], acc[ai][bj][m][n], 0, 0, 0); __builtin_amdgcn_s_setprio(0); } while (0)
#define PG8_WAIT_V(n) asm volatile("s_waitcnt vmcnt(" #n ")" ::: "memory")
#define PG8_WAIT_L(n) asm volatile("s_waitcnt lgkmcnt(" #n ")" ::: "memory")
#define PG8_BAR __builtin_amdgcn_s_barrier()
#define PG8_SCHED __builtin_amdgcn_sched_barrier(0)
    Unit cur, nxt; int ui = 0;
    if (!S.next(0, cur)) return;
    f32x4 acc[2][2][4][2];
#pragma unroll
    for (int a = 0; a < 2; ++a)
#pragma unroll
        for (int b = 0; b < 2; ++b)
#pragma unroll
            for (int m = 0; m < 4; ++m)
#pragma unroll
                for (int n = 0; n < 2; ++n) acc[a][b][m][n] = (f32x4){0.f, 0.f, 0.f, 0.f};
    bf16x8 At[4][2], B0[2][2], B1[2][2];
    const char* cA = Abase + cur.aoff; const char* cB = Bbase + cur.boff;
    if constexpr (SP2) {
        PG8_STAGE(PG8_SB(0, 0), cB, voffB); PG8_STAGE(PG8_SB(0, 1), cB + hstep, voffB); PG8_STAGE(PG8_SA(0, 0), cA, voffA); PG8_STAGE(PG8_SA(0, 1), cA + hstep, voffA);
        if (wr == 1) PG8_BAR;
        PG8_WAIT_V(2); PG8_BAR;
        PG8_STAGE(PG8_SB(1, 0), cB + kstep, voffB); PG8_STAGE(PG8_SA(1, 0), cA + kstep, voffA); PG8_STAGE(PG8_SB(1, 1), cB + hstep + kstep, voffB);
        PG8_WAIT_V(6); PG8_BAR;
    } else {
        PG8_STAGE(PG8_SB(0, 0), cB, voffB); PG8_STAGE(PG8_SA(0, 0), cA, voffA); PG8_STAGE(PG8_SB(0, 1), cB + hstep, voffB); PG8_STAGE(PG8_SA(0, 1), cA + hstep, voffA);
        if (wr == 1) PG8_BAR;
        PG8_WAIT_V(4); PG8_BAR;
        PG8_STAGE(PG8_SB(1, 0), cB + kstep, voffB); PG8_STAGE(PG8_SA(1, 0), cA + kstep, voffA); PG8_STAGE(PG8_SB(1, 1), cB + hstep + kstep, voffB);
        PG8_WAIT_V(6); PG8_BAR;
    }
    for (;;) {
        const bool has_next = S.next(ui + 1, nxt);
        const char* nA = has_next ? Abase + nxt.aoff : cA; const char* nB = has_next ? Bbase + nxt.boff : cB;
        for (int t = 0; t < nt; t += 2) {
            const bool last = (t == nt - 2);
            const char* a1 = cA + (size_t)(t + 1) * kstep;
            const char* a2 = last ? nA : cA + (size_t)(t + 2) * kstep; const char* b2 = last ? nB : cB + (size_t)(t + 2) * kstep;
            const char* a3 = a2 + kstep; const char* b3 = b2 + kstep;
            if constexpr (SP2) {
            PG8_LDB(B0, 0, 0); PG8_LDB(B1, 0, 1); PG8_SCHED; PG8_LDA(At, 0, 0); PG8_STAGE(PG8_SA(1, 1), a1 + hstep, voffA);
            PG8_WAIT_V(8); PG8_WAIT_L(0); PG8_BAR; PG8_MMA(0, 0, At, B0); PG8_MMA(0, 1, At, B1); PG8_BAR; PG8_SCHED;
            PG8_LDA(At, 0, 1); PG8_STAGE(PG8_SB(0, 0), b2, voffB); PG8_STAGE(PG8_SB(0, 1), b2 + hstep, voffB); PG8_STAGE(PG8_SA(0, 0), a2, voffA);
            PG8_WAIT_V(8); PG8_WAIT_L(0); PG8_BAR; PG8_MMA(1, 0, At, B0); PG8_MMA(1, 1, At, B1); PG8_BAR; PG8_SCHED;
            PG8_LDB(B0, 1, 0); PG8_LDB(B1, 1, 1); PG8_SCHED; PG8_LDA(At, 1, 0); PG8_STAGE(PG8_SA(0, 1), a2 + hstep, voffA);
            PG8_WAIT_V(8); PG8_WAIT_L(0); PG8_BAR; PG8_MMA(0, 0, At, B0); PG8_MMA(0, 1, At, B1); PG8_BAR; PG8_SCHED;
            PG8_LDA(At, 1, 1); PG8_STAGE(PG8_SB(1, 0), b3, voffB); PG8_STAGE(PG8_SB(1, 1), b3 + hstep, voffB); PG8_STAGE(PG8_SA(1, 0), a3, voffA);
            PG8_WAIT_V(8); PG8_WAIT_L(0); PG8_BAR; PG8_MMA(1, 0, At, B0); PG8_MMA(1, 1, At, B1); PG8_BAR; PG8_SCHED;
            } else {
            PG8_LDB(B0, 0, 0); PG8_SCHED; PG8_LDA(At, 0, 0); PG8_STAGE(PG8_SA(1, 1), a1 + hstep, voffA);
            PG8_WAIT_L(8); PG8_BAR; PG8_WAIT_L(0); PG8_MMA(0, 0, At, B0); PG8_BAR; PG8_SCHED;
            PG8_LDB(B1, 0, 1); PG8_STAGE(PG8_SB(0, 0), b2, voffB);
            PG8_BAR; PG8_WAIT_L(0); PG8_MMA(0, 1, At, B1); PG8_BAR;
            PG8_LDA(At, 0, 1); PG8_STAGE(PG8_SA(0, 0), a2, voffA);
            PG8_BAR; PG8_WAIT_L(0); PG8_MMA(1, 0, At, B0); PG8_BAR; PG8_SCHED;
            PG8_STAGE(PG8_SB(0, 1), b2 + hstep, voffB);
            PG8_WAIT_V(6); PG8_BAR; PG8_MMA(1, 1, At, B1); PG8_BAR;
            PG8_LDB(B0, 1, 0); PG8_SCHED; PG8_LDA(At, 1, 0); PG8_STAGE(PG8_SA(0, 1), a2 + hstep, voffA);
            PG8_WAIT_L(8); PG8_BAR; PG8_WAIT_L(0); PG8_MMA(0, 0, At, B0); PG8_BAR; PG8_SCHED;
            PG8_LDB(B1, 1, 1); PG8_STAGE(PG8_SB(1, 0), b3, voffB);
            PG8_BAR; PG8_WAIT_L(0); PG8_MMA(0, 1, At, B1); PG8_BAR;
            PG8_LDA(At, 1, 1); PG8_STAGE(PG8_SA(1, 0), a3, voffA);
            PG8_BAR; PG8_WAIT_L(0); PG8_MMA(1, 0, At, B0); PG8_BAR; PG8_SCHED;
            PG8_STAGE(PG8_SB(1, 1), b3 + hstep, voffB);
            PG8_WAIT_V(6); PG8_BAR; PG8_MMA(1, 1, At, B1); PG8_BAR;
            }
        }
        if constexpr (ALIGN_EPI) { if (wr == 0) PG8_BAR; }
        E(acc, cur, wr, wc, fr, fq);
        if (!has_next) break;
#pragma unroll
        for (int a = 0; a < 2; ++a)
#pragma unroll
            for (int b = 0; b < 2; ++b)
#pragma unroll
                for (int m = 0; m < 4; ++m)
#pragma unroll
                    for (int n = 0; n < 2; ++n) acc[a][b][m][n] = (f32x4){0.f, 0.f, 0.f, 0.f};
        cur = nxt; cA = nA; cB = nB; ++ui;
        if constexpr (ALIGN_EPI) { if (wr == 1) PG8_BAR; }
    }
    PG8_WAIT_V(0);
    if constexpr (!ALIGN_EPI) { if (wr == 0) PG8_BAR; }
    PG8_BAR;
#undef PG8_SA
#undef PG8_SB
#undef PG8_STAGE
#undef PG8_LDA
#undef PG8_LDB
#undef PG8_MMA
#undef PG8_WAIT_V
#undef PG8_WAIT_L
#undef PG8_BAR
#undef PG8_SCHED
}
}
constexpr int DM = 1024, BATCH = 2, SEQ = 8192, DEPTH = 4, CTXL = 256, GRIDW = 64;
constexpr int MLAT = BATCH * SEQ, MCTX = BATCH * CTXL, MT = MLAT + MCTX;
constexpr int NP = 8192;
constexpr int PC_GQ = 0, PC_GK = 512, PC_GV = 1024, PC_GZ = 1536, PC_DQ = 2048, PC_DK = 2560, PC_DV = 3072, PC_NQ = 3584, PC_NK = 4096, PC_NV = 4608, PC_GATE = 5120;
constexpr int D_IN = 8208, NEXP = 32, TOPK = 4, DEXP = 1024;
constexpr float LN_EPS = 1e-5f, RMS_EPS = 1e-6f;
constexpr float DN_ALPHA = 1.6817928305074292f;
constexpr int NWAVES = 8, NTHREADS = 512;
constexpr int RG_ROWS = 66, NRG = MT / RG_ROWS;
constexpr int RPAD = MT * TOPK + NEXP * 256;
constexpr int MAXTILES = RPAD / 256;

constexpr size_t MiB = 1u << 20;
constexpr size_t al256(size_t x) { return (x + 255) / 256 * 256; }
constexpr size_t WS_CTL = 0, CTL_ZERO_BYTES = 1 * MiB;
constexpr size_t WS_MOD = WS_CTL + CTL_ZERO_BYTES;
constexpr size_t WS_LAM = WS_MOD + al256((size_t)DEPTH * 3 * 6144 * 4);
constexpr size_t WS_WDEC = WS_LAM + 256;
constexpr size_t WS_WRT = WS_WDEC + (size_t)DEPTH * 16 * 1024 * 4;
constexpr size_t WS_WIN = WS_WRT + (size_t)DEPTH * 32 * 1024 * 4;
constexpr size_t WS_WBR = WS_WIN + (size_t)DEPTH * 8192 * 1024 * 2;
constexpr size_t WS_WOUT = WS_WBR + (size_t)DEPTH * 3 * 1024 * 512 * 2;
constexpr size_t WS_W1 = WS_WOUT + (size_t)DEPTH * 1024 * 1024 * 2;
constexpr size_t WS_W2 = WS_W1 + (size_t)DEPTH * 32 * 2048 * 1024 * 2;
constexpr size_t WS_X = WS_W2 + (size_t)DEPTH * 32 * 1024 * 1024 * 2;
constexpr size_t WS_HX = WS_X + (size_t)MT * DM * 4;
constexpr size_t WS_P = WS_HX + (size_t)MT * DM * 2;
constexpr size_t WS_DEC = WS_P + (size_t)MT * NP * 2;
constexpr size_t WS_QN = WS_DEC + (size_t)MT * 16 * 4;
constexpr size_t WS_KN = WS_QN + (size_t)MT * 512 * 4;
constexpr size_t WS_VV = WS_KN + (size_t)MT * 512 * 4;
constexpr size_t WS_OG = WS_VV + (size_t)MT * 512 * 4;
constexpr size_t WS_OD = WS_OG + (size_t)2 * MT * 512 * 4;
constexpr size_t WS_YA = WS_OD + (size_t)2 * MT * 512 * 4;
constexpr size_t WS_YB = WS_YA + (size_t)MT * 512 * 2;
constexpr size_t WS_YC = WS_YB + (size_t)MT * 512 * 2;
constexpr size_t WS_MACC = WS_YC + (size_t)MT * 512 * 2;
constexpr size_t WS_MBF = WS_MACC + (size_t)MT * DM * 4;
constexpr size_t WS_T = WS_MBF + (size_t)MT * DM * 2;
constexpr size_t WS_TOPE = WS_T + (size_t)MT * DM * 4;
constexpr size_t WS_TOPR = WS_TOPE + (size_t)MT * 4 * 4;
constexpr size_t WS_TOPG = WS_TOPR + (size_t)MT * 4 * 4;
constexpr size_t WS_SLOT = WS_TOPG + (size_t)MT * 4 * 4;
constexpr size_t WS_BLKB = WS_SLOT + (size_t)MT * 4 * 4;
constexpr size_t WS_HP = WS_BLKB + (size_t)NRG * 32 * 4;
constexpr size_t WS_ACT = WS_HP + (size_t)RPAD * 1024 * 2;
constexpr size_t WS_Y = WS_ACT + (size_t)RPAD * 1024 * 2;
constexpr size_t WS_END = WS_Y + (size_t)RPAD * 1024 * 2;
constexpr int CW_BAR = 4096;
constexpr int CW_CNT = 16384;
constexpr int CW_Q = 20480;

constexpr int RING_BYTES = 131072;
constexpr int LDSCTL_OFF = RING_BYTES, MISC_OFF = LDSCTL_OFF + 2048;
constexpr int LDS_BYTES = 147456;

#define RLX_AGENT __ATOMIC_RELAXED, __HIP_MEMORY_SCOPE_AGENT
#define LDS_WAIT() asm volatile("s_waitcnt lgkmcnt(0)" ::: "memory")
#define VM_WAIT() asm volatile("s_waitcnt vmcnt(0)" ::: "memory")
__device__ __forceinline__ float bf2f(unsigned b) { return __uint_as_float(b << 16); }
__device__ __forceinline__ float bflo(unsigned w) { return __uint_as_float(w << 16); }
__device__ __forceinline__ float bfhi(unsigned w) { return __uint_as_float(w & 0xffff0000u); }
__device__ __forceinline__ unsigned f2bf(float f) { unsigned u = __float_as_uint(f); return (u + 0x7fffu + ((u >> 16) & 1u)) >> 16; }
__device__ __forceinline__ unsigned pk2(float lo, float hi) { return pg8::cvt_pk_bf16(lo, hi); }
__device__ __forceinline__ float siluf(float x) { return x / (1.f + __expf(-x)); }
__device__ __forceinline__ float sigmf(float x) { return 1.f / (1.f + __expf(-x)); }

#define XB_TMO      128
#define XB_XCNT(j)  (256  + 64 * (j))
#define XB_XSUB(j)  (1280 + 64 * (j))
#define XB_XGEN(j)  (2304 + 64 * (j))
#define XB_TOP      3328
#define XB_TOPGEN   3392
#define XCD_BAR_WORDS 3456
#define XB_SPIN_CAP (1u << 22)
__device__ __forceinline__ unsigned xb_ld(unsigned* p)              { return __hip_atomic_load(p, __ATOMIC_RELAXED, __HIP_MEMORY_SCOPE_AGENT); }
__device__ __forceinline__ unsigned xb_add(unsigned* p, unsigned v) { return __hip_atomic_fetch_add(p, v, __ATOMIC_RELAXED, __HIP_MEMORY_SCOPE_AGENT); }
__device__ __forceinline__ unsigned xb_xcc_id() { return (unsigned)__builtin_amdgcn_s_getreg((3 << 11) | 20) & 0xFu; }
#define XB_SPIN(cond, bar) do { unsigned _sp = 0; while (cond) { __builtin_amdgcn_s_sleep(1); \
    if ((++_sp & 255u) == 0u) { if (xb_ld(&(bar)[XB_TMO])) break; if (_sp > XB_SPIN_CAP) { atomicAdd(&(bar)[XB_TMO], 1u); break; } } } } while (0)
struct XcdBarrier { unsigned* bar; unsigned x; volatile LAS unsigned* st; };
__device__ __forceinline__ XcdBarrier xcd_barrier_post(unsigned* bar, volatile LAS unsigned* st) {
    XcdBarrier b; b.bar = bar; b.x = xb_xcc_id(); b.st = st;
    if (threadIdx.x == 0) (void)xb_add(&bar[XB_XCNT(b.x)], 1u);
    return b;
}
__device__ __forceinline__ void xcd_barrier_complete(unsigned* bar, unsigned x, unsigned& nloc, unsigned& nx) {
    const unsigned G = gridDim.x * gridDim.y * gridDim.z;
    unsigned sum, cnt, mine, sp = 0u;
    for (;;) {
        sum = 0u; cnt = 0u; mine = 0u;
#pragma unroll
        for (unsigned j = 0; j < 16; ++j) { const unsigned c = xb_ld(&bar[XB_XCNT(j)]); sum += c; cnt += (c > 0u) ? 1u : 0u; mine = (j == x) ? c : mine; }
        if (sum == G) break;
        __builtin_amdgcn_s_sleep(1);
        if ((++sp & 255u) == 0u) { if (xb_ld(&bar[XB_TMO])) break; if (sp > XB_SPIN_CAP) { atomicAdd(&bar[XB_TMO], 1u); break; } }
    }
    nloc = mine > 0u ? mine : 1u; nx = cnt > 0u ? cnt : 1u;
}
__device__ __forceinline__ void xcd_barrier(const XcdBarrier& b) {
#ifdef BAR_BRUTE
    __builtin_amdgcn_fence(__ATOMIC_RELEASE, "agent");
#endif
    asm volatile("s_waitcnt vmcnt(0)" ::: "memory");
    __syncthreads();
    if (threadIdx.x == 0) {
        unsigned* bar = b.bar;
        __builtin_amdgcn_s_waitcnt(0);
        unsigned nloc = b.st[0], nx = b.st[1];
        if (nloc == 0u) { xcd_barrier_complete(bar, b.x, nloc, nx); b.st[0] = nloc; b.st[1] = nx; }
        const unsigned old = xb_add(&bar[XB_XSUB(b.x)], 1u);
        const unsigned gen = old / nloc;
        if (old + 1u == (gen + 1u) * nloc) {
            __builtin_amdgcn_fence(__ATOMIC_RELEASE, "agent");
            asm volatile("s_waitcnt vmcnt(0)" ::: "memory");
            const unsigned og = xb_add(&bar[XB_TOP], 1u);
            const unsigned tg = og / nx;
            if (og + 1u == (tg + 1u) * nx) xb_add(&bar[XB_TOPGEN], 1u);
            else XB_SPIN(xb_ld(&bar[XB_TOPGEN]) == tg, bar);
            __builtin_amdgcn_fence(__ATOMIC_ACQUIRE, "agent");
            xb_add(&bar[XB_XGEN(b.x)], 1u);
            asm volatile("s_waitcnt vmcnt(0)" ::: "memory");
        } else {
            XB_SPIN(xb_ld(&bar[XB_XGEN(b.x)]) == gen, bar);
            __builtin_amdgcn_fence(__ATOMIC_ACQUIRE, "agent");
            asm volatile("s_waitcnt vmcnt(0)" ::: "memory");
        }
    }
    __syncthreads();
#ifdef BAR_BRUTE
    __builtin_amdgcn_fence(__ATOMIC_ACQUIRE, "agent");
    asm volatile("s_waitcnt vmcnt(0)" ::: "memory");
    __syncthreads();
#endif
}

struct Args { const float* in[24]; float* out; unsigned char* ws; int ph_lo, ph_hi; };
enum { I_X = 0, I_C, I_CTX, I_CCTX, I_WADA, I_BADA, I_WIN, I_CONVW, I_ALOG, I_DTB, I_GNW, I_DLAM, I_DNW, I_RPB, I_WBR, I_WOUT, I_LNG, I_LNB, I_WR, I_BR, I_W1, I_B1, I_W2, I_B2 };
struct Frame {
    LAS unsigned char* lds;
    unsigned* ctl;
    unsigned char* ws;
    int tid, lane, wave, G, bid, wv;
};
#define REFRESH(F) do { int l_; asm volatile("v_mbcnt_lo_u32_b32 %0, -1, 0\n\tv_mbcnt_hi_u32_b32 %0, -1, %0" : "=v"(l_)); (F).lane = l_; (F).wave = (F).wv; (F).tid = (F).wv * 64 + l_; } while (0)
__device__ __forceinline__ float wave_sum(float v) {
#pragma unroll
    for (int o = 1; o < 64; o <<= 1) v += __shfl_xor(v, o);
    return v;
}
__device__ __forceinline__ float wave_max(float v) {
#pragma unroll
    for (int o = 1; o < 64; o <<= 1) v = fmaxf(v, __shfl_xor(v, o));
    return v;
}
__device__ __forceinline__ int mod_index(int row) { return row < MLAT ? (row >> 13) : 2; }
static_assert(WS_YB == WS_YA + (size_t)MT * 512 * 2 && WS_YC == WS_YB + (size_t)MT * 512 * 2, "YA|YB|YC contiguous");
__device__ __forceinline__ void transpose_item(const float* W, int ldw, int K, int src_col0, bf16* WT, int dst_row0, int k0, LAS float* scr, int lane) {
#pragma unroll 8
    for (int i = 0; i < 32; ++i) { const int kk = 2 * i + (lane >> 5); scr[kk * 33 + (lane & 31)] = W[(size_t)(k0 + kk) * ldw + src_col0 + (lane & 31)]; }
    LDS_WAIT(); asm volatile("" ::: "memory");
    const int c = lane & 7;
#pragma unroll
    for (int j = 0; j < 4; ++j) { const int n = (lane >> 3) + 8 * j; const LAS float* s = scr + (8 * c) * 33 + n;
        u32x4 o; o.x = pk2(s[0 * 33], s[1 * 33]); o.y = pk2(s[2 * 33], s[3 * 33]); o.z = pk2(s[4 * 33], s[5 * 33]); o.w = pk2(s[6 * 33], s[7 * 33]);
        *(u32x4*)(WT + (size_t)(dst_row0 + n) * K + k0 + 8 * c) = o; }
    LDS_WAIT(); asm volatile("" ::: "memory");
}
constexpr int IT_WIN = DEPTH * 16 * 256, IT_WBR = DEPTH * 3 * 8 * 32, IT_WOUT = DEPTH * 16 * 32, IT_W1 = DEPTH * 32 * 16 * 64, IT_W2 = DEPTH * 32 * 16 * 32;
constexpr int IT_ALL = IT_WIN + IT_WBR + IT_WOUT + IT_W1 + IT_W2;

__device__ __forceinline__ void p0_prologue(Frame& F, const Args& a) {
    REFRESH(F);
    unsigned char* ws = F.ws;
    LAS float* scr = (LAS float*)(F.lds + F.wave * 16384);
    const int gw = F.bid * NWAVES + F.wave, NGW = F.G * NWAVES;
    for (int it = gw; it < IT_ALL; it += NGW) {
        int r = it;
        if (r < IT_WIN) { const int l = r / 4096, q = r % 4096, kb = q / 256, nb = q % 256, d0 = 32 * nb, s0 = d0 + (d0 >= 2048 ? 16 : 0);
            transpose_item(a.in[I_WIN] + (size_t)l * 1024 * D_IN, D_IN, 1024, s0, (bf16*)(ws + WS_WIN) + (size_t)l * 8192 * 1024, d0, 64 * kb, scr, F.lane); continue; }
        r -= IT_WIN;
        if (r < IT_WBR) { const int mi = r / 256, q = r % 256, kb = q / 32, nb = q % 32;
            transpose_item(a.in[I_WBR] + (size_t)mi * 512 * 1024, 1024, 512, 32 * nb, (bf16*)(ws + WS_WBR) + (size_t)mi * 1024 * 512, 32 * nb, 64 * kb, scr, F.lane); continue; }
        r -= IT_WBR;
        if (r < IT_WOUT) { const int l = r / 512, q = r % 512, kb = q / 32, nb = q % 32;
            transpose_item(a.in[I_WOUT] + (size_t)l * 1024 * 1024, 1024, 1024, 32 * nb, (bf16*)(ws + WS_WOUT) + (size_t)l * 1024 * 1024, 32 * nb, 64 * kb, scr, F.lane); continue; }
        r -= IT_WOUT;
        if (r < IT_W1) { const int mi = r / 1024, q = r % 1024, kb = q / 64, nb = q % 64, d0 = 32 * nb, pn = d0 >> 8, bj = (d0 >> 7) & 1, j = d0 & 127, s0 = 1024 * bj + 128 * pn + j;
            transpose_item(a.in[I_W1] + (size_t)mi * 1024 * 2048, 2048, 1024, s0, (bf16*)(ws + WS_W1) + (size_t)mi * 2048 * 1024, d0, 64 * kb, scr, F.lane); continue; }
        r -= IT_W1;
        { const int mi = r / 512, q = r % 512, kb = q / 32, nb = q % 32;
            transpose_item(a.in[I_W2] + (size_t)mi * 1024 * 1024, 1024, 1024, 32 * nb, (bf16*)(ws + WS_W2) + (size_t)mi * 1024 * 1024, 32 * nb, 64 * kb, scr, F.lane); }
    }
    const size_t gt = (size_t)F.bid * NTHREADS + F.tid, NGT = (size_t)F.G * NTHREADS;
    { float* wd = (float*)(ws + WS_WDEC);
      for (size_t i = gt; i < (size_t)DEPTH * 16 * 1024; i += NGT) { const int l = (int)(i >> 14), c = (int)(i >> 10) & 15, k = (int)i & 1023; wd[i] = a.in[I_WIN][((size_t)l * 1024 + k) * D_IN + 2048 + c]; }
      float* wr = (float*)(ws + WS_WRT);
      for (size_t i = gt; i < (size_t)DEPTH * 32 * 1024; i += NGT) { const int l = (int)(i >> 15), e = (int)(i >> 10) & 31, k = (int)i & 1023; wr[i] = a.in[I_WR][((size_t)l * 1024 + k) * 32 + e]; } }
    { f32x4* X4 = (f32x4*)(ws + WS_X); const f32x4* x4 = (const f32x4*)a.in[I_X]; const f32x4* c4 = (const f32x4*)a.in[I_CTX];
      for (size_t i = gt; i < (size_t)MT * 256; i += NGT) X4[i] = i < (size_t)MLAT * 256 ? x4[i] : c4[i - (size_t)MLAT * 256]; }
    if (F.bid == 0 && F.wave < DEPTH) { const int l = F.wave; const float* lv = a.in[I_DLAM] + l * 256;
        const float s1 = wave_sum(lv[F.lane] * lv[64 + F.lane]), s2 = wave_sum(lv[128 + F.lane] * lv[192 + F.lane]);
        if (F.lane == 0) ((float*)(ws + WS_LAM))[l] = expf(s1) - expf(s2) + (0.8f - 0.6f * expf(-0.3f * (float)l)); }
    { LAS float* red = (LAS float*)(F.lds);
      float* MOD = (float*)(ws + WS_MOD);
      __syncthreads();
      for (int it = F.bid; it < DEPTH * 96; it += F.G) {
        const int l = it / 96, n = (it % 96) * 64 + F.lane; const float* wa = a.in[I_WADA] + (size_t)l * 1024 * 6144 + n;
        float a0 = 0.f, a1 = 0.f, a2 = 0.f;
        for (int k = F.wave * 128; k < F.wave * 128 + 128; ++k) { const float w = wa[(size_t)k * 6144];
            a0 += siluf(a.in[I_C][k]) * w; a1 += siluf(a.in[I_C][1024 + k]) * w; a2 += siluf(a.in[I_CCTX][k]) * w; }
        red[(F.wave * 3 + 0) * 64 + F.lane] = a0; red[(F.wave * 3 + 1) * 64 + F.lane] = a1; red[(F.wave * 3 + 2) * 64 + F.lane] = a2;
        __syncthreads();
        if (F.tid < 192) { const int i = F.tid >> 6, c = F.tid & 63; float s = 0.f;
#pragma unroll
            for (int w = 0; w < 8; ++w) s += red[(w * 3 + i) * 64 + c];
            const int nn = (it % 96) * 64 + c; MOD[((size_t)l * 3 + i) * 6144 + nn] = s + a.in[I_BADA][l * 6144 + nn]; }
        __syncthreads();
      } }
}

__device__ __forceinline__ void ln_inplace(f32x4 (&v)[4]) {
    float s = 0.f;
#pragma unroll
    for (int j = 0; j < 4; ++j) s += (v[j].x + v[j].y) + (v[j].z + v[j].w);
    const float mean = wave_sum(s) * (1.f / DM); float s2 = 0.f;
#pragma unroll
    for (int j = 0; j < 4; ++j) { v[j] = v[j] - mean; s2 += (v[j].x * v[j].x + v[j].y * v[j].y) + (v[j].z * v[j].z + v[j].w * v[j].w); }
    const float rstd = 1.f / sqrtf(wave_sum(s2) * (1.f / DM) + LN_EPS);
#pragma unroll
    for (int j = 0; j < 4; ++j) v[j] = v[j] * rstd;
}
__device__ __forceinline__ void modulate_store(const Frame& F, int l, int which, int row, f32x4 (&v)[4]) {
    ln_inplace(v);
    const float* mod = (const float*)(F.ws + WS_MOD) + ((size_t)l * 3 + mod_index(row)) * 6144 + which * 3072;
    bf16* hx = (bf16*)(F.ws + WS_HX) + (size_t)row * DM;
#pragma unroll
    for (int j = 0; j < 4; ++j) { const int c = 4 * F.lane + 256 * j; const f32x4 sh = *(const f32x4*)(mod + c), sc = *(const f32x4*)(mod + 1024 + c);
        v[j] = v[j] * (sc + 1.f) + sh;
        u32x2 o; o.x = pk2(v[j].x, v[j].y); o.y = pk2(v[j].z, v[j].w); *(u32x2*)(hx + c) = o; }
}
__device__ __forceinline__ void decay_cols(const Frame& F, int l, int row, const f32x4 (&h)[4]) {
    const float* wd = (const float*)(F.ws + WS_WDEC) + (size_t)l * 16 * 1024; float* dec = (float*)(F.ws + WS_DEC) + (size_t)row * 16;
    float mine = 0.f;
#pragma unroll
    for (int i = 0; i < 16; ++i) { float s = 0.f;
#pragma unroll
        for (int j = 0; j < 4; ++j) { const f32x4 w = *(const f32x4*)(wd + i * 1024 + 4 * F.lane + 256 * j); s += (h[j].x * w.x + h[j].y * w.y) + (h[j].z * w.z + h[j].w * w.w); }
        s = wave_sum(s); if (F.lane == i) mine = s; }
    if (F.lane < 16) dec[F.lane] = mine;
}
__device__ __forceinline__ void ph_lnmod0(Frame& F) {
    REFRESH(F);
    const int gw = F.bid * NWAVES + F.wave, NGW = F.G * NWAVES;
    for (int row = gw; row < MT; row += NGW) { f32x4 v[4]; const f32x4* xr = (const f32x4*)(F.ws + WS_X) + (size_t)row * 256 + F.lane;
#pragma unroll
        for (int j = 0; j < 4; ++j) v[j] = xr[64 * j];
        modulate_store(F, 0, 0, row, v); decay_cols(F, 0, row, v); }
}

struct TileMap {
    __device__ static __forceinline__ bool map(int i, int G, int c, int nM, int nN, int& pm, int& pn) {
        const int nwg = nM * nN; const long L = (long)i * G + c; if (L >= nwg) return false;
        int wgid = (int)L; { const int q = nwg / 8, r = nwg % 8, xcd = wgid % 8, off = wgid / 8; wgid = (xcd < r ? xcd * (q + 1) : r * (q + 1) + (xcd - r) * q) + off; }
        const int nig = 8 * nN, gid = wgid / nig, fm = gid * 8, gsz = (nM - fm) < 8 ? (nM - fm) : 8;
        pm = fm + ((wgid % nig) % gsz); pn = (wgid % nig) / gsz; return true; }
};
struct StaticOrder { int nM, nN, G, c, K;
    __device__ __forceinline__ bool next(int i, pg8::Unit& u) const { if (!TileMap::map(i, G, c, nM, nN, u.pm, u.pn)) return false; u.aux = 0;
        u.aoff = (unsigned)u.pm * 256u * (unsigned)K * 2u; u.boff = (unsigned)u.pn * 256u * (unsigned)K * 2u; return true; } };
struct MergeOrder { int G, c;
    __device__ __forceinline__ bool next(int i, pg8::Unit& u) const { const int br = i % 3; if (!TileMap::map(i / 3, G, c, MT / 256, 4, u.pm, u.pn)) return false; u.aux = br;
        u.aoff = (unsigned)br * (unsigned)(MT * 512 * 2) + (unsigned)u.pm * (256u * 512u * 2u); u.boff = ((unsigned)br * 1024u + (unsigned)u.pn * 256u) * (512u * 2u); return true; } };
struct MoeOrder { const volatile LAS int* tab;
    __device__ __forceinline__ bool next(int i, pg8::Unit& u) const { const int w = tab[416 + i]; if (w < 0) return false; u.pm = w & 0xfff; u.pn = (w >> 12) & 0xf; u.aux = (w >> 16) & 0xff; const int nN = (w >> 24) & 0xf;
        u.aoff = (unsigned)u.pm * (256u * 1024u * 2u); u.boff = (unsigned)((u.aux * nN + u.pn) * 256) * (1024u * 2u); return true; } };

struct EpiWin { bf16* P;
    __device__ __forceinline__ void operator()(const f32x4 (&acc)[2][2][4][2], const pg8::Unit& u, int wr, int wc, int fr, int fq) const {
        const int row0 = u.pm * 256 + wr * 64 + fr, col0 = u.pn * 256 + wc * 32 + 8 * fq; const bool sg = u.pn >= 20;
#pragma unroll
        for (int ai = 0; ai < 2; ++ai)
#pragma unroll
            for (int m = 0; m < 4; ++m) { bf16* rowp = P + (size_t)(row0 + ai * 128 + m * 16) * NP + col0;
#pragma unroll
                for (int bj = 0; bj < 2; ++bj) { f32x4 v0 = acc[ai][bj][m][0], v1 = acc[ai][bj][m][1];
                    if (sg) {
#pragma unroll
                        for (int q = 0; q < 4; ++q) { v0[q] = sigmf(v0[q]); v1[q] = sigmf(v1[q]); } }
                    u32x4 w; w.x = pk2(v0[0], v0[1]); w.y = pk2(v0[2], v0[3]); w.z = pk2(v1[0], v1[1]); w.w = pk2(v1[2], v1[3]);
                    *(u32x4*)(rowp + bj * 128) = w; } }
    } };
struct EpiMerge { const bf16* P; float* MACC; bf16* MBF;
    __device__ __forceinline__ void operator()(const f32x4 (&acc)[2][2][4][2], const pg8::Unit& u, int wr, int wc, int fr, int fq) const {
        const int row0 = u.pm * 256 + wr * 64 + fr, col0 = u.pn * 256 + wc * 32 + 8 * fq, br = u.aux;
#pragma unroll
        for (int ai = 0; ai < 2; ++ai)
#pragma unroll
            for (int m = 0; m < 4; ++m) { const size_t row = (size_t)(row0 + ai * 128 + m * 16);
#pragma unroll
                for (int bj = 0; bj < 2; ++bj) { const int col = col0 + bj * 128;
                    const u32x4 g = *(const u32x4*)(P + row * NP + PC_GATE + 1024 * br + col);
                    f32x4 v0 = acc[ai][bj][m][0], v1 = acc[ai][bj][m][1];
                    v0[0] *= bflo(g.x); v0[1] *= bfhi(g.x); v0[2] *= bflo(g.y); v0[3] *= bfhi(g.y); v1[0] *= bflo(g.z); v1[1] *= bfhi(g.z); v1[2] *= bflo(g.w); v1[3] *= bfhi(g.w);
                    float* mp = MACC + row * DM + col;
                    if (br > 0) { v0 = v0 + *(const f32x4*)mp; v1 = v1 + *(const f32x4*)(mp + 4); }
                    if (br < 2) { *(f32x4*)mp = v0; *(f32x4*)(mp + 4) = v1; }
                    else { u32x4 w; w.x = pk2(v0[0], v0[1]); w.y = pk2(v0[2], v0[3]); w.z = pk2(v1[0], v1[1]); w.w = pk2(v1[2], v1[3]); *(u32x4*)(MBF + row * DM + col) = w; } } }
    } };
struct EpiWout { const float* X; const float* MODL; float* T;
    __device__ __forceinline__ void operator()(const f32x4 (&acc)[2][2][4][2], const pg8::Unit& u, int wr, int wc, int fr, int fq) const {
        const int row0 = u.pm * 256 + wr * 64 + fr, col0 = u.pn * 256 + wc * 32 + 8 * fq; const float* g1 = MODL + (size_t)(u.pm < 64 ? (u.pm >> 5) : 2) * 6144 + 2048;
#pragma unroll
        for (int bj = 0; bj < 2; ++bj) { const int col = col0 + bj * 128; const f32x4 ga = *(const f32x4*)(g1 + col), gb = *(const f32x4*)(g1 + col + 4);
#pragma unroll
            for (int ai = 0; ai < 2; ++ai)
#pragma unroll
                for (int m = 0; m < 4; ++m) { const size_t o = (size_t)(row0 + ai * 128 + m * 16) * DM + col;
                    const f32x4 xa = *(const f32x4*)(X + o), xb = *(const f32x4*)(X + o + 4);
                    *(f32x4*)(T + o) = xa * DN_ALPHA + ga * acc[ai][bj][m][0]; *(f32x4*)(T + o + 4) = xb * DN_ALPHA + gb * acc[ai][bj][m][1]; } }
    } };
struct EpiAct { const float* B1; bf16* ACT;
    __device__ __forceinline__ void operator()(const f32x4 (&acc)[2][2][4][2], const pg8::Unit& u, int wr, int wc, int fr, int fq) const {
        const int row0 = u.pm * 256 + wr * 64 + fr, cc = u.pn * 128 + wc * 32 + 8 * fq; const float* b = B1 + (size_t)u.aux * 2048;
        const f32x4 bg0 = *(const f32x4*)(b + cc), bg1 = *(const f32x4*)(b + cc + 4), bl0 = *(const f32x4*)(b + 1024 + cc), bl1 = *(const f32x4*)(b + 1024 + cc + 4);
#pragma unroll
        for (int ai = 0; ai < 2; ++ai)
#pragma unroll
            for (int m = 0; m < 4; ++m) { const size_t row = (size_t)(row0 + ai * 128 + m * 16);
                f32x4 g0 = acc[ai][0][m][0] + bg0, g1 = acc[ai][0][m][1] + bg1, l0 = acc[ai][1][m][0] + bl0, l1 = acc[ai][1][m][1] + bl1; float r[8];
#pragma unroll
                for (int q = 0; q < 4; ++q) { const float xg = fminf(g0[q], 7.f), xl = fminf(fmaxf(l0[q], -7.f), 7.f); r[q] = xg * sigmf(1.702f * xg) * (xl + 1.f);
                    const float yg = fminf(g1[q], 7.f), yl = fminf(fmaxf(l1[q], -7.f), 7.f); r[4 + q] = yg * sigmf(1.702f * yg) * (yl + 1.f); }
                u32x4 w; w.x = pk2(r[0], r[1]); w.y = pk2(r[2], r[3]); w.z = pk2(r[4], r[5]); w.w = pk2(r[6], r[7]);
                *(u32x4*)(ACT + row * 1024 + cc) = w; }
    } };
struct EpiY { const float* B2; bf16* Y;
    __device__ __forceinline__ void operator()(const f32x4 (&acc)[2][2][4][2], const pg8::Unit& u, int wr, int wc, int fr, int fq) const {
        const int row0 = u.pm * 256 + wr * 64 + fr, col0 = u.pn * 256 + wc * 32 + 8 * fq; const float* b = B2 + (size_t)u.aux * 1024;
#pragma unroll
        for (int bj = 0; bj < 2; ++bj) { const int col = col0 + bj * 128; const f32x4 ba = *(const f32x4*)(b + col), bb = *(const f32x4*)(b + col + 4);
#pragma unroll
            for (int ai = 0; ai < 2; ++ai)
#pragma unroll
                for (int m = 0; m < 4; ++m) { const size_t row = (size_t)(row0 + ai * 128 + m * 16); const f32x4 v0 = acc[ai][bj][m][0] + ba, v1 = acc[ai][bj][m][1] + bb;
                    u32x4 w; w.x = pk2(v0[0], v0[1]); w.y = pk2(v0[2], v0[3]); w.z = pk2(v1[0], v1[1]); w.w = pk2(v1[2], v1[3]); *(u32x4*)(Y + row * 1024 + col) = w; } }
    } };
__device__ __forceinline__ void ph_prep(Frame& F, const Args& a, int l) {
    REFRESH(F);
    const int gw = F.bid * NWAVES + F.wave, NGW = F.G * NWAVES;
    bf16* P = (bf16*)(F.ws + WS_P);
    for (int row = gw; row < MLAT; row += NGW) {
        const int t = row & (SEQ - 1), j = F.lane & 31, f = j & 15; const float pos = (float)(j < 16 ? (t >> 6) : (t & 63));
        const float inv = exp2f(-(float)f * (13.287712379549449f / 16.f));
        const float ang = pos * inv, rev = ang * 0.15915494309189535f, fr = rev - floorf(rev);
        const float cs = __builtin_amdgcn_cosf(fr), sn = __builtin_amdgcn_sinf(fr);
        bf16* pr = P + (size_t)row * NP + PC_DQ;
#pragma unroll
        for (int it = 0; it < 8; ++it) { const int blk = 2 * it + (F.lane >> 5); bf16* p = pr + blk * 64 + j;
            const float x1 = bf2f(p[0]), x2 = bf2f(p[32]); p[0] = (bf16)f2bf(x1 * cs - x2 * sn); p[32] = (bf16)f2bf(x2 * cs + x1 * sn); }
    }
    float* QN = (float*)(F.ws + WS_QN); float* KN = (float*)(F.ws + WS_KN); float* VV = (float*)(F.ws + WS_VV);
    const float* cw = a.in[I_CONVW] + (size_t)l * 3 * 1536;
    for (int row = gw; row < MT; row += NGW) {
        const bool lat = row < MLAT; const int t = lat ? (row & (SEQ - 1)) : ((row - MLAT) & (CTXL - 1)), L = lat ? SEQ : CTXL; const bool hm = t > 0, hp = t < L - 1;
        const bf16* p0 = P + (size_t)row * NP;
#pragma unroll
        for (int wh = 0; wh < 3; ++wh)
#pragma unroll
            for (int h = 0; h < 4; ++h) { const int c = wh * 512 + h * 128 + 2 * F.lane;
                const unsigned x0 = *(const unsigned*)(p0 + c), xm = hm ? *(const unsigned*)(p0 - NP + c) : 0u, xp = hp ? *(const unsigned*)(p0 + NP + c) : 0u;
                const f32x2 w0 = *(const f32x2*)(cw + c), w1 = *(const f32x2*)(cw + 1536 + c), w2 = *(const f32x2*)(cw + 3072 + c);
                float y0 = bflo(xm) * w0.x + bflo(x0) * w1.x + bflo(xp) * w2.x, y1 = bfhi(xm) * w0.y + bfhi(x0) * w1.y + bfhi(xp) * w2.y;
                y0 = siluf(y0); y1 = siluf(y1);
                if (wh < 2) { const float ss = wave_sum(y0 * y0 + y1 * y1), sc = (1.f / sqrtf(ss + RMS_EPS)) * (wh == 0 ? 0.08838834764831845f : 1.f); y0 *= sc; y1 *= sc; }
                float* o = (wh == 0 ? QN : wh == 1 ? KN : VV) + (size_t)row * 512 + h * 128 + 2 * F.lane; *(f32x2*)o = (f32x2){y0, y1}; }
    }
}

__device__ __forceinline__ void ph_gdn_chain_naive(Frame& F, const Args& a, int l) {
    REFRESH(F);
    LAS float* kq = (LAS float*)F.lds;
    const float* QN = (const float*)(F.ws + WS_QN); const float* KN = (const float*)(F.ws + WS_KN); const float* VV = (const float*)(F.ws + WS_VV);
    const float* DEC = (const float*)(F.ws + WS_DEC); float* OG = (float*)(F.ws + WS_OG);
    for (int it = F.bid; it < 16; it += F.G) {
        const int b = it >> 3, h = (it >> 1) & 3, d = it & 1, v = (F.tid >> 1) & 127, hf = F.tid & 1;
        const float al = expf(a.in[I_ALOG][(l * 2 + d) * 4 + h]), dtb = a.in[I_DTB][(l * 2 + d) * 4 + h];
        float S[64];
#pragma unroll
        for (int k = 0; k < 64; ++k) S[k] = 0.f;
        __syncthreads();
        for (int step = 0; step < CTXL + SEQ; ++step) {
            int row; if (step < CTXL) { const int pos = d ? CTXL - 1 - step : step; row = MLAT + b * CTXL + pos; } else { const int tt = step - CTXL, pos = d ? SEQ - 1 - tt : tt; row = b * SEQ + pos; }
            LAS float* buf = kq + (step & 1) * 256;
            if (F.tid >= 256) { if (F.tid < 384) buf[F.tid - 256] = KN[(size_t)row * 512 + h * 128 + F.tid - 256]; else buf[F.tid - 256] = QN[(size_t)row * 512 + h * 128 + F.tid - 384]; }
            __syncthreads();
            if (F.tid < 256) {
                const float av = DEC[(size_t)row * 16 + 8 * d + h] + dtb, bb = DEC[(size_t)row * 16 + 8 * d + 4 + h];
                const float sp = av > 20.f ? av : log1pf(expf(av)); const float eg = expf(-al * sp), beta = sigmf(bb);
                const float vt = VV[(size_t)row * 512 + h * 128 + v];
                const LAS float* kb = buf + 64 * hf; const LAS float* qb = buf + 128 + 64 * hf;
                float kS = 0.f;
#pragma unroll
                for (int k4 = 0; k4 < 16; ++k4) { const f32x4 kk = *(const LAS f32x4*)(kb + 4 * k4); kS += (kk.x * S[4 * k4] + kk.y * S[4 * k4 + 1]) + (kk.z * S[4 * k4 + 2] + kk.w * S[4 * k4 + 3]); }
                kS += __shfl_xor(kS, 1);
                const float vn = beta * (vt - eg * kS); float o = 0.f;
#pragma unroll
                for (int k4 = 0; k4 < 16; ++k4) { const f32x4 kk = *(const LAS f32x4*)(kb + 4 * k4), qq = *(const LAS f32x4*)(qb + 4 * k4);
                    S[4 * k4] = eg * S[4 * k4] + kk.x * vn; S[4 * k4 + 1] = eg * S[4 * k4 + 1] + kk.y * vn; S[4 * k4 + 2] = eg * S[4 * k4 + 2] + kk.z * vn; S[4 * k4 + 3] = eg * S[4 * k4 + 3] + kk.w * vn;
                    o += (qq.x * S[4 * k4] + qq.y * S[4 * k4 + 1]) + (qq.z * S[4 * k4 + 2] + qq.w * S[4 * k4 + 3]); }
                o += __shfl_xor(o, 1);
                if (hf == 0) OG[((size_t)d * MT + row) * 512 + h * 128 + v] = o;
            }
        }
        __syncthreads();
    }
}

__device__ __forceinline__ void ph_diff_naive(Frame& F, int l) {
    REFRESH(F);
    LAS float* Kf = (LAS float*)F.lds;
    LAS float* Vf = (LAS float*)(F.lds + 16384);
    const bf16* P = (const bf16*)(F.ws + WS_P); float* OD = (float*)(F.ws + WS_OD);
    for (int it = F.bid; it < 512 + 16; it += F.G) {
        int b, h, m, q0, t0, t1;
        if (it < 512) { b = it >> 8; h = (it >> 6) & 3; m = (it >> 5) & 1; q0 = b * SEQ + (it & 31) * 256; t0 = 0; t1 = 132; }
        else { const int j = it - 512; b = j >> 3; h = (j >> 1) & 3; m = j & 1; q0 = MLAT + b * CTXL; t0 = 128; t1 = 132; }
        const int qi = F.tid & 255, eh = F.tid >> 8;
        float q[64], o[64];
        { const bf16* qp = P + (size_t)(q0 + qi) * NP + PC_DQ + h * 128 + m * 64;
#pragma unroll
          for (int d8 = 0; d8 < 8; ++d8) { const u32x4 w = *(const u32x4*)(qp + 8 * d8); q[8 * d8] = bflo(w.x) * 0.125f; q[8 * d8 + 1] = bfhi(w.x) * 0.125f; q[8 * d8 + 2] = bflo(w.y) * 0.125f; q[8 * d8 + 3] = bfhi(w.y) * 0.125f;
              q[8 * d8 + 4] = bflo(w.z) * 0.125f; q[8 * d8 + 5] = bfhi(w.z) * 0.125f; q[8 * d8 + 6] = bflo(w.w) * 0.125f; q[8 * d8 + 7] = bfhi(w.w) * 0.125f; } }
#pragma unroll
        for (int e = 0; e < 64; ++e) o[e] = 0.f;
        float mx = -1e30f, ls = 0.f;
        for (int t = t0; t < t1; ++t) {
            const int krow0 = t < 128 ? b * SEQ + 64 * t : MLAT + b * CTXL + 64 * (t - 128);
            __syncthreads();
            { const int key = F.tid >> 3, c8 = (F.tid & 7) * 8; const bf16* kp = P + (size_t)(krow0 + key) * NP + PC_DK + h * 128 + m * 64 + c8; const u32x4 w = *(const u32x4*)kp;
              LAS float* kd = Kf + key * 64 + c8; *(LAS f32x4*)kd = (f32x4){bflo(w.x), bfhi(w.x), bflo(w.y), bfhi(w.y)}; *(LAS f32x4*)(kd + 4) = (f32x4){bflo(w.z), bfhi(w.z), bflo(w.w), bfhi(w.w)};
              const int c16 = (F.tid & 7) * 16; const bf16* vp = P + (size_t)(krow0 + key) * NP + PC_DV + h * 128 + c16; const u32x4 w0 = *(const u32x4*)vp, w1 = *(const u32x4*)(vp + 8);
              LAS float* vd = Vf + key * 128 + c16; *(LAS f32x4*)vd = (f32x4){bflo(w0.x), bfhi(w0.x), bflo(w0.y), bfhi(w0.y)}; *(LAS f32x4*)(vd + 4) = (f32x4){bflo(w0.z), bfhi(w0.z), bflo(w0.w), bfhi(w0.w)};
              *(LAS f32x4*)(vd + 8) = (f32x4){bflo(w1.x), bfhi(w1.x), bflo(w1.y), bfhi(w1.y)}; *(LAS f32x4*)(vd + 12) = (f32x4){bflo(w1.z), bfhi(w1.z), bflo(w1.w), bfhi(w1.w)}; }
            __syncthreads();
            for (int kk = 0; kk < 64; ++kk) {
                float s = 0.f;
#pragma unroll
                for (int d4 = 0; d4 < 16; ++d4) { const f32x4 kv = *(const LAS f32x4*)(Kf + kk * 64 + 4 * d4); s += (q[4 * d4] * kv.x + q[4 * d4 + 1] * kv.y) + (q[4 * d4 + 2] * kv.z + q[4 * d4 + 3] * kv.w); }
                const float mn = fmaxf(mx, s), corr = __expf(mx - mn), p = __expf(s - mn); mx = mn; ls = ls * corr + p;
#pragma unroll
                for (int e4 = 0; e4 < 16; ++e4) { const f32x4 vv = *(const LAS f32x4*)(Vf + kk * 128 + eh * 64 + 4 * e4);
                    o[4 * e4] = o[4 * e4] * corr + p * vv.x; o[4 * e4 + 1] = o[4 * e4 + 1] * corr + p * vv.y; o[4 * e4 + 2] = o[4 * e4 + 2] * corr + p * vv.z; o[4 * e4 + 3] = o[4 * e4 + 3] * corr + p * vv.w; }
            }
        }
        const float il = 1.f / ls; float* op = OD + ((size_t)m * MT + q0 + qi) * 512 + h * 128 + eh * 64;
#pragma unroll
        for (int e4 = 0; e4 < 16; ++e4) *(f32x4*)(op + 4 * e4) = (f32x4){o[4 * e4] * il, o[4 * e4 + 1] * il, o[4 * e4 + 2] * il, o[4 * e4 + 3] * il};
    }
    __syncthreads();
}

__device__ __forceinline__ void na_key(const bf16* kp, const bf16* vp, const float (&q)[64], float bias, float& mx, float& ls, float (&o)[64]) {
    float s = 0.f;
#pragma unroll
    for (int d8 = 0; d8 < 8; ++d8) { const u32x4 w = *(const u32x4*)(kp + 8 * d8);
        s += (q[8 * d8] * bflo(w.x) + q[8 * d8 + 1] * bfhi(w.x)) + (q[8 * d8 + 2] * bflo(w.y) + q[8 * d8 + 3] * bfhi(w.y)) + (q[8 * d8 + 4] * bflo(w.z) + q[8 * d8 + 5] * bfhi(w.z)) + (q[8 * d8 + 6] * bflo(w.w) + q[8 * d8 + 7] * bfhi(w.w)); }
    s += bias;
    const float mn = fmaxf(mx, s), corr = __expf(mx - mn), p = __expf(s - mn); mx = mn; ls = ls * corr + p;
#pragma unroll
    for (int d8 = 0; d8 < 8; ++d8) { const u32x4 w = *(const u32x4*)(vp + 8 * d8);
        o[8 * d8] = o[8 * d8] * corr + p * bflo(w.x); o[8 * d8 + 1] = o[8 * d8 + 1] * corr + p * bfhi(w.x); o[8 * d8 + 2] = o[8 * d8 + 2] * corr + p * bflo(w.y); o[8 * d8 + 3] = o[8 * d8 + 3] * corr + p * bfhi(w.y);
        o[8 * d8 + 4] = o[8 * d8 + 4] * corr + p * bflo(w.z); o[8 * d8 + 5] = o[8 * d8 + 5] * corr + p * bfhi(w.z); o[8 * d8 + 6] = o[8 * d8 + 6] * corr + p * bflo(w.w); o[8 * d8 + 7] = o[8 * d8 + 7] * corr + p * bfhi(w.w); }
}
__device__ __forceinline__ void ph_na_naive(Frame& F, const Args& a, int l) {
    REFRESH(F);
    const bf16* P = (const bf16*)(F.ws + WS_P); bf16* YC = (bf16*)(F.ws + WS_YC);
    const int gt = F.bid * NTHREADS + F.tid, NGT = F.G * NTHREADS;
    for (int idx = gt; idx < 8 * MT; idx += NGT) {
        int b, h, qrow, t; bool lat = idx < 8 * MLAT;
        if (lat) { b = idx >> 16; h = (idx >> 13) & 7; t = idx & (SEQ - 1); qrow = b * SEQ + t; } else { const int j = idx - 8 * MLAT; b = j >> 11; h = (j >> 8) & 7; t = j & 255; qrow = MLAT + b * CTXL + t; }
        float q[64], o[64];
        { const bf16* qp = P + (size_t)qrow * NP + PC_NQ + h * 64;
#pragma unroll
          for (int d8 = 0; d8 < 8; ++d8) { const u32x4 w = *(const u32x4*)(qp + 8 * d8); q[8 * d8] = bflo(w.x) * 0.125f; q[8 * d8 + 1] = bfhi(w.x) * 0.125f; q[8 * d8 + 2] = bflo(w.y) * 0.125f; q[8 * d8 + 3] = bfhi(w.y) * 0.125f;
              q[8 * d8 + 4] = bflo(w.z) * 0.125f; q[8 * d8 + 5] = bfhi(w.z) * 0.125f; q[8 * d8 + 6] = bflo(w.w) * 0.125f; q[8 * d8 + 7] = bfhi(w.w) * 0.125f; } }
#pragma unroll
        for (int e = 0; e < 64; ++e) o[e] = 0.f;
        float mx = -1e30f, ls = 0.f;
        if (lat) { const int r = t >> 6, c = t & 63; const int r0 = min(max(r - 4, 0), 120), c0 = min(max(c - 8, 0), 48);
            const float* rp = a.in[I_RPB] + ((size_t)l * 8 + h) * 15 * 31;
            for (int kr = 0; kr < 8; ++kr) for (int kc = 0; kc < 16; ++kc) { const int krow = b * SEQ + (r0 + kr) * 64 + c0 + kc;
                const float bias = rp[(r0 + kr - r + 7) * 31 + (c0 + kc - c + 15)];
                na_key(P + (size_t)krow * NP + PC_NK + h * 64, P + (size_t)krow * NP + PC_NV + h * 64, q, bias, mx, ls, o); } }
        for (int j = 0; j < CTXL; ++j) { const int krow = MLAT + b * CTXL + j; na_key(P + (size_t)krow * NP + PC_NK + h * 64, P + (size_t)krow * NP + PC_NV + h * 64, q, 0.f, mx, ls, o); }
        const float il = 1.f / ls; bf16* op = YC + (size_t)qrow * 512 + h * 64;
#pragma unroll
        for (int d8 = 0; d8 < 8; ++d8) { u32x4 w; w.x = pk2(o[8 * d8] * il, o[8 * d8 + 1] * il); w.y = pk2(o[8 * d8 + 2] * il, o[8 * d8 + 3] * il); w.z = pk2(o[8 * d8 + 4] * il, o[8 * d8 + 5] * il); w.w = pk2(o[8 * d8 + 6] * il, o[8 * d8 + 7] * il);
            *(u32x4*)(op + 8 * d8) = w; }
    }
}

__device__ __forceinline__ float grp16_sum(float v) { v += __shfl_xor(v, 1); v += __shfl_xor(v, 2); v += __shfl_xor(v, 4); v += __shfl_xor(v, 8); return v; }
__device__ __forceinline__ void ph_combine(Frame& F, const Args& a, int l) {
    REFRESH(F);
    const int gw = F.bid * NWAVES + F.wave, NGW = F.G * NWAVES;
    const float* OG = (const float*)(F.ws + WS_OG); const float* OD = (const float*)(F.ws + WS_OD); const bf16* P = (const bf16*)(F.ws + WS_P);
    bf16* YA = (bf16*)(F.ws + WS_YA); bf16* YB = (bf16*)(F.ws + WS_YB);
    const float lam = ((const float*)(F.ws + WS_LAM))[l], omli = 1.f - (0.8f - 0.6f * expf(-0.3f * (float)l));
    const float* gnw = a.in[I_GNW] + l * 128; const float* dnw = a.in[I_DNW] + l * 128;
    for (int row = gw; row < MT; row += NGW) {
        const int c = 8 * F.lane, ch = c & 127;
        { const float* p0 = OG + (size_t)row * 512 + c; const float* p1 = p0 + (size_t)MT * 512;
          const f32x4 a0 = *(const f32x4*)p0 + *(const f32x4*)p1, a1 = *(const f32x4*)(p0 + 4) + *(const f32x4*)(p1 + 4);
          float ss = (a0.x * a0.x + a0.y * a0.y) + (a0.z * a0.z + a0.w * a0.w) + (a1.x * a1.x + a1.y * a1.y) + (a1.z * a1.z + a1.w * a1.w);
          const float rs = 1.f / sqrtf(grp16_sum(ss) * (1.f / 128.f) + RMS_EPS);
          const u32x4 z = *(const u32x4*)(P + (size_t)row * NP + PC_GZ + c); const f32x4 w0 = *(const f32x4*)(gnw + ch), w1 = *(const f32x4*)(gnw + ch + 4);
          u32x4 o; o.x = pk2(a0.x * rs * w0.x * siluf(bflo(z.x)), a0.y * rs * w0.y * siluf(bfhi(z.x))); o.y = pk2(a0.z * rs * w0.z * siluf(bflo(z.y)), a0.w * rs * w0.w * siluf(bfhi(z.y)));
          o.z = pk2(a1.x * rs * w1.x * siluf(bflo(z.z)), a1.y * rs * w1.y * siluf(bfhi(z.z))); o.w = pk2(a1.z * rs * w1.z * siluf(bflo(z.w)), a1.w * rs * w1.w * siluf(bfhi(z.w)));
          *(u32x4*)(YA + (size_t)row * 512 + c) = o; }
        { const float* p0 = OD + (size_t)row * 512 + c; const float* p1 = p0 + (size_t)MT * 512;
          const f32x4 a0 = *(const f32x4*)p0 - *(const f32x4*)p1 * lam, a1 = *(const f32x4*)(p0 + 4) - *(const f32x4*)(p1 + 4) * lam;
          float ss = (a0.x * a0.x + a0.y * a0.y) + (a0.z * a0.z + a0.w * a0.w) + (a1.x * a1.x + a1.y * a1.y) + (a1.z * a1.z + a1.w * a1.w);
          const float rs = (1.f / sqrtf(grp16_sum(ss) * (1.f / 128.f) + RMS_EPS)) * omli;
          const f32x4 w0 = *(const f32x4*)(dnw + ch), w1 = *(const f32x4*)(dnw + ch + 4);
          u32x4 o; o.x = pk2(a0.x * rs * w0.x, a0.y * rs * w0.y); o.y = pk2(a0.z * rs * w0.z, a0.w * rs * w0.w); o.z = pk2(a1.x * rs * w1.x, a1.y * rs * w1.y); o.w = pk2(a1.z * rs * w1.z, a1.w * rs * w1.w);
          *(u32x4*)(YB + (size_t)row * 512 + c) = o; }
    }
}
constexpr int TAB_OFF = LDSCTL_OFF;
__device__ __forceinline__ void ph_ln1_router(Frame& F, const Args& a, int l) {
    REFRESH(F);
    volatile LAS int* tab = (volatile LAS int*)(F.lds + TAB_OFF);
    const float* T = (const float*)(F.ws + WS_T); float* X = (float*)(F.ws + WS_X);
    const float* wrT = (const float*)(F.ws + WS_WRT) + (size_t)l * 32 * 1024;
    const float* lng = a.in[I_LNG] + (size_t)(l * 2 + 0) * DM; const float* lnb = a.in[I_LNB] + (size_t)(l * 2 + 0) * DM;
    int* TOPE = (int*)(F.ws + WS_TOPE); int* TOPR = (int*)(F.ws + WS_TOPR); float* TOPG = (float*)(F.ws + WS_TOPG); int* BLKB = (int*)(F.ws + WS_BLKB);
    for (int rg = F.bid; rg < NRG; rg += F.G) {
        if (F.tid < 32) tab[384 + F.tid] = 0;
        __syncthreads();
        for (int i = F.wave; i < RG_ROWS; i += NWAVES) {
            const int row = rg * RG_ROWS + i; f32x4 v[4];
            const f32x4* tr = (const f32x4*)T + (size_t)row * 256 + F.lane;
#pragma unroll
            for (int j = 0; j < 4; ++j) v[j] = tr[64 * j];
            ln_inplace(v);
#pragma unroll
            for (int j = 0; j < 4; ++j) { const int c = 4 * F.lane + 256 * j; v[j] = v[j] * *(const f32x4*)(lng + c) + *(const f32x4*)(lnb + c); *((f32x4*)X + (size_t)row * 256 + F.lane + 64 * j) = v[j]; }
            modulate_store(F, l, 1, row, v);
            float lg = -3.0e38f; const int me = F.lane;
#pragma unroll 4
            for (int e = 0; e < 32; ++e) { float s = 0.f;
#pragma unroll
                for (int j = 0; j < 4; ++j) { const f32x4 w = *(const f32x4*)(wrT + e * 1024 + 4 * F.lane + 256 * j); s += (v[j].x * w.x + v[j].y * w.y) + (v[j].z * w.z + v[j].w * w.w); }
                s = wave_sum(s); if (F.lane == e) lg = s; }
            if (F.lane < 32) lg += a.in[I_BR][l * 32 + me];
            int te[4]; float tv[4];
#pragma unroll
            for (int k = 0; k < 4; ++k) { float bv = lg; int be = me;
#pragma unroll
                for (int o = 1; o < 64; o <<= 1) { const float ov = __shfl_xor(bv, o); const int oe = __shfl_xor(be, o); if (ov > bv || (ov == bv && oe < be)) { bv = ov; be = oe; } }
                te[k] = be; tv[k] = bv; if (me == be) lg = -3.0e38f; }
            const float e1 = __expf(tv[1] - tv[0]), e2 = __expf(tv[2] - tv[0]), e3 = __expf(tv[3] - tv[0]), isum = 1.f / (1.f + e1 + e2 + e3);
            if (F.lane < 4) { const int k = F.lane; const int e = k == 0 ? te[0] : k == 1 ? te[1] : k == 2 ? te[2] : te[3]; const float g = (k == 0 ? 1.f : k == 1 ? e1 : k == 2 ? e2 : e3) * isum;
                const int lr = __hip_atomic_fetch_add((LAS int*)&tab[384 + e], 1, __ATOMIC_RELAXED, __HIP_MEMORY_SCOPE_WORKGROUP);
                TOPE[row * 4 + k] = e; TOPR[row * 4 + k] = lr; TOPG[row * 4 + k] = g; }
        }
        __syncthreads();
        if (F.tid < 32) { const int n = tab[384 + F.tid]; const unsigned base = __hip_atomic_fetch_add(F.ctl + CW_CNT + l * 32 + F.tid, (unsigned)n, __ATOMIC_RELAXED, __HIP_MEMORY_SCOPE_AGENT); BLKB[rg * 32 + F.tid] = (int)base; }
        __syncthreads();
    }
}
__device__ __forceinline__ void moe_tables(Frame& F, int l, int nN) {
    REFRESH(F);
    volatile LAS int* tab = (volatile LAS int*)(F.lds + TAB_OFF);
    __syncthreads();
    if (F.tid == 0) { int t = 0;
#pragma unroll 1
        for (int e = 0; e < 32; ++e) { const int n = (int)__hip_atomic_load(F.ctl + CW_CNT + l * 32 + e, __ATOMIC_RELAXED, __HIP_MEMORY_SCOPE_AGENT), nt = (n + 255) >> 8; tab[352 + e] = t * 256;
            for (int i = 0; i < nt; ++i) tab[t + i] = e; t += nt; }
        tab[320] = t; }
    __syncthreads();
    if (nN > 0 && F.tid < 16) { int pm, pn; const int T = tab[320]; int w = -1;
        if (TileMap::map(F.tid, F.G, F.bid, T, nN, pm, pn)) w = pm | (pn << 12) | (tab[pm] << 16) | (nN << 24);
        tab[416 + F.tid] = w; }
    __syncthreads();
}
__device__ __forceinline__ void ph_moe_gather(Frame& F, int l) {
    REFRESH(F);
    volatile LAS int* tab = (volatile LAS int*)(F.lds + TAB_OFF);
    moe_tables(F, l, 0);
    const int gw = F.bid * NWAVES + F.wave, NGW = F.G * NWAVES;
    const int* TOPE = (const int*)(F.ws + WS_TOPE); const int* TOPR = (const int*)(F.ws + WS_TOPR); const int* BLKB = (const int*)(F.ws + WS_BLKB); int* SLOT = (int*)(F.ws + WS_SLOT);
    const bf16* HX = (const bf16*)(F.ws + WS_HX); bf16* HP = (bf16*)(F.ws + WS_HP);
    for (int row = gw; row < MT; row += NGW) {
        const u32x4 h0 = *(const u32x4*)(HX + (size_t)row * DM + 8 * F.lane), h1 = *(const u32x4*)(HX + (size_t)row * DM + 512 + 8 * F.lane);
#pragma unroll
        for (int k = 0; k < 4; ++k) { const int e = TOPE[row * 4 + k], slot = tab[352 + e] + BLKB[(row / RG_ROWS) * 32 + e] + TOPR[row * 4 + k];
            if (F.lane == 0) SLOT[row * 4 + k] = slot;
            *(u32x4*)(HP + (size_t)slot * DM + 8 * F.lane) = h0; *(u32x4*)(HP + (size_t)slot * DM + 512 + 8 * F.lane) = h1; }
    }
}
__device__ __forceinline__ void ph_ln2(Frame& F, const Args& a, int l) {
    REFRESH(F);
    const int gw = F.bid * NWAVES + F.wave, NGW = F.G * NWAVES;
    float* X = (float*)(F.ws + WS_X); const bf16* Y = (const bf16*)(F.ws + WS_Y);
    const int* SLOT = (const int*)(F.ws + WS_SLOT); const float* TOPG = (const float*)(F.ws + WS_TOPG);
    const float* lng = a.in[I_LNG] + (size_t)(l * 2 + 1) * DM; const float* lnb = a.in[I_LNB] + (size_t)(l * 2 + 1) * DM;
    const bool poison = __hip_atomic_load(F.ctl + CW_BAR + XB_TMO, __ATOMIC_RELAXED, __HIP_MEMORY_SCOPE_AGENT) != 0u;
    for (int row = gw; row < MT; row += NGW) {
        const float* g2 = (const float*)(F.ws + WS_MOD) + ((size_t)l * 3 + mod_index(row)) * 6144 + 5120;
        f32x4 fx[4];
#pragma unroll
        for (int j = 0; j < 4; ++j) fx[j] = (f32x4){0.f, 0.f, 0.f, 0.f};
#pragma unroll
        for (int k = 0; k < 4; ++k) { const int slot = SLOT[row * 4 + k]; const float g = TOPG[row * 4 + k]; const bf16* yr = Y + (size_t)slot * DM + 4 * F.lane;
#pragma unroll
            for (int j = 0; j < 4; ++j) { const u32x2 w = *(const u32x2*)(yr + 256 * j); fx[j] += (f32x4){bflo(w.x), bfhi(w.x), bflo(w.y), bfhi(w.y)} * g; } }
        f32x4 v[4];
#pragma unroll
        for (int j = 0; j < 4; ++j) { const int c = 4 * F.lane + 256 * j; v[j] = *((const f32x4*)X + (size_t)row * 256 + F.lane + 64 * j) * DN_ALPHA + *(const f32x4*)(g2 + c) * fx[j]; }
        ln_inplace(v);
#pragma unroll
        for (int j = 0; j < 4; ++j) { const int c = 4 * F.lane + 256 * j; v[j] = v[j] * *(const f32x4*)(lng + c) + *(const f32x4*)(lnb + c); }
        if (l == DEPTH - 1) { if (row < MLAT) {
            if (poison) { const float qn = __builtin_nanf("");
#pragma unroll
                for (int j = 0; j < 4; ++j) v[j] = (f32x4){qn, qn, qn, qn}; }
#pragma unroll
            for (int j = 0; j < 4; ++j) *((f32x4*)a.out + (size_t)row * 256 + F.lane + 64 * j) = v[j]; } }
        else {
#pragma unroll
            for (int j = 0; j < 4; ++j) *((f32x4*)X + (size_t)row * 256 + F.lane + 64 * j) = v[j];
            modulate_store(F, l + 1, 0, row, v); decay_cols(F, l + 1, row, v); }
    }
}

constexpr int NPH_LAYER = 12, NPHASES = 2 + DEPTH * NPH_LAYER;
#ifndef PH_MASK
#define PH_MASK 0xFFFF
#endif
#define EN(k) ((PH_MASK >> (k)) & 1)
__global__ void __launch_bounds__(NTHREADS, 2) fwd_kernel(Args args) {
    extern __shared__ __attribute__((aligned(16))) unsigned char lds_raw[];
    Frame F; F.lds = (LAS unsigned char*)lds_raw; F.ws = args.ws; F.ctl = (unsigned*)(args.ws + WS_CTL);
    F.tid = threadIdx.x; F.lane = F.tid & 63; F.wave = __builtin_amdgcn_readfirstlane(F.tid >> 6); F.wv = F.wave; F.G = gridDim.x; F.bid = blockIdx.x;
    volatile LAS unsigned* MISC = (volatile LAS unsigned*)(F.lds + MISC_OFF);
    for (int u = F.tid; u < (LDS_BYTES - LDSCTL_OFF) / 4; u += NTHREADS) ((LAS unsigned*)(F.lds + LDSCTL_OFF))[u] = 0u;
    __syncthreads();
    const int lo = args.ph_lo, hi = args.ph_hi;
    const bool multi = (hi - lo) > 1;
    XcdBarrier bar; bar.bar = F.ctl + CW_BAR; bar.x = 0; bar.st = nullptr;
    if (multi) bar = xcd_barrier_post(F.ctl + CW_BAR, MISC + 8);
#define IN(k) (lo <= (k) && (k) < hi)
#define SEAM(k) do { if (IN(k) && IN((k) + 1)) xcd_barrier(bar); } while (0)
    unsigned char* ws = args.ws;
    if (EN(12) && IN(0)) { p0_prologue(F, args); SEAM(0); }
    if (EN(13) && IN(1)) { ph_lnmod0(F); SEAM(1); }
    for (int l = 0; l < DEPTH; ++l) {
        const int pb = 2 + l * NPH_LAYER;
        if (EN(0) && IN(pb + 0)) {
            StaticOrder S{MT / 256, NP / 256, F.G, F.bid, 1024};
            EpiWin E{(bf16*)(ws + WS_P)};
            pg8::gemm_phase<EpiWin, StaticOrder>(F.lds, 1024, (const char*)(ws + WS_HX), (const char*)(ws + WS_WIN) + (size_t)l * 8192 * 1024 * 2, S, E, F.wv);
            SEAM(pb + 0); }
        if (EN(1) && IN(pb + 1)) { ph_prep(F, args, l); SEAM(pb + 1); }
        if (EN(2) && IN(pb + 2)) { ph_gdn_chain_naive(F, args, l); SEAM(pb + 2); }
        if (EN(3) && IN(pb + 3)) { ph_diff_naive(F, l); ph_na_naive(F, args, l); SEAM(pb + 3); }
        if (EN(4) && IN(pb + 4)) { ph_combine(F, args, l); SEAM(pb + 4); }
        if (EN(5) && IN(pb + 5)) {
            MergeOrder S{F.G, F.bid};
            EpiMerge E{(const bf16*)(ws + WS_P), (float*)(ws + WS_MACC), (bf16*)(ws + WS_MBF)};
            pg8::gemm_phase<EpiMerge, MergeOrder>(F.lds, 512, (const char*)(ws + WS_YA), (const char*)(ws + WS_WBR) + (size_t)l * 3 * 1024 * 512 * 2, S, E, F.wv);
            SEAM(pb + 5); }
        if (EN(6) && IN(pb + 6)) {
            StaticOrder S{MT / 256, 4, F.G, F.bid, 1024};
            EpiWout E{(const float*)(ws + WS_X), (const float*)(ws + WS_MOD) + (size_t)l * 3 * 6144, (float*)(ws + WS_T)};
            pg8::gemm_phase<EpiWout, StaticOrder>(F.lds, 1024, (const char*)(ws + WS_MBF), (const char*)(ws + WS_WOUT) + (size_t)l * 1024 * 1024 * 2, S, E, F.wv);
            SEAM(pb + 6); }
        if (EN(7) && IN(pb + 7)) { ph_ln1_router(F, args, l); SEAM(pb + 7); }
        if (EN(8) && IN(pb + 8)) { ph_moe_gather(F, l); SEAM(pb + 8); }
        if (EN(9) && IN(pb + 9)) {
            moe_tables(F, l, 8);
            MoeOrder S{(const volatile LAS int*)(F.lds + TAB_OFF)};
            EpiAct E{args.in[I_B1] + (size_t)l * 32 * 2048, (bf16*)(ws + WS_ACT)};
            pg8::gemm_phase<EpiAct, MoeOrder>(F.lds, 1024, (const char*)(ws + WS_HP), (const char*)(ws + WS_W1) + (size_t)l * 32 * 2048 * 1024 * 2, S, E, F.wv);
            SEAM(pb + 9); }
        if (EN(10) && IN(pb + 10)) {
            moe_tables(F, l, 4);
            MoeOrder S{(const volatile LAS int*)(F.lds + TAB_OFF)};
            EpiY E{args.in[I_B2] + (size_t)l * 32 * 1024, (bf16*)(ws + WS_Y)};
            pg8::gemm_phase<EpiY, MoeOrder>(F.lds, 1024, (const char*)(ws + WS_ACT), (const char*)(ws + WS_W2) + (size_t)l * 32 * 1024 * 1024 * 2, S, E, F.wv);
            SEAM(pb + 10); }
        if (EN(11) && IN(pb + 11)) { ph_ln2(F, args, l); SEAM(pb + 11); }
    }
#undef IN
#undef SEAM
}

#ifndef MK_PER_PHASE
#define MK_PER_PHASE 0
#endif
extern "C" void kernel_launch(void* const* d_in, const int* in_sizes, int n_in, void* d_out, int out_size, void* d_ws, size_t ws_size, hipStream_t stream) {
    static int grid = 0;
    if (grid == 0) {
        if (n_in != 24 || out_size != MLAT * DM || ws_size < WS_END) { fprintf(stderr, "kernel_launch: unexpected shapes (n_in %d out %d ws %zu need %zu)\n", n_in, out_size, ws_size, (size_t)WS_END); grid = -1; return; }
        int dev = 0, cus = 0, per_cu = 0;
        if (hipGetDevice(&dev) != hipSuccess || hipDeviceGetAttribute(&cus, hipDeviceAttributeMultiprocessorCount, dev) != hipSuccess) { grid = -1; return; }
        if (hipFuncSetAttribute((const void*)fwd_kernel, hipFuncAttributeMaxDynamicSharedMemorySize, LDS_BYTES) != hipSuccess) { fprintf(stderr, "kernel_launch: hipFuncSetAttribute failed\n"); grid = -1; return; }
        if (hipOccupancyMaxActiveBlocksPerMultiprocessor(&per_cu, (const void*)fwd_kernel, NTHREADS, LDS_BYTES) != hipSuccess || per_cu < 1) { fprintf(stderr, "kernel_launch: occupancy query says %d\n", per_cu); }
        (void)hipGetLastError();
        grid = cus;
    }
    if (grid < 0) return;
    (void)hipMemsetAsync((char*)d_ws + WS_CTL, 0, CTL_ZERO_BYTES, stream);
    Args a{};
    for (int i = 0; i < 24; ++i) a.in[i] = (const float*)d_in[i];
    a.out = (float*)d_out; a.ws = (unsigned char*)d_ws;
#if MK_PER_PHASE
    for (int p = 0; p < NPHASES; ++p) { a.ph_lo = p; a.ph_hi = p + 1; hipLaunchKernelGGL(fwd_kernel, dim3(grid), dim3(NTHREADS), LDS_BYTES, stream, a); }
#else
    a.ph_lo = 0; a.ph_hi = NPHASES; hipLaunchKernelGGL(fwd_kernel, dim3(grid), dim3(NTHREADS), LDS_BYTES, stream, a);
#endif
    const hipError_t le = hipPeekAtLastError();
    if (le != hipSuccess) fprintf(stderr, "kernel_launch: launch failed: %s\n", hipGetErrorName(le));
}
```

```cpp
#include <hip/hip_runtime.h>
#include <cstdio>
#include <cstdint>
#include <cmath>

#define GAS __attribute__((address_space(1)))
#define LAS __attribute__((address_space(3)))
typedef unsigned short bf16;
typedef float f32x4 __attribute__((ext_vector_type(4)));
typedef float f32x2 __attribute__((ext_vector_type(2)));
typedef unsigned u32x4 __attribute__((ext_vector_type(4)));
typedef unsigned u32x2 __attribute__((ext_vector_type(2)));
typedef short bf16x8 __attribute__((ext_vector_type(8)));

namespace pg8 {
#define PG8_LAS __attribute__((address_space(3)))
constexpr int BM = 256, BK = 64, HALF = 128, HTB = HALF * BK * 2, STAGE_BYTES = 8 * HTB, NXCD = 8, WGM = 8;
__host__ __device__ __forceinline__ int lds_byte(int r, int c) { const int st = (r >> 4) * 2 + (c >> 5), rr = r & 15, cc = c & 31, ob = rr * 64 + cc * 2; return st * 1024 + (ob ^ (((ob >> 9) & 1) << 5)); }
__host__ __device__ __forceinline__ void stage_rc(int b, int& R, int& C) { const int st = b / 1024, sb = b % 1024, swz = sb ^ (((sb >> 9) & 1) << 5); R = (st >> 1) * 16 + swz / 64; C = (st & 1) * 32 + (swz % 64) / 2; }
__host__ __device__ __forceinline__ int perm32(int rho) { const int n = rho >> 4, i = rho & 15; return 8 * (i >> 2) + 4 * n + (i & 3); }

struct Unit { int pm, pn, aux; unsigned aoff, boff; };

typedef float cvt_f32x2_t __attribute__((ext_vector_type(2))); typedef __bf16 cvt_bf16x2_t __attribute__((ext_vector_type(2)));
__device__ __forceinline__ unsigned cvt_pk_bf16(float lo, float hi) { cvt_f32x2_t v = {lo, hi}; cvt_bf16x2_t b = __builtin_convertvector(v, cvt_bf16x2_t); return __builtin_bit_cast(unsigned, b); }

template <class Epi, class Sched, bool ALIGN_EPI = true, bool SP2 = true>
__device__ __forceinline__ void gemm_phase(PG8_LAS unsigned char* lds, const int K, const char* Abase, const char* Bbase, const Sched& S, const Epi& E, const int wv) {
    int lane_; asm volatile("v_mbcnt_lo_u32_b32 %0, -1, 0\n\tv_mbcnt_hi_u32_b32 %0, -1, %0" : "=v"(lane_));
    const int wid = wv, lane = lane_, tid = wv * 64 + lane_, wr = wid >> 2, wc = wid & 3, fr = lane & 15, fq = lane >> 4;
    const int nt = K / BK;
    unsigned voffA[2], voffB[2];
#pragma unroll
    for (int i = 0; i < 2; ++i) { int R, C; stage_rc(tid * 16 + i * 8192, R, C); const int Rb = ((R & ~31) + perm32(R & 31));
        voffA[i] = (unsigned)(R * K + C) * 2u; voffB[i] = (unsigned)(Rb * K + C) * 2u; }
    const size_t kstep = (size_t)(BK * 2);
    const size_t hstep = (size_t)HALF * K * 2;
    const unsigned ldsw = (unsigned)wid * 1024u;
    const int aoff = lds_byte(wr * 64 + fr, fq * 8), boff = lds_byte(wc * 32 + fr, fq * 8);
#define PG8_SA(b, h) (((b) * 2 + (h)) * HTB)
#define PG8_SB(b, h) ((4 + (b) * 2 + (h)) * HTB)
#define PG8_STAGE(bufoff, gbase, voff) do { _Pragma("unroll") for (int _i = 0; _i < 2; ++_i) \
        __builtin_amdgcn_global_load_lds((const GAS unsigned*)((const char*)(gbase) + (voff)[_i]), (PG8_LAS unsigned*)(lds + (bufoff) + ldsw + _i * 8192), 16, 0, 0); } while (0)
#define PG8_LDA(dst, b, h) do { _Pragma("unroll") for (int m = 0; m < 4; ++m) _Pragma("unroll") for (int k = 0; k < 2; ++k) dst[m][k] = *(const PG8_LAS bf16x8*)(lds + PG8_SA(b, h) + aoff + m * 2048 + k * 1024); } while (0)
#define PG8_LDB(dst, b, h) do { _Pragma("unroll") for (int n = 0; n < 2; ++n) _Pragma("unroll") for (int k = 0; k < 2; ++k) dst[n][k] = *(const PG8_LAS bf16x8*)(lds + PG8_SB(b, h) + boff + n * 2048 + k * 1024); } while (0)
#define PG8_MMA(ai, bj, At, Bt) do { __builtin_amdgcn_s_setprio(1); _Pragma("unroll") for (int m = 0; m < 4; ++m) _Pragma("unroll") for (int n = 0; n < 2; ++n) _Pragma("unroll") for (int k = 0; k < 2; ++k) \
        acc[ai][bj][m][n] = __builtin_amdgcn_mfma_f32_16x16x32_bf16(Bt[n][k], At[m][k], acc[ai][bj][m][n], 0, 0, 0); __builtin_amdgcn_s_setprio(0); } while (0)
#define PG8_WAIT_V(n) asm volatile("s_waitcnt vmcnt(" #n ")" ::: "memory")
#define PG8_WAIT_L(n) asm volatile("s_waitcnt lgkmcnt(" #n ")" ::: "memory")
#define PG8_BAR __builtin_amdgcn_s_barrier()
#define PG8_SCHED __builtin_amdgcn_sched_barrier(0)
    Unit cur, nxt; int ui = 0;
    if (!S.next(0, cur)) return;
    f32x4 acc[2][2][4][2];
#pragma unroll
    for (int a = 0; a < 2; ++a)
#pragma unroll
        for (int b = 0; b < 2; ++b)
#pragma unroll
            for (int m = 0; m < 4; ++m)
#pragma unroll
                for (int n = 0; n < 2; ++n) acc[a][b][m][n] = (f32x4){0.f, 0.f, 0.f, 0.f};
    bf16x8 At[4][2], B0[2][2], B1[2][2];
    const char* cA = Abase + cur.aoff; const char* cB = Bbase + cur.boff;
    if constexpr (SP2) {
        PG8_STAGE(PG8_SB(0, 0), cB, voffB); PG8_STAGE(PG8_SB(0, 1), cB + hstep, voffB); PG8_STAGE(PG8_SA(0, 0), cA, voffA); PG8_STAGE(PG8_SA(0, 1), cA + hstep, voffA);
        if (wr == 1) PG8_BAR;
        PG8_WAIT_V(2); PG8_BAR;
        PG8_STAGE(PG8_SB(1, 0), cB + kstep, voffB); PG8_STAGE(PG8_SA(1, 0), cA + kstep, voffA); PG8_STAGE(PG8_SB(1, 1), cB + hstep + kstep, voffB);
        PG8_WAIT_V(6); PG8_BAR;
    } else {
        PG8_STAGE(PG8_SB(0, 0), cB, voffB); PG8_STAGE(PG8_SA(0, 0), cA, voffA); PG8_STAGE(PG8_SB(0, 1), cB + hstep, voffB); PG8_STAGE(PG8_SA(0, 1), cA + hstep, voffA);
        if (wr == 1) PG8_BAR;
        PG8_WAIT_V(4); PG8_BAR;
        PG8_STAGE(PG8_SB(1, 0), cB + kstep, voffB); PG8_STAGE(PG8_SA(1, 0), cA + kstep, voffA); PG8_STAGE(PG8_SB(1, 1), cB + hstep + kstep, voffB);
        PG8_WAIT_V(6); PG8_BAR;
    }
    for (;;) {
        const bool has_next = S.next(ui + 1, nxt);
        const char* nA = has_next ? Abase + nxt.aoff : cA; const char* nB = has_next ? Bbase + nxt.boff : cB;
        for (int t = 0; t < nt; t += 2) {
            const bool last = (t == nt - 2);
            const char* a1 = cA + (size_t)(t + 1) * kstep;
            const char* a2 = last ? nA : cA + (size_t)(t + 2) * kstep; const char* b2 = last ? nB : cB + (size_t)(t + 2) * kstep;
            const char* a3 = a2 + kstep; const char* b3 = b2 + kstep;
            if constexpr (SP2) {
            PG8_LDB(B0, 0, 0); PG8_LDB(B1, 0, 1); PG8_SCHED; PG8_LDA(At, 0, 0); PG8_STAGE(PG8_SA(1, 1), a1 + hstep, voffA);
            PG8_WAIT_V(8); PG8_WAIT_L(0); PG8_BAR; PG8_MMA(0, 0, At, B0); PG8_MMA(0, 1, At, B1); PG8_BAR; PG8_SCHED;
            PG8_LDA(At, 0, 1); PG8_STAGE(PG8_SB(0, 0), b2, voffB); PG8_STAGE(PG8_SB(0, 1), b2 + hstep, voffB); PG8_STAGE(PG8_SA(0, 0), a2, voffA);
            PG8_WAIT_V(8); PG8_WAIT_L(0); PG8_BAR; PG8_MMA(1, 0, At, B0); PG8_MMA(1, 1, At, B1); PG8_BAR; PG8_SCHED;
            PG8_LDB(B0, 1, 0); PG8_LDB(B1, 1, 1); PG8_SCHED; PG8_LDA(At, 1, 0); PG8_STAGE(PG8_SA(0, 1), a2 + hstep, voffA);
            PG8_WAIT_V(8); PG8_WAIT_L(0); PG8_BAR; PG8_MMA(0, 0, At, B0); PG8_MMA(0, 1, At, B1); PG8_BAR; PG8_SCHED;
            PG8_LDA(At, 1, 1); PG8_STAGE(PG8_SB(1, 0), b3, voffB); PG8_STAGE(PG8_SB(1, 1), b3 + hstep, voffB); PG8_STAGE(PG8_SA(1, 0), a3, voffA);
            PG8_WAIT_V(8); PG8_WAIT_L(0); PG8_BAR; PG8_MMA(1, 0, At, B0); PG8_MMA(1, 1, At, B1); PG8_BAR; PG8_SCHED;
            } else {
            PG8_LDB(B0, 0, 0); PG8_SCHED; PG8_LDA(At, 0, 0); PG8_STAGE(PG8_SA(1, 1), a1 + hstep, voffA);
            PG8_WAIT_L(8); PG8_BAR; PG8_WAIT_L(0); PG8_MMA(0, 0, At, B0); PG8_BAR; PG8_SCHED;
            PG8_LDB(B1, 0, 1); PG8_STAGE(PG8_SB(0, 0), b2, voffB);
            PG8_BAR; PG8_WAIT_L(0); PG8_MMA(0, 1, At, B1); PG8_BAR;
            PG8_LDA(At, 0, 1); PG8_STAGE(PG8_SA(0, 0), a2, voffA);
            PG8_BAR; PG8_WAIT_L(0); PG8_MMA(1, 0, At, B0); PG8_BAR; PG8_SCHED;
            PG8_STAGE(PG8_SB(0, 1), b2 + hstep, voffB);
            PG8_WAIT_V(6); PG8_BAR; PG8_MMA(1, 1, At, B1); PG8_BAR;
            PG8_LDB(B0, 1, 0); PG8_SCHED; PG8_LDA(At, 1, 0); PG8_STAGE(PG8_SA(0, 1), a2 + hstep, voffA);
            PG8_WAIT_L(8); PG8_BAR; PG8_WAIT_L(0); PG8_MMA(0, 0, At, B0); PG8_BAR; PG8_SCHED;
            PG8_LDB(B1, 1, 1); PG8_STAGE(PG8_SB(1, 0), b3, voffB);
            PG8_BAR; PG8_WAIT_L(0); PG8_MMA(0, 1, At, B1); PG8_BAR;
            PG8_LDA(At, 1, 1); PG8_STAGE(PG8_SA(1, 0), a3, voffA);
            PG8_BAR; PG8_WAIT_L(0); PG8_MMA(1, 0, At, B0); PG8_BAR; PG8_SCHED;
            PG8_STAGE(PG8_SB(1, 1), b3 + hstep, voffB);
            PG8_WAIT_V(6); PG8_BAR; PG8_MMA(1, 1, At, B1); PG8_BAR;
            }
        }
        if constexpr (ALIGN_EPI) { if (wr == 0) PG8_BAR; }
        E(acc, cur, wr, wc, fr, fq);
        if (!has_next) break;
#pragma unroll
        for (int a = 0; a < 2; ++a)
#pragma unroll
            for (int b = 0; b < 2; ++b)
#pragma unroll
                for (int m = 0; m < 4; ++m)
#pragma unroll
                    for (int n = 0; n < 2; ++n) acc[a][b][m][n] = (f32x4){0.f, 0.f, 0.f, 0.f};
        cur = nxt; cA = nA; cB = nB; ++ui;
        if constexpr (ALIGN_EPI) { if (wr == 1) PG8_BAR; }
    }
    PG8_WAIT_V(0);
    if constexpr (!ALIGN_EPI) { if (wr == 0) PG8_BAR; }
    PG8_BAR;
#undef PG8_SA
#undef PG8_SB
#undef PG8_STAGE
#undef PG8_LDA
#undef PG8_LDB
#undef PG8_MMA
#undef PG8_WAIT_V
#undef PG8_WAIT_L
#undef PG8_BAR
#undef PG8_SCHED
}
}
#ifndef USE_GDN_FAST
#define USE_GDN_FAST 1
#endif
#ifndef USE_DIFF_MFMA
#define USE_DIFF_MFMA 1
#endif
constexpr int DM = 1024, BATCH = 2, SEQ = 8192, DEPTH = 4, CTXL = 256, GRIDW = 64;
constexpr int MLAT = BATCH * SEQ, MCTX = BATCH * CTXL, MT = MLAT + MCTX;
constexpr int NP = 8192;
constexpr int PC_GQ = 0, PC_GK = 512, PC_GV = 1024, PC_GZ = 1536, PC_DQ = 2048, PC_DK = 2560, PC_DV = 3072, PC_NQ = 3584, PC_NK = 4096, PC_NV = 4608, PC_GATE = 5120;
constexpr int D_IN = 8208, NEXP = 32, TOPK = 4, DEXP = 1024;
constexpr float LN_EPS = 1e-5f, RMS_EPS = 1e-6f;
constexpr float DN_ALPHA = 1.6817928305074292f;
constexpr int NWAVES = 8, NTHREADS = 512;
constexpr int RG_ROWS = 66, NRG = MT / RG_ROWS;
constexpr int RPAD = MT * TOPK + NEXP * 256;
constexpr int MAXTILES = RPAD / 256;

constexpr size_t MiB = 1u << 20;
constexpr size_t al256(size_t x) { return (x + 255) / 256 * 256; }
constexpr size_t WS_CTL = 0, CTL_ZERO_BYTES = 1 * MiB;
constexpr size_t WS_MOD = WS_CTL + CTL_ZERO_BYTES;
constexpr size_t WS_LAM = WS_MOD + al256((size_t)DEPTH * 3 * 6144 * 4);
constexpr size_t WS_WDEC = WS_LAM + 256;
constexpr size_t WS_WRT = WS_WDEC + (size_t)DEPTH * 16 * 1024 * 4;
constexpr size_t WS_WIN = WS_WRT + (size_t)DEPTH * 32 * 1024 * 4;
constexpr size_t WS_WBR = WS_WIN + (size_t)DEPTH * 8192 * 1024 * 2;
constexpr size_t WS_WOUT = WS_WBR + (size_t)DEPTH * 3 * 1024 * 512 * 2;
constexpr size_t WS_W1 = WS_WOUT + (size_t)DEPTH * 1024 * 1024 * 2;
constexpr size_t WS_W2 = WS_W1 + (size_t)DEPTH * 32 * 2048 * 1024 * 2;
constexpr size_t WS_X = WS_W2 + (size_t)DEPTH * 32 * 1024 * 1024 * 2;
constexpr size_t WS_HX = WS_X + (size_t)MT * DM * 4;
constexpr size_t WS_P = WS_HX + (size_t)MT * DM * 2;
constexpr size_t WS_DEC = WS_P + (size_t)MT * NP * 2;
constexpr size_t WS_QN = WS_DEC + (size_t)MT * 16 * 4;
constexpr size_t WS_KN = WS_QN + (size_t)MT * 512 * 4;
constexpr size_t WS_VV = WS_KN + (size_t)MT * 512 * 4;
constexpr size_t WS_OG = WS_VV + (size_t)MT * 512 * 4;
constexpr size_t WS_OD = WS_OG + (size_t)2 * MT * 512 * 4;
constexpr size_t WS_YA = WS_OD + (size_t)2 * MT * 512 * 4;
constexpr size_t WS_YB = WS_YA + (size_t)MT * 512 * 2;
constexpr size_t WS_YC = WS_YB + (size_t)MT * 512 * 2;
constexpr size_t WS_MACC = WS_YC + (size_t)MT * 512 * 2;
constexpr size_t WS_MBF = WS_MACC + (size_t)MT * DM * 4;
constexpr size_t WS_T = WS_MBF + (size_t)MT * DM * 2;
constexpr size_t WS_TOPE = WS_T + (size_t)MT * DM * 4;
constexpr size_t WS_TOPR = WS_TOPE + (size_t)MT * 4 * 4;
constexpr size_t WS_TOPG = WS_TOPR + (size_t)MT * 4 * 4;
constexpr size_t WS_SLOT = WS_TOPG + (size_t)MT * 4 * 4;
constexpr size_t WS_BLKB = WS_SLOT + (size_t)MT * 4 * 4;
constexpr size_t WS_HP = WS_BLKB + (size_t)NRG * 32 * 4;
constexpr size_t WS_ACT = WS_HP + (size_t)RPAD * 1024 * 2;
constexpr size_t WS_Y = WS_ACT + (size_t)RPAD * 1024 * 2;
constexpr size_t WS_REC = WS_Y + (size_t)RPAD * 1024 * 2;
constexpr size_t WS_U = WS_REC + (size_t)2 * 4 * 2 * 132 * 57344;
constexpr size_t WS_GL = WS_U + (size_t)2 * 4 * 2 * 132 * 16384;
constexpr size_t WS_END = WS_GL + (size_t)2 * 4 * 2 * 132 * 4 + 256;
constexpr int CW_BAR = 4096;
constexpr int CW_CNT = 16384;
constexpr int CW_Q = 20480;

constexpr int RING_BYTES = 131072;
constexpr int LDSCTL_OFF = RING_BYTES, MISC_OFF = LDSCTL_OFF + 2048;
constexpr int LDS_BYTES = 147456;

#define RLX_AGENT __ATOMIC_RELAXED, __HIP_MEMORY_SCOPE_AGENT
#define LDS_WAIT() asm volatile("s_waitcnt lgkmcnt(0)" ::: "memory")
#define VM_WAIT() asm volatile("s_waitcnt vmcnt(0)" ::: "memory")
__device__ __forceinline__ float bf2f(unsigned b) { return __uint_as_float(b << 16); }
__device__ __forceinline__ float bflo(unsigned w) { return __uint_as_float(w << 16); }
__device__ __forceinline__ float bfhi(unsigned w) { return __uint_as_float(w & 0xffff0000u); }
__device__ __forceinline__ unsigned f2bf(float f) { unsigned u = __float_as_uint(f); return (u + 0x7fffu + ((u >> 16) & 1u)) >> 16; }
__device__ __forceinline__ unsigned pk2(float lo, float hi) { return pg8::cvt_pk_bf16(lo, hi); }
__device__ __forceinline__ float siluf(float x) { return x / (1.f + __expf(-x)); }
__device__ __forceinline__ float sigmf(float x) { return 1.f / (1.f + __expf(-x)); }

#define XB_TMO      128
#define XB_XCNT(j)  (256  + 64 * (j))
#define XB_XSUB(j)  (1280 + 64 * (j))
#define XB_XGEN(j)  (2304 + 64 * (j))
#define XB_TOP      3328
#define XB_TOPGEN   3392
#define XCD_BAR_WORDS 3456
#define XB_SPIN_CAP (1u << 22)
__device__ __forceinline__ unsigned xb_ld(unsigned* p)              { return __hip_atomic_load(p, __ATOMIC_RELAXED, __HIP_MEMORY_SCOPE_AGENT); }
__device__ __forceinline__ unsigned xb_add(unsigned* p, unsigned v) { return __hip_atomic_fetch_add(p, v, __ATOMIC_RELAXED, __HIP_MEMORY_SCOPE_AGENT); }
__device__ __forceinline__ unsigned xb_xcc_id() { return (unsigned)__builtin_amdgcn_s_getreg((3 << 11) | 20) & 0xFu; }
#define XB_SPIN(cond, bar) do { unsigned _sp = 0; while (cond) { __builtin_amdgcn_s_sleep(1); \
    if ((++_sp & 255u) == 0u) { if (xb_ld(&(bar)[XB_TMO])) break; if (_sp > XB_SPIN_CAP) { atomicAdd(&(bar)[XB_TMO], 1u); break; } } } } while (0)
struct XcdBarrier { unsigned* bar; unsigned x; volatile LAS unsigned* st; };
__device__ __forceinline__ XcdBarrier xcd_barrier_post(unsigned* bar, volatile LAS unsigned* st) {
    XcdBarrier b; b.bar = bar; b.x = xb_xcc_id(); b.st = st;
    if (threadIdx.x == 0) (void)xb_add(&bar[XB_XCNT(b.x)], 1u);
    return b;
}
__device__ __forceinline__ void xcd_barrier_complete(unsigned* bar, unsigned x, unsigned& nloc, unsigned& nx) {
    const unsigned G = gridDim.x * gridDim.y * gridDim.z;
    unsigned sum, cnt, mine, sp = 0u;
    for (;;) {
        sum = 0u; cnt = 0u; mine = 0u;
#pragma unroll
        for (unsigned j = 0; j < 16; ++j) { const unsigned c = xb_ld(&bar[XB_XCNT(j)]); sum += c; cnt += (c > 0u) ? 1u : 0u; mine = (j == x) ? c : mine; }
        if (sum == G) break;
        __builtin_amdgcn_s_sleep(1);
        if ((++sp & 255u) == 0u) { if (xb_ld(&bar[XB_TMO])) break; if (sp > XB_SPIN_CAP) { atomicAdd(&bar[XB_TMO], 1u); break; } }
    }
    nloc = mine > 0u ? mine : 1u; nx = cnt > 0u ? cnt : 1u;
}
__device__ __forceinline__ void xcd_barrier(const XcdBarrier& b) {
#ifdef BAR_BRUTE
    __builtin_amdgcn_fence(__ATOMIC_RELEASE, "agent");
#endif
    asm volatile("s_waitcnt vmcnt(0)" ::: "memory");
    __syncthreads();
    if (threadIdx.x == 0) {
        unsigned* bar = b.bar;
        __builtin_amdgcn_s_waitcnt(0);
        unsigned nloc = b.st[0], nx = b.st[1];
        if (nloc == 0u) { xcd_barrier_complete(bar, b.x, nloc, nx); b.st[0] = nloc; b.st[1] = nx; }
        const unsigned old = xb_add(&bar[XB_XSUB(b.x)], 1u);
        const unsigned gen = old / nloc;
        if (old + 1u == (gen + 1u) * nloc) {
            __builtin_amdgcn_fence(__ATOMIC_RELEASE, "agent");
            asm volatile("s_waitcnt vmcnt(0)" ::: "memory");
            const unsigned og = xb_add(&bar[XB_TOP], 1u);
            const unsigned tg = og / nx;
            if (og + 1u == (tg + 1u) * nx) xb_add(&bar[XB_TOPGEN], 1u);
            else XB_SPIN(xb_ld(&bar[XB_TOPGEN]) == tg, bar);
            __builtin_amdgcn_fence(__ATOMIC_ACQUIRE, "agent");
            xb_add(&bar[XB_XGEN(b.x)], 1u);
            asm volatile("s_waitcnt vmcnt(0)" ::: "memory");
        } else {
            XB_SPIN(xb_ld(&bar[XB_XGEN(b.x)]) == gen, bar);
            __builtin_amdgcn_fence(__ATOMIC_ACQUIRE, "agent");
            asm volatile("s_waitcnt vmcnt(0)" ::: "memory");
        }
    }
    __syncthreads();
#ifdef BAR_BRUTE
    __builtin_amdgcn_fence(__ATOMIC_ACQUIRE, "agent");
    asm volatile("s_waitcnt vmcnt(0)" ::: "memory");
    __syncthreads();
#endif
}

struct Args { const float* in[24]; float* out; unsigned char* ws; int ph_lo, ph_hi; };
enum { I_X = 0, I_C, I_CTX, I_CCTX, I_WADA, I_BADA, I_WIN, I_CONVW, I_ALOG, I_DTB, I_GNW, I_DLAM, I_DNW, I_RPB, I_WBR, I_WOUT, I_LNG, I_LNB, I_WR, I_BR, I_W1, I_B1, I_W2, I_B2 };
typedef const __attribute__((address_space(4))) Args* ArgsP;
struct Ctx { LAS unsigned char* lds; unsigned char* ws; ArgsP ap; int G, bid, wv; };
#define PHASE_FN __device__ __forceinline__
__device__ __forceinline__ int rfl(int v) { return __builtin_amdgcn_readfirstlane(v); }
struct Frame {
    ArgsP ap;
    LAS unsigned char* lds;
    unsigned* ctl;
    unsigned char* ws;
    int tid, lane, wave, G, bid, wv;
};
#define REFRESH(F) do { int l_; asm volatile("v_mbcnt_lo_u32_b32 %0, -1, 0\n\tv_mbcnt_hi_u32_b32 %0, -1, %0" : "=v"(l_)); (F).lane = l_; (F).wave = (F).wv; (F).tid = (F).wv * 64 + l_; } while (0)
__device__ __forceinline__ Frame mkframe(const Ctx& c) {
    Frame F;
    F.lds = (LAS unsigned char*)(size_t)(unsigned)rfl((int)(unsigned)(size_t)c.lds);
    { const unsigned long long w = (unsigned long long)c.ws; F.ws = (unsigned char*)(((unsigned long long)(unsigned)rfl((int)(unsigned)(w >> 32)) << 32) | (unsigned)rfl((int)(unsigned)w)); }
    { const unsigned long long w = (unsigned long long)c.ap; F.ap = (ArgsP)(((unsigned long long)(unsigned)rfl((int)(unsigned)(w >> 32)) << 32) | (unsigned)rfl((int)(unsigned)w)); }
    F.ctl = (unsigned*)F.ws; F.G = rfl(c.G); F.bid = rfl(c.bid); F.wv = rfl(c.wv); F.wave = F.wv; F.lane = 0; F.tid = 0;
    return F;
}
__device__ __forceinline__ float wave_sum(float v) {
#pragma unroll
    for (int o = 1; o < 64; o <<= 1) v += __shfl_xor(v, o);
    return v;
}
__device__ __forceinline__ float wave_max(float v) {
#pragma unroll
    for (int o = 1; o < 64; o <<= 1) v = fmaxf(v, __shfl_xor(v, o));
    return v;
}
__device__ __forceinline__ int mod_index(int row) { return row < MLAT ? (row >> 13) : 2; }
static_assert(WS_YB == WS_YA + (size_t)MT * 512 * 2 && WS_YC == WS_YB + (size_t)MT * 512 * 2, "YA|YB|YC contiguous");
__device__ __forceinline__ void transpose_item(const float* W, int ldw, int K, int src_col0, bf16* WT, int dst_row0, int k0, LAS float* scr, int lane) {
#pragma unroll 8
    for (int i = 0; i < 32; ++i) { const int kk = 2 * i + (lane >> 5); scr[kk * 33 + (lane & 31)] = W[(size_t)(k0 + kk) * ldw + src_col0 + (lane & 31)]; }
    LDS_WAIT(); asm volatile("" ::: "memory");
    const int c = lane & 7;
#pragma unroll
    for (int j = 0; j < 4; ++j) { const int n = (lane >> 3) + 8 * j; const LAS float* s = scr + (8 * c) * 33 + n;
        u32x4 o; o.x = pk2(s[0 * 33], s[1 * 33]); o.y = pk2(s[2 * 33], s[3 * 33]); o.z = pk2(s[4 * 33], s[5 * 33]); o.w = pk2(s[6 * 33], s[7 * 33]);
        *(u32x4*)(WT + (size_t)(dst_row0 + n) * K + k0 + 8 * c) = o; }
    LDS_WAIT(); asm volatile("" ::: "memory");
}
constexpr int IT_WIN = DEPTH * 16 * 256, IT_WBR = DEPTH * 3 * 8 * 32, IT_WOUT = DEPTH * 16 * 32, IT_W1 = DEPTH * 32 * 16 * 64, IT_W2 = DEPTH * 32 * 16 * 32;
constexpr int IT_ALL = IT_WIN + IT_WBR + IT_WOUT + IT_W1 + IT_W2;

PHASE_FN void p0_prologue(Ctx cx) {
    Frame F = mkframe(cx); const ArgsP a = F.ap;
    REFRESH(F);
    unsigned char* ws = F.ws;
    LAS float* scr = (LAS float*)(F.lds + F.wave * 16384);
    const int gw = F.bid * NWAVES + F.wave, NGW = F.G * NWAVES;
    for (int it = gw; it < IT_ALL; it += NGW) {
        int r = it;
        if (r < IT_WIN) { const int l = r / 4096, q = r % 4096, kb = q / 256, nb = q % 256, d0 = 32 * nb, s0 = d0 + (d0 >= 2048 ? 16 : 0);
            transpose_item(a->in[I_WIN] + (size_t)l * 1024 * D_IN, D_IN, 1024, s0, (bf16*)(ws + WS_WIN) + (size_t)l * 8192 * 1024, d0, 64 * kb, scr, F.lane); continue; }
        r -= IT_WIN;
        if (r < IT_WBR) { const int mi = r / 256, q = r % 256, kb = q / 32, nb = q % 32;
            transpose_item(a->in[I_WBR] + (size_t)mi * 512 * 1024, 1024, 512, 32 * nb, (bf16*)(ws + WS_WBR) + (size_t)mi * 1024 * 512, 32 * nb, 64 * kb, scr, F.lane); continue; }
        r -= IT_WBR;
        if (r < IT_WOUT) { const int l = r / 512, q = r % 512, kb = q / 32, nb = q % 32;
            transpose_item(a->in[I_WOUT] + (size_t)l * 1024 * 1024, 1024, 1024, 32 * nb, (bf16*)(ws + WS_WOUT) + (size_t)l * 1024 * 1024, 32 * nb, 64 * kb, scr, F.lane); continue; }
        r -= IT_WOUT;
        if (r < IT_W1) { const int mi = r / 1024, q = r % 1024, kb = q / 64, nb = q % 64, d0 = 32 * nb, pn = d0 >> 8, bj = (d0 >> 7) & 1, j = d0 & 127, s0 = 1024 * bj + 128 * pn + j;
            transpose_item(a->in[I_W1] + (size_t)mi * 1024 * 2048, 2048, 1024, s0, (bf16*)(ws + WS_W1) + (size_t)mi * 2048 * 1024, d0, 64 * kb, scr, F.lane); continue; }
        r -= IT_W1;
        { const int mi = r / 512, q = r % 512, kb = q / 32, nb = q % 32;
            transpose_item(a->in[I_W2] + (size_t)mi * 1024 * 1024, 1024, 1024, 32 * nb, (bf16*)(ws + WS_W2) + (size_t)mi * 1024 * 1024, 32 * nb, 64 * kb, scr, F.lane); }
    }
    const size_t gt = (size_t)F.bid * NTHREADS + F.tid, NGT = (size_t)F.G * NTHREADS;
    { float* wd = (float*)(ws + WS_WDEC);
      for (size_t i = gt; i < (size_t)DEPTH * 16 * 1024; i += NGT) { const int l = (int)(i >> 14), c = (int)(i >> 10) & 15, k = (int)i & 1023; wd[i] = a->in[I_WIN][((size_t)l * 1024 + k) * D_IN + 2048 + c]; }
      float* wr = (float*)(ws + WS_WRT);
      for (size_t i = gt; i < (size_t)DEPTH * 32 * 1024; i += NGT) { const int l = (int)(i >> 15), e = (int)(i >> 10) & 31, k = (int)i & 1023; wr[i] = a->in[I_WR][((size_t)l * 1024 + k) * 32 + e]; } }
    { f32x4* X4 = (f32x4*)(ws + WS_X); const f32x4* x4 = (const f32x4*)a->in[I_X]; const f32x4* c4 = (const f32x4*)a->in[I_CTX];
      for (size_t i = gt; i < (size_t)MT * 256; i += NGT) X4[i] = i < (size_t)MLAT * 256 ? x4[i] : c4[i - (size_t)MLAT * 256]; }
    if (F.bid == 0 && F.wave < DEPTH) { const int l = F.wave; const float* lv = a->in[I_DLAM] + l * 256;
        const float s1 = wave_sum(lv[F.lane] * lv[64 + F.lane]), s2 = wave_sum(lv[128 + F.lane] * lv[192 + F.lane]);
        if (F.lane == 0) ((float*)(ws + WS_LAM))[l] = expf(s1) - expf(s2) + (0.8f - 0.6f * expf(-0.3f * (float)l)); }
    { LAS float* red = (LAS float*)(F.lds);
      float* MOD = (float*)(ws + WS_MOD);
      __syncthreads();
      for (int it = F.bid; it < DEPTH * 96; it += F.G) {
        const int l = it / 96, n = (it % 96) * 64 + F.lane; const float* wa = a->in[I_WADA] + (size_t)l * 1024 * 6144 + n;
        float a0 = 0.f, a1 = 0.f, a2 = 0.f;
        for (int k = F.wave * 128; k < F.wave * 128 + 128; ++k) { const float w = wa[(size_t)k * 6144];
            a0 += siluf(a->in[I_C][k]) * w; a1 += siluf(a->in[I_C][1024 + k]) * w; a2 += siluf(a->in[I_CCTX][k]) * w; }
        red[(F.wave * 3 + 0) * 64 + F.lane] = a0; red[(F.wave * 3 + 1) * 64 + F.lane] = a1; red[(F.wave * 3 + 2) * 64 + F.lane] = a2;
        __syncthreads();
        if (F.tid < 192) { const int i = F.tid >> 6, c = F.tid & 63; float s = 0.f;
#pragma unroll
            for (int w = 0; w < 8; ++w) s += red[(w * 3 + i) * 64 + c];
            const int nn = (it % 96) * 64 + c; MOD[((size_t)l * 3 + i) * 6144 + nn] = s + a->in[I_BADA][l * 6144 + nn]; }
        __syncthreads();
      } }
}

__device__ __forceinline__ void ln_inplace(f32x4 (&v)[4]) {
    float s = 0.f;
#pragma unroll
    for (int j = 0; j < 4; ++j) s += (v[j].x + v[j].y) + (v[j].z + v[j].w);
    const float mean = wave_sum(s) * (1.f / DM); float s2 = 0.f;
#pragma unroll
    for (int j = 0; j < 4; ++j) { v[j] = v[j] - mean; s2 += (v[j].x * v[j].x + v[j].y * v[j].y) + (v[j].z * v[j].z + v[j].w * v[j].w); }
    const float rstd = 1.f / sqrtf(wave_sum(s2) * (1.f / DM) + LN_EPS);
#pragma unroll
    for (int j = 0; j < 4; ++j) v[j] = v[j] * rstd;
}
__device__ __forceinline__ void modulate_store(const Frame& F, int l, int which, int row, f32x4 (&v)[4]) {
    ln_inplace(v);
    const float* mod = (const float*)(F.ws + WS_MOD) + ((size_t)l * 3 + mod_index(row)) * 6144 + which * 3072;
    bf16* hx = (bf16*)(F.ws + WS_HX) + (size_t)row * DM;
#pragma unroll
    for (int j = 0; j < 4; ++j) { const int c = 4 * F.lane + 256 * j; const f32x4 sh = *(const f32x4*)(mod + c), sc = *(const f32x4*)(mod + 1024 + c);
        v[j] = v[j] * (sc + 1.f) + sh;
        u32x2 o; o.x = pk2(v[j].x, v[j].y); o.y = pk2(v[j].z, v[j].w); *(u32x2*)(hx + c) = o; }
}
__device__ __forceinline__ void decay_cols(const Frame& F, int l, int row, const f32x4 (&h)[4]) {
    const float* wd = (const float*)(F.ws + WS_WDEC) + (size_t)l * 16 * 1024; float* dec = (float*)(F.ws + WS_DEC) + (size_t)row * 16;
    float mine = 0.f;
#pragma unroll
    for (int i = 0; i < 16; ++i) { float s = 0.f;
#pragma unroll
        for (int j = 0; j < 4; ++j) { const f32x4 w = *(const f32x4*)(wd + i * 1024 + 4 * F.lane + 256 * j); s += (h[j].x * w.x + h[j].y * w.y) + (h[j].z * w.z + h[j].w * w.w); }
        s = wave_sum(s); if (F.lane == i) mine = s; }
    if (F.lane < 16) dec[F.lane] = mine;
}
PHASE_FN void ph_lnmod0(Ctx cx) {
    Frame F = mkframe(cx);
    REFRESH(F);
    const int gw = F.bid * NWAVES + F.wave, NGW = F.G * NWAVES;
    for (int row = gw; row < MT; row += NGW) { f32x4 v[4]; const f32x4* xr = (const f32x4*)(F.ws + WS_X) + (size_t)row * 256 + F.lane;
#pragma unroll
        for (int j = 0; j < 4; ++j) v[j] = xr[64 * j];
        modulate_store(F, 0, 0, row, v); decay_cols(F, 0, row, v); }
}

struct TileMap {
    __device__ static __forceinline__ bool map(int i, int G, int c, int nM, int nN, int& pm, int& pn) {
        const int nwg = nM * nN; const long L = (long)i * G + c; if (L >= nwg) return false;
        int wgid = (int)L; { const int q = nwg / 8, r = nwg % 8, xcd = wgid % 8, off = wgid / 8; wgid = (xcd < r ? xcd * (q + 1) : r * (q + 1) + (xcd - r) * q) + off; }
        const int nig = 8 * nN, gid = wgid / nig, fm = gid * 8, gsz = (nM - fm) < 8 ? (nM - fm) : 8;
        pm = fm + ((wgid % nig) % gsz); pn = (wgid % nig) / gsz; return true; }
};
struct StaticOrder { int nM, nN, G, c, K;
    __device__ __forceinline__ bool next(int i, pg8::Unit& u) const { if (!TileMap::map(i, G, c, nM, nN, u.pm, u.pn)) return false; u.aux = 0;
        u.aoff = (unsigned)u.pm * 256u * (unsigned)K * 2u; u.boff = (unsigned)u.pn * 256u * (unsigned)K * 2u; return true; } };
struct MergeOrder { int G, c;
    __device__ __forceinline__ bool next(int i, pg8::Unit& u) const { const int br = i % 3; if (!TileMap::map(i / 3, G, c, MT / 256, 4, u.pm, u.pn)) return false; u.aux = br;
        u.aoff = (unsigned)br * (unsigned)(MT * 512 * 2) + (unsigned)u.pm * (256u * 512u * 2u); u.boff = ((unsigned)br * 1024u + (unsigned)u.pn * 256u) * (512u * 2u); return true; } };
struct MoeOrder { const volatile LAS int* tab;
    __device__ __forceinline__ bool next(int i, pg8::Unit& u) const { const int w = tab[416 + i]; if (w < 0) return false; u.pm = w & 0xfff; u.pn = (w >> 12) & 0xf; u.aux = (w >> 16) & 0xff; const int nN = (w >> 24) & 0xf;
        u.aoff = (unsigned)u.pm * (256u * 1024u * 2u); u.boff = (unsigned)((u.aux * nN + u.pn) * 256) * (1024u * 2u); return true; } };

struct EpiWin { bf16* P;
    __device__ __forceinline__ void operator()(const f32x4 (&acc)[2][2][4][2], const pg8::Unit& u, int wr, int wc, int fr, int fq) const {
        const int row0 = u.pm * 256 + wr * 64 + fr, col0 = u.pn * 256 + wc * 32 + 8 * fq; const bool sg = u.pn >= 20;
#pragma unroll
        for (int ai = 0; ai < 2; ++ai)
#pragma unroll
            for (int m = 0; m < 4; ++m) { bf16* rowp = P + (size_t)(row0 + ai * 128 + m * 16) * NP + col0;
#pragma unroll
                for (int bj = 0; bj < 2; ++bj) { f32x4 v0 = acc[ai][bj][m][0], v1 = acc[ai][bj][m][1];
                    if (sg) {
#pragma unroll
                        for (int q = 0; q < 4; ++q) { v0[q] = sigmf(v0[q]); v1[q] = sigmf(v1[q]); } }
                    u32x4 w; w.x = pk2(v0[0], v0[1]); w.y = pk2(v0[2], v0[3]); w.z = pk2(v1[0], v1[1]); w.w = pk2(v1[2], v1[3]);
                    *(u32x4*)(rowp + bj * 128) = w; } }
    } };
struct EpiMerge { const bf16* P; float* MACC; bf16* MBF;
    __device__ __forceinline__ void operator()(const f32x4 (&acc)[2][2][4][2], const pg8::Unit& u, int wr, int wc, int fr, int fq) const {
        const int row0 = u.pm * 256 + wr * 64 + fr, col0 = u.pn * 256 + wc * 32 + 8 * fq, br = u.aux;
#pragma unroll
        for (int ai = 0; ai < 2; ++ai)
#pragma unroll
            for (int m = 0; m < 4; ++m) { const size_t row = (size_t)(row0 + ai * 128 + m * 16);
#pragma unroll
                for (int bj = 0; bj < 2; ++bj) { const int col = col0 + bj * 128;
                    const u32x4 g = *(const u32x4*)(P + row * NP + PC_GATE + 1024 * br + col);
                    f32x4 v0 = acc[ai][bj][m][0], v1 = acc[ai][bj][m][1];
                    v0[0] *= bflo(g.x); v0[1] *= bfhi(g.x); v0[2] *= bflo(g.y); v0[3] *= bfhi(g.y); v1[0] *= bflo(g.z); v1[1] *= bfhi(g.z); v1[2] *= bflo(g.w); v1[3] *= bfhi(g.w);
                    float* mp = MACC + row * DM + col;
                    if (br > 0) { v0 = v0 + *(const f32x4*)mp; v1 = v1 + *(const f32x4*)(mp + 4); }
                    if (br < 2) { *(f32x4*)mp = v0; *(f32x4*)(mp + 4) = v1; }
                    else { u32x4 w; w.x = pk2(v0[0], v0[1]); w.y = pk2(v0[2], v0[3]); w.z = pk2(v1[0], v1[1]); w.w = pk2(v1[2], v1[3]); *(u32x4*)(MBF + row * DM + col) = w; } } }
    } };
struct EpiWout { const float* X; const float* MODL; float* T;
    __device__ __forceinline__ void operator()(const f32x4 (&acc)[2][2][4][2], const pg8::Unit& u, int wr, int wc, int fr, int fq) const {
        const int row0 = u.pm * 256 + wr * 64 + fr, col0 = u.pn * 256 + wc * 32 + 8 * fq; const float* g1 = MODL + (size_t)(u.pm < 64 ? (u.pm >> 5) : 2) * 6144 + 2048;
#pragma unroll
        for (int bj = 0; bj < 2; ++bj) { const int col = col0 + bj * 128; const f32x4 ga = *(const f32x4*)(g1 + col), gb = *(const f32x4*)(g1 + col + 4);
#pragma unroll
            for (int ai = 0; ai < 2; ++ai)
#pragma unroll
                for (int m = 0; m < 4; ++m) { const size_t o = (size_t)(row0 + ai * 128 + m * 16) * DM + col;
                    const f32x4 xa = *(const f32x4*)(X + o), xb = *(const f32x4*)(X + o + 4);
                    *(f32x4*)(T + o) = xa * DN_ALPHA + ga * acc[ai][bj][m][0]; *(f32x4*)(T + o + 4) = xb * DN_ALPHA + gb * acc[ai][bj][m][1]; } }
    } };
struct EpiAct { const float* B1; bf16* ACT;
    __device__ __forceinline__ void operator()(const f32x4 (&acc)[2][2][4][2], const pg8::Unit& u, int wr, int wc, int fr, int fq) const {
        const int row0 = u.pm * 256 + wr * 64 + fr, cc = u.pn * 128 + wc * 32 + 8 * fq; const float* b = B1 + (size_t)u.aux * 2048;
        const f32x4 bg0 = *(const f32x4*)(b + cc), bg1 = *(const f32x4*)(b + cc + 4), bl0 = *(const f32x4*)(b + 1024 + cc), bl1 = *(const f32x4*)(b + 1024 + cc + 4);
#pragma unroll
        for (int ai = 0; ai < 2; ++ai)
#pragma unroll
            for (int m = 0; m < 4; ++m) { const size_t row = (size_t)(row0 + ai * 128 + m * 16);
                f32x4 g0 = acc[ai][0][m][0] + bg0, g1 = acc[ai][0][m][1] + bg1, l0 = acc[ai][1][m][0] + bl0, l1 = acc[ai][1][m][1] + bl1; float r[8];
#pragma unroll
                for (int q = 0; q < 4; ++q) { const float xg = fminf(g0[q], 7.f), xl = fminf(fmaxf(l0[q], -7.f), 7.f); r[q] = xg * sigmf(1.702f * xg) * (xl + 1.f);
                    const float yg = fminf(g1[q], 7.f), yl = fminf(fmaxf(l1[q], -7.f), 7.f); r[4 + q] = yg * sigmf(1.702f * yg) * (yl + 1.f); }
                u32x4 w; w.x = pk2(r[0], r[1]); w.y = pk2(r[2], r[3]); w.z = pk2(r[4], r[5]); w.w = pk2(r[6], r[7]);
                *(u32x4*)(ACT + row * 1024 + cc) = w; }
    } };
struct EpiY { const float* B2; bf16* Y;
    __device__ __forceinline__ void operator()(const f32x4 (&acc)[2][2][4][2], const pg8::Unit& u, int wr, int wc, int fr, int fq) const {
        const int row0 = u.pm * 256 + wr * 64 + fr, col0 = u.pn * 256 + wc * 32 + 8 * fq; const float* b = B2 + (size_t)u.aux * 1024;
#pragma unroll
        for (int bj = 0; bj < 2; ++bj) { const int col = col0 + bj * 128; const f32x4 ba = *(const f32x4*)(b + col), bb = *(const f32x4*)(b + col + 4);
#pragma unroll
            for (int ai = 0; ai < 2; ++ai)
#pragma unroll
                for (int m = 0; m < 4; ++m) { const size_t row = (size_t)(row0 + ai * 128 + m * 16); const f32x4 v0 = acc[ai][bj][m][0] + ba, v1 = acc[ai][bj][m][1] + bb;
                    u32x4 w; w.x = pk2(v0[0], v0[1]); w.y = pk2(v0[2], v0[3]); w.z = pk2(v1[0], v1[1]); w.w = pk2(v1[2], v1[3]); *(u32x4*)(Y + row * 1024 + col) = w; } }
    } };
PHASE_FN void ph_prep(Ctx cx, int l_) {
    Frame F = mkframe(cx); const ArgsP a = F.ap; const int l = rfl(l_);
    REFRESH(F);
    const int gw = F.bid * NWAVES + F.wave, NGW = F.G * NWAVES;
    bf16* P = (bf16*)(F.ws + WS_P);
    for (int row = gw; row < MLAT; row += NGW) {
        const int t = row & (SEQ - 1), j = F.lane & 31, f = j & 15; const float pos = (float)(j < 16 ? (t >> 6) : (t & 63));
        const float inv = exp2f(-(float)f * (13.287712379549449f / 16.f));
        const float ang = pos * inv, rev = ang * 0.15915494309189535f, fr = rev - floorf(rev);
        const float cs = __builtin_amdgcn_cosf(fr), sn = __builtin_amdgcn_sinf(fr);
        bf16* pr = P + (size_t)row * NP + PC_DQ;
#pragma unroll
        for (int it = 0; it < 8; ++it) { const int blk = 2 * it + (F.lane >> 5); bf16* p = pr + blk * 64 + j;
            const float x1 = bf2f(p[0]), x2 = bf2f(p[32]); p[0] = (bf16)f2bf(x1 * cs - x2 * sn); p[32] = (bf16)f2bf(x2 * cs + x1 * sn); }
    }
#if !USE_GDN_FAST
    float* QN = (float*)(F.ws + WS_QN); float* KN = (float*)(F.ws + WS_KN); float* VV = (float*)(F.ws + WS_VV);
    const float* cw = a->in[I_CONVW] + (size_t)l * 3 * 1536;
    for (int row = gw; row < MT; row += NGW) {
        const bool lat = row < MLAT; const int t = lat ? (row & (SEQ - 1)) : ((row - MLAT) & (CTXL - 1)), L = lat ? SEQ : CTXL; const bool hm = t > 0, hp = t < L - 1;
        const bf16* p0 = P + (size_t)row * NP;
#pragma unroll
        for (int wh = 0; wh < 3; ++wh)
#pragma unroll
            for (int h = 0; h < 4; ++h) { const int c = wh * 512 + h * 128 + 2 * F.lane;
                const unsigned x0 = *(const unsigned*)(p0 + c), xm = hm ? *(const unsigned*)(p0 - NP + c) : 0u, xp = hp ? *(const unsigned*)(p0 + NP + c) : 0u;
                const f32x2 w0 = *(const f32x2*)(cw + c), w1 = *(const f32x2*)(cw + 1536 + c), w2 = *(const f32x2*)(cw + 3072 + c);
                float y0 = bflo(xm) * w0.x + bflo(x0) * w1.x + bflo(xp) * w2.x, y1 = bfhi(xm) * w0.y + bfhi(x0) * w1.y + bfhi(xp) * w2.y;
                y0 = siluf(y0); y1 = siluf(y1);
                if (wh < 2) { const float ss = wave_sum(y0 * y0 + y1 * y1), sc = (1.f / sqrtf(ss + RMS_EPS)) * (wh == 0 ? 0.08838834764831845f : 1.f); y0 *= sc; y1 *= sc; }
                float* o = (wh == 0 ? QN : wh == 1 ? KN : VV) + (size_t)row * 512 + h * 128 + 2 * F.lane; *(f32x2*)o = (f32x2){y0, y1}; }
    }
#endif
}

PHASE_FN void ph_gdn_chain_naive(Ctx cx, int l_) {
    Frame F = mkframe(cx); const ArgsP a = F.ap; const int l = rfl(l_);
    REFRESH(F);
    LAS float* kq = (LAS float*)F.lds;
    const float* QN = (const float*)(F.ws + WS_QN); const float* KN = (const float*)(F.ws + WS_KN); const float* VV = (const float*)(F.ws + WS_VV);
    const float* DEC = (const float*)(F.ws + WS_DEC); float* OG = (float*)(F.ws + WS_OG);
    for (int it = F.bid; it < 16; it += F.G) {
        const int b = it >> 3, h = (it >> 1) & 3, d = it & 1, v = (F.tid >> 1) & 127, hf = F.tid & 1;
        const float al = expf(a->in[I_ALOG][(l * 2 + d) * 4 + h]), dtb = a->in[I_DTB][(l * 2 + d) * 4 + h];
        float S[64];
#pragma unroll
        for (int k = 0; k < 64; ++k) S[k] = 0.f;
        __syncthreads();
        for (int step = 0; step < CTXL + SEQ; ++step) {
            int row; if (step < CTXL) { const int pos = d ? CTXL - 1 - step : step; row = MLAT + b * CTXL + pos; } else { const int tt = step - CTXL, pos = d ? SEQ - 1 - tt : tt; row = b * SEQ + pos; }
            LAS float* buf = kq + (step & 1) * 256;
            if (F.tid >= 256) { if (F.tid < 384) buf[F.tid - 256] = KN[(size_t)row * 512 + h * 128 + F.tid - 256]; else buf[F.tid - 256] = QN[(size_t)row * 512 + h * 128 + F.tid - 384]; }
            __syncthreads();
            if (F.tid < 256) {
                const float av = DEC[(size_t)row * 16 + 8 * d + h] + dtb, bb = DEC[(size_t)row * 16 + 8 * d + 4 + h];
                const float sp = av > 20.f ? av : log1pf(expf(av)); const float eg = expf(-al * sp), beta = sigmf(bb);
                const float vt = VV[(size_t)row * 512 + h * 128 + v];
                const LAS float* kb = buf + 64 * hf; const LAS float* qb = buf + 128 + 64 * hf;
                float kS = 0.f;
#pragma unroll
                for (int k4 = 0; k4 < 16; ++k4) { const f32x4 kk = *(const LAS f32x4*)(kb + 4 * k4); kS += (kk.x * S[4 * k4] + kk.y * S[4 * k4 + 1]) + (kk.z * S[4 * k4 + 2] + kk.w * S[4 * k4 + 3]); }
                kS += __shfl_xor(kS, 1);
                const float vn = beta * (vt - eg * kS); float o = 0.f;
#pragma unroll
                for (int k4 = 0; k4 < 16; ++k4) { const f32x4 kk = *(const LAS f32x4*)(kb + 4 * k4), qq = *(const LAS f32x4*)(qb + 4 * k4);
                    S[4 * k4] = eg * S[4 * k4] + kk.x * vn; S[4 * k4 + 1] = eg * S[4 * k4 + 1] + kk.y * vn; S[4 * k4 + 2] = eg * S[4 * k4 + 2] + kk.z * vn; S[4 * k4 + 3] = eg * S[4 * k4 + 3] + kk.w * vn;
                    o += (qq.x * S[4 * k4] + qq.y * S[4 * k4 + 1]) + (qq.z * S[4 * k4 + 2] + qq.w * S[4 * k4 + 3]); }
                o += __shfl_xor(o, 1);
                if (hf == 0) OG[((size_t)d * MT + row) * 512 + h * 128 + v] = o;
            }
        }
        __syncthreads();
    }
}

PHASE_FN void ph_diff_naive(Ctx cx, int l_) {
    Frame F = mkframe(cx); const int l = rfl(l_);
    REFRESH(F);
    LAS float* Kf = (LAS float*)F.lds;
    LAS float* Vf = (LAS float*)(F.lds + 16384);
    const bf16* P = (const bf16*)(F.ws + WS_P); float* OD = (float*)(F.ws + WS_OD);
    for (int it = F.bid; it < 512 + 16; it += F.G) {
        int b, h, m, q0, t0, t1;
        if (it < 512) { b = it >> 8; h = (it >> 6) & 3; m = (it >> 5) & 1; q0 = b * SEQ + (it & 31) * 256; t0 = 0; t1 = 132; }
        else { const int j = it - 512; b = j >> 3; h = (j >> 1) & 3; m = j & 1; q0 = MLAT + b * CTXL; t0 = 128; t1 = 132; }
        const int qi = F.tid & 255, eh = F.tid >> 8;
        float q[64], o[64];
        { const bf16* qp = P + (size_t)(q0 + qi) * NP + PC_DQ + h * 128 + m * 64;
#pragma unroll
          for (int d8 = 0; d8 < 8; ++d8) { const u32x4 w = *(const u32x4*)(qp + 8 * d8); q[8 * d8] = bflo(w.x) * 0.125f; q[8 * d8 + 1] = bfhi(w.x) * 0.125f; q[8 * d8 + 2] = bflo(w.y) * 0.125f; q[8 * d8 + 3] = bfhi(w.y) * 0.125f;
              q[8 * d8 + 4] = bflo(w.z) * 0.125f; q[8 * d8 + 5] = bfhi(w.z) * 0.125f; q[8 * d8 + 6] = bflo(w.w) * 0.125f; q[8 * d8 + 7] = bfhi(w.w) * 0.125f; } }
#pragma unroll
        for (int e = 0; e < 64; ++e) o[e] = 0.f;
        float mx = -1e30f, ls = 0.f;
        for (int t = t0; t < t1; ++t) {
            const int krow0 = t < 128 ? b * SEQ + 64 * t : MLAT + b * CTXL + 64 * (t - 128);
            __syncthreads();
            { const int key = F.tid >> 3, c8 = (F.tid & 7) * 8; const bf16* kp = P + (size_t)(krow0 + key) * NP + PC_DK + h * 128 + m * 64 + c8; const u32x4 w = *(const u32x4*)kp;
              LAS float* kd = Kf + key * 64 + c8; *(LAS f32x4*)kd = (f32x4){bflo(w.x), bfhi(w.x), bflo(w.y), bfhi(w.y)}; *(LAS f32x4*)(kd + 4) = (f32x4){bflo(w.z), bfhi(w.z), bflo(w.w), bfhi(w.w)};
              const int c16 = (F.tid & 7) * 16; const bf16* vp = P + (size_t)(krow0 + key) * NP + PC_DV + h * 128 + c16; const u32x4 w0 = *(const u32x4*)vp, w1 = *(const u32x4*)(vp + 8);
              LAS float* vd = Vf + key * 128 + c16; *(LAS f32x4*)vd = (f32x4){bflo(w0.x), bfhi(w0.x), bflo(w0.y), bfhi(w0.y)}; *(LAS f32x4*)(vd + 4) = (f32x4){bflo(w0.z), bfhi(w0.z), bflo(w0.w), bfhi(w0.w)};
              *(LAS f32x4*)(vd + 8) = (f32x4){bflo(w1.x), bfhi(w1.x), bflo(w1.y), bfhi(w1.y)}; *(LAS f32x4*)(vd + 12) = (f32x4){bflo(w1.z), bfhi(w1.z), bflo(w1.w), bfhi(w1.w)}; }
            __syncthreads();
            for (int kk = 0; kk < 64; ++kk) {
                float s = 0.f;
#pragma unroll
                for (int d4 = 0; d4 < 16; ++d4) { const f32x4 kv = *(const LAS f32x4*)(Kf + kk * 64 + 4 * d4); s += (q[4 * d4] * kv.x + q[4 * d4 + 1] * kv.y) + (q[4 * d4 + 2] * kv.z + q[4 * d4 + 3] * kv.w); }
                const float mn = fmaxf(mx, s), corr = __expf(mx - mn), p = __expf(s - mn); mx = mn; ls = ls * corr + p;
#pragma unroll
                for (int e4 = 0; e4 < 16; ++e4) { const f32x4 vv = *(const LAS f32x4*)(Vf + kk * 128 + eh * 64 + 4 * e4);
                    o[4 * e4] = o[4 * e4] * corr + p * vv.x; o[4 * e4 + 1] = o[4 * e4 + 1] * corr + p * vv.y; o[4 * e4 + 2] = o[4 * e4 + 2] * corr + p * vv.z; o[4 * e4 + 3] = o[4 * e4 + 3] * corr + p * vv.w; }
            }
        }
        const float il = 1.f / ls; float* op = OD + ((size_t)m * MT + q0 + qi) * 512 + h * 128 + eh * 64;
#pragma unroll
        for (int e4 = 0; e4 < 16; ++e4) *(f32x4*)(op + 4 * e4) = (f32x4){o[4 * e4] * il, o[4 * e4 + 1] * il, o[4 * e4 + 2] * il, o[4 * e4 + 3] * il};
    }
    __syncthreads();
}

__device__ __forceinline__ void na_key(const bf16* kp, const bf16* vp, const float (&q)[64], float bias, float& mx, float& ls, float (&o)[64]) {
    float s = 0.f;
#pragma unroll
    for (int d8 = 0; d8 < 8; ++d8) { const u32x4 w = *(const u32x4*)(kp + 8 * d8);
        s += (q[8 * d8] * bflo(w.x) + q[8 * d8 + 1] * bfhi(w.x)) + (q[8 * d8 + 2] * bflo(w.y) + q[8 * d8 + 3] * bfhi(w.y)) + (q[8 * d8 + 4] * bflo(w.z) + q[8 * d8 + 5] * bfhi(w.z)) + (q[8 * d8 + 6] * bflo(w.w) + q[8 * d8 + 7] * bfhi(w.w)); }
    s += bias;
    const float mn = fmaxf(mx, s), corr = __expf(mx - mn), p = __expf(s - mn); mx = mn; ls = ls * corr + p;
#pragma unroll
    for (int d8 = 0; d8 < 8; ++d8) { const u32x4 w = *(const u32x4*)(vp + 8 * d8);
        o[8 * d8] = o[8 * d8] * corr + p * bflo(w.x); o[8 * d8 + 1] = o[8 * d8 + 1] * corr + p * bfhi(w.x); o[8 * d8 + 2] = o[8 * d8 + 2] * corr + p * bflo(w.y); o[8 * d8 + 3] = o[8 * d8 + 3] * corr + p * bfhi(w.y);
        o[8 * d8 + 4] = o[8 * d8 + 4] * corr + p * bflo(w.z); o[8 * d8 + 5] = o[8 * d8 + 5] * corr + p * bfhi(w.z); o[8 * d8 + 6] = o[8 * d8 + 6] * corr + p * bflo(w.w); o[8 * d8 + 7] = o[8 * d8 + 7] * corr + p * bfhi(w.w); }
}
PHASE_FN void ph_na_naive(Ctx cx, int l_) {
    Frame F = mkframe(cx); const ArgsP a = F.ap; const int l = rfl(l_);
    REFRESH(F);
    const bf16* P = (const bf16*)(F.ws + WS_P); bf16* YC = (bf16*)(F.ws + WS_YC);
    const int gt = F.bid * NTHREADS + F.tid, NGT = F.G * NTHREADS;
    for (int idx = gt; idx < 8 * MT; idx += NGT) {
        int b, h, qrow, t; bool lat = idx < 8 * MLAT;
        if (lat) { b = idx >> 16; h = (idx >> 13) & 7; t = idx & (SEQ - 1); qrow = b * SEQ + t; } else { const int j = idx - 8 * MLAT; b = j >> 11; h = (j >> 8) & 7; t = j & 255; qrow = MLAT + b * CTXL + t; }
        float q[64], o[64];
        { const bf16* qp = P + (size_t)qrow * NP + PC_NQ + h * 64;
#pragma unroll
          for (int d8 = 0; d8 < 8; ++d8) { const u32x4 w = *(const u32x4*)(qp + 8 * d8); q[8 * d8] = bflo(w.x) * 0.125f; q[8 * d8 + 1] = bfhi(w.x) * 0.125f; q[8 * d8 + 2] = bflo(w.y) * 0.125f; q[8 * d8 + 3] = bfhi(w.y) * 0.125f;
              q[8 * d8 + 4] = bflo(w.z) * 0.125f; q[8 * d8 + 5] = bfhi(w.z) * 0.125f; q[8 * d8 + 6] = bflo(w.w) * 0.125f; q[8 * d8 + 7] = bfhi(w.w) * 0.125f; } }
#pragma unroll
        for (int e = 0; e < 64; ++e) o[e] = 0.f;
        float mx = -1e30f, ls = 0.f;
        if (lat) { const int r = t >> 6, c = t & 63; const int r0 = min(max(r - 4, 0), 120), c0 = min(max(c - 8, 0), 48);
            const float* rp = a->in[I_RPB] + ((size_t)l * 8 + h) * 15 * 31;
            for (int kr = 0; kr < 8; ++kr) for (int kc = 0; kc < 16; ++kc) { const int krow = b * SEQ + (r0 + kr) * 64 + c0 + kc;
                const float bias = rp[(r0 + kr - r + 7) * 31 + (c0 + kc - c + 15)];
                na_key(P + (size_t)krow * NP + PC_NK + h * 64, P + (size_t)krow * NP + PC_NV + h * 64, q, bias, mx, ls, o); } }
        for (int j = 0; j < CTXL; ++j) { const int krow = MLAT + b * CTXL + j; na_key(P + (size_t)krow * NP + PC_NK + h * 64, P + (size_t)krow * NP + PC_NV + h * 64, q, 0.f, mx, ls, o); }
        const float il = 1.f / ls; bf16* op = YC + (size_t)qrow * 512 + h * 64;
#pragma unroll
        for (int d8 = 0; d8 < 8; ++d8) { u32x4 w; w.x = pk2(o[8 * d8] * il, o[8 * d8 + 1] * il); w.y = pk2(o[8 * d8 + 2] * il, o[8 * d8 + 3] * il); w.z = pk2(o[8 * d8 + 4] * il, o[8 * d8 + 5] * il); w.w = pk2(o[8 * d8 + 6] * il, o[8 * d8 + 7] * il);
            *(u32x4*)(op + 8 * d8) = w; }
    }
}

__device__ __forceinline__ float grp16_sum(float v) { v += __shfl_xor(v, 1); v += __shfl_xor(v, 2); v += __shfl_xor(v, 4); v += __shfl_xor(v, 8); return v; }
PHASE_FN void ph_combine(Ctx cx, int l_) {
    Frame F = mkframe(cx); const ArgsP a = F.ap; const int l = rfl(l_);
    REFRESH(F);
    const int gw = F.bid * NWAVES + F.wave, NGW = F.G * NWAVES;
    const float* OG = (const float*)(F.ws + WS_OG); const float* OD = (const float*)(F.ws + WS_OD); const bf16* P = (const bf16*)(F.ws + WS_P);
    bf16* YA = (bf16*)(F.ws + WS_YA); bf16* YB = (bf16*)(F.ws + WS_YB);
    const float lam = ((const float*)(F.ws + WS_LAM))[l], omli = 1.f - (0.8f - 0.6f * expf(-0.3f * (float)l));
    const float* gnw = a->in[I_GNW] + l * 128; const float* dnw = a->in[I_DNW] + l * 128;
    for (int row = gw; row < MT; row += NGW) {
        const int c = 8 * F.lane, ch = c & 127;
        { const float* p0 = OG + (size_t)row * 512 + c; const float* p1 = p0 + (size_t)MT * 512;
          const f32x4 a0 = *(const f32x4*)p0 + *(const f32x4*)p1, a1 = *(const f32x4*)(p0 + 4) + *(const f32x4*)(p1 + 4);
          float ss = (a0.x * a0.x + a0.y * a0.y) + (a0.z * a0.z + a0.w * a0.w) + (a1.x * a1.x + a1.y * a1.y) + (a1.z * a1.z + a1.w * a1.w);
          const float rs = 1.f / sqrtf(grp16_sum(ss) * (1.f / 128.f) + RMS_EPS);
          const u32x4 z = *(const u32x4*)(P + (size_t)row * NP + PC_GZ + c); const f32x4 w0 = *(const f32x4*)(gnw + ch), w1 = *(const f32x4*)(gnw + ch + 4);
          u32x4 o; o.x = pk2(a0.x * rs * w0.x * siluf(bflo(z.x)), a0.y * rs * w0.y * siluf(bfhi(z.x))); o.y = pk2(a0.z * rs * w0.z * siluf(bflo(z.y)), a0.w * rs * w0.w * siluf(bfhi(z.y)));
          o.z = pk2(a1.x * rs * w1.x * siluf(bflo(z.z)), a1.y * rs * w1.y * siluf(bfhi(z.z))); o.w = pk2(a1.z * rs * w1.z * siluf(bflo(z.w)), a1.w * rs * w1.w * siluf(bfhi(z.w)));
          *(u32x4*)(YA + (size_t)row * 512 + c) = o; }
#if !USE_DIFF_MFMA
        { const float* p0 = OD + (size_t)row * 512 + c; const float* p1 = p0 + (size_t)MT * 512;
          const f32x4 a0 = *(const f32x4*)p0 - *(const f32x4*)p1 * lam, a1 = *(const f32x4*)(p0 + 4) - *(const f32x4*)(p1 + 4) * lam;
          float ss = (a0.x * a0.x + a0.y * a0.y) + (a0.z * a0.z + a0.w * a0.w) + (a1.x * a1.x + a1.y * a1.y) + (a1.z * a1.z + a1.w * a1.w);
          const float rs = (1.f / sqrtf(grp16_sum(ss) * (1.f / 128.f) + RMS_EPS)) * omli;
          const f32x4 w0 = *(const f32x4*)(dnw + ch), w1 = *(const f32x4*)(dnw + ch + 4);
          u32x4 o; o.x = pk2(a0.x * rs * w0.x, a0.y * rs * w0.y); o.y = pk2(a0.z * rs * w0.z, a0.w * rs * w0.w); o.z = pk2(a1.x * rs * w1.x, a1.y * rs * w1.y); o.w = pk2(a1.z * rs * w1.z, a1.w * rs * w1.w);
          *(u32x4*)(YB + (size_t)row * 512 + c) = o; }
#endif
    }
}
namespace dattn {
using s16x4  = __attribute__((ext_vector_type(4))) short;
using f32x16 = __attribute__((ext_vector_type(16))) float;
constexpr int KVBLK = 64;
constexpr float SCALE = 0.125f, THR = 8.f;
constexpr int SHM_V = KVBLK * 128 * 2, SHM_K = KVBLK * 128 * 2, SHM_ATTN = 2 * SHM_V + 2 * SHM_K + 8 * 64 * 4;
#define DA_KSWZ(row, colB) ((row) * 256 + ((colB) ^ (((row) & 7) << 4)))
#define DA_SBAR() __builtin_amdgcn_sched_barrier(0)
__device__ __forceinline__ int crow(int r, int hi) { return (r & 3) + 8 * (r >> 2) + 4 * hi; }
__device__ __forceinline__ unsigned cvtpk(float lo, float hi) { return pg8::cvt_pk_bf16(lo, hi); }
__device__ __forceinline__ void partialSM(f32x16& p0, f32x16& p1, float& m_reg, float& mn, float& alpha) {
  constexpr float C = SCALE * 1.4426950408889634f;
  float pmax = p0[0];
#pragma unroll
  for (int r = 1; r < 16; ++r) pmax = fmaxf(pmax, p0[r]);
#pragma unroll
  for (int r = 0; r < 16; ++r) pmax = fmaxf(pmax, p1[r]);
  { auto rr = __builtin_amdgcn_permlane32_swap(__float_as_uint(pmax), __float_as_uint(pmax), false, false);
    pmax = fmaxf(__uint_as_float(rr[0]), __uint_as_float(rr[1])); }
  if (__builtin_expect(__all(pmax - m_reg <= THR / SCALE), 1)) { mn = m_reg; alpha = 1.f; }
  else { mn = fmaxf(m_reg, pmax); alpha = __builtin_amdgcn_exp2f((m_reg - mn) * C); m_reg = mn; }
  const float mnC = -mn * C;
#pragma unroll
  for (int r = 0; r < 16; ++r) p0[r] = fmaf(p0[r], C, mnC);
#pragma unroll
  for (int r = 0; r < 16; ++r) p1[r] = fmaf(p1[r], C, mnC);
#pragma unroll
  for (int r = 0; r < 16; ++r) p0[r] = __builtin_amdgcn_exp2f(p0[r]);
}
__device__ __forceinline__ void finishSM(f32x16& p0, f32x16& p1, float alpha, float& l_reg, bf16x8& pa0, bf16x8& pa1, bf16x8& pa2, bf16x8& pa3) {
#pragma unroll
  for (int r = 0; r < 16; ++r) p1[r] = __builtin_amdgcn_exp2f(p1[r]);
  float ps = 0;
#pragma unroll
  for (int r = 0; r < 16; ++r) ps += p0[r];
#pragma unroll
  for (int r = 0; r < 16; ++r) ps += p1[r];
  { auto rr = __builtin_amdgcn_permlane32_swap(__float_as_uint(ps), __float_as_uint(ps), false, false);
    ps = __uint_as_float(rr[0]) + __uint_as_float(rr[1]); }
  l_reg = l_reg * alpha + ps;
#define DA_PK4(P, BASE, OUT) do { unsigned a0 = cvtpk(P[BASE + 0], P[BASE + 1]), a1 = cvtpk(P[BASE + 2], P[BASE + 3]);   \
    unsigned b0 = cvtpk(P[BASE + 4], P[BASE + 5]), b1 = cvtpk(P[BASE + 6], P[BASE + 7]);                              \
    auto r0 = __builtin_amdgcn_permlane32_swap(a0, b0, false, false); auto r1 = __builtin_amdgcn_permlane32_swap(a1, b1, false, false); \
    u32x4 w = {r0[0], r1[0], r0[1], r1[1]}; OUT = *reinterpret_cast<bf16x8*>(&w); } while (0)
  DA_PK4(p0, 0, pa0); DA_PK4(p0, 8, pa1); DA_PK4(p1, 0, pa2); DA_PK4(p1, 8, pa3);
#undef DA_PK4
}
__device__ __forceinline__ void qkt(f32x16& p0, f32x16& p1, const LAS char* Ks, const bf16x8* qr, int r32, int hi, int m) {
  p0 = f32x16{}; p1 = f32x16{};
#pragma unroll
  for (int d0 = 0; d0 < 4; ++d0) { const int cb = (m * 64 + d0 * 16 + hi * 8) * 2;
    const bf16x8 b0 = *reinterpret_cast<const LAS bf16x8*>(Ks + DA_KSWZ(r32, cb));
    const bf16x8 b1 = *reinterpret_cast<const LAS bf16x8*>(Ks + DA_KSWZ(32 + r32, cb));
    p0 = __builtin_amdgcn_mfma_f32_32x32x16_bf16(b0, qr[d0], p0, 0, 0, 0);
    p1 = __builtin_amdgcn_mfma_f32_32x32x16_bf16(b1, qr[d0], p1, 0, 0, 0); }
}
__device__ __forceinline__ int v_st(int k, int c) { const int kk = (k & ~0xC) | ((k & 4) << 1) | ((k & 8) >> 1); return ((kk >> 3) * 4 + (c >> 5)) * 512 + ((kk & 7) * 32 + (c & 31)) * 2; }
__device__ __forceinline__ int v_rd_base(int lane) { return ((lane & 3) << 3) | (((lane >> 2) & 3) << 6) | (((lane >> 4) & 1) << 5) | (((lane >> 5) & 1) << 8); }
constexpr int v_rd_off(int d0, int ks, int half) { return d0 * 512 + ks * 4096 + half * 2048; }
template <int OFF> __device__ __forceinline__ s16x4 tr_read(int vb) { s16x4 r; asm volatile("ds_read_b64_tr_b16 %0, %1 offset:%2" : "=&v"(r) : "v"(vb), "i"(OFF) : "memory"); return r; }
template <int D0> __device__ __forceinline__ void pv_one(f32x16& od, int vb, bf16x8 pa0, bf16x8 pa1, bf16x8 pa2, bf16x8 pa3) {
  const s16x4 l0 = tr_read<v_rd_off(D0, 0, 0)>(vb), h0 = tr_read<v_rd_off(D0, 0, 1)>(vb), l1 = tr_read<v_rd_off(D0, 1, 0)>(vb), h1 = tr_read<v_rd_off(D0, 1, 1)>(vb);
  const s16x4 l2 = tr_read<v_rd_off(D0, 2, 0)>(vb), h2 = tr_read<v_rd_off(D0, 2, 1)>(vb), l3 = tr_read<v_rd_off(D0, 3, 0)>(vb), h3 = tr_read<v_rd_off(D0, 3, 1)>(vb);
  asm volatile("s_waitcnt lgkmcnt(0)" ::: "memory"); DA_SBAR();
#define DA_PK(L, H) (bf16x8){L[0], L[1], L[2], L[3], H[0], H[1], H[2], H[3]}
  od = __builtin_amdgcn_mfma_f32_32x32x16_bf16(pa0, DA_PK(l0, h0), od, 0, 0, 0);
  od = __builtin_amdgcn_mfma_f32_32x32x16_bf16(pa1, DA_PK(l1, h1), od, 0, 0, 0);
  od = __builtin_amdgcn_mfma_f32_32x32x16_bf16(pa2, DA_PK(l2, h2), od, 0, 0, 0);
  od = __builtin_amdgcn_mfma_f32_32x32x16_bf16(pa3, DA_PK(l3, h3), od, 0, 0, 0);
#undef DA_PK
}
__device__ __forceinline__ void pv_d0(f32x16* o, int vb, bf16x8 pa0, bf16x8 pa1, bf16x8 pa2, bf16x8 pa3) {
  pv_one<0>(o[0], vb, pa0, pa1, pa2, pa3); pv_one<1>(o[1], vb, pa0, pa1, pa2, pa3); pv_one<2>(o[2], vb, pa0, pa1, pa2, pa3); pv_one<3>(o[3], vb, pa0, pa1, pa2, pa3);
}

__device__ __forceinline__ void unit(const bf16* __restrict__ P, bf16* __restrict__ YB, const float* __restrict__ nw, float lam, float omli,
                                     int b, int h, int qrow0, int t0, int NT, LAS char* lds, int wid, int lane) {
  const int tid = wid * 64 + lane, r32 = lane & 31, hi = lane >> 5, m = wid >> 2, wq = wid & 3;
  LAS char* V_lds = lds; LAS char* K_lds = lds + 2 * SHM_V;
  LAS float* ws = (LAS float*)(lds + 2 * SHM_V + 2 * SHM_K) + wid * 64; LAS float* li_l = ws; LAS float* al_l = ws + 32;
  float m_reg = -1e30f, l_reg = 0; f32x16 o[4] = {}; bf16x8 qr[4];
  { const bf16* Qw = P + (size_t)(qrow0 + wq * 32 + r32) * NP + PC_DQ + h * 128 + m * 64 + hi * 8;
#pragma unroll
    for (int d0 = 0; d0 < 4; ++d0) qr[d0] = *reinterpret_cast<const bf16x8*>(Qw + d0 * 16); }
  const int sr = tid >> 4, sc = (tid & 15) * 8, vst0 = v_st(sr, sc), vst1 = v_st(32 + sr, sc);
  const int vb0 = (int)(uintptr_t)V_lds + v_rd_base(lane);
  const bf16* Kcol = P + PC_DK + h * 128 + sc; const bf16* Vcol = P + PC_DV + h * 128 + sc;
  bf16x8 vs0, vs1, ks0, ks1;
#define DA_KROW(j) ((size_t)(((j) + t0) < 128 ? b * SEQ + 64 * ((j) + t0) : MLAT + b * CTXL + 64 * ((j) + t0 - 128)))
#define DA_SLOAD(j) do { const size_t k0_ = DA_KROW(j); vs0 = *reinterpret_cast<const bf16x8*>(Vcol + (k0_ + sr) * NP); vs1 = *reinterpret_cast<const bf16x8*>(Vcol + (k0_ + 32 + sr) * NP); \
    ks0 = *reinterpret_cast<const bf16x8*>(Kcol + (k0_ + sr) * NP); ks1 = *reinterpret_cast<const bf16x8*>(Kcol + (k0_ + 32 + sr) * NP); } while (0)
#define DA_SWRITE(bb) do { *(LAS bf16x8*)(V_lds + (bb) * SHM_V + vst0) = vs0; *(LAS bf16x8*)(V_lds + (bb) * SHM_V + vst1) = vs1; const int kc = sc * 2; \
    *(LAS bf16x8*)(K_lds + (bb) * SHM_K + DA_KSWZ(sr, kc)) = ks0; *(LAS bf16x8*)(K_lds + (bb) * SHM_K + DA_KSWZ(32 + sr, kc)) = ks1; } while (0)
#define DA_RESC(a) do { if (__any((a) < 1.f)) { if (hi == 0) al_l[r32] = (a); asm volatile("s_waitcnt lgkmcnt(0)" ::: "memory"); \
    _Pragma("unroll") for (int d = 0; d < 4; ++d) _Pragma("unroll") for (int r = 0; r < 16; ++r) o[d][r] *= al_l[crow(r, hi)]; } } while (0)
  f32x16 pA0, pA1, pB0, pB1; float mnA, mnB, alA, alB; bf16x8 pa0, pa1, pa2, pa3;
  DA_SLOAD(0); asm volatile("s_waitcnt vmcnt(0)" ::: "memory"); DA_SWRITE(0); __syncthreads();
  qkt(pA0, pA1, K_lds, qr, r32, hi, m); partialSM(pA0, pA1, m_reg, mnA, alA);
  DA_SLOAD(1);
  asm volatile("s_waitcnt vmcnt(0)" ::: "memory"); DA_SWRITE(1); __syncthreads();
  for (int j = 1; j + 1 < NT; j += 2) {
    DA_SBAR(); qkt(pB0, pB1, K_lds + SHM_K, qr, r32, hi, m);
    finishSM(pA0, pA1, alA, l_reg, pa0, pa1, pa2, pa3); DA_SBAR();
    DA_SLOAD(j + 1); DA_SBAR();
    pv_d0(o, vb0, pa0, pa1, pa2, pa3); partialSM(pB0, pB1, m_reg, mnB, alB);
    __syncthreads(); asm volatile("s_waitcnt vmcnt(0)" ::: "memory"); DA_SWRITE(0);
    DA_RESC(alB); __syncthreads();
    DA_SBAR(); qkt(pA0, pA1, K_lds, qr, r32, hi, m);
    finishSM(pB0, pB1, alB, l_reg, pa0, pa1, pa2, pa3); DA_SBAR();
    DA_SLOAD(j + 2); DA_SBAR();
    pv_d0(o, vb0 + SHM_V, pa0, pa1, pa2, pa3); partialSM(pA0, pA1, m_reg, mnA, alA);
    __syncthreads(); asm volatile("s_waitcnt vmcnt(0)" ::: "memory"); DA_SWRITE(1);
    DA_RESC(alA); __syncthreads();
  }
  DA_SBAR(); qkt(pB0, pB1, K_lds + SHM_K, qr, r32, hi, m);
  finishSM(pA0, pA1, alA, l_reg, pa0, pa1, pa2, pa3); DA_SBAR();
  pv_d0(o, vb0, pa0, pa1, pa2, pa3); partialSM(pB0, pB1, m_reg, mnB, alB);
  __syncthreads(); DA_RESC(alB);
  finishSM(pB0, pB1, alB, l_reg, pa0, pa1, pa2, pa3); DA_SBAR();
  pv_d0(o, vb0 + SHM_V, pa0, pa1, pa2, pa3);
  if (hi == 0) li_l[r32] = l_reg; asm volatile("s_waitcnt lgkmcnt(0)" ::: "memory");
  float rli[16];
#pragma unroll
  for (int r = 0; r < 16; ++r) rli[r] = __builtin_amdgcn_rcpf(li_l[crow(r, hi)]);
  __syncthreads();
  LAS float* X = (LAS float*)lds;
  if (m == 1) {
#pragma unroll
    for (int r = 0; r < 16; ++r) { const int row = wq * 32 + crow(r, hi);
#pragma unroll
      for (int d0 = 0; d0 < 4; ++d0) X[row * 132 + d0 * 32 + r32] = o[d0][r] * rli[r]; } }
  __syncthreads();
  if (m == 0) {
#pragma unroll
    for (int r = 0; r < 16; ++r) { const int row = wq * 32 + crow(r, hi);
#pragma unroll
      for (int d0 = 0; d0 < 4; ++d0) { LAS float* p = X + row * 132 + d0 * 32 + r32; *p = o[d0][r] * rli[r] - lam * *p; } }
    asm volatile("s_waitcnt lgkmcnt(0)" ::: "memory");
    const int row = wq * 32 + (lane >> 1), hf = lane & 1; const LAS float* xr = X + row * 132 + hf * 64;
    f32x4 v[16]; float ss = 0.f;
#pragma unroll
    for (int i = 0; i < 16; ++i) { v[i] = *(const LAS f32x4*)(xr + 4 * i); ss += (v[i].x * v[i].x + v[i].y * v[i].y) + (v[i].z * v[i].z + v[i].w * v[i].w); }
    ss += __shfl_xor(ss, 1);
    const float rs = (1.f / sqrtf(ss * (1.f / 128.f) + RMS_EPS)) * omli;
    bf16* op = YB + (size_t)(qrow0 + row) * 512 + h * 128 + hf * 64; const float* wp = nw + hf * 64;
#pragma unroll
    for (int i = 0; i < 8; ++i) { const f32x4 w0 = *(const f32x4*)(wp + 8 * i), w1 = *(const f32x4*)(wp + 8 * i + 4); const f32x4 a0 = v[2 * i] * rs * w0, a1 = v[2 * i + 1] * rs * w1;
      u32x4 w; w.x = cvtpk(a0.x, a0.y); w.y = cvtpk(a0.z, a0.w); w.z = cvtpk(a1.x, a1.y); w.w = cvtpk(a1.z, a1.w); *(u32x4*)(op + 8 * i) = w; }
  }
  __syncthreads();
#undef DA_KROW
#undef DA_SLOAD
#undef DA_SWRITE
#undef DA_RESC
}
#undef DA_KSWZ
#undef DA_SBAR
}

PHASE_FN void ph_diff_mfma(Ctx cx, int l_) {
    Frame F = mkframe(cx); const ArgsP a = F.ap; const int l = rfl(l_);
    REFRESH(F);
    const bf16* P = (const bf16*)(F.ws + WS_P); bf16* YB = (bf16*)(F.ws + WS_YB);
    const float lam = ((const float*)(F.ws + WS_LAM))[l], omli = 1.f - (0.8f - 0.6f * expf(-0.3f * (float)l));
    const float* nw = a->in[I_DNW] + l * 128;
    for (int it = F.bid; it < 512 + 16; it += F.G) {
        int b, h, q0, t0, NT;
        if (it < 512) { b = it >> 8; h = (it >> 6) & 3; q0 = b * SEQ + (it & 63) * 128; t0 = 0; NT = 132; }
        else { const int j = it - 512; b = j >> 3; h = (j >> 1) & 3; q0 = MLAT + b * CTXL + (j & 1) * 128; t0 = 128; NT = 4; }
        dattn::unit(P, YB, nw, lam, omli, b, h, q0, t0, NT, (LAS char*)F.lds, F.wave, F.lane);
    }
}
namespace gdn {
using f32x16 = __attribute__((ext_vector_type(16))) float;
constexpr int REC_BYTES = 57344, U_BYTES = 16384, OFF_NEGW = 0, OFF_QG = 16384, OFF_KT = 32768, OFF_QK = 49152, NSTEP = 132;
constexpr int QS = 0, KS = 17408, VS = 34816, L0 = 52224, A0 = 84992, SC = 117760;
__device__ __forceinline__ unsigned pk(float lo, float hi) { return pg8::cvt_pk_bf16(lo, hi); }
__device__ __forceinline__ float ldbf(const LAS unsigned short* p) { return __uint_as_float(((unsigned)*p) << 16); }

__device__ __forceinline__ void prep_item(const Frame& F, const ArgsP a, int l, int item) {
    const int b = item / (NSTEP * 4), rem = item % (NSTEP * 4), cn = rem >> 2, h = rem & 3;
    const bool isctx = cn < 4; const int row0 = isctx ? MLAT + b * CTXL + 64 * cn : b * SEQ + 64 * (cn - 4), t0 = isctx ? 64 * cn : 64 * (cn - 4), L = isctx ? CTXL : SEQ;
    const bf16* P = (const bf16*)(F.ws + WS_P); const float* DEC = (const float*)(F.ws + WS_DEC);
    LAS unsigned char* lds = F.lds; const int lane = F.lane, wave = F.wave, tid = F.tid;
    LAS unsigned short* Qs = (LAS unsigned short*)(lds + QS); LAS unsigned short* Ks = (LAS unsigned short*)(lds + KS); LAS unsigned short* Vs = (LAS unsigned short*)(lds + VS);
    LAS float* GC = (LAS float*)(lds + SC); LAS float* BE = GC + 128; LAS float* EG = GC + 256; LAS float* ET = GC + 384;
    { const float* cw = a->in[I_CONVW] + (size_t)l * 3 * 1536;
#pragma unroll 1
      for (int ii = 0; ii < 8; ++ii) { const int i = wave * 8 + ii, t = t0 + i; const bool hm = t > 0, hp = t < L - 1; const bf16* p0 = P + (size_t)(row0 + i) * NP;
#pragma unroll
        for (int wh = 0; wh < 3; ++wh) { const int c = wh * 512 + h * 128 + 2 * lane;
            const unsigned x0 = *(const unsigned*)(p0 + c), xm = hm ? *(const unsigned*)(p0 - NP + c) : 0u, xp = hp ? *(const unsigned*)(p0 + NP + c) : 0u;
            const f32x2 w0 = *(const f32x2*)(cw + c), w1 = *(const f32x2*)(cw + 1536 + c), w2 = *(const f32x2*)(cw + 3072 + c);
            float y0 = bflo(xm) * w0.x + bflo(x0) * w1.x + bflo(xp) * w2.x, y1 = bfhi(xm) * w0.y + bfhi(x0) * w1.y + bfhi(xp) * w2.y;
            y0 = siluf(y0); y1 = siluf(y1);
            if (wh < 2) { const float ss = wave_sum(y0 * y0 + y1 * y1), sc = (1.f / sqrtf(ss + RMS_EPS)) * (wh == 0 ? 0.08838834764831845f : 1.f); y0 *= sc; y1 *= sc; }
            LAS unsigned short* dst = (wh == 0 ? Qs : wh == 1 ? Ks : Vs) + i * 136 + 2 * lane; *(LAS unsigned*)dst = pk(y0, y1); } } }
    if (wave < 2) { const int d = wave, t = d ? 63 - lane : lane; const size_t row = (size_t)(row0 + t);
        const float al = expf(a->in[I_ALOG][(l * 2 + d) * 4 + h]), av = DEC[row * 16 + 8 * d + h] + a->in[I_DTB][(l * 2 + d) * 4 + h], bb = DEC[row * 16 + 8 * d + 4 + h];
        const float sp = av > 20.f ? av : log1pf(expf(av)); float gc = -al * sp;
#pragma unroll
        for (int o = 1; o < 64; o <<= 1) { const float v = __shfl_up(gc, o); if (lane >= o) gc += v; }
        const float gl = __shfl(gc, 63);
        GC[d * 64 + lane] = gc; BE[d * 64 + lane] = sigmf(bb); EG[d * 64 + lane] = expf(gc); ET[d * 64 + lane] = expf(gl - gc);
        if (lane == 63) { const int step = d ? (cn < 4 ? 3 - cn : 135 - cn) : cn; ((float*)(F.ws + WS_GL))[((b * 4 + h) * 2 + d) * NSTEP + step] = expf(gl); } }
    __syncthreads();
    { const int mat = wave >> 2, mi = wave & 3, fr = lane & 15, fq = lane >> 4; const LAS unsigned short* As = mat ? Qs : Ks;
#pragma unroll 1
      for (int nj = 0; nj < 4; ++nj) { f32x4 acc = {0.f, 0.f, 0.f, 0.f};
#pragma unroll
        for (int ks = 0; ks < 4; ++ks) { const bf16x8 af = *(const LAS bf16x8*)(As + (16 * mi + fr) * 136 + 32 * ks + 8 * fq), bfr = *(const LAS bf16x8*)(Ks + (16 * nj + fr) * 136 + 32 * ks + 8 * fq);
            acc = __builtin_amdgcn_mfma_f32_16x16x32_bf16(af, bfr, acc, 0, 0, 0); }
#pragma unroll
        for (int r = 0; r < 4; ++r) { const int ti = 16 * mi + 4 * fq + r, tj = 16 * nj + fr;
#pragma unroll
            for (int d = 0; d < 2; ++d) { const int i = d ? 63 - ti : ti, j = d ? 63 - tj : tj; const bool keep = mat ? (i >= j) : (i > j);
                float v = 0.f; if (keep) { v = acc[r] * __expf(fminf(GC[d * 64 + i] - GC[d * 64 + j], 0.f)); if (!mat) v *= BE[d * 64 + i]; }
                ((LAS float*)(lds + (mat ? A0 : L0) + d * 16384))[i * 64 + j] = v; } } } }
    __syncthreads();
    const int d = __builtin_amdgcn_readfirstlane(tid >> 8), c = tid & 255, cc = c & 127; const bool isw = __builtin_amdgcn_readfirstlane(c >> 7) != 0;
    float x[64];
    { const LAS float* Ld = (const LAS float*)(lds + L0 + d * 16384); const LAS unsigned short* src = (isw ? Ks : Vs) + cc;
#pragma unroll
      for (int i = 0; i < 64; ++i) x[i] = 0.f;
#pragma unroll
      for (int i = 0; i < 64; ++i) { const int t = d ? 63 - i : i; float acc = ldbf(src + t * 136) * BE[d * 64 + i] * (isw ? EG[d * 64 + i] : 1.f);
#pragma unroll
          for (int j4 = 0; j4 < (i + 3) / 4; ++j4) { const f32x4 lv = *(const LAS f32x4*)(Ld + i * 64 + 4 * j4);
              acc -= lv.x * x[4 * j4]; if (4 * j4 + 1 < i) acc -= lv.y * x[4 * j4 + 1]; if (4 * j4 + 2 < i) acc -= lv.z * x[4 * j4 + 2]; if (4 * j4 + 3 < i) acc -= lv.w * x[4 * j4 + 3]; }
          asm volatile("" : "+v"(acc) :: "memory"); x[i] = acc; } }
    const int step = d ? (cn < 4 ? 3 - cn : 135 - cn) : cn; const size_t ridx = (size_t)((b * 4 + h) * 2 + d) * NSTEP + step;
    unsigned char* rec = F.ws + WS_REC + ridx * REC_BYTES;
    if (!isw) {
        unsigned char* ub = F.ws + WS_U + ridx * U_BYTES; const int nt = cc >> 5, col = cc & 31;
#pragma unroll
        for (int mt = 0; mt < 2; ++mt)
#pragma unroll
            for (int hi = 0; hi < 2; ++hi) { u32x4 w0, w1; const int ib = 32 * mt + 4 * hi;
                w0.x = pk(x[ib + 0], x[ib + 1]); w0.y = pk(x[ib + 2], x[ib + 3]); w0.z = pk(x[ib + 8], x[ib + 9]); w0.w = pk(x[ib + 10], x[ib + 11]);
                w1.x = pk(x[ib + 16], x[ib + 17]); w1.y = pk(x[ib + 18], x[ib + 19]); w1.z = pk(x[ib + 24], x[ib + 25]); w1.w = pk(x[ib + 26], x[ib + 27]);
                u32x4* dst = (u32x4*)(ub + (size_t)(((mt * 4 + nt) * 64 + hi * 32 + col) * 32)); dst[0] = w0; dst[1] = w1; } }
    __syncthreads();
    LAS unsigned short* Xw = (LAS unsigned short*)(lds + L0 + d * 16384);
    if (isw) {
#pragma unroll
        for (int i = 0; i < 64; ++i) Xw[i * 128 + cc] = (unsigned short)(pk(-x[i], 0.f) & 0xffffu); }
    __syncthreads();
    { const int u2 = tid & 255; const LAS float* Ad = (const LAS float*)(lds + A0 + d * 16384);
#pragma unroll
      for (int q = 0; q < 4; ++q) { const int s = u2 + 256 * q, f = s >> 6, ln = s & 63, r32 = ln & 31, hi = ln >> 5;
          { const int mt = f >> 3, ks = f & 7, i = 32 * mt + r32, t = d ? 63 - i : i, k0 = 16 * ks + 4 * hi;
            const u32x2 wa = *(const LAS u32x2*)(Xw + i * 128 + k0), wb = *(const LAS u32x2*)(Xw + i * 128 + k0 + 8);
            *(u32x4*)(rec + OFF_NEGW + s * 16) = (u32x4){wa.x, wa.y, wb.x, wb.y};
            const float eg = EG[d * 64 + i]; const u32x2 qa = *(const LAS u32x2*)(Qs + t * 136 + k0), qb = *(const LAS u32x2*)(Qs + t * 136 + k0 + 8);
            *(u32x4*)(rec + OFF_QG + s * 16) = (u32x4){pk(bflo(qa.x) * eg, bfhi(qa.x) * eg), pk(bflo(qa.y) * eg, bfhi(qa.y) * eg), pk(bflo(qb.x) * eg, bfhi(qb.x) * eg), pk(bflo(qb.y) * eg, bfhi(qb.y) * eg)}; }
          { const int mtS = f >> 2, ks = f & 3, dk = 32 * mtS + r32; float kv[8];
#pragma unroll
            for (int j = 0; j < 8; ++j) { const int i = 16 * ks + 8 * (j >> 2) + 4 * hi + (j & 3), t = d ? 63 - i : i; kv[j] = ldbf(Ks + t * 136 + dk) * ET[d * 64 + i]; }
            *(u32x4*)(rec + OFF_KT + s * 16) = (u32x4){pk(kv[0], kv[1]), pk(kv[2], kv[3]), pk(kv[4], kv[5]), pk(kv[6], kv[7])}; } }
#pragma unroll
      for (int q = 0; q < 2; ++q) { const int s = u2 + 256 * q, f = s >> 6, ln = s & 63, r32 = ln & 31, hi = ln >> 5, mt = f >> 2, ks = f & 3, i = 32 * mt + r32, j0 = 16 * ks + 4 * hi;
          const f32x4 va = *(const LAS f32x4*)(Ad + i * 64 + j0), vb = *(const LAS f32x4*)(Ad + i * 64 + j0 + 8);
          *(u32x4*)(rec + OFF_QK + s * 16) = (u32x4){pk(va.x, va.y), pk(va.z, va.w), pk(vb.x, vb.y), pk(vb.z, vb.w)}; } }
    __syncthreads();
}

__device__ __forceinline__ bf16x8 pack8(const f32x16& v, int s) {
    u32x4 p; p.x = pk(v[8 * s], v[8 * s + 1]); p.y = pk(v[8 * s + 2], v[8 * s + 3]); p.z = pk(v[8 * s + 4], v[8 * s + 5]); p.w = pk(v[8 * s + 6], v[8 * s + 7]); return __builtin_bit_cast(bf16x8, p); }
#define GDN_MFMA(a, b, c) __builtin_amdgcn_mfma_f32_32x32x16_bf16((a), (b), (c), 0, 0, 0)
#define GDN_FRAG(buf, off, f) (*(const LAS bf16x8*)((buf) + (off) + (f) * 1024 + lane * 16))
__device__ __forceinline__ void chain(const Frame& F, int b, int h, int d) {
    const int lane = F.lane, wave = F.wave, r32 = lane & 31, hi = lane >> 5, nt = wave & 3; const bool comp = wave < 4;
    LAS unsigned char* lds = F.lds;
    const size_t rbase = (size_t)((b * 4 + h) * 2 + d) * NSTEP;
    const unsigned char* recs = F.ws + WS_REC + rbase * REC_BYTES; const unsigned char* us = F.ws + WS_U + rbase * U_BYTES; const float* gls = (const float*)(F.ws + WS_GL) + rbase;
    float* OG = (float*)(F.ws + WS_OG) + (size_t)d * MT * 512 + h * 128 + nt * 32 + r32;
    f32x16 S[4]; bf16x8 Sb[8];
#pragma unroll
    for (int i = 0; i < 4; ++i) S[i] = f32x16{};
#pragma unroll
    for (int i = 0; i < 8; ++i) Sb[i] = bf16x8{};
#define GDN_DMA(step, bufi) do { const unsigned char* src_ = recs + (size_t)(step) * REC_BYTES + lane * 16; LAS unsigned char* dst_ = lds + (bufi) * REC_BYTES; \
        _Pragma("unroll") for (int p_ = 0; p_ < 7; ++p_) __builtin_amdgcn_global_load_lds((const GAS unsigned*)(src_ + (wave * 7 + p_) * 1024), (LAS unsigned*)(dst_ + (wave * 7 + p_) * 1024), 16, 0, 0); } while (0)
    GDN_DMA(0, 0);
    asm volatile("s_waitcnt vmcnt(0)" ::: "memory"); __syncthreads();
#pragma unroll 1
    for (int step = 0; step < NSTEP; ++step) {
        const LAS unsigned char* buf = lds + (step & 1) * REC_BYTES;
        if (step + 1 < NSTEP) GDN_DMA(step + 1, (step + 1) & 1);
        if (comp) {
            const float egl = gls[step];
            f32x16 Vp[2];
#pragma unroll
            for (int mt = 0; mt < 2; ++mt) { const u32x4* up = (const u32x4*)(us + (size_t)step * U_BYTES + (size_t)(((mt * 4 + nt) * 64 + lane) * 32)); const u32x4 w0 = up[0], w1 = up[1];
                Vp[mt] = (f32x16){bflo(w0.x), bfhi(w0.x), bflo(w0.y), bfhi(w0.y), bflo(w0.z), bfhi(w0.z), bflo(w0.w), bfhi(w0.w), bflo(w1.x), bfhi(w1.x), bflo(w1.y), bfhi(w1.y), bflo(w1.z), bfhi(w1.z), bflo(w1.w), bfhi(w1.w)}; }
#pragma unroll
            for (int ks = 0; ks < 8; ++ks) {
#pragma unroll
                for (int mt = 0; mt < 2; ++mt) Vp[mt] = GDN_MFMA(GDN_FRAG(buf, OFF_NEGW, mt * 8 + ks), Sb[ks], Vp[mt]);
                if ((ks & 3) == 3) asm volatile("" ::: "memory"); }
            bf16x8 Vb[4];
            Vb[0] = pack8(Vp[0], 0); Vb[1] = pack8(Vp[0], 1); Vb[2] = pack8(Vp[1], 0); Vb[3] = pack8(Vp[1], 1);
            const int cn = d ? (step < 4 ? 3 - step : 135 - step) : step; const size_t orow0 = cn < 4 ? (size_t)(MLAT + b * CTXL + 64 * cn) : (size_t)(b * SEQ + 64 * (cn - 4));
#pragma unroll
            for (int mt = 0; mt < 2; ++mt) { f32x16 O = f32x16{};
#pragma unroll
                for (int ks = 0; ks < 8; ++ks) { O = GDN_MFMA(GDN_FRAG(buf, OFF_QG, mt * 8 + ks), Sb[ks], O); if ((ks & 3) == 3) asm volatile("" ::: "memory"); }
#pragma unroll
                for (int ks = 0; ks < 4; ++ks) O = GDN_MFMA(GDN_FRAG(buf, OFF_QK, mt * 4 + ks), Vb[ks], O);
#pragma unroll
                for (int r = 0; r < 16; ++r) { const int i = 32 * mt + (r & 3) + 8 * (r >> 2) + 4 * hi, t = d ? 63 - i : i; OG[(orow0 + t) * 512] = O[r]; } }
#pragma unroll
            for (int mtS = 0; mtS < 4; ++mtS) {
#pragma unroll
                for (int r = 0; r < 16; ++r) S[mtS][r] *= egl;
#pragma unroll
                for (int ks = 0; ks < 4; ++ks) S[mtS] = GDN_MFMA(GDN_FRAG(buf, OFF_KT, mtS * 4 + ks), Vb[ks], S[mtS]);
                Sb[2 * mtS] = pack8(S[mtS], 0); Sb[2 * mtS + 1] = pack8(S[mtS], 1); asm volatile("" ::: "memory"); }
        }
        asm volatile("s_waitcnt vmcnt(0)" ::: "memory"); __syncthreads();
    }
#undef GDN_DMA
}
#undef GDN_MFMA
#undef GDN_FRAG
}

PHASE_FN void ph_gdn_prep(Ctx cx, int l_) {
    Frame F = mkframe(cx); const ArgsP a = F.ap; const int l = rfl(l_);
    REFRESH(F);
    for (int it = F.bid; it < BATCH * gdn::NSTEP * 4; it += F.G) { REFRESH(F); gdn::prep_item(F, a, l, it); }
}
PHASE_FN void ph_gdn_chain(Ctx cx, int l_) {
    Frame F = mkframe(cx); const int l = rfl(l_);
    REFRESH(F);
    for (int it = F.bid; it < 16; it += F.G) gdn::chain(F, it >> 3, (it >> 1) & 3, it & 1);
}
constexpr int TAB_OFF = LDSCTL_OFF;
PHASE_FN void ph_ln1_router(Ctx cx, int l_) {
    Frame F = mkframe(cx); const ArgsP a = F.ap; const int l = rfl(l_);
    REFRESH(F);
    volatile LAS int* tab = (volatile LAS int*)(F.lds + TAB_OFF);
    const float* T = (const float*)(F.ws + WS_T); float* X = (float*)(F.ws + WS_X);
    const float* wrT = (const float*)(F.ws + WS_WRT) + (size_t)l * 32 * 1024;
    const float* lng = a->in[I_LNG] + (size_t)(l * 2 + 0) * DM; const float* lnb = a->in[I_LNB] + (size_t)(l * 2 + 0) * DM;
    int* TOPE = (int*)(F.ws + WS_TOPE); int* TOPR = (int*)(F.ws + WS_TOPR); float* TOPG = (float*)(F.ws + WS_TOPG); int* BLKB = (int*)(F.ws + WS_BLKB);
    for (int rg = F.bid; rg < NRG; rg += F.G) {
        if (F.tid < 32) tab[384 + F.tid] = 0;
        __syncthreads();
        for (int i = F.wave; i < RG_ROWS; i += NWAVES) {
            const int row = rg * RG_ROWS + i; f32x4 v[4];
            const f32x4* tr = (const f32x4*)T + (size_t)row * 256 + F.lane;
#pragma unroll
            for (int j = 0; j < 4; ++j) v[j] = tr[64 * j];
            ln_inplace(v);
#pragma unroll
            for (int j = 0; j < 4; ++j) { const int c = 4 * F.lane + 256 * j; v[j] = v[j] * *(const f32x4*)(lng + c) + *(const f32x4*)(lnb + c); *((f32x4*)X + (size_t)row * 256 + F.lane + 64 * j) = v[j]; }
            modulate_store(F, l, 1, row, v);
            float lg = -3.0e38f; const int me = F.lane;
#pragma unroll 4
            for (int e = 0; e < 32; ++e) { float s = 0.f;
#pragma unroll
                for (int j = 0; j < 4; ++j) { const f32x4 w = *(const f32x4*)(wrT + e * 1024 + 4 * F.lane + 256 * j); s += (v[j].x * w.x + v[j].y * w.y) + (v[j].z * w.z + v[j].w * w.w); }
                s = wave_sum(s); if (F.lane == e) lg = s; }
            if (F.lane < 32) lg += a->in[I_BR][l * 32 + me];
            int te[4]; float tv[4];
#pragma unroll
            for (int k = 0; k < 4; ++k) { float bv = lg; int be = me;
#pragma unroll
                for (int o = 1; o < 64; o <<= 1) { const float ov = __shfl_xor(bv, o); const int oe = __shfl_xor(be, o); if (ov > bv || (ov == bv && oe < be)) { bv = ov; be = oe; } }
                te[k] = be; tv[k] = bv; if (me == be) lg = -3.0e38f; }
            const float e1 = __expf(tv[1] - tv[0]), e2 = __expf(tv[2] - tv[0]), e3 = __expf(tv[3] - tv[0]), isum = 1.f / (1.f + e1 + e2 + e3);
            if (F.lane < 4) { const int k = F.lane; const int e = k == 0 ? te[0] : k == 1 ? te[1] : k == 2 ? te[2] : te[3]; const float g = (k == 0 ? 1.f : k == 1 ? e1 : k == 2 ? e2 : e3) * isum;
                const int lr = __hip_atomic_fetch_add((LAS int*)&tab[384 + e], 1, __ATOMIC_RELAXED, __HIP_MEMORY_SCOPE_WORKGROUP);
                TOPE[row * 4 + k] = e; TOPR[row * 4 + k] = lr; TOPG[row * 4 + k] = g; }
        }
        __syncthreads();
        if (F.tid < 32) { const int n = tab[384 + F.tid]; const unsigned base = __hip_atomic_fetch_add(F.ctl + CW_CNT + l * 32 + F.tid, (unsigned)n, __ATOMIC_RELAXED, __HIP_MEMORY_SCOPE_AGENT); BLKB[rg * 32 + F.tid] = (int)base; }
        __syncthreads();
    }
}
__device__ __forceinline__ void moe_tables(Frame& F, int l, int nN) {
    REFRESH(F);
    volatile LAS int* tab = (volatile LAS int*)(F.lds + TAB_OFF);
    __syncthreads();
    if (F.tid == 0) { int t = 0;
#pragma unroll 1
        for (int e = 0; e < 32; ++e) { const int n = (int)__hip_atomic_load(F.ctl + CW_CNT + l * 32 + e, __ATOMIC_RELAXED, __HIP_MEMORY_SCOPE_AGENT), nt = (n + 255) >> 8; tab[352 + e] = t * 256;
            for (int i = 0; i < nt; ++i) tab[t + i] = e; t += nt; }
        tab[320] = t; }
    __syncthreads();
    if (nN > 0 && F.tid < 16) { int pm, pn; const int T = tab[320]; int w = -1;
        if (TileMap::map(F.tid, F.G, F.bid, T, nN, pm, pn)) w = pm | (pn << 12) | (tab[pm] << 16) | (nN << 24);
        tab[416 + F.tid] = w; }
    __syncthreads();
}
PHASE_FN void ph_moe_gather(Ctx cx, int l_) {
    Frame F = mkframe(cx); const int l = rfl(l_);
    REFRESH(F);
    volatile LAS int* tab = (volatile LAS int*)(F.lds + TAB_OFF);
    moe_tables(F, l, 0);
    const int gw = F.bid * NWAVES + F.wave, NGW = F.G * NWAVES;
    const int* TOPE = (const int*)(F.ws + WS_TOPE); const int* TOPR = (const int*)(F.ws + WS_TOPR); const int* BLKB = (const int*)(F.ws + WS_BLKB); int* SLOT = (int*)(F.ws + WS_SLOT);
    const bf16* HX = (const bf16*)(F.ws + WS_HX); bf16* HP = (bf16*)(F.ws + WS_HP);
    for (int row = gw; row < MT; row += NGW) {
        const u32x4 h0 = *(const u32x4*)(HX + (size_t)row * DM + 8 * F.lane), h1 = *(const u32x4*)(HX + (size_t)row * DM + 512 + 8 * F.lane);
#pragma unroll
        for (int k = 0; k < 4; ++k) { const int e = TOPE[row * 4 + k], slot = tab[352 + e] + BLKB[(row / RG_ROWS) * 32 + e] + TOPR[row * 4 + k];
            if (F.lane == 0) SLOT[row * 4 + k] = slot;
            *(u32x4*)(HP + (size_t)slot * DM + 8 * F.lane) = h0; *(u32x4*)(HP + (size_t)slot * DM + 512 + 8 * F.lane) = h1; }
    }
}
PHASE_FN void ph_ln2(Ctx cx, int l_) {
    Frame F = mkframe(cx); const ArgsP a = F.ap; const int l = rfl(l_);
    REFRESH(F);
    const int gw = F.bid * NWAVES + F.wave, NGW = F.G * NWAVES;
    float* X = (float*)(F.ws + WS_X); const bf16* Y = (const bf16*)(F.ws + WS_Y);
    const int* SLOT = (const int*)(F.ws + WS_SLOT); const float* TOPG = (const float*)(F.ws + WS_TOPG);
    const float* lng = a->in[I_LNG] + (size_t)(l * 2 + 1) * DM; const float* lnb = a->in[I_LNB] + (size_t)(l * 2 + 1) * DM;
    const bool poison = __hip_atomic_load(F.ctl + CW_BAR + XB_TMO, __ATOMIC_RELAXED, __HIP_MEMORY_SCOPE_AGENT) != 0u;
    for (int row = gw; row < MT; row += NGW) {
        const float* g2 = (const float*)(F.ws + WS_MOD) + ((size_t)l * 3 + mod_index(row)) * 6144 + 5120;
        f32x4 fx[4];
#pragma unroll
        for (int j = 0; j < 4; ++j) fx[j] = (f32x4){0.f, 0.f, 0.f, 0.f};
#pragma unroll
        for (int k = 0; k < 4; ++k) { const int slot = SLOT[row * 4 + k]; const float g = TOPG[row * 4 + k]; const bf16* yr = Y + (size_t)slot * DM + 4 * F.lane;
#pragma unroll
            for (int j = 0; j < 4; ++j) { const u32x2 w = *(const u32x2*)(yr + 256 * j); fx[j] += (f32x4){bflo(w.x), bfhi(w.x), bflo(w.y), bfhi(w.y)} * g; } }
        f32x4 v[4];
#pragma unroll
        for (int j = 0; j < 4; ++j) { const int c = 4 * F.lane + 256 * j; v[j] = *((const f32x4*)X + (size_t)row * 256 + F.lane + 64 * j) * DN_ALPHA + *(const f32x4*)(g2 + c) * fx[j]; }
        ln_inplace(v);
#pragma unroll
        for (int j = 0; j < 4; ++j) { const int c = 4 * F.lane + 256 * j; v[j] = v[j] * *(const f32x4*)(lng + c) + *(const f32x4*)(lnb + c); }
        if (l == DEPTH - 1) { if (row < MLAT) {
            if (poison) { const float qn = __builtin_nanf("");
#pragma unroll
                for (int j = 0; j < 4; ++j) v[j] = (f32x4){qn, qn, qn, qn}; }
#pragma unroll
            for (int j = 0; j < 4; ++j) *((f32x4*)a->out + (size_t)row * 256 + F.lane + 64 * j) = v[j]; } }
        else {
#pragma unroll
            for (int j = 0; j < 4; ++j) *((f32x4*)X + (size_t)row * 256 + F.lane + 64 * j) = v[j];
            modulate_store(F, l + 1, 0, row, v); decay_cols(F, l + 1, row, v); }
    }
}

PHASE_FN void ph_gemm_win(Ctx cx, int l_) {
    Frame F = mkframe(cx); const int l = rfl(l_); unsigned char* ws = F.ws;
    StaticOrder S{MT / 256, NP / 256, F.G, F.bid, 1024}; EpiWin E{(bf16*)(ws + WS_P)};
    pg8::gemm_phase<EpiWin, StaticOrder>(F.lds, 1024, (const char*)(ws + WS_HX), (const char*)(ws + WS_WIN) + (size_t)l * 8192 * 1024 * 2, S, E, F.wv);
}
PHASE_FN void ph_gemm_merge(Ctx cx, int l_) {
    Frame F = mkframe(cx); const int l = rfl(l_); unsigned char* ws = F.ws;
    MergeOrder S{F.G, F.bid}; EpiMerge E{(const bf16*)(ws + WS_P), (float*)(ws + WS_MACC), (bf16*)(ws + WS_MBF)};
    pg8::gemm_phase<EpiMerge, MergeOrder>(F.lds, 512, (const char*)(ws + WS_YA), (const char*)(ws + WS_WBR) + (size_t)l * 3 * 1024 * 512 * 2, S, E, F.wv);
}
PHASE_FN void ph_gemm_wout(Ctx cx, int l_) {
    Frame F = mkframe(cx); const int l = rfl(l_); unsigned char* ws = F.ws;
    StaticOrder S{MT / 256, 4, F.G, F.bid, 1024}; EpiWout E{(const float*)(ws + WS_X), (const float*)(ws + WS_MOD) + (size_t)l * 3 * 6144, (float*)(ws + WS_T)};
    pg8::gemm_phase<EpiWout, StaticOrder>(F.lds, 1024, (const char*)(ws + WS_MBF), (const char*)(ws + WS_WOUT) + (size_t)l * 1024 * 1024 * 2, S, E, F.wv);
}
PHASE_FN void ph_gemm_moe1(Ctx cx, int l_) {
    Frame F = mkframe(cx); const int l = rfl(l_); unsigned char* ws = F.ws; const ArgsP a = F.ap;
    moe_tables(F, l, 8);
    MoeOrder S{(const volatile LAS int*)(F.lds + TAB_OFF)}; EpiAct E{a->in[I_B1] + (size_t)l * 32 * 2048, (bf16*)(ws + WS_ACT)};
    pg8::gemm_phase<EpiAct, MoeOrder>(F.lds, 1024, (const char*)(ws + WS_HP), (const char*)(ws + WS_W1) + (size_t)l * 32 * 2048 * 1024 * 2, S, E, F.wv);
}
PHASE_FN void ph_gemm_moe2(Ctx cx, int l_) {
    Frame F = mkframe(cx); const int l = rfl(l_); unsigned char* ws = F.ws; const ArgsP a = F.ap;
    moe_tables(F, l, 4);
    MoeOrder S{(const volatile LAS int*)(F.lds + TAB_OFF)}; EpiY E{a->in[I_B2] + (size_t)l * 32 * 1024, (bf16*)(ws + WS_Y)};
    pg8::gemm_phase<EpiY, MoeOrder>(F.lds, 1024, (const char*)(ws + WS_ACT), (const char*)(ws + WS_W2) + (size_t)l * 32 * 1024 * 1024 * 2, S, E, F.wv);
}
constexpr int NPH_LAYER = 12, NPHASES = 2 + DEPTH * NPH_LAYER;
__global__ void __launch_bounds__(NTHREADS, 2) fwd_kernel(Args args) {
    extern __shared__ __attribute__((aligned(16))) unsigned char lds_raw[];
    LAS unsigned char* lds = (LAS unsigned char*)lds_raw;
    const int tid = threadIdx.x;
    volatile LAS unsigned* MISC = (volatile LAS unsigned*)(lds + MISC_OFF);
    for (int u = tid; u < (LDS_BYTES - LDSCTL_OFF) / 4; u += NTHREADS) ((LAS unsigned*)(lds + LDSCTL_OFF))[u] = 0u;
    __syncthreads();
    const int lo = args.ph_lo, hi = args.ph_hi;
    const bool multi = (hi - lo) > 1;
    unsigned* ctl = (unsigned*)(args.ws + WS_CTL);
    XcdBarrier bar; bar.bar = ctl + CW_BAR; bar.x = 0; bar.st = nullptr;
    if (multi) bar = xcd_barrier_post(ctl + CW_BAR, MISC + 8);
    Ctx cx; cx.lds = lds; cx.ws = args.ws; cx.ap = (ArgsP)__builtin_amdgcn_kernarg_segment_ptr(); cx.G = gridDim.x; cx.bid = blockIdx.x; cx.wv = __builtin_amdgcn_readfirstlane(tid >> 6);
#define IN(k) (lo <= (k) && (k) < hi)
#define SEAM(k) do { if (IN(k) && IN((k) + 1)) xcd_barrier(bar); } while (0)
    if (IN(0)) { p0_prologue(cx); SEAM(0); }
    if (IN(1)) { ph_lnmod0(cx); SEAM(1); }
    for (int l = 0; l < DEPTH; ++l) {
        const int pb = 2 + l * NPH_LAYER;
        if (IN(pb + 0)) { ph_gemm_win(cx, l); SEAM(pb + 0); }
        if (IN(pb + 1)) { ph_prep(cx, l);
#if USE_GDN_FAST
            ph_gdn_prep(cx, l);
#endif
            SEAM(pb + 1); }
        if (IN(pb + 2)) {
#if USE_GDN_FAST
            ph_gdn_chain(cx, l);
#else
            ph_gdn_chain_naive(cx, l);
#endif
            SEAM(pb + 2); }
        if (IN(pb + 3)) {
#if USE_DIFF_MFMA
            ph_diff_mfma(cx, l);
#else
            ph_diff_naive(cx, l);
#endif
            ph_na_naive(cx, l); SEAM(pb + 3); }
        if (IN(pb + 4)) { ph_combine(cx, l); SEAM(pb + 4); }
        if (IN(pb + 5)) { ph_gemm_merge(cx, l); SEAM(pb + 5); }
        if (IN(pb + 6)) { ph_gemm_wout(cx, l); SEAM(pb + 6); }
        if (IN(pb + 7)) { ph_ln1_router(cx, l); SEAM(pb + 7); }
        if (IN(pb + 8)) { ph_moe_gather(cx, l); SEAM(pb + 8); }
        if (IN(pb + 9)) { ph_gemm_moe1(cx, l); SEAM(pb + 9); }
        if (IN(pb + 10)) { ph_gemm_moe2(cx, l); SEAM(pb + 10); }
        if (IN(pb + 11)) { ph_ln2(cx, l); SEAM(pb + 11); }
    }
#undef IN
#undef SEAM
}

#ifndef MK_PER_PHASE
#define MK_PER_PHASE 0
#endif
extern "C" void kernel_launch(void* const* d_in, const int* in_sizes, int n_in, void* d_out, int out_size, void* d_ws, size_t ws_size, hipStream_t stream) {
    static int grid = 0;
    if (grid == 0) {
        if (n_in != 24 || out_size != MLAT * DM || ws_size < WS_END) { fprintf(stderr, "kernel_launch: unexpected shapes (n_in %d out %d ws %zu need %zu)\n", n_in, out_size, ws_size, (size_t)WS_END); grid = -1; return; }
        int dev = 0, cus = 0, per_cu = 0;
        if (hipGetDevice(&dev) != hipSuccess || hipDeviceGetAttribute(&cus, hipDeviceAttributeMultiprocessorCount, dev) != hipSuccess) { grid = -1; return; }
        if (hipFuncSetAttribute((const void*)fwd_kernel, hipFuncAttributeMaxDynamicSharedMemorySize, LDS_BYTES) != hipSuccess) { fprintf(stderr, "kernel_launch: hipFuncSetAttribute failed\n"); grid = -1; return; }
        if (hipOccupancyMaxActiveBlocksPerMultiprocessor(&per_cu, (const void*)fwd_kernel, NTHREADS, LDS_BYTES) != hipSuccess || per_cu < 1) { fprintf(stderr, "kernel_launch: occupancy query says %d\n", per_cu); }
        (void)hipGetLastError();
        grid = cus;
    }
    if (grid < 0) return;
    (void)hipMemsetAsync((char*)d_ws + WS_CTL, 0, CTL_ZERO_BYTES, stream);
    Args a{};
    for (int i = 0; i < 24; ++i) a.in[i] = (const float*)d_in[i];
    a.out = (float*)d_out; a.ws = (unsigned char*)d_ws;
#if MK_PER_PHASE
    for (int p = 0; p < NPHASES; ++p) { a.ph_lo = p; a.ph_hi = p + 1; hipLaunchKernelGGL(fwd_kernel, dim3(grid), dim3(NTHREADS), LDS_BYTES, stream, a); }
#else
    a.ph_lo = 0; a.ph_hi = NPHASES; hipLaunchKernelGGL(fwd_kernel, dim3(grid), dim3(NTHREADS), LDS_BYTES, stream, a);
#endif
    const hipError_t le = hipPeekAtLastError();
    if (le != hipSuccess) fprintf(stderr, "kernel_launch: launch failed: %s\n", hipGetErrorName(le));
}
```

```cpp
#include <hip/hip_runtime.h>
#include <cstdio>
#include <cstdint>
#include <cmath>

#define GAS __attribute__((address_space(1)))
#define LAS __attribute__((address_space(3)))
typedef unsigned short bf16;
typedef float f32x4 __attribute__((ext_vector_type(4)));
typedef float f32x2 __attribute__((ext_vector_type(2)));
typedef unsigned u32x4 __attribute__((ext_vector_type(4)));
typedef unsigned u32x2 __attribute__((ext_vector_type(2)));
typedef short bf16x8 __attribute__((ext_vector_type(8)));

namespace pg8 {
#define PG8_LAS __attribute__((address_space(3)))
constexpr int BM = 256, BK = 64, HALF = 128, HTB = HALF * BK * 2, STAGE_BYTES = 8 * HTB, NXCD = 8, WGM = 8;
__host__ __device__ __forceinline__ int lds_byte(int r, int c) { const int st = (r >> 4) * 2 + (c >> 5), rr = r & 15, cc = c & 31, ob = rr * 64 + cc * 2; return st * 1024 + (ob ^ (((ob >> 9) & 1) << 5)); }
__host__ __device__ __forceinline__ void stage_rc(int b, int& R, int& C) { const int st = b / 1024, sb = b % 1024, swz = sb ^ (((sb >> 9) & 1) << 5); R = (st >> 1) * 16 + swz / 64; C = (st & 1) * 32 + (swz % 64) / 2; }
__host__ __device__ __forceinline__ int perm32(int rho) { const int n = rho >> 4, i = rho & 15; return 8 * (i >> 2) + 4 * n + (i & 3); }

struct Unit { int pm, pn, aux; unsigned aoff, boff; };

typedef float cvt_f32x2_t __attribute__((ext_vector_type(2))); typedef __bf16 cvt_bf16x2_t __attribute__((ext_vector_type(2)));
__device__ __forceinline__ unsigned cvt_pk_bf16(float lo, float hi) { cvt_f32x2_t v = {lo, hi}; cvt_bf16x2_t b = __builtin_convertvector(v, cvt_bf16x2_t); return __builtin_bit_cast(unsigned, b); }

template <class Epi, class Sched, bool ALIGN_EPI = true, bool SP2 = true>
__device__ __forceinline__ void gemm_phase(PG8_LAS unsigned char* lds, const int K, const char* Abase, const char* Bbase, const Sched& S, const Epi& E, const int wv) {
    int lane_; asm volatile("v_mbcnt_lo_u32_b32 %0, -1, 0\n\tv_mbcnt_hi_u32_b32 %0, -1, %0" : "=v"(lane_));
    const int wid = wv, lane = lane_, tid = wv * 64 + lane_, wr = wid >> 2, wc = wid & 3, fr = lane & 15, fq = lane >> 4;
    const int nt = K / BK;
    unsigned voffA[2], voffB[2];
#pragma unroll
    for (int i = 0; i < 2; ++i) { int R, C; stage_rc(tid * 16 + i * 8192, R, C); const int Rb = ((R & ~31) + perm32(R & 31));
        voffA[i] = (unsigned)(R * K + C) * 2u; voffB[i] = (unsigned)(Rb * K + C) * 2u; }
    const size_t kstep = (size_t)(BK * 2);
    const size_t hstep = (size_t)HALF * K * 2;
    const unsigned ldsw = (unsigned)wid * 1024u;
    const int aoff = lds_byte(wr * 64 + fr, fq * 8), boff = lds_byte(wc * 32 + fr, fq * 8);
#define PG8_SA(b, h) (((b) * 2 + (h)) * HTB)
#define PG8_SB(b, h) ((4 + (b) * 2 + (h)) * HTB)
#define PG8_STAGE(bufoff, gbase, voff) do { _Pragma("unroll") for (int _i = 0; _i < 2; ++_i) \
        __builtin_amdgcn_global_load_lds((const GAS unsigned*)((const char*)(gbase) + (voff)[_i]), (PG8_LAS unsigned*)(lds + (bufoff) + ldsw + _i * 8192), 16, 0, 0); } while (0)
#define PG8_LDA(dst, b, h) do { _Pragma("unroll") for (int m = 0; m < 4; ++m) _Pragma("unroll") for (int k = 0; k < 2; ++k) dst[m][k] = *(const PG8_LAS bf16x8*)(lds + PG8_SA(b, h) + aoff + m * 2048 + k * 1024); } while (0)
#define PG8_LDB(dst, b, h) do { _Pragma("unroll") for (int n = 0; n < 2; ++n) _Pragma("unroll") for (int k = 0; k < 2; ++k) dst[n][k] = *(const PG8_LAS bf16x8*)(lds + PG8_SB(b, h) + boff + n * 2048 + k * 1024); } while (0)
#define PG8_MMA(ai, bj, At, Bt) do { __builtin_amdgcn_s_setprio(1); _Pragma("unroll") for (int m = 0; m < 4; ++m) _Pragma("unroll") for (int n = 0; n < 2; ++n) _Pragma("unroll") for (int k = 0; k < 2; ++k) \
        acc[ai][bj][m][n] = __builtin_amdgcn_mfma_f32_16x16x32_bf16(Bt[n][k], At[m][k], acc[ai][bj][m][n], 0, 0, 0); __builtin_amdgcn_s_setprio(0); } while (0)
#define PG8_WAIT_V(n) asm volatile("s_waitcnt vmcnt(" #n ")" ::: "memory")
#define PG8_WAIT_L(n) asm volatile("s_waitcnt lgkmcnt(" #n ")" ::: "memory")
#define PG8_BAR __builtin_amdgcn_s_barrier()
#define PG8_SCHED __builtin_amdgcn_sched_barrier(0)
    Unit cur, nxt; int ui = 0;
    if (!S.next(0, cur)) return;
    f32x4 acc[2][2][4][2];
#pragma unroll
    for (int a = 0; a < 2; ++a)
#pragma unroll
        for (int b = 0; b < 2; ++b)
#pragma unroll
            for (int m = 0; m < 4; ++m)
#pragma unroll
                for (int n = 0; n < 2; ++n) acc[a][b][m][n] = (f32x4){0.f, 0.f, 0.f, 0.f};
    bf16x8 At[4][2], B0[2][2], B1[2][2];
    const char* cA = Abase + cur.aoff; const char* cB = Bbase + cur.boff;
    if constexpr (SP2) {
        PG8_STAGE(PG8_SB(0, 0), cB, voffB); PG8_STAGE(PG8_SB(0, 1), cB + hstep, voffB); PG8_STAGE(PG8_SA(0, 0), cA, voffA); PG8_STAGE(PG8_SA(0, 1), cA + hstep, voffA);
        if (wr == 1) PG8_BAR;
        PG8_WAIT_V(2); PG8_BAR;
        PG8_STAGE(PG8_SB(1, 0), cB + kstep, voffB); PG8_STAGE(PG8_SA(1, 0), cA + kstep, voffA); PG8_STAGE(PG8_SB(1, 1), cB + hstep + kstep, voffB);
        PG8_WAIT_V(6); PG8_BAR;
    } else {
        PG8_STAGE(PG8_SB(0, 0), cB, voffB); PG8_STAGE(PG8_SA(0, 0), cA, voffA); PG8_STAGE(PG8_SB(0, 1), cB + hstep, voffB); PG8_STAGE(PG8_SA(0, 1), cA + hstep, voffA);
        if (wr == 1) PG8_BAR;
        PG8_WAIT_V(4); PG8_BAR;
        PG8_STAGE(PG8_SB(1, 0), cB + kstep, voffB); PG8_STAGE(PG8_SA(1, 0), cA + kstep, voffA); PG8_STAGE(PG8_SB(1, 1), cB + hstep + kstep, voffB);
        PG8_WAIT_V(6); PG8_BAR;
    }
    for (;;) {
        const bool has_next = S.next(ui + 1, nxt);
        const char* nA = has_next ? Abase + nxt.aoff : cA; const char* nB = has_next ? Bbase + nxt.boff : cB;
        for (int t = 0; t < nt; t += 2) {
            const bool last = (t == nt - 2);
            const char* a1 = cA + (size_t)(t + 1) * kstep;
            const char* a2 = last ? nA : cA + (size_t)(t + 2) * kstep; const char* b2 = last ? nB : cB + (size_t)(t + 2) * kstep;
            const char* a3 = a2 + kstep; const char* b3 = b2 + kstep;
            if constexpr (SP2) {
            PG8_LDB(B0, 0, 0); PG8_LDB(B1, 0, 1); PG8_SCHED; PG8_LDA(At, 0, 0); PG8_STAGE(PG8_SA(1, 1), a1 + hstep, voffA);
            PG8_WAIT_V(8); PG8_WAIT_L(0); PG8_BAR; PG8_MMA(0, 0, At, B0); PG8_MMA(0, 1, At, B1); PG8_BAR; PG8_SCHED;
            PG8_LDA(At, 0, 1); PG8_STAGE(PG8_SB(0, 0), b2, voffB); PG8_STAGE(PG8_SB(0, 1), b2 + hstep, voffB); PG8_STAGE(PG8_SA(0, 0), a2, voffA);
            PG8_WAIT_V(8); PG8_WAIT_L(0); PG8_BAR; PG8_MMA(1, 0, At, B0); PG8_MMA(1, 1, At, B1); PG8_BAR; PG8_SCHED;
            PG8_LDB(B0, 1, 0); PG8_LDB(B1, 1, 1); PG8_SCHED; PG8_LDA(At, 1, 0); PG8_STAGE(PG8_SA(0, 1), a2 + hstep, voffA);
            PG8_WAIT_V(8); PG8_WAIT_L(0); PG8_BAR; PG8_MMA(0, 0, At, B0); PG8_MMA(0, 1, At, B1); PG8_BAR; PG8_SCHED;
            PG8_LDA(At, 1, 1); PG8_STAGE(PG8_SB(1, 0), b3, voffB); PG8_STAGE(PG8_SB(1, 1), b3 + hstep, voffB); PG8_STAGE(PG8_SA(1, 0), a3, voffA);
            PG8_WAIT_V(8); PG8_WAIT_L(0); PG8_BAR; PG8_MMA(1, 0, At, B0); PG8_MMA(1, 1, At, B1); PG8_BAR; PG8_SCHED;
            } else {
            PG8_LDB(B0, 0, 0); PG8_SCHED; PG8_LDA(At, 0, 0); PG8_STAGE(PG8_SA(1, 1), a1 + hstep, voffA);
            PG8_WAIT_L(8); PG8_BAR; PG8_WAIT_L(0); PG8_MMA(0, 0, At, B0); PG8_BAR; PG8_SCHED;
            PG8_LDB(B1, 0, 1); PG8_STAGE(PG8_SB(0, 0), b2, voffB);
            PG8_BAR; PG8_WAIT_L(0); PG8_MMA(0, 1, At, B1); PG8_BAR;
            PG8_LDA(At, 0, 1); PG8_STAGE(PG8_SA(0, 0), a2, voffA);
            PG8_BAR; PG8_WAIT_L(0); PG8_MMA(1, 0, At, B0); PG8_BAR; PG8_SCHED;
            PG8_STAGE(PG8_SB(0, 1), b2 + hstep, voffB);
            PG8_WAIT_V(6); PG8_BAR; PG8_MMA(1, 1, At, B1); PG8_BAR;
            PG8_LDB(B0, 1, 0); PG8_SCHED; PG8_LDA(At, 1, 0); PG8_STAGE(PG8_SA(0, 1), a2 + hstep, voffA);
            PG8_WAIT_L(8); PG8_BAR; PG8_WAIT_L(0); PG8_MMA(0, 0, At, B0); PG8_BAR; PG8_SCHED;
            PG8_LDB(B1, 1, 1); PG8_STAGE(PG8_SB(1, 0), b3, voffB);
            PG8_BAR; PG8_WAIT_L(0); PG8_MMA(0, 1, At, B1); PG8_BAR;
            PG8_LDA(At, 1, 1); PG8_STAGE(PG8_SA(1, 0), a3, voffA);
            PG8_BAR; PG8_WAIT_L(0); PG8_MMA(1, 0, At, B0); PG8_BAR; PG8_SCHED;
            PG8_STAGE(PG8_SB(1, 1), b3 + hstep, voffB);
            PG8_WAIT_V(6); PG8_BAR; PG8_MMA(1, 1, At, B1); PG8_BAR;
            }
        }
        if constexpr (ALIGN_EPI) { if (wr == 0) PG8_BAR; }
        E(acc, cur, wr, wc, fr, fq);
        if (!has_next) break;
#pragma unroll
        for (int a = 0; a < 2; ++a)
#pragma unroll
            for (int b = 0; b < 2; ++b)
#pragma unroll
                for (int m = 0; m < 4; ++m)
#pragma unroll
                    for (int n = 0; n < 2; ++n) acc[a][b][m][n] = (f32x4){0.f, 0.f, 0.f, 0.f};
        cur = nxt; cA = nA; cB = nB; ++ui;
        if constexpr (ALIGN_EPI) { if (wr == 1) PG8_BAR; }
    }
    PG8_WAIT_V(0);
    if constexpr (!ALIGN_EPI) { if (wr == 0) PG8_BAR; }
    PG8_BAR;
#undef PG8_SA
#undef PG8_SB
#undef PG8_STAGE
#undef PG8_LDA
#undef PG8_LDB
#undef PG8_MMA
#undef PG8_WAIT_V
#undef PG8_WAIT_L
#undef PG8_BAR
#undef PG8_SCHED
}
}
#ifndef USE_NA_MFMA
#define USE_NA_MFMA 1
#endif
#ifndef USE_GDN_FAST
#define USE_GDN_FAST 1
#endif
#ifndef USE_DIFF_MFMA
#define USE_DIFF_MFMA 1
#endif
constexpr int DM = 1024, BATCH = 2, SEQ = 8192, DEPTH = 4, CTXL = 256, GRIDW = 64;
constexpr int MLAT = BATCH * SEQ, MCTX = BATCH * CTXL, MT = MLAT + MCTX;
constexpr int NP = 8192;
constexpr int PC_GQ = 0, PC_GK = 512, PC_GV = 1024, PC_GZ = 1536, PC_DQ = 2048, PC_DK = 2560, PC_DV = 3072, PC_NQ = 3584, PC_NK = 4096, PC_NV = 4608, PC_GATE = 5120;
constexpr int D_IN = 8208, NEXP = 32, TOPK = 4, DEXP = 1024;
constexpr float LN_EPS = 1e-5f, RMS_EPS = 1e-6f;
constexpr float DN_ALPHA = 1.6817928305074292f;
constexpr int NWAVES = 8, NTHREADS = 512;
constexpr int RG_ROWS = 66, NRG = MT / RG_ROWS;
constexpr int RPAD = MT * TOPK + NEXP * 256;
constexpr int MAXTILES = RPAD / 256;

constexpr size_t MiB = 1u << 20;
constexpr size_t al256(size_t x) { return (x + 255) / 256 * 256; }
constexpr size_t WS_CTL = 0, CTL_ZERO_BYTES = 1 * MiB;
constexpr size_t WS_MOD = WS_CTL + CTL_ZERO_BYTES;
constexpr size_t WS_LAM = WS_MOD + al256((size_t)DEPTH * 3 * 6144 * 4);
constexpr size_t WS_WDEC = WS_LAM + 256;
constexpr size_t WS_WRT = WS_WDEC + (size_t)DEPTH * 16 * 1024 * 4;
constexpr size_t WS_WIN = WS_WRT + (size_t)DEPTH * 32 * 1024 * 4;
constexpr size_t WS_WBR = WS_WIN + (size_t)DEPTH * 8192 * 1024 * 2;
constexpr size_t WS_WOUT = WS_WBR + (size_t)DEPTH * 3 * 1024 * 512 * 2;
constexpr size_t WS_W1 = WS_WOUT + (size_t)DEPTH * 1024 * 1024 * 2;
constexpr size_t WS_W2 = WS_W1 + (size_t)DEPTH * 32 * 2048 * 1024 * 2;
constexpr size_t WS_X = WS_W2 + (size_t)DEPTH * 32 * 1024 * 1024 * 2;
constexpr size_t WS_HX = WS_X + (size_t)MT * DM * 4;
constexpr size_t WS_P = WS_HX + (size_t)MT * DM * 2;
constexpr size_t WS_DEC = WS_P + (size_t)MT * NP * 2;
constexpr size_t WS_QN = WS_DEC + (size_t)MT * 16 * 4;
constexpr size_t WS_KN = WS_QN + (size_t)MT * 512 * 4;
constexpr size_t WS_VV = WS_KN + (size_t)MT * 512 * 4;
constexpr size_t WS_OG = WS_VV + (size_t)MT * 512 * 4;
constexpr size_t WS_OD = WS_OG + (size_t)2 * MT * 512 * 4;
constexpr size_t WS_YA = WS_OD + (size_t)2 * MT * 512 * 4;
constexpr size_t WS_YB = WS_YA + (size_t)MT * 512 * 2;
constexpr size_t WS_YC = WS_YB + (size_t)MT * 512 * 2;
constexpr size_t WS_MACC = WS_YC + (size_t)MT * 512 * 2;
constexpr size_t WS_MBF = WS_MACC + (size_t)MT * DM * 4;
constexpr size_t WS_T = WS_MBF + (size_t)MT * DM * 2;
constexpr size_t WS_TOPE = WS_T + (size_t)MT * DM * 4;
constexpr size_t WS_TOPR = WS_TOPE + (size_t)MT * 4 * 4;
constexpr size_t WS_TOPG = WS_TOPR + (size_t)MT * 4 * 4;
constexpr size_t WS_SLOT = WS_TOPG + (size_t)MT * 4 * 4;
constexpr size_t WS_BLKB = WS_SLOT + (size_t)MT * 4 * 4;
constexpr size_t WS_HP = WS_BLKB + (size_t)NRG * 32 * 4;
constexpr size_t WS_ACT = WS_HP + (size_t)RPAD * 1024 * 2;
constexpr size_t WS_Y = WS_ACT + (size_t)RPAD * 1024 * 2;
constexpr size_t WS_REC = WS_Y + (size_t)RPAD * 1024 * 2;
constexpr size_t WS_U = WS_REC + (size_t)2 * 4 * 2 * 132 * 57344;
constexpr size_t WS_GL = WS_U + (size_t)2 * 4 * 2 * 132 * 16384;
constexpr size_t WS_VT = WS_GL + (size_t)2 * 4 * 2 * 132 * 4 + 256;
constexpr size_t WS_END = WS_VT + (size_t)2 * 8 * 64 * 8448 * 2;
constexpr int CW_BAR = 4096;
constexpr int CW_CNT = 16384;
constexpr int CW_Q = 20480;

constexpr int RING_BYTES = 131072;
constexpr int LDSCTL_OFF = RING_BYTES, MISC_OFF = LDSCTL_OFF + 2048;
constexpr int LDS_BYTES = 147456;

#define RLX_AGENT __ATOMIC_RELAXED, __HIP_MEMORY_SCOPE_AGENT
#define LDS_WAIT() asm volatile("s_waitcnt lgkmcnt(0)" ::: "memory")
#define VM_WAIT() asm volatile("s_waitcnt vmcnt(0)" ::: "memory")
__device__ __forceinline__ float bf2f(unsigned b) { return __uint_as_float(b << 16); }
__device__ __forceinline__ float bflo(unsigned w) { return __uint_as_float(w << 16); }
__device__ __forceinline__ float bfhi(unsigned w) { return __uint_as_float(w & 0xffff0000u); }
__device__ __forceinline__ unsigned f2bf(float f) { unsigned u = __float_as_uint(f); return (u + 0x7fffu + ((u >> 16) & 1u)) >> 16; }
__device__ __forceinline__ unsigned pk2(float lo, float hi) { return pg8::cvt_pk_bf16(lo, hi); }
__device__ __forceinline__ float siluf(float x) { return x / (1.f + __expf(-x)); }
__device__ __forceinline__ float sigmf(float x) { return 1.f / (1.f + __expf(-x)); }

#define XB_TMO      128
#define XB_XCNT(j)  (256  + 64 * (j))
#define XB_XSUB(j)  (1280 + 64 * (j))
#define XB_XGEN(j)  (2304 + 64 * (j))
#define XB_TOP      3328
#define XB_TOPGEN   3392
#define XCD_BAR_WORDS 3456
#define XB_SPIN_CAP (1u << 22)
__device__ __forceinline__ unsigned xb_ld(unsigned* p)              { return __hip_atomic_load(p, __ATOMIC_RELAXED, __HIP_MEMORY_SCOPE_AGENT); }
__device__ __forceinline__ unsigned xb_add(unsigned* p, unsigned v) { return __hip_atomic_fetch_add(p, v, __ATOMIC_RELAXED, __HIP_MEMORY_SCOPE_AGENT); }
__device__ __forceinline__ unsigned xb_xcc_id() { return (unsigned)__builtin_amdgcn_s_getreg((3 << 11) | 20) & 0xFu; }
#define XB_SPIN(cond, bar) do { unsigned _sp = 0; while (cond) { __builtin_amdgcn_s_sleep(1); \
    if ((++_sp & 255u) == 0u) { if (xb_ld(&(bar)[XB_TMO])) break; if (_sp > XB_SPIN_CAP) { atomicAdd(&(bar)[XB_TMO], 1u); break; } } } } while (0)
struct XcdBarrier { unsigned* bar; unsigned x; volatile LAS unsigned* st; };
__device__ __forceinline__ XcdBarrier xcd_barrier_post(unsigned* bar, volatile LAS unsigned* st) {
    XcdBarrier b; b.bar = bar; b.x = xb_xcc_id(); b.st = st;
    if (threadIdx.x == 0) (void)xb_add(&bar[XB_XCNT(b.x)], 1u);
    return b;
}
__device__ __forceinline__ void xcd_barrier_complete(unsigned* bar, unsigned x, unsigned& nloc, unsigned& nx) {
    const unsigned G = gridDim.x * gridDim.y * gridDim.z;
    unsigned sum, cnt, mine, sp = 0u;
    for (;;) {
        sum = 0u; cnt = 0u; mine = 0u;
#pragma unroll
        for (unsigned j = 0; j < 16; ++j) { const unsigned c = xb_ld(&bar[XB_XCNT(j)]); sum += c; cnt += (c > 0u) ? 1u : 0u; mine = (j == x) ? c : mine; }
        if (sum == G) break;
        __builtin_amdgcn_s_sleep(1);
        if ((++sp & 255u) == 0u) { if (xb_ld(&bar[XB_TMO])) break; if (sp > XB_SPIN_CAP) { atomicAdd(&bar[XB_TMO], 1u); break; } }
    }
    nloc = mine > 0u ? mine : 1u; nx = cnt > 0u ? cnt : 1u;
}
__device__ __forceinline__ void xcd_barrier(const XcdBarrier& b) {
#ifdef BAR_BRUTE
    __builtin_amdgcn_fence(__ATOMIC_RELEASE, "agent");
#endif
    asm volatile("s_waitcnt vmcnt(0)" ::: "memory");
    __syncthreads();
    if (threadIdx.x == 0) {
        unsigned* bar = b.bar;
        __builtin_amdgcn_s_waitcnt(0);
        unsigned nloc = b.st[0], nx = b.st[1];
        if (nloc == 0u) { xcd_barrier_complete(bar, b.x, nloc, nx); b.st[0] = nloc; b.st[1] = nx; }
        const unsigned old = xb_add(&bar[XB_XSUB(b.x)], 1u);
        const unsigned gen = old / nloc;
        if (old + 1u == (gen + 1u) * nloc) {
            __builtin_amdgcn_fence(__ATOMIC_RELEASE, "agent");
            asm volatile("s_waitcnt vmcnt(0)" ::: "memory");
            const unsigned og = xb_add(&bar[XB_TOP], 1u);
            const unsigned tg = og / nx;
            if (og + 1u == (tg + 1u) * nx) xb_add(&bar[XB_TOPGEN], 1u);
            else XB_SPIN(xb_ld(&bar[XB_TOPGEN]) == tg, bar);
            __builtin_amdgcn_fence(__ATOMIC_ACQUIRE, "agent");
            xb_add(&bar[XB_XGEN(b.x)], 1u);
            asm volatile("s_waitcnt vmcnt(0)" ::: "memory");
        } else {
            XB_SPIN(xb_ld(&bar[XB_XGEN(b.x)]) == gen, bar);
            __builtin_amdgcn_fence(__ATOMIC_ACQUIRE, "agent");
            asm volatile("s_waitcnt vmcnt(0)" ::: "memory");
        }
    }
    __syncthreads();
#ifdef BAR_BRUTE
    __builtin_amdgcn_fence(__ATOMIC_ACQUIRE, "agent");
    asm volatile("s_waitcnt vmcnt(0)" ::: "memory");
    __syncthreads();
#endif
}

struct Args { const float* in[24]; float* out; unsigned char* ws; int ph_lo, ph_hi; };
enum { I_X = 0, I_C, I_CTX, I_CCTX, I_WADA, I_BADA, I_WIN, I_CONVW, I_ALOG, I_DTB, I_GNW, I_DLAM, I_DNW, I_RPB, I_WBR, I_WOUT, I_LNG, I_LNB, I_WR, I_BR, I_W1, I_B1, I_W2, I_B2 };
typedef const __attribute__((address_space(4))) Args* ArgsP;
struct Ctx { LAS unsigned char* lds; unsigned char* ws; ArgsP ap; int G, bid, wv; };
#define PHASE_FN __device__ __forceinline__
__device__ __forceinline__ int rfl(int v) { return __builtin_amdgcn_readfirstlane(v); }
struct Frame {
    ArgsP ap;
    LAS unsigned char* lds;
    unsigned* ctl;
    unsigned char* ws;
    int tid, lane, wave, G, bid, wv;
};
#define REFRESH(F) do { int l_; asm volatile("v_mbcnt_lo_u32_b32 %0, -1, 0\n\tv_mbcnt_hi_u32_b32 %0, -1, %0" : "=v"(l_)); (F).lane = l_; (F).wave = (F).wv; (F).tid = (F).wv * 64 + l_; } while (0)
__device__ __forceinline__ Frame mkframe(const Ctx& c) {
    Frame F;
    F.lds = (LAS unsigned char*)(size_t)(unsigned)rfl((int)(unsigned)(size_t)c.lds);
    { const unsigned long long w = (unsigned long long)c.ws; F.ws = (unsigned char*)(((unsigned long long)(unsigned)rfl((int)(unsigned)(w >> 32)) << 32) | (unsigned)rfl((int)(unsigned)w)); }
    { const unsigned long long w = (unsigned long long)c.ap; F.ap = (ArgsP)(((unsigned long long)(unsigned)rfl((int)(unsigned)(w >> 32)) << 32) | (unsigned)rfl((int)(unsigned)w)); }
    F.ctl = (unsigned*)F.ws; F.G = rfl(c.G); F.bid = rfl(c.bid); F.wv = rfl(c.wv); F.wave = F.wv; F.lane = 0; F.tid = 0;
    return F;
}
__device__ __forceinline__ float wave_sum(float v) {
#pragma unroll
    for (int o = 1; o < 64; o <<= 1) v += __shfl_xor(v, o);
    return v;
}
__device__ __forceinline__ float wave_max(float v) {
#pragma unroll
    for (int o = 1; o < 64; o <<= 1) v = fmaxf(v, __shfl_xor(v, o));
    return v;
}
__device__ __forceinline__ int mod_index(int row) { return row < MLAT ? (row >> 13) : 2; }
static_assert(WS_YB == WS_YA + (size_t)MT * 512 * 2 && WS_YC == WS_YB + (size_t)MT * 512 * 2, "YA|YB|YC contiguous");
__device__ __forceinline__ void transpose_item(const float* W, int ldw, int K, int src_col0, bf16* WT, int dst_row0, int k0, LAS float* scr, int lane) {
#pragma unroll 8
    for (int i = 0; i < 32; ++i) { const int kk = 2 * i + (lane >> 5); scr[kk * 33 + (lane & 31)] = W[(size_t)(k0 + kk) * ldw + src_col0 + (lane & 31)]; }
    LDS_WAIT(); asm volatile("" ::: "memory");
    const int c = lane & 7;
#pragma unroll
    for (int j = 0; j < 4; ++j) { const int n = (lane >> 3) + 8 * j; const LAS float* s = scr + (8 * c) * 33 + n;
        u32x4 o; o.x = pk2(s[0 * 33], s[1 * 33]); o.y = pk2(s[2 * 33], s[3 * 33]); o.z = pk2(s[4 * 33], s[5 * 33]); o.w = pk2(s[6 * 33], s[7 * 33]);
        *(u32x4*)(WT + (size_t)(dst_row0 + n) * K + k0 + 8 * c) = o; }
    LDS_WAIT(); asm volatile("" ::: "memory");
}
constexpr int IT_WIN = DEPTH * 16 * 256, IT_WBR = DEPTH * 3 * 8 * 32, IT_WOUT = DEPTH * 16 * 32, IT_W1 = DEPTH * 32 * 16 * 64, IT_W2 = DEPTH * 32 * 16 * 32;
constexpr int IT_ALL = IT_WIN + IT_WBR + IT_WOUT + IT_W1 + IT_W2;

PHASE_FN void p0_prologue(Ctx cx) {
    Frame F = mkframe(cx); const ArgsP a = F.ap;
    REFRESH(F);
    unsigned char* ws = F.ws;
    LAS float* scr = (LAS float*)(F.lds + F.wave * 16384);
    const int gw = F.bid * NWAVES + F.wave, NGW = F.G * NWAVES;
    for (int it = gw; it < IT_ALL; it += NGW) {
        int r = it;
        if (r < IT_WIN) { const int l = r / 4096, q = r % 4096, kb = q / 256, nb = q % 256, d0 = 32 * nb, s0 = d0 + (d0 >= 2048 ? 16 : 0);
            transpose_item(a->in[I_WIN] + (size_t)l * 1024 * D_IN, D_IN, 1024, s0, (bf16*)(ws + WS_WIN) + (size_t)l * 8192 * 1024, d0, 64 * kb, scr, F.lane); continue; }
        r -= IT_WIN;
        if (r < IT_WBR) { const int mi = r / 256, q = r % 256, kb = q / 32, nb = q % 32;
            transpose_item(a->in[I_WBR] + (size_t)mi * 512 * 1024, 1024, 512, 32 * nb, (bf16*)(ws + WS_WBR) + (size_t)mi * 1024 * 512, 32 * nb, 64 * kb, scr, F.lane); continue; }
        r -= IT_WBR;
        if (r < IT_WOUT) { const int l = r / 512, q = r % 512, kb = q / 32, nb = q % 32;
            transpose_item(a->in[I_WOUT] + (size_t)l * 1024 * 1024, 1024, 1024, 32 * nb, (bf16*)(ws + WS_WOUT) + (size_t)l * 1024 * 1024, 32 * nb, 64 * kb, scr, F.lane); continue; }
        r -= IT_WOUT;
        if (r < IT_W1) { const int mi = r / 1024, q = r % 1024, kb = q / 64, nb = q % 64, d0 = 32 * nb, pn = d0 >> 8, bj = (d0 >> 7) & 1, j = d0 & 127, s0 = 1024 * bj + 128 * pn + j;
            transpose_item(a->in[I_W1] + (size_t)mi * 1024 * 2048, 2048, 1024, s0, (bf16*)(ws + WS_W1) + (size_t)mi * 2048 * 1024, d0, 64 * kb, scr, F.lane); continue; }
        r -= IT_W1;
        { const int mi = r / 512, q = r % 512, kb = q / 32, nb = q % 32;
            transpose_item(a->in[I_W2] + (size_t)mi * 1024 * 1024, 1024, 1024, 32 * nb, (bf16*)(ws + WS_W2) + (size_t)mi * 1024 * 1024, 32 * nb, 64 * kb, scr, F.lane); }
    }
    const size_t gt = (size_t)F.bid * NTHREADS + F.tid, NGT = (size_t)F.G * NTHREADS;
    { float* wd = (float*)(ws + WS_WDEC);
      for (size_t i = gt; i < (size_t)DEPTH * 16 * 1024; i += NGT) { const int l = (int)(i >> 14), c = (int)(i >> 10) & 15, k = (int)i & 1023; wd[i] = a->in[I_WIN][((size_t)l * 1024 + k) * D_IN + 2048 + c]; }
      float* wr = (float*)(ws + WS_WRT);
      for (size_t i = gt; i < (size_t)DEPTH * 32 * 1024; i += NGT) { const int l = (int)(i >> 15), e = (int)(i >> 10) & 31, k = (int)i & 1023; wr[i] = a->in[I_WR][((size_t)l * 1024 + k) * 32 + e]; } }
    { f32x4* X4 = (f32x4*)(ws + WS_X); const f32x4* x4 = (const f32x4*)a->in[I_X]; const f32x4* c4 = (const f32x4*)a->in[I_CTX];
      for (size_t i = gt; i < (size_t)MT * 256; i += NGT) X4[i] = i < (size_t)MLAT * 256 ? x4[i] : c4[i - (size_t)MLAT * 256]; }
    if (F.bid == 0 && F.wave < DEPTH) { const int l = F.wave; const float* lv = a->in[I_DLAM] + l * 256;
        const float s1 = wave_sum(lv[F.lane] * lv[64 + F.lane]), s2 = wave_sum(lv[128 + F.lane] * lv[192 + F.lane]);
        if (F.lane == 0) ((float*)(ws + WS_LAM))[l] = expf(s1) - expf(s2) + (0.8f - 0.6f * expf(-0.3f * (float)l)); }
    { LAS float* red = (LAS float*)(F.lds);
      float* MOD = (float*)(ws + WS_MOD);
      __syncthreads();
      for (int it = F.bid; it < DEPTH * 96; it += F.G) {
        const int l = it / 96, n = (it % 96) * 64 + F.lane; const float* wa = a->in[I_WADA] + (size_t)l * 1024 * 6144 + n;
        float a0 = 0.f, a1 = 0.f, a2 = 0.f;
        for (int k = F.wave * 128; k < F.wave * 128 + 128; ++k) { const float w = wa[(size_t)k * 6144];
            a0 += siluf(a->in[I_C][k]) * w; a1 += siluf(a->in[I_C][1024 + k]) * w; a2 += siluf(a->in[I_CCTX][k]) * w; }
        red[(F.wave * 3 + 0) * 64 + F.lane] = a0; red[(F.wave * 3 + 1) * 64 + F.lane] = a1; red[(F.wave * 3 + 2) * 64 + F.lane] = a2;
        __syncthreads();
        if (F.tid < 192) { const int i = F.tid >> 6, c = F.tid & 63; float s = 0.f;
#pragma unroll
            for (int w = 0; w < 8; ++w) s += red[(w * 3 + i) * 64 + c];
            const int nn = (it % 96) * 64 + c; MOD[((size_t)l * 3 + i) * 6144 + nn] = s + a->in[I_BADA][l * 6144 + nn]; }
        __syncthreads();
      } }
}

__device__ __forceinline__ void ln_inplace(f32x4 (&v)[4]) {
    float s = 0.f;
#pragma unroll
    for (int j = 0; j < 4; ++j) s += (v[j].x + v[j].y) + (v[j].z + v[j].w);
    const float mean = wave_sum(s) * (1.f / DM); float s2 = 0.f;
#pragma unroll
    for (int j = 0; j < 4; ++j) { v[j] = v[j] - mean; s2 += (v[j].x * v[j].x + v[j].y * v[j].y) + (v[j].z * v[j].z + v[j].w * v[j].w); }
    const float rstd = 1.f / sqrtf(wave_sum(s2) * (1.f / DM) + LN_EPS);
#pragma unroll
    for (int j = 0; j < 4; ++j) v[j] = v[j] * rstd;
}
__device__ __forceinline__ void modulate_store(const Frame& F, int l, int which, int row, f32x4 (&v)[4]) {
    ln_inplace(v);
    const float* mod = (const float*)(F.ws + WS_MOD) + ((size_t)l * 3 + mod_index(row)) * 6144 + which * 3072;
    bf16* hx = (bf16*)(F.ws + WS_HX) + (size_t)row * DM;
#pragma unroll
    for (int j = 0; j < 4; ++j) { const int c = 4 * F.lane + 256 * j; const f32x4 sh = *(const f32x4*)(mod + c), sc = *(const f32x4*)(mod + 1024 + c);
        v[j] = v[j] * (sc + 1.f) + sh;
        u32x2 o; o.x = pk2(v[j].x, v[j].y); o.y = pk2(v[j].z, v[j].w); *(u32x2*)(hx + c) = o; }
}
__device__ __forceinline__ void decay_cols(const Frame& F, int l, int row, const f32x4 (&h)[4]) {
    const float* wd = (const float*)(F.ws + WS_WDEC) + (size_t)l * 16 * 1024; float* dec = (float*)(F.ws + WS_DEC) + (size_t)row * 16;
    float mine = 0.f;
#pragma unroll
    for (int i = 0; i < 16; ++i) { float s = 0.f;
#pragma unroll
        for (int j = 0; j < 4; ++j) { const f32x4 w = *(const f32x4*)(wd + i * 1024 + 4 * F.lane + 256 * j); s += (h[j].x * w.x + h[j].y * w.y) + (h[j].z * w.z + h[j].w * w.w); }
        s = wave_sum(s); if (F.lane == i) mine = s; }
    if (F.lane < 16) dec[F.lane] = mine;
}
PHASE_FN void ph_lnmod0(Ctx cx) {
    Frame F = mkframe(cx);
    REFRESH(F);
    const int gw = F.bid * NWAVES + F.wave, NGW = F.G * NWAVES;
    for (int row = gw; row < MT; row += NGW) { f32x4 v[4]; const f32x4* xr = (const f32x4*)(F.ws + WS_X) + (size_t)row * 256 + F.lane;
#pragma unroll
        for (int j = 0; j < 4; ++j) v[j] = xr[64 * j];
        modulate_store(F, 0, 0, row, v); decay_cols(F, 0, row, v); }
}

struct TileMap {
    __device__ static __forceinline__ bool map(int i, int G, int c, int nM, int nN, int& pm, int& pn) {
        const int nwg = nM * nN; const long L = (long)i * G + c; if (L >= nwg) return false;
        int wgid = (int)L; { const int q = nwg / 8, r = nwg % 8, xcd = wgid % 8, off = wgid / 8; wgid = (xcd < r ? xcd * (q + 1) : r * (q + 1) + (xcd - r) * q) + off; }
        const int nig = 8 * nN, gid = wgid / nig, fm = gid * 8, gsz = (nM - fm) < 8 ? (nM - fm) : 8;
        pm = fm + ((wgid % nig) % gsz); pn = (wgid % nig) / gsz; return true; }
};
struct StaticOrder { int nM, nN, G, c, K;
    __device__ __forceinline__ bool next(int i, pg8::Unit& u) const { if (!TileMap::map(i, G, c, nM, nN, u.pm, u.pn)) return false; u.aux = 0;
        u.aoff = (unsigned)u.pm * 256u * (unsigned)K * 2u; u.boff = (unsigned)u.pn * 256u * (unsigned)K * 2u; return true; } };
struct MergeOrder { int G, c;
    __device__ __forceinline__ bool next(int i, pg8::Unit& u) const { const int br = i % 3; if (!TileMap::map(i / 3, G, c, MT / 256, 4, u.pm, u.pn)) return false; u.aux = br;
        u.aoff = (unsigned)br * (unsigned)(MT * 512 * 2) + (unsigned)u.pm * (256u * 512u * 2u); u.boff = ((unsigned)br * 1024u + (unsigned)u.pn * 256u) * (512u * 2u); return true; } };
struct MoeOrder { const volatile LAS int* tab;
    __device__ __forceinline__ bool next(int i, pg8::Unit& u) const { const int w = tab[416 + i]; if (w < 0) return false; u.pm = w & 0xfff; u.pn = (w >> 12) & 0xf; u.aux = (w >> 16) & 0xff; const int nN = (w >> 24) & 0xf;
        u.aoff = (unsigned)u.pm * (256u * 1024u * 2u); u.boff = (unsigned)((u.aux * nN + u.pn) * 256) * (1024u * 2u); return true; } };

struct EpiWin { bf16* P;
    __device__ __forceinline__ void operator()(const f32x4 (&acc)[2][2][4][2], const pg8::Unit& u, int wr, int wc, int fr, int fq) const {
        const int row0 = u.pm * 256 + wr * 64 + fr, col0 = u.pn * 256 + wc * 32 + 8 * fq; const bool sg = u.pn >= 20;
#pragma unroll
        for (int ai = 0; ai < 2; ++ai)
#pragma unroll
            for (int m = 0; m < 4; ++m) { bf16* rowp = P + (size_t)(row0 + ai * 128 + m * 16) * NP + col0;
#pragma unroll
                for (int bj = 0; bj < 2; ++bj) { f32x4 v0 = acc[ai][bj][m][0], v1 = acc[ai][bj][m][1];
                    if (sg) {
#pragma unroll
                        for (int q = 0; q < 4; ++q) { v0[q] = sigmf(v0[q]); v1[q] = sigmf(v1[q]); } }
                    u32x4 w; w.x = pk2(v0[0], v0[1]); w.y = pk2(v0[2], v0[3]); w.z = pk2(v1[0], v1[1]); w.w = pk2(v1[2], v1[3]);
                    *(u32x4*)(rowp + bj * 128) = w; } }
    } };
struct EpiMerge { const bf16* P; float* MACC; bf16* MBF;
    __device__ __forceinline__ void operator()(const f32x4 (&acc)[2][2][4][2], const pg8::Unit& u, int wr, int wc, int fr, int fq) const {
        const int row0 = u.pm * 256 + wr * 64 + fr, col0 = u.pn * 256 + wc * 32 + 8 * fq, br = u.aux;
#pragma unroll
        for (int ai = 0; ai < 2; ++ai)
#pragma unroll
            for (int m = 0; m < 4; ++m) { const size_t row = (size_t)(row0 + ai * 128 + m * 16);
#pragma unroll
                for (int bj = 0; bj < 2; ++bj) { const int col = col0 + bj * 128;
                    const u32x4 g = *(const u32x4*)(P + row * NP + PC_GATE + 1024 * br + col);
                    f32x4 v0 = acc[ai][bj][m][0], v1 = acc[ai][bj][m][1];
                    v0[0] *= bflo(g.x); v0[1] *= bfhi(g.x); v0[2] *= bflo(g.y); v0[3] *= bfhi(g.y); v1[0] *= bflo(g.z); v1[1] *= bfhi(g.z); v1[2] *= bflo(g.w); v1[3] *= bfhi(g.w);
                    float* mp = MACC + row * DM + col;
                    if (br > 0) { v0 = v0 + *(const f32x4*)mp; v1 = v1 + *(const f32x4*)(mp + 4); }
                    if (br < 2) { *(f32x4*)mp = v0; *(f32x4*)(mp + 4) = v1; }
                    else { u32x4 w; w.x = pk2(v0[0], v0[1]); w.y = pk2(v0[2], v0[3]); w.z = pk2(v1[0], v1[1]); w.w = pk2(v1[2], v1[3]); *(u32x4*)(MBF + row * DM + col) = w; } } }
    } };
struct EpiWout { const float* X; const float* MODL; float* T;
    __device__ __forceinline__ void operator()(const f32x4 (&acc)[2][2][4][2], const pg8::Unit& u, int wr, int wc, int fr, int fq) const {
        const int row0 = u.pm * 256 + wr * 64 + fr, col0 = u.pn * 256 + wc * 32 + 8 * fq; const float* g1 = MODL + (size_t)(u.pm < 64 ? (u.pm >> 5) : 2) * 6144 + 2048;
#pragma unroll
        for (int bj = 0; bj < 2; ++bj) { const int col = col0 + bj * 128; const f32x4 ga = *(const f32x4*)(g1 + col), gb = *(const f32x4*)(g1 + col + 4);
#pragma unroll
            for (int ai = 0; ai < 2; ++ai)
#pragma unroll
                for (int m = 0; m < 4; ++m) { const size_t o = (size_t)(row0 + ai * 128 + m * 16) * DM + col;
                    const f32x4 xa = *(const f32x4*)(X + o), xb = *(const f32x4*)(X + o + 4);
                    *(f32x4*)(T + o) = xa * DN_ALPHA + ga * acc[ai][bj][m][0]; *(f32x4*)(T + o + 4) = xb * DN_ALPHA + gb * acc[ai][bj][m][1]; } }
    } };
struct EpiAct { const float* B1; bf16* ACT;
    __device__ __forceinline__ void operator()(const f32x4 (&acc)[2][2][4][2], const pg8::Unit& u, int wr, int wc, int fr, int fq) const {
        const int row0 = u.pm * 256 + wr * 64 + fr, cc = u.pn * 128 + wc * 32 + 8 * fq; const float* b = B1 + (size_t)u.aux * 2048;
        const f32x4 bg0 = *(const f32x4*)(b + cc), bg1 = *(const f32x4*)(b + cc + 4), bl0 = *(const f32x4*)(b + 1024 + cc), bl1 = *(const f32x4*)(b + 1024 + cc + 4);
#pragma unroll
        for (int ai = 0; ai < 2; ++ai)
#pragma unroll
            for (int m = 0; m < 4; ++m) { const size_t row = (size_t)(row0 + ai * 128 + m * 16);
                f32x4 g0 = acc[ai][0][m][0] + bg0, g1 = acc[ai][0][m][1] + bg1, l0 = acc[ai][1][m][0] + bl0, l1 = acc[ai][1][m][1] + bl1; float r[8];
#pragma unroll
                for (int q = 0; q < 4; ++q) { const float xg = fminf(g0[q], 7.f), xl = fminf(fmaxf(l0[q], -7.f), 7.f); r[q] = xg * sigmf(1.702f * xg) * (xl + 1.f);
                    const float yg = fminf(g1[q], 7.f), yl = fminf(fmaxf(l1[q], -7.f), 7.f); r[4 + q] = yg * sigmf(1.702f * yg) * (yl + 1.f); }
                u32x4 w; w.x = pk2(r[0], r[1]); w.y = pk2(r[2], r[3]); w.z = pk2(r[4], r[5]); w.w = pk2(r[6], r[7]);
                *(u32x4*)(ACT + row * 1024 + cc) = w; }
    } };
struct EpiY { const float* B2; bf16* Y;
    __device__ __forceinline__ void operator()(const f32x4 (&acc)[2][2][4][2], const pg8::Unit& u, int wr, int wc, int fr, int fq) const {
        const int row0 = u.pm * 256 + wr * 64 + fr, col0 = u.pn * 256 + wc * 32 + 8 * fq; const float* b = B2 + (size_t)u.aux * 1024;
#pragma unroll
        for (int bj = 0; bj < 2; ++bj) { const int col = col0 + bj * 128; const f32x4 ba = *(const f32x4*)(b + col), bb = *(const f32x4*)(b + col + 4);
#pragma unroll
            for (int ai = 0; ai < 2; ++ai)
#pragma unroll
                for (int m = 0; m < 4; ++m) { const size_t row = (size_t)(row0 + ai * 128 + m * 16); const f32x4 v0 = acc[ai][bj][m][0] + ba, v1 = acc[ai][bj][m][1] + bb;
                    u32x4 w; w.x = pk2(v0[0], v0[1]); w.y = pk2(v0[2], v0[3]); w.z = pk2(v1[0], v1[1]); w.w = pk2(v1[2], v1[3]); *(u32x4*)(Y + row * 1024 + col) = w; } }
    } };
PHASE_FN void ph_prep(Ctx cx, int l_) {
    Frame F = mkframe(cx); const ArgsP a = F.ap; const int l = rfl(l_);
    REFRESH(F);
    const int gw = F.bid * NWAVES + F.wave, NGW = F.G * NWAVES;
    bf16* P = (bf16*)(F.ws + WS_P);
    for (int row = gw; row < MLAT; row += NGW) {
        const int t = row & (SEQ - 1), j = F.lane & 31, f = j & 15; const float pos = (float)(j < 16 ? (t >> 6) : (t & 63));
        const float inv = exp2f(-(float)f * (13.287712379549449f / 16.f));
        const float ang = pos * inv, rev = ang * 0.15915494309189535f, fr = rev - floorf(rev);
        const float cs = __builtin_amdgcn_cosf(fr), sn = __builtin_amdgcn_sinf(fr);
        bf16* pr = P + (size_t)row * NP + PC_DQ;
#pragma unroll
        for (int it = 0; it < 8; ++it) { const int blk = 2 * it + (F.lane >> 5); bf16* p = pr + blk * 64 + j;
            const float x1 = bf2f(p[0]), x2 = bf2f(p[32]); p[0] = (bf16)f2bf(x1 * cs - x2 * sn); p[32] = (bf16)f2bf(x2 * cs + x1 * sn); }
    }
#if !USE_GDN_FAST
    float* QN = (float*)(F.ws + WS_QN); float* KN = (float*)(F.ws + WS_KN); float* VV = (float*)(F.ws + WS_VV);
    const float* cw = a->in[I_CONVW] + (size_t)l * 3 * 1536;
    for (int row = gw; row < MT; row += NGW) {
        const bool lat = row < MLAT; const int t = lat ? (row & (SEQ - 1)) : ((row - MLAT) & (CTXL - 1)), L = lat ? SEQ : CTXL; const bool hm = t > 0, hp = t < L - 1;
        const bf16* p0 = P + (size_t)row * NP;
#pragma unroll
        for (int wh = 0; wh < 3; ++wh)
#pragma unroll
            for (int h = 0; h < 4; ++h) { const int c = wh * 512 + h * 128 + 2 * F.lane;
                const unsigned x0 = *(const unsigned*)(p0 + c), xm = hm ? *(const unsigned*)(p0 - NP + c) : 0u, xp = hp ? *(const unsigned*)(p0 + NP + c) : 0u;
                const f32x2 w0 = *(const f32x2*)(cw + c), w1 = *(const f32x2*)(cw + 1536 + c), w2 = *(const f32x2*)(cw + 3072 + c);
                float y0 = bflo(xm) * w0.x + bflo(x0) * w1.x + bflo(xp) * w2.x, y1 = bfhi(xm) * w0.y + bfhi(x0) * w1.y + bfhi(xp) * w2.y;
                y0 = siluf(y0); y1 = siluf(y1);
                if (wh < 2) { const float ss = wave_sum(y0 * y0 + y1 * y1), sc = (1.f / sqrtf(ss + RMS_EPS)) * (wh == 0 ? 0.08838834764831845f : 1.f); y0 *= sc; y1 *= sc; }
                float* o = (wh == 0 ? QN : wh == 1 ? KN : VV) + (size_t)row * 512 + h * 128 + 2 * F.lane; *(f32x2*)o = (f32x2){y0, y1}; }
    }
#endif
}

PHASE_FN void ph_gdn_chain_naive(Ctx cx, int l_) {
    Frame F = mkframe(cx); const ArgsP a = F.ap; const int l = rfl(l_);
    REFRESH(F);
    LAS float* kq = (LAS float*)F.lds;
    const float* QN = (const float*)(F.ws + WS_QN); const float* KN = (const float*)(F.ws + WS_KN); const float* VV = (const float*)(F.ws + WS_VV);
    const float* DEC = (const float*)(F.ws + WS_DEC); float* OG = (float*)(F.ws + WS_OG);
    for (int it = F.bid; it < 16; it += F.G) {
        const int b = it >> 3, h = (it >> 1) & 3, d = it & 1, v = (F.tid >> 1) & 127, hf = F.tid & 1;
        const float al = expf(a->in[I_ALOG][(l * 2 + d) * 4 + h]), dtb = a->in[I_DTB][(l * 2 + d) * 4 + h];
        float S[64];
#pragma unroll
        for (int k = 0; k < 64; ++k) S[k] = 0.f;
        __syncthreads();
        for (int step = 0; step < CTXL + SEQ; ++step) {
            int row; if (step < CTXL) { const int pos = d ? CTXL - 1 - step : step; row = MLAT + b * CTXL + pos; } else { const int tt = step - CTXL, pos = d ? SEQ - 1 - tt : tt; row = b * SEQ + pos; }
            LAS float* buf = kq + (step & 1) * 256;
            if (F.tid >= 256) { if (F.tid < 384) buf[F.tid - 256] = KN[(size_t)row * 512 + h * 128 + F.tid - 256]; else buf[F.tid - 256] = QN[(size_t)row * 512 + h * 128 + F.tid - 384]; }
            __syncthreads();
            if (F.tid < 256) {
                const float av = DEC[(size_t)row * 16 + 8 * d + h] + dtb, bb = DEC[(size_t)row * 16 + 8 * d + 4 + h];
                const float sp = av > 20.f ? av : log1pf(expf(av)); const float eg = expf(-al * sp), beta = sigmf(bb);
                const float vt = VV[(size_t)row * 512 + h * 128 + v];
                const LAS float* kb = buf + 64 * hf; const LAS float* qb = buf + 128 + 64 * hf;
                float kS = 0.f;
#pragma unroll
                for (int k4 = 0; k4 < 16; ++k4) { const f32x4 kk = *(const LAS f32x4*)(kb + 4 * k4); kS += (kk.x * S[4 * k4] + kk.y * S[4 * k4 + 1]) + (kk.z * S[4 * k4 + 2] + kk.w * S[4 * k4 + 3]); }
                kS += __shfl_xor(kS, 1);
                const float vn = beta * (vt - eg * kS); float o = 0.f;
#pragma unroll
                for (int k4 = 0; k4 < 16; ++k4) { const f32x4 kk = *(const LAS f32x4*)(kb + 4 * k4), qq = *(const LAS f32x4*)(qb + 4 * k4);
                    S[4 * k4] = eg * S[4 * k4] + kk.x * vn; S[4 * k4 + 1] = eg * S[4 * k4 + 1] + kk.y * vn; S[4 * k4 + 2] = eg * S[4 * k4 + 2] + kk.z * vn; S[4 * k4 + 3] = eg * S[4 * k4 + 3] + kk.w * vn;
                    o += (qq.x * S[4 * k4] + qq.y * S[4 * k4 + 1]) + (qq.z * S[4 * k4 + 2] + qq.w * S[4 * k4 + 3]); }
                o += __shfl_xor(o, 1);
                if (hf == 0) OG[((size_t)d * MT + row) * 512 + h * 128 + v] = o;
            }
        }
        __syncthreads();
    }
}

PHASE_FN void ph_diff_naive(Ctx cx, int l_) {
    Frame F = mkframe(cx); const int l = rfl(l_);
    REFRESH(F);
    LAS float* Kf = (LAS float*)F.lds;
    LAS float* Vf = (LAS float*)(F.lds + 16384);
    const bf16* P = (const bf16*)(F.ws + WS_P); float* OD = (float*)(F.ws + WS_OD);
    for (int it = F.bid; it < 512 + 16; it += F.G) {
        int b, h, m, q0, t0, t1;
        if (it < 512) { b = it >> 8; h = (it >> 6) & 3; m = (it >> 5) & 1; q0 = b * SEQ + (it & 31) * 256; t0 = 0; t1 = 132; }
        else { const int j = it - 512; b = j >> 3; h = (j >> 1) & 3; m = j & 1; q0 = MLAT + b * CTXL; t0 = 128; t1 = 132; }
        const int qi = F.tid & 255, eh = F.tid >> 8;
        float q[64], o[64];
        { const bf16* qp = P + (size_t)(q0 + qi) * NP + PC_DQ + h * 128 + m * 64;
#pragma unroll
          for (int d8 = 0; d8 < 8; ++d8) { const u32x4 w = *(const u32x4*)(qp + 8 * d8); q[8 * d8] = bflo(w.x) * 0.125f; q[8 * d8 + 1] = bfhi(w.x) * 0.125f; q[8 * d8 + 2] = bflo(w.y) * 0.125f; q[8 * d8 + 3] = bfhi(w.y) * 0.125f;
              q[8 * d8 + 4] = bflo(w.z) * 0.125f; q[8 * d8 + 5] = bfhi(w.z) * 0.125f; q[8 * d8 + 6] = bflo(w.w) * 0.125f; q[8 * d8 + 7] = bfhi(w.w) * 0.125f; } }
#pragma unroll
        for (int e = 0; e < 64; ++e) o[e] = 0.f;
        float mx = -1e30f, ls = 0.f;
        for (int t = t0; t < t1; ++t) {
            const int krow0 = t < 128 ? b * SEQ + 64 * t : MLAT + b * CTXL + 64 * (t - 128);
            __syncthreads();
            { const int key = F.tid >> 3, c8 = (F.tid & 7) * 8; const bf16* kp = P + (size_t)(krow0 + key) * NP + PC_DK + h * 128 + m * 64 + c8; const u32x4 w = *(const u32x4*)kp;
              LAS float* kd = Kf + key * 64 + c8; *(LAS f32x4*)kd = (f32x4){bflo(w.x), bfhi(w.x), bflo(w.y), bfhi(w.y)}; *(LAS f32x4*)(kd + 4) = (f32x4){bflo(w.z), bfhi(w.z), bflo(w.w), bfhi(w.w)};
              const int c16 = (F.tid & 7) * 16; const bf16* vp = P + (size_t)(krow0 + key) * NP + PC_DV + h * 128 + c16; const u32x4 w0 = *(const u32x4*)vp, w1 = *(const u32x4*)(vp + 8);
              LAS float* vd = Vf + key * 128 + c16; *(LAS f32x4*)vd = (f32x4){bflo(w0.x), bfhi(w0.x), bflo(w0.y), bfhi(w0.y)}; *(LAS f32x4*)(vd + 4) = (f32x4){bflo(w0.z), bfhi(w0.z), bflo(w0.w), bfhi(w0.w)};
              *(LAS f32x4*)(vd + 8) = (f32x4){bflo(w1.x), bfhi(w1.x), bflo(w1.y), bfhi(w1.y)}; *(LAS f32x4*)(vd + 12) = (f32x4){bflo(w1.z), bfhi(w1.z), bflo(w1.w), bfhi(w1.w)}; }
            __syncthreads();
            for (int kk = 0; kk < 64; ++kk) {
                float s = 0.f;
#pragma unroll
                for (int d4 = 0; d4 < 16; ++d4) { const f32x4 kv = *(const LAS f32x4*)(Kf + kk * 64 + 4 * d4); s += (q[4 * d4] * kv.x + q[4 * d4 + 1] * kv.y) + (q[4 * d4 + 2] * kv.z + q[4 * d4 + 3] * kv.w); }
                const float mn = fmaxf(mx, s), corr = __expf(mx - mn), p = __expf(s - mn); mx = mn; ls = ls * corr + p;
#pragma unroll
                for (int e4 = 0; e4 < 16; ++e4) { const f32x4 vv = *(const LAS f32x4*)(Vf + kk * 128 + eh * 64 + 4 * e4);
                    o[4 * e4] = o[4 * e4] * corr + p * vv.x; o[4 * e4 + 1] = o[4 * e4 + 1] * corr + p * vv.y; o[4 * e4 + 2] = o[4 * e4 + 2] * corr + p * vv.z; o[4 * e4 + 3] = o[4 * e4 + 3] * corr + p * vv.w; }
            }
        }
        const float il = 1.f / ls; float* op = OD + ((size_t)m * MT + q0 + qi) * 512 + h * 128 + eh * 64;
#pragma unroll
        for (int e4 = 0; e4 < 16; ++e4) *(f32x4*)(op + 4 * e4) = (f32x4){o[4 * e4] * il, o[4 * e4 + 1] * il, o[4 * e4 + 2] * il, o[4 * e4 + 3] * il};
    }
    __syncthreads();
}

__device__ __forceinline__ void na_key(const bf16* kp, const bf16* vp, const float (&q)[64], float bias, float& mx, float& ls, float (&o)[64]) {
    float s = 0.f;
#pragma unroll
    for (int d8 = 0; d8 < 8; ++d8) { const u32x4 w = *(const u32x4*)(kp + 8 * d8);
        s += (q[8 * d8] * bflo(w.x) + q[8 * d8 + 1] * bfhi(w.x)) + (q[8 * d8 + 2] * bflo(w.y) + q[8 * d8 + 3] * bfhi(w.y)) + (q[8 * d8 + 4] * bflo(w.z) + q[8 * d8 + 5] * bfhi(w.z)) + (q[8 * d8 + 6] * bflo(w.w) + q[8 * d8 + 7] * bfhi(w.w)); }
    s += bias;
    const float mn = fmaxf(mx, s), corr = __expf(mx - mn), p = __expf(s - mn); mx = mn; ls = ls * corr + p;
#pragma unroll
    for (int d8 = 0; d8 < 8; ++d8) { const u32x4 w = *(const u32x4*)(vp + 8 * d8);
        o[8 * d8] = o[8 * d8] * corr + p * bflo(w.x); o[8 * d8 + 1] = o[8 * d8 + 1] * corr + p * bfhi(w.x); o[8 * d8 + 2] = o[8 * d8 + 2] * corr + p * bflo(w.y); o[8 * d8 + 3] = o[8 * d8 + 3] * corr + p * bfhi(w.y);
        o[8 * d8 + 4] = o[8 * d8 + 4] * corr + p * bflo(w.z); o[8 * d8 + 5] = o[8 * d8 + 5] * corr + p * bfhi(w.z); o[8 * d8 + 6] = o[8 * d8 + 6] * corr + p * bflo(w.w); o[8 * d8 + 7] = o[8 * d8 + 7] * corr + p * bfhi(w.w); }
}
PHASE_FN void ph_na_naive(Ctx cx, int l_) {
    Frame F = mkframe(cx); const ArgsP a = F.ap; const int l = rfl(l_);
    REFRESH(F);
    const bf16* P = (const bf16*)(F.ws + WS_P); bf16* YC = (bf16*)(F.ws + WS_YC);
    const int gt = F.bid * NTHREADS + F.tid, NGT = F.G * NTHREADS;
    for (int idx = gt; idx < 8 * MT; idx += NGT) {
        int b, h, qrow, t; bool lat = idx < 8 * MLAT;
        if (lat) { b = idx >> 16; h = (idx >> 13) & 7; t = idx & (SEQ - 1); qrow = b * SEQ + t; } else { const int j = idx - 8 * MLAT; b = j >> 11; h = (j >> 8) & 7; t = j & 255; qrow = MLAT + b * CTXL + t; }
        float q[64], o[64];
        { const bf16* qp = P + (size_t)qrow * NP + PC_NQ + h * 64;
#pragma unroll
          for (int d8 = 0; d8 < 8; ++d8) { const u32x4 w = *(const u32x4*)(qp + 8 * d8); q[8 * d8] = bflo(w.x) * 0.125f; q[8 * d8 + 1] = bfhi(w.x) * 0.125f; q[8 * d8 + 2] = bflo(w.y) * 0.125f; q[8 * d8 + 3] = bfhi(w.y) * 0.125f;
              q[8 * d8 + 4] = bflo(w.z) * 0.125f; q[8 * d8 + 5] = bfhi(w.z) * 0.125f; q[8 * d8 + 6] = bflo(w.w) * 0.125f; q[8 * d8 + 7] = bfhi(w.w) * 0.125f; } }
#pragma unroll
        for (int e = 0; e < 64; ++e) o[e] = 0.f;
        float mx = -1e30f, ls = 0.f;
        if (lat) { const int r = t >> 6, c = t & 63; const int r0 = min(max(r - 4, 0), 120), c0 = min(max(c - 8, 0), 48);
            const float* rp = a->in[I_RPB] + ((size_t)l * 8 + h) * 15 * 31;
            for (int kr = 0; kr < 8; ++kr) for (int kc = 0; kc < 16; ++kc) { const int krow = b * SEQ + (r0 + kr) * 64 + c0 + kc;
                const float bias = rp[(r0 + kr - r + 7) * 31 + (c0 + kc - c + 15)];
                na_key(P + (size_t)krow * NP + PC_NK + h * 64, P + (size_t)krow * NP + PC_NV + h * 64, q, bias, mx, ls, o); } }
        for (int j = 0; j < CTXL; ++j) { const int krow = MLAT + b * CTXL + j; na_key(P + (size_t)krow * NP + PC_NK + h * 64, P + (size_t)krow * NP + PC_NV + h * 64, q, 0.f, mx, ls, o); }
        const float il = 1.f / ls; bf16* op = YC + (size_t)qrow * 512 + h * 64;
#pragma unroll
        for (int d8 = 0; d8 < 8; ++d8) { u32x4 w; w.x = pk2(o[8 * d8] * il, o[8 * d8 + 1] * il); w.y = pk2(o[8 * d8 + 2] * il, o[8 * d8 + 3] * il); w.z = pk2(o[8 * d8 + 4] * il, o[8 * d8 + 5] * il); w.w = pk2(o[8 * d8 + 6] * il, o[8 * d8 + 7] * il);
            *(u32x4*)(op + 8 * d8) = w; }
    }
}

__device__ __forceinline__ float grp16_sum(float v) { v += __shfl_xor(v, 1); v += __shfl_xor(v, 2); v += __shfl_xor(v, 4); v += __shfl_xor(v, 8); return v; }
PHASE_FN void ph_combine(Ctx cx, int l_) {
    Frame F = mkframe(cx); const ArgsP a = F.ap; const int l = rfl(l_);
    REFRESH(F);
    const int gw = F.bid * NWAVES + F.wave, NGW = F.G * NWAVES;
    const float* OG = (const float*)(F.ws + WS_OG); const float* OD = (const float*)(F.ws + WS_OD); const bf16* P = (const bf16*)(F.ws + WS_P);
    bf16* YA = (bf16*)(F.ws + WS_YA); bf16* YB = (bf16*)(F.ws + WS_YB);
    const float lam = ((const float*)(F.ws + WS_LAM))[l], omli = 1.f - (0.8f - 0.6f * expf(-0.3f * (float)l));
    const float* gnw = a->in[I_GNW] + l * 128; const float* dnw = a->in[I_DNW] + l * 128;
    for (int row = gw; row < MT; row += NGW) {
        const int c = 8 * F.lane, ch = c & 127;
        { const float* p0 = OG + (size_t)row * 512 + c; const float* p1 = p0 + (size_t)MT * 512;
          const f32x4 a0 = *(const f32x4*)p0 + *(const f32x4*)p1, a1 = *(const f32x4*)(p0 + 4) + *(const f32x4*)(p1 + 4);
          float ss = (a0.x * a0.x + a0.y * a0.y) + (a0.z * a0.z + a0.w * a0.w) + (a1.x * a1.x + a1.y * a1.y) + (a1.z * a1.z + a1.w * a1.w);
          const float rs = 1.f / sqrtf(grp16_sum(ss) * (1.f / 128.f) + RMS_EPS);
          const u32x4 z = *(const u32x4*)(P + (size_t)row * NP + PC_GZ + c); const f32x4 w0 = *(const f32x4*)(gnw + ch), w1 = *(const f32x4*)(gnw + ch + 4);
          u32x4 o; o.x = pk2(a0.x * rs * w0.x * siluf(bflo(z.x)), a0.y * rs * w0.y * siluf(bfhi(z.x))); o.y = pk2(a0.z * rs * w0.z * siluf(bflo(z.y)), a0.w * rs * w0.w * siluf(bfhi(z.y)));
          o.z = pk2(a1.x * rs * w1.x * siluf(bflo(z.z)), a1.y * rs * w1.y * siluf(bfhi(z.z))); o.w = pk2(a1.z * rs * w1.z * siluf(bflo(z.w)), a1.w * rs * w1.w * siluf(bfhi(z.w)));
          *(u32x4*)(YA + (size_t)row * 512 + c) = o; }
#if !USE_DIFF_MFMA
        { const float* p0 = OD + (size_t)row * 512 + c; const float* p1 = p0 + (size_t)MT * 512;
          const f32x4 a0 = *(const f32x4*)p0 - *(const f32x4*)p1 * lam, a1 = *(const f32x4*)(p0 + 4) - *(const f32x4*)(p1 + 4) * lam;
          float ss = (a0.x * a0.x + a0.y * a0.y) + (a0.z * a0.z + a0.w * a0.w) + (a1.x * a1.x + a1.y * a1.y) + (a1.z * a1.z + a1.w * a1.w);
          const float rs = (1.f / sqrtf(grp16_sum(ss) * (1.f / 128.f) + RMS_EPS)) * omli;
          const f32x4 w0 = *(const f32x4*)(dnw + ch), w1 = *(const f32x4*)(dnw + ch + 4);
          u32x4 o; o.x = pk2(a0.x * rs * w0.x, a0.y * rs * w0.y); o.y = pk2(a0.z * rs * w0.z, a0.w * rs * w0.w); o.z = pk2(a1.x * rs * w1.x, a1.y * rs * w1.y); o.w = pk2(a1.z * rs * w1.z, a1.w * rs * w1.w);
          *(u32x4*)(YB + (size_t)row * 512 + c) = o; }
#endif
    }
}
namespace dattn {
using s16x4  = __attribute__((ext_vector_type(4))) short;
using f32x16 = __attribute__((ext_vector_type(16))) float;
constexpr int KVBLK = 64;
constexpr float SCALE = 0.125f, THR = 8.f;
constexpr int SHM_V = KVBLK * 128 * 2, SHM_K = KVBLK * 128 * 2, SHM_ATTN = 2 * SHM_V + 2 * SHM_K + 8 * 64 * 4;
#define DA_KSWZ(row, colB) ((row) * 256 + ((colB) ^ (((row) & 7) << 4)))
#define DA_SBAR() __builtin_amdgcn_sched_barrier(0)
__device__ __forceinline__ int crow(int r, int hi) { return (r & 3) + 8 * (r >> 2) + 4 * hi; }
__device__ __forceinline__ unsigned cvtpk(float lo, float hi) { return pg8::cvt_pk_bf16(lo, hi); }
__device__ __forceinline__ void partialSM(f32x16& p0, f32x16& p1, float& m_reg, float& mn, float& alpha) {
  constexpr float C = SCALE * 1.4426950408889634f;
  float pmax = p0[0];
#pragma unroll
  for (int r = 1; r < 16; ++r) pmax = fmaxf(pmax, p0[r]);
#pragma unroll
  for (int r = 0; r < 16; ++r) pmax = fmaxf(pmax, p1[r]);
  { auto rr = __builtin_amdgcn_permlane32_swap(__float_as_uint(pmax), __float_as_uint(pmax), false, false);
    pmax = fmaxf(__uint_as_float(rr[0]), __uint_as_float(rr[1])); }
  if (__builtin_expect(__all(pmax - m_reg <= THR / SCALE), 1)) { mn = m_reg; alpha = 1.f; }
  else { mn = fmaxf(m_reg, pmax); alpha = __builtin_amdgcn_exp2f((m_reg - mn) * C); m_reg = mn; }
  const float mnC = -mn * C;
#pragma unroll
  for (int r = 0; r < 16; ++r) p0[r] = fmaf(p0[r], C, mnC);
#pragma unroll
  for (int r = 0; r < 16; ++r) p1[r] = fmaf(p1[r], C, mnC);
#pragma unroll
  for (int r = 0; r < 16; ++r) p0[r] = __builtin_amdgcn_exp2f(p0[r]);
}
__device__ __forceinline__ void finishSM(f32x16& p0, f32x16& p1, float alpha, float& l_reg, bf16x8& pa0, bf16x8& pa1, bf16x8& pa2, bf16x8& pa3) {
#pragma unroll
  for (int r = 0; r < 16; ++r) p1[r] = __builtin_amdgcn_exp2f(p1[r]);
  float ps = 0;
#pragma unroll
  for (int r = 0; r < 16; ++r) ps += p0[r];
#pragma unroll
  for (int r = 0; r < 16; ++r) ps += p1[r];
  { auto rr = __builtin_amdgcn_permlane32_swap(__float_as_uint(ps), __float_as_uint(ps), false, false);
    ps = __uint_as_float(rr[0]) + __uint_as_float(rr[1]); }
  l_reg = l_reg * alpha + ps;
#define DA_PK4(P, BASE, OUT) do { unsigned a0 = cvtpk(P[BASE + 0], P[BASE + 1]), a1 = cvtpk(P[BASE + 2], P[BASE + 3]);   \
    unsigned b0 = cvtpk(P[BASE + 4], P[BASE + 5]), b1 = cvtpk(P[BASE + 6], P[BASE + 7]);                              \
    auto r0 = __builtin_amdgcn_permlane32_swap(a0, b0, false, false); auto r1 = __builtin_amdgcn_permlane32_swap(a1, b1, false, false); \
    u32x4 w = {r0[0], r1[0], r0[1], r1[1]}; OUT = *reinterpret_cast<bf16x8*>(&w); } while (0)
  DA_PK4(p0, 0, pa0); DA_PK4(p0, 8, pa1); DA_PK4(p1, 0, pa2); DA_PK4(p1, 8, pa3);
#undef DA_PK4
}
__device__ __forceinline__ void qkt(f32x16& p0, f32x16& p1, const LAS char* Ks, const bf16x8* qr, int r32, int hi, int m) {
  p0 = f32x16{}; p1 = f32x16{};
#pragma unroll
  for (int d0 = 0; d0 < 4; ++d0) { const int cb = (m * 64 + d0 * 16 + hi * 8) * 2;
    const bf16x8 b0 = *reinterpret_cast<const LAS bf16x8*>(Ks + DA_KSWZ(r32, cb));
    const bf16x8 b1 = *reinterpret_cast<const LAS bf16x8*>(Ks + DA_KSWZ(32 + r32, cb));
    p0 = __builtin_amdgcn_mfma_f32_32x32x16_bf16(b0, qr[d0], p0, 0, 0, 0);
    p1 = __builtin_amdgcn_mfma_f32_32x32x16_bf16(b1, qr[d0], p1, 0, 0, 0); }
}
__device__ __forceinline__ int v_st(int k, int c) { const int kk = (k & ~0xC) | ((k & 4) << 1) | ((k & 8) >> 1); return ((kk >> 3) * 4 + (c >> 5)) * 512 + ((kk & 7) * 32 + (c & 31)) * 2; }
__device__ __forceinline__ int v_rd_base(int lane) { return ((lane & 3) << 3) | (((lane >> 2) & 3) << 6) | (((lane >> 4) & 1) << 5) | (((lane >> 5) & 1) << 8); }
constexpr int v_rd_off(int d0, int ks, int half) { return d0 * 512 + ks * 4096 + half * 2048; }
template <int OFF> __device__ __forceinline__ s16x4 tr_read(int vb) { s16x4 r; asm volatile("ds_read_b64_tr_b16 %0, %1 offset:%2" : "=&v"(r) : "v"(vb), "i"(OFF) : "memory"); return r; }
template <int D0> __device__ __forceinline__ void pv_one(f32x16& od, int vb, bf16x8 pa0, bf16x8 pa1, bf16x8 pa2, bf16x8 pa3) {
  const s16x4 l0 = tr_read<v_rd_off(D0, 0, 0)>(vb), h0 = tr_read<v_rd_off(D0, 0, 1)>(vb), l1 = tr_read<v_rd_off(D0, 1, 0)>(vb), h1 = tr_read<v_rd_off(D0, 1, 1)>(vb);
  const s16x4 l2 = tr_read<v_rd_off(D0, 2, 0)>(vb), h2 = tr_read<v_rd_off(D0, 2, 1)>(vb), l3 = tr_read<v_rd_off(D0, 3, 0)>(vb), h3 = tr_read<v_rd_off(D0, 3, 1)>(vb);
  asm volatile("s_waitcnt lgkmcnt(0)" ::: "memory"); DA_SBAR();
#define DA_PK(L, H) (bf16x8){L[0], L[1], L[2], L[3], H[0], H[1], H[2], H[3]}
  od = __builtin_amdgcn_mfma_f32_32x32x16_bf16(pa0, DA_PK(l0, h0), od, 0, 0, 0);
  od = __builtin_amdgcn_mfma_f32_32x32x16_bf16(pa1, DA_PK(l1, h1), od, 0, 0, 0);
  od = __builtin_amdgcn_mfma_f32_32x32x16_bf16(pa2, DA_PK(l2, h2), od, 0, 0, 0);
  od = __builtin_amdgcn_mfma_f32_32x32x16_bf16(pa3, DA_PK(l3, h3), od, 0, 0, 0);
#undef DA_PK
}
__device__ __forceinline__ void pv_d0(f32x16* o, int vb, bf16x8 pa0, bf16x8 pa1, bf16x8 pa2, bf16x8 pa3) {
  pv_one<0>(o[0], vb, pa0, pa1, pa2, pa3); pv_one<1>(o[1], vb, pa0, pa1, pa2, pa3); pv_one<2>(o[2], vb, pa0, pa1, pa2, pa3); pv_one<3>(o[3], vb, pa0, pa1, pa2, pa3);
}

__device__ __forceinline__ void unit(const bf16* __restrict__ P, bf16* __restrict__ YB, const float* __restrict__ nw, float lam, float omli,
                                     int b, int h, int qrow0, int t0, int NT, LAS char* lds, int wid, int lane) {
  const int tid = wid * 64 + lane, r32 = lane & 31, hi = lane >> 5, m = wid >> 2, wq = wid & 3;
  LAS char* V_lds = lds; LAS char* K_lds = lds + 2 * SHM_V;
  LAS float* ws = (LAS float*)(lds + 2 * SHM_V + 2 * SHM_K) + wid * 64; LAS float* li_l = ws; LAS float* al_l = ws + 32;
  float m_reg = -1e30f, l_reg = 0; f32x16 o[4] = {}; bf16x8 qr[4];
  { const bf16* Qw = P + (size_t)(qrow0 + wq * 32 + r32) * NP + PC_DQ + h * 128 + m * 64 + hi * 8;
#pragma unroll
    for (int d0 = 0; d0 < 4; ++d0) qr[d0] = *reinterpret_cast<const bf16x8*>(Qw + d0 * 16); }
  const int sr = tid >> 4, sc = (tid & 15) * 8, vst0 = v_st(sr, sc), vst1 = v_st(32 + sr, sc);
  const int vb0 = (int)(uintptr_t)V_lds + v_rd_base(lane);
  const bf16* Kcol = P + PC_DK + h * 128 + sc; const bf16* Vcol = P + PC_DV + h * 128 + sc;
  bf16x8 vs0, vs1, ks0, ks1;
#define DA_KROW(j) ((size_t)(((j) + t0) < 128 ? b * SEQ + 64 * ((j) + t0) : MLAT + b * CTXL + 64 * ((j) + t0 - 128)))
#define DA_SLOAD(j) do { const size_t k0_ = DA_KROW(j); vs0 = *reinterpret_cast<const bf16x8*>(Vcol + (k0_ + sr) * NP); vs1 = *reinterpret_cast<const bf16x8*>(Vcol + (k0_ + 32 + sr) * NP); \
    ks0 = *reinterpret_cast<const bf16x8*>(Kcol + (k0_ + sr) * NP); ks1 = *reinterpret_cast<const bf16x8*>(Kcol + (k0_ + 32 + sr) * NP); } while (0)
#define DA_SWRITE(bb) do { *(LAS bf16x8*)(V_lds + (bb) * SHM_V + vst0) = vs0; *(LAS bf16x8*)(V_lds + (bb) * SHM_V + vst1) = vs1; const int kc = sc * 2; \
    *(LAS bf16x8*)(K_lds + (bb) * SHM_K + DA_KSWZ(sr, kc)) = ks0; *(LAS bf16x8*)(K_lds + (bb) * SHM_K + DA_KSWZ(32 + sr, kc)) = ks1; } while (0)
#define DA_RESC(a) do { if (__any((a) < 1.f)) { if (hi == 0) al_l[r32] = (a); asm volatile("s_waitcnt lgkmcnt(0)" ::: "memory"); \
    _Pragma("unroll") for (int d = 0; d < 4; ++d) _Pragma("unroll") for (int r = 0; r < 16; ++r) o[d][r] *= al_l[crow(r, hi)]; } } while (0)
  f32x16 pA0, pA1, pB0, pB1; float mnA, mnB, alA, alB; bf16x8 pa0, pa1, pa2, pa3;
  DA_SLOAD(0); asm volatile("s_waitcnt vmcnt(0)" ::: "memory"); DA_SWRITE(0); __syncthreads();
  qkt(pA0, pA1, K_lds, qr, r32, hi, m); partialSM(pA0, pA1, m_reg, mnA, alA);
  DA_SLOAD(1);
  asm volatile("s_waitcnt vmcnt(0)" ::: "memory"); DA_SWRITE(1); __syncthreads();
  for (int j = 1; j + 1 < NT; j += 2) {
    DA_SBAR(); qkt(pB0, pB1, K_lds + SHM_K, qr, r32, hi, m);
    finishSM(pA0, pA1, alA, l_reg, pa0, pa1, pa2, pa3); DA_SBAR();
    DA_SLOAD(j + 1); DA_SBAR();
    pv_d0(o, vb0, pa0, pa1, pa2, pa3); partialSM(pB0, pB1, m_reg, mnB, alB);
    __syncthreads(); asm volatile("s_waitcnt vmcnt(0)" ::: "memory"); DA_SWRITE(0);
    DA_RESC(alB); __syncthreads();
    DA_SBAR(); qkt(pA0, pA1, K_lds, qr, r32, hi, m);
    finishSM(pB0, pB1, alB, l_reg, pa0, pa1, pa2, pa3); DA_SBAR();
    DA_SLOAD(j + 2); DA_SBAR();
    pv_d0(o, vb0 + SHM_V, pa0, pa1, pa2, pa3); partialSM(pA0, pA1, m_reg, mnA, alA);
    __syncthreads(); asm volatile("s_waitcnt vmcnt(0)" ::: "memory"); DA_SWRITE(1);
    DA_RESC(alA); __syncthreads();
  }
  DA_SBAR(); qkt(pB0, pB1, K_lds + SHM_K, qr, r32, hi, m);
  finishSM(pA0, pA1, alA, l_reg, pa0, pa1, pa2, pa3); DA_SBAR();
  pv_d0(o, vb0, pa0, pa1, pa2, pa3); partialSM(pB0, pB1, m_reg, mnB, alB);
  __syncthreads(); DA_RESC(alB);
  finishSM(pB0, pB1, alB, l_reg, pa0, pa1, pa2, pa3); DA_SBAR();
  pv_d0(o, vb0 + SHM_V, pa0, pa1, pa2, pa3);
  if (hi == 0) li_l[r32] = l_reg; asm volatile("s_waitcnt lgkmcnt(0)" ::: "memory");
  float rli[16];
#pragma unroll
  for (int r = 0; r < 16; ++r) rli[r] = __builtin_amdgcn_rcpf(li_l[crow(r, hi)]);
  __syncthreads();
  LAS float* X = (LAS float*)lds;
  if (m == 1) {
#pragma unroll
    for (int r = 0; r < 16; ++r) { const int row = wq * 32 + crow(r, hi);
#pragma unroll
      for (int d0 = 0; d0 < 4; ++d0) X[row * 132 + d0 * 32 + r32] = o[d0][r] * rli[r]; } }
  __syncthreads();
  if (m == 0) {
#pragma unroll
    for (int r = 0; r < 16; ++r) { const int row = wq * 32 + crow(r, hi);
#pragma unroll
      for (int d0 = 0; d0 < 4; ++d0) { LAS float* p = X + row * 132 + d0 * 32 + r32; *p = o[d0][r] * rli[r] - lam * *p; } }
    asm volatile("s_waitcnt lgkmcnt(0)" ::: "memory");
    const int row = wq * 32 + (lane >> 1), hf = lane & 1; const LAS float* xr = X + row * 132 + hf * 64;
    f32x4 v[16]; float ss = 0.f;
#pragma unroll
    for (int i = 0; i < 16; ++i) { v[i] = *(const LAS f32x4*)(xr + 4 * i); ss += (v[i].x * v[i].x + v[i].y * v[i].y) + (v[i].z * v[i].z + v[i].w * v[i].w); }
    ss += __shfl_xor(ss, 1);
    const float rs = (1.f / sqrtf(ss * (1.f / 128.f) + RMS_EPS)) * omli;
    bf16* op = YB + (size_t)(qrow0 + row) * 512 + h * 128 + hf * 64; const float* wp = nw + hf * 64;
#pragma unroll
    for (int i = 0; i < 8; ++i) { const f32x4 w0 = *(const f32x4*)(wp + 8 * i), w1 = *(const f32x4*)(wp + 8 * i + 4); const f32x4 a0 = v[2 * i] * rs * w0, a1 = v[2 * i + 1] * rs * w1;
      u32x4 w; w.x = cvtpk(a0.x, a0.y); w.y = cvtpk(a0.z, a0.w); w.z = cvtpk(a1.x, a1.y); w.w = cvtpk(a1.z, a1.w); *(u32x4*)(op + 8 * i) = w; }
  }
  __syncthreads();
#undef DA_KROW
#undef DA_SLOAD
#undef DA_SWRITE
#undef DA_RESC
}
#undef DA_KSWZ
#undef DA_SBAR
}

PHASE_FN void ph_diff_mfma(Ctx cx, int l_) {
    Frame F = mkframe(cx); const ArgsP a = F.ap; const int l = rfl(l_);
    REFRESH(F);
    const bf16* P = (const bf16*)(F.ws + WS_P); bf16* YB = (bf16*)(F.ws + WS_YB);
    const float lam = ((const float*)(F.ws + WS_LAM))[l], omli = 1.f - (0.8f - 0.6f * expf(-0.3f * (float)l));
    const float* nw = a->in[I_DNW] + l * 128;
    for (int it = F.bid; it < 512 + 16; it += F.G) {
        int b, h, q0, t0, NT;
        if (it < 512) { b = it >> 8; h = (it >> 6) & 3; q0 = b * SEQ + (it & 63) * 128; t0 = 0; NT = 132; }
        else { const int j = it - 512; b = j >> 3; h = (j >> 1) & 3; q0 = MLAT + b * CTXL + (j & 1) * 128; t0 = 128; NT = 4; }
        dattn::unit(P, YB, nw, lam, omli, b, h, q0, t0, NT, (LAS char*)F.lds, F.wave, F.lane);
    }
}
namespace gdn {
using f32x16 = __attribute__((ext_vector_type(16))) float;
constexpr int REC_BYTES = 57344, U_BYTES = 16384, OFF_NEGW = 0, OFF_QG = 16384, OFF_KT = 32768, OFF_QK = 49152, NSTEP = 132;
constexpr int QS = 0, KS = 17408, VS = 34816, L0 = 52224, A0 = 84992, SC = 117760;
__device__ __forceinline__ unsigned pk(float lo, float hi) { return pg8::cvt_pk_bf16(lo, hi); }
__device__ __forceinline__ float ldbf(const LAS unsigned short* p) { return __uint_as_float(((unsigned)*p) << 16); }

__device__ __forceinline__ void prep_item(const Frame& F, const ArgsP a, int l, int item) {
    const int b = item / (NSTEP * 4), rem = item % (NSTEP * 4), cn = rem >> 2, h = rem & 3;
    const bool isctx = cn < 4; const int row0 = isctx ? MLAT + b * CTXL + 64 * cn : b * SEQ + 64 * (cn - 4), t0 = isctx ? 64 * cn : 64 * (cn - 4), L = isctx ? CTXL : SEQ;
    const bf16* P = (const bf16*)(F.ws + WS_P); const float* DEC = (const float*)(F.ws + WS_DEC);
    LAS unsigned char* lds = F.lds; const int lane = F.lane, wave = F.wave, tid = F.tid;
    LAS unsigned short* Qs = (LAS unsigned short*)(lds + QS); LAS unsigned short* Ks = (LAS unsigned short*)(lds + KS); LAS unsigned short* Vs = (LAS unsigned short*)(lds + VS);
    LAS float* GC = (LAS float*)(lds + SC); LAS float* BE = GC + 128; LAS float* EG = GC + 256; LAS float* ET = GC + 384;
    { const float* cw = a->in[I_CONVW] + (size_t)l * 3 * 1536;
#pragma unroll 1
      for (int ii = 0; ii < 8; ++ii) { const int i = wave * 8 + ii, t = t0 + i; const bool hm = t > 0, hp = t < L - 1; const bf16* p0 = P + (size_t)(row0 + i) * NP;
#pragma unroll
        for (int wh = 0; wh < 3; ++wh) { const int c = wh * 512 + h * 128 + 2 * lane;
            const unsigned x0 = *(const unsigned*)(p0 + c), xm = hm ? *(const unsigned*)(p0 - NP + c) : 0u, xp = hp ? *(const unsigned*)(p0 + NP + c) : 0u;
            const f32x2 w0 = *(const f32x2*)(cw + c), w1 = *(const f32x2*)(cw + 1536 + c), w2 = *(const f32x2*)(cw + 3072 + c);
            float y0 = bflo(xm) * w0.x + bflo(x0) * w1.x + bflo(xp) * w2.x, y1 = bfhi(xm) * w0.y + bfhi(x0) * w1.y + bfhi(xp) * w2.y;
            y0 = siluf(y0); y1 = siluf(y1);
            if (wh < 2) { const float ss = wave_sum(y0 * y0 + y1 * y1), sc = (1.f / sqrtf(ss + RMS_EPS)) * (wh == 0 ? 0.08838834764831845f : 1.f); y0 *= sc; y1 *= sc; }
            LAS unsigned short* dst = (wh == 0 ? Qs : wh == 1 ? Ks : Vs) + i * 136 + 2 * lane; *(LAS unsigned*)dst = pk(y0, y1); } } }
    if (wave < 2) { const int d = wave, t = d ? 63 - lane : lane; const size_t row = (size_t)(row0 + t);
        const float al = expf(a->in[I_ALOG][(l * 2 + d) * 4 + h]), av = DEC[row * 16 + 8 * d + h] + a->in[I_DTB][(l * 2 + d) * 4 + h], bb = DEC[row * 16 + 8 * d + 4 + h];
        const float sp = av > 20.f ? av : log1pf(expf(av)); float gc = -al * sp;
#pragma unroll
        for (int o = 1; o < 64; o <<= 1) { const float v = __shfl_up(gc, o); if (lane >= o) gc += v; }
        const float gl = __shfl(gc, 63);
        GC[d * 64 + lane] = gc; BE[d * 64 + lane] = sigmf(bb); EG[d * 64 + lane] = expf(gc); ET[d * 64 + lane] = expf(gl - gc);
        if (lane == 63) { const int step = d ? (cn < 4 ? 3 - cn : 135 - cn) : cn; ((float*)(F.ws + WS_GL))[((b * 4 + h) * 2 + d) * NSTEP + step] = expf(gl); } }
    __syncthreads();
    { const int mat = wave >> 2, mi = wave & 3, fr = lane & 15, fq = lane >> 4; const LAS unsigned short* As = mat ? Qs : Ks;
#pragma unroll 1
      for (int nj = 0; nj < 4; ++nj) { f32x4 acc = {0.f, 0.f, 0.f, 0.f};
#pragma unroll
        for (int ks = 0; ks < 4; ++ks) { const bf16x8 af = *(const LAS bf16x8*)(As + (16 * mi + fr) * 136 + 32 * ks + 8 * fq), bfr = *(const LAS bf16x8*)(Ks + (16 * nj + fr) * 136 + 32 * ks + 8 * fq);
            acc = __builtin_amdgcn_mfma_f32_16x16x32_bf16(af, bfr, acc, 0, 0, 0); }
#pragma unroll
        for (int r = 0; r < 4; ++r) { const int ti = 16 * mi + 4 * fq + r, tj = 16 * nj + fr;
#pragma unroll
            for (int d = 0; d < 2; ++d) { const int i = d ? 63 - ti : ti, j = d ? 63 - tj : tj; const bool keep = mat ? (i >= j) : (i > j);
                float v = 0.f; if (keep) { v = acc[r] * __expf(fminf(GC[d * 64 + i] - GC[d * 64 + j], 0.f)); if (!mat) v *= BE[d * 64 + i]; }
                ((LAS float*)(lds + (mat ? A0 : L0) + d * 16384))[i * 64 + j] = v; } } } }
    __syncthreads();
    const int d = __builtin_amdgcn_readfirstlane(tid >> 8), c = tid & 255, cc = c & 127; const bool isw = __builtin_amdgcn_readfirstlane(c >> 7) != 0;
    float x[64];
    { const LAS float* Ld = (const LAS float*)(lds + L0 + d * 16384); const LAS unsigned short* src = (isw ? Ks : Vs) + cc;
#pragma unroll
      for (int i = 0; i < 64; ++i) x[i] = 0.f;
#pragma unroll
      for (int i = 0; i < 64; ++i) { const int t = d ? 63 - i : i; float acc = ldbf(src + t * 136) * BE[d * 64 + i] * (isw ? EG[d * 64 + i] : 1.f);
#pragma unroll
          for (int j4 = 0; j4 < (i + 3) / 4; ++j4) { const f32x4 lv = *(const LAS f32x4*)(Ld + i * 64 + 4 * j4);
              acc -= lv.x * x[4 * j4]; if (4 * j4 + 1 < i) acc -= lv.y * x[4 * j4 + 1]; if (4 * j4 + 2 < i) acc -= lv.z * x[4 * j4 + 2]; if (4 * j4 + 3 < i) acc -= lv.w * x[4 * j4 + 3]; }
          asm volatile("" : "+v"(acc) :: "memory"); x[i] = acc; } }
    const int step = d ? (cn < 4 ? 3 - cn : 135 - cn) : cn; const size_t ridx = (size_t)((b * 4 + h) * 2 + d) * NSTEP + step;
    unsigned char* rec = F.ws + WS_REC + ridx * REC_BYTES;
    if (!isw) {
        unsigned char* ub = F.ws + WS_U + ridx * U_BYTES; const int nt = cc >> 5, col = cc & 31;
#pragma unroll
        for (int mt = 0; mt < 2; ++mt)
#pragma unroll
            for (int hi = 0; hi < 2; ++hi) { u32x4 w0, w1; const int ib = 32 * mt + 4 * hi;
                w0.x = pk(x[ib + 0], x[ib + 1]); w0.y = pk(x[ib + 2], x[ib + 3]); w0.z = pk(x[ib + 8], x[ib + 9]); w0.w = pk(x[ib + 10], x[ib + 11]);
                w1.x = pk(x[ib + 16], x[ib + 17]); w1.y = pk(x[ib + 18], x[ib + 19]); w1.z = pk(x[ib + 24], x[ib + 25]); w1.w = pk(x[ib + 26], x[ib + 27]);
                u32x4* dst = (u32x4*)(ub + (size_t)(((mt * 4 + nt) * 64 + hi * 32 + col) * 32)); dst[0] = w0; dst[1] = w1; } }
    __syncthreads();
    LAS unsigned short* Xw = (LAS unsigned short*)(lds + L0 + d * 16384);
    if (isw) {
#pragma unroll
        for (int i = 0; i < 64; ++i) Xw[i * 128 + cc] = (unsigned short)(pk(-x[i], 0.f) & 0xffffu); }
    __syncthreads();
    { const int u2 = tid & 255; const LAS float* Ad = (const LAS float*)(lds + A0 + d * 16384);
#pragma unroll
      for (int q = 0; q < 4; ++q) { const int s = u2 + 256 * q, f = s >> 6, ln = s & 63, r32 = ln & 31, hi = ln >> 5;
          { const int mt = f >> 3, ks = f & 7, i = 32 * mt + r32, t = d ? 63 - i : i, k0 = 16 * ks + 4 * hi;
            const u32x2 wa = *(const LAS u32x2*)(Xw + i * 128 + k0), wb = *(const LAS u32x2*)(Xw + i * 128 + k0 + 8);
            *(u32x4*)(rec + OFF_NEGW + s * 16) = (u32x4){wa.x, wa.y, wb.x, wb.y};
            const float eg = EG[d * 64 + i]; const u32x2 qa = *(const LAS u32x2*)(Qs + t * 136 + k0), qb = *(const LAS u32x2*)(Qs + t * 136 + k0 + 8);
            *(u32x4*)(rec + OFF_QG + s * 16) = (u32x4){pk(bflo(qa.x) * eg, bfhi(qa.x) * eg), pk(bflo(qa.y) * eg, bfhi(qa.y) * eg), pk(bflo(qb.x) * eg, bfhi(qb.x) * eg), pk(bflo(qb.y) * eg, bfhi(qb.y) * eg)}; }
          { const int mtS = f >> 2, ks = f & 3, dk = 32 * mtS + r32; float kv[8];
#pragma unroll
            for (int j = 0; j < 8; ++j) { const int i = 16 * ks + 8 * (j >> 2) + 4 * hi + (j & 3), t = d ? 63 - i : i; kv[j] = ldbf(Ks + t * 136 + dk) * ET[d * 64 + i]; }
            *(u32x4*)(rec + OFF_KT + s * 16) = (u32x4){pk(kv[0], kv[1]), pk(kv[2], kv[3]), pk(kv[4], kv[5]), pk(kv[6], kv[7])}; } }
#pragma unroll
      for (int q = 0; q < 2; ++q) { const int s = u2 + 256 * q, f = s >> 6, ln = s & 63, r32 = ln & 31, hi = ln >> 5, mt = f >> 2, ks = f & 3, i = 32 * mt + r32, j0 = 16 * ks + 4 * hi;
          const f32x4 va = *(const LAS f32x4*)(Ad + i * 64 + j0), vb = *(const LAS f32x4*)(Ad + i * 64 + j0 + 8);
          *(u32x4*)(rec + OFF_QK + s * 16) = (u32x4){pk(va.x, va.y), pk(va.z, va.w), pk(vb.x, vb.y), pk(vb.z, vb.w)}; } }
    __syncthreads();
}

__device__ __forceinline__ bf16x8 pack8(const f32x16& v, int s) {
    u32x4 p; p.x = pk(v[8 * s], v[8 * s + 1]); p.y = pk(v[8 * s + 2], v[8 * s + 3]); p.z = pk(v[8 * s + 4], v[8 * s + 5]); p.w = pk(v[8 * s + 6], v[8 * s + 7]); return __builtin_bit_cast(bf16x8, p); }
#define GDN_MFMA(a, b, c) __builtin_amdgcn_mfma_f32_32x32x16_bf16((a), (b), (c), 0, 0, 0)
#define GDN_FRAG(buf, off, f) (*(const LAS bf16x8*)((buf) + (off) + (f) * 1024 + lane * 16))
__device__ __forceinline__ void chain(const Frame& F, int b, int h, int d) {
    const int lane = F.lane, wave = F.wave, r32 = lane & 31, hi = lane >> 5, nt = wave & 3; const bool comp = wave < 4;
    LAS unsigned char* lds = F.lds;
    const size_t rbase = (size_t)((b * 4 + h) * 2 + d) * NSTEP;
    const unsigned char* recs = F.ws + WS_REC + rbase * REC_BYTES; const unsigned char* us = F.ws + WS_U + rbase * U_BYTES; const float* gls = (const float*)(F.ws + WS_GL) + rbase;
    float* OG = (float*)(F.ws + WS_OG) + (size_t)d * MT * 512 + h * 128 + nt * 32 + r32;
    f32x16 S[4]; bf16x8 Sb[8];
#pragma unroll
    for (int i = 0; i < 4; ++i) S[i] = f32x16{};
#pragma unroll
    for (int i = 0; i < 8; ++i) Sb[i] = bf16x8{};
#define GDN_DMA(step, bufi) do { const unsigned char* src_ = recs + (size_t)(step) * REC_BYTES + lane * 16; LAS unsigned char* dst_ = lds + (bufi) * REC_BYTES; \
        _Pragma("unroll") for (int p_ = 0; p_ < 7; ++p_) __builtin_amdgcn_global_load_lds((const GAS unsigned*)(src_ + (wave * 7 + p_) * 1024), (LAS unsigned*)(dst_ + (wave * 7 + p_) * 1024), 16, 0, 0); } while (0)
    GDN_DMA(0, 0);
    asm volatile("s_waitcnt vmcnt(0)" ::: "memory"); __syncthreads();
#pragma unroll 1
    for (int step = 0; step < NSTEP; ++step) {
        const LAS unsigned char* buf = lds + (step & 1) * REC_BYTES;
        if (step + 1 < NSTEP) GDN_DMA(step + 1, (step + 1) & 1);
        if (comp) {
            const float egl = gls[step];
            f32x16 Vp[2];
#pragma unroll
            for (int mt = 0; mt < 2; ++mt) { const u32x4* up = (const u32x4*)(us + (size_t)step * U_BYTES + (size_t)(((mt * 4 + nt) * 64 + lane) * 32)); const u32x4 w0 = up[0], w1 = up[1];
                Vp[mt] = (f32x16){bflo(w0.x), bfhi(w0.x), bflo(w0.y), bfhi(w0.y), bflo(w0.z), bfhi(w0.z), bflo(w0.w), bfhi(w0.w), bflo(w1.x), bfhi(w1.x), bflo(w1.y), bfhi(w1.y), bflo(w1.z), bfhi(w1.z), bflo(w1.w), bfhi(w1.w)}; }
#pragma unroll
            for (int ks = 0; ks < 8; ++ks) {
#pragma unroll
                for (int mt = 0; mt < 2; ++mt) Vp[mt] = GDN_MFMA(GDN_FRAG(buf, OFF_NEGW, mt * 8 + ks), Sb[ks], Vp[mt]);
                if ((ks & 3) == 3) asm volatile("" ::: "memory"); }
            bf16x8 Vb[4];
            Vb[0] = pack8(Vp[0], 0); Vb[1] = pack8(Vp[0], 1); Vb[2] = pack8(Vp[1], 0); Vb[3] = pack8(Vp[1], 1);
            const int cn = d ? (step < 4 ? 3 - step : 135 - step) : step; const size_t orow0 = cn < 4 ? (size_t)(MLAT + b * CTXL + 64 * cn) : (size_t)(b * SEQ + 64 * (cn - 4));
#pragma unroll
            for (int mt = 0; mt < 2; ++mt) { f32x16 O = f32x16{};
#pragma unroll
                for (int ks = 0; ks < 8; ++ks) { O = GDN_MFMA(GDN_FRAG(buf, OFF_QG, mt * 8 + ks), Sb[ks], O); if ((ks & 3) == 3) asm volatile("" ::: "memory"); }
#pragma unroll
                for (int ks = 0; ks < 4; ++ks) O = GDN_MFMA(GDN_FRAG(buf, OFF_QK, mt * 4 + ks), Vb[ks], O);
#pragma unroll
                for (int r = 0; r < 16; ++r) { const int i = 32 * mt + (r & 3) + 8 * (r >> 2) + 4 * hi, t = d ? 63 - i : i; OG[(orow0 + t) * 512] = O[r]; } }
#pragma unroll
            for (int mtS = 0; mtS < 4; ++mtS) {
#pragma unroll
                for (int r = 0; r < 16; ++r) S[mtS][r] *= egl;
#pragma unroll
                for (int ks = 0; ks < 4; ++ks) S[mtS] = GDN_MFMA(GDN_FRAG(buf, OFF_KT, mtS * 4 + ks), Vb[ks], S[mtS]);
                Sb[2 * mtS] = pack8(S[mtS], 0); Sb[2 * mtS + 1] = pack8(S[mtS], 1); asm volatile("" ::: "memory"); }
        }
        asm volatile("s_waitcnt vmcnt(0)" ::: "memory"); __syncthreads();
    }
#undef GDN_DMA
}
#undef GDN_MFMA
#undef GDN_FRAG
}

PHASE_FN void ph_gdn_prep(Ctx cx, int l_) {
    Frame F = mkframe(cx); const ArgsP a = F.ap; const int l = rfl(l_);
    REFRESH(F);
    for (int it = F.bid; it < BATCH * gdn::NSTEP * 4; it += F.G) { REFRESH(F); gdn::prep_item(F, a, l, it); }
}
PHASE_FN void ph_gdn_chain(Ctx cx, int l_) {
    Frame F = mkframe(cx); const int l = rfl(l_);
    REFRESH(F);
    for (int it = F.bid; it < 16; it += F.G) gdn::chain(F, it >> 3, (it >> 1) & 3, it & 1);
}
namespace na {
constexpr int VTL = SEQ + CTXL;
constexpr float C2 = 0.125f * 1.4426950408889634f, L2E = 1.4426950408889634f;
template <bool LOCAL>
__device__ __forceinline__ void group(const bf16* kp0, const bf16* vt, const bf16x8 (&qf)[2], const float* rprow, int cmin, int cq, int kc0, int lane, float& mrun, float& lrun, f32x4 (&o)[4]) {
    const int m = lane & 15, kq = lane >> 4;
    const bf16* ka = kp0 + (size_t)(8 * (m >> 2) + (m & 3)) * NP + 8 * kq;
    f32x4 sa = {0.f, 0.f, 0.f, 0.f}, sb = {0.f, 0.f, 0.f, 0.f};
#pragma unroll
    for (int s = 0; s < 2; ++s) { const bf16x8 a0 = *(const bf16x8*)(ka + 32 * s), a1 = *(const bf16x8*)(ka + 4 * NP + 32 * s);
        sa = __builtin_amdgcn_mfma_f32_16x16x32_bf16(a0, qf[s], sa, 0, 0, 0); sb = __builtin_amdgcn_mfma_f32_16x16x32_bf16(a1, qf[s], sb, 0, 0, 0); }
    float t[8];
#pragma unroll
    for (int j = 0; j < 4; ++j) { t[j] = sa[j] * C2; t[4 + j] = sb[j] * C2; }
    if (LOCAL) {
#pragma unroll
        for (int j = 0; j < 8; ++j) { const int kc = kc0 + 8 * kq + j; const bool ok = (kc >= cmin) && (kc < cmin + 16); const int bi = min(max(kc - cq + 15, 0), 30);
            t[j] = ok ? t[j] + rprow[bi] * L2E : -1e30f; } }
    float gm = fmaxf(fmaxf(fmaxf(t[0], t[1]), fmaxf(t[2], t[3])), fmaxf(fmaxf(t[4], t[5]), fmaxf(t[6], t[7])));
    gm = fmaxf(gm, __shfl_xor(gm, 16)); gm = fmaxf(gm, __shfl_xor(gm, 32));
    const float mn = fmaxf(mrun, gm), corr = __builtin_amdgcn_exp2f(mrun - mn); mrun = mn;
    float ps = 0.f;
#pragma unroll
    for (int j = 0; j < 8; ++j) { t[j] = __builtin_amdgcn_exp2f(t[j] - mn); ps += t[j]; }
    ps += __shfl_xor(ps, 16); ps += __shfl_xor(ps, 32);
    lrun = lrun * corr + ps;
    u32x4 pw; pw.x = pg8::cvt_pk_bf16(t[0], t[1]); pw.y = pg8::cvt_pk_bf16(t[2], t[3]); pw.z = pg8::cvt_pk_bf16(t[4], t[5]); pw.w = pg8::cvt_pk_bf16(t[6], t[7]);
    const bf16x8 pf = __builtin_bit_cast(bf16x8, pw);
    const bf16* va = vt + (size_t)m * VTL + 8 * kq;
#pragma unroll
    for (int dt = 0; dt < 4; ++dt) { const bf16x8 vf = *(const bf16x8*)(va + (size_t)(16 * dt) * VTL); o[dt] = o[dt] * corr; o[dt] = __builtin_amdgcn_mfma_f32_16x16x32_bf16(vf, pf, o[dt], 0, 0, 0); }
}
}

PHASE_FN void ph_na_vt(Ctx cx, int l_) {
    Frame F = mkframe(cx); REFRESH(F);
    const bf16* P = (const bf16*)(F.ws + WS_P); bf16* VT = (bf16*)(F.ws + WS_VT);
    LAS unsigned char* tile = F.lds + F.wave * 9216;
    const int gw = F.bid * NWAVES + F.wave, NGW = F.G * NWAVES, lane = F.lane;
    for (int it = gw; it < BATCH * 8 * 132; it += NGW) {
        const int b = it / (8 * 132), rem = it % (8 * 132), h = rem / 132, tb = rem % 132;
        const size_t row0 = tb < 128 ? (size_t)(b * SEQ + 64 * tb) : (size_t)(MLAT + b * CTXL + 64 * (tb - 128));
        const bf16* src = P + (row0 + lane) * NP + PC_NV + h * 64;
#pragma unroll
        for (int c = 0; c < 8; ++c) *(LAS u32x4*)(tile + lane * 144 + 16 * c) = *(const u32x4*)(src + 8 * c);
        LDS_WAIT(); asm volatile("" ::: "memory");
        bf16* dst = VT + ((size_t)((b * 8 + h) * 64 + lane)) * na::VTL + 64 * tb;
#pragma unroll
        for (int c = 0; c < 8; ++c) { unsigned w[4];
#pragma unroll
            for (int q = 0; q < 4; ++q) { const unsigned lo = *(const LAS unsigned short*)(tile + (8 * c + 2 * q) * 144 + 2 * lane), hi = *(const LAS unsigned short*)(tile + (8 * c + 2 * q + 1) * 144 + 2 * lane); w[q] = lo | (hi << 16); }
            *(u32x4*)(dst + 8 * c) = (u32x4){w[0], w[1], w[2], w[3]}; }
        LDS_WAIT(); asm volatile("" ::: "memory");
    }
}

PHASE_FN void ph_na_mfma(Ctx cx, int l_) {
    Frame F = mkframe(cx); const ArgsP a = F.ap; const int l = rfl(l_); REFRESH(F);
    const bf16* P = (const bf16*)(F.ws + WS_P); const bf16* VT = (const bf16*)(F.ws + WS_VT); bf16* YC = (bf16*)(F.ws + WS_YC);
    const int gw = F.bid * NWAVES + F.wave, NGW = F.G * NWAVES, lane = F.lane, qi = lane & 15, kq = lane >> 4;
    constexpr int NLAT = BATCH * 8 * 128 * 4, NCTX = BATCH * 8 * 16;
    for (int it = gw; it < NLAT + NCTX; it += NGW) {
        const bool lat = it < NLAT; int b, h, r = 0, n = 0, qrow;
        if (lat) { b = it >> 12; h = (it >> 9) & 7; r = (it >> 2) & 127; n = it & 3; qrow = b * SEQ + r * 64 + 16 * n + qi; }
        else { const int j = it - NLAT; b = j >> 7; h = (j >> 4) & 7; qrow = MLAT + b * CTXL + 16 * (j & 15) + qi; }
        bf16x8 qf[2];
        { const bf16* qp = P + (size_t)qrow * NP + PC_NQ + h * 64 + 8 * kq; qf[0] = *(const bf16x8*)qp; qf[1] = *(const bf16x8*)(qp + 32); }
        f32x4 o[4];
#pragma unroll
        for (int dt = 0; dt < 4; ++dt) o[dt] = (f32x4){0.f, 0.f, 0.f, 0.f};
        float mrun = -1e30f, lrun = 0.f;
        const bf16* Kb = P + PC_NK + h * 64; const bf16* VTh = VT + (size_t)((b * 8 + h) * 64) * na::VTL;
        if (lat) { const int r0 = min(max(r - 4, 0), 120), kc0 = min(max(16 * n - 8, 0), 32), cq = 16 * n + qi, cmin = min(max(cq - 8, 0), 48);
            const float* rp = a->in[I_RPB] + ((size_t)l * 8 + h) * 15 * 31;
#pragma unroll 1
            for (int kr = 0; kr < 8; ++kr) { const int tok = (r0 + kr) * 64 + kc0;
                na::group<true>(Kb + (size_t)(b * SEQ + tok) * NP, VTh + tok, qf, rp + (r0 + kr - r + 7) * 31, cmin, cq, kc0, lane, mrun, lrun, o); } }
#pragma unroll 1
        for (int g = 0; g < 8; ++g) na::group<false>(Kb + (size_t)(MLAT + b * CTXL + 32 * g) * NP, VTh + SEQ + 32 * g, qf, nullptr, 0, 0, 0, lane, mrun, lrun, o);
        const float il = 1.f / lrun; bf16* op = YC + (size_t)qrow * 512 + h * 64 + 4 * kq;
#pragma unroll
        for (int dt = 0; dt < 4; ++dt) { u32x2 w; w.x = pg8::cvt_pk_bf16(o[dt][0] * il, o[dt][1] * il); w.y = pg8::cvt_pk_bf16(o[dt][2] * il, o[dt][3] * il); *(u32x2*)(op + 16 * dt) = w; }
    }
}
constexpr int TAB_OFF = LDSCTL_OFF;
PHASE_FN void ph_ln1_router(Ctx cx, int l_) {
    Frame F = mkframe(cx); const ArgsP a = F.ap; const int l = rfl(l_);
    REFRESH(F);
    volatile LAS int* tab = (volatile LAS int*)(F.lds + TAB_OFF);
    const float* T = (const float*)(F.ws + WS_T); float* X = (float*)(F.ws + WS_X);
    const float* wrT = (const float*)(F.ws + WS_WRT) + (size_t)l * 32 * 1024;
    const float* lng = a->in[I_LNG] + (size_t)(l * 2 + 0) * DM; const float* lnb = a->in[I_LNB] + (size_t)(l * 2 + 0) * DM;
    int* TOPE = (int*)(F.ws + WS_TOPE); int* TOPR = (int*)(F.ws + WS_TOPR); float* TOPG = (float*)(F.ws + WS_TOPG); int* BLKB = (int*)(F.ws + WS_BLKB);
    for (int rg = F.bid; rg < NRG; rg += F.G) {
        if (F.tid < 32) tab[384 + F.tid] = 0;
        __syncthreads();
        for (int i = F.wave; i < RG_ROWS; i += NWAVES) {
            const int row = rg * RG_ROWS + i; f32x4 v[4];
            const f32x4* tr = (const f32x4*)T + (size_t)row * 256 + F.lane;
#pragma unroll
            for (int j = 0; j < 4; ++j) v[j] = tr[64 * j];
            ln_inplace(v);
#pragma unroll
            for (int j = 0; j < 4; ++j) { const int c = 4 * F.lane + 256 * j; v[j] = v[j] * *(const f32x4*)(lng + c) + *(const f32x4*)(lnb + c); *((f32x4*)X + (size_t)row * 256 + F.lane + 64 * j) = v[j]; }
            modulate_store(F, l, 1, row, v);
            float lg = -3.0e38f; const int me = F.lane;
#pragma unroll 4
            for (int e = 0; e < 32; ++e) { float s = 0.f;
#pragma unroll
                for (int j = 0; j < 4; ++j) { const f32x4 w = *(const f32x4*)(wrT + e * 1024 + 4 * F.lane + 256 * j); s += (v[j].x * w.x + v[j].y * w.y) + (v[j].z * w.z + v[j].w * w.w); }
                s = wave_sum(s); if (F.lane == e) lg = s; }
            if (F.lane < 32) lg += a->in[I_BR][l * 32 + me];
            int te[4]; float tv[4];
#pragma unroll
            for (int k = 0; k < 4; ++k) { float bv = lg; int be = me;
#pragma unroll
                for (int o = 1; o < 64; o <<= 1) { const float ov = __shfl_xor(bv, o); const int oe = __shfl_xor(be, o); if (ov > bv || (ov == bv && oe < be)) { bv = ov; be = oe; } }
                te[k] = be; tv[k] = bv; if (me == be) lg = -3.0e38f; }
            const float e1 = __expf(tv[1] - tv[0]), e2 = __expf(tv[2] - tv[0]), e3 = __expf(tv[3] - tv[0]), isum = 1.f / (1.f + e1 + e2 + e3);
            if (F.lane < 4) { const int k = F.lane; const int e = k == 0 ? te[0] : k == 1 ? te[1] : k == 2 ? te[2] : te[3]; const float g = (k == 0 ? 1.f : k == 1 ? e1 : k == 2 ? e2 : e3) * isum;
                const int lr = __hip_atomic_fetch_add((LAS int*)&tab[384 + e], 1, __ATOMIC_RELAXED, __HIP_MEMORY_SCOPE_WORKGROUP);
                TOPE[row * 4 + k] = e; TOPR[row * 4 + k] = lr; TOPG[row * 4 + k] = g; }
        }
        __syncthreads();
        if (F.tid < 32) { const int n = tab[384 + F.tid]; const unsigned base = __hip_atomic_fetch_add(F.ctl + CW_CNT + l * 32 + F.tid, (unsigned)n, __ATOMIC_RELAXED, __HIP_MEMORY_SCOPE_AGENT); BLKB[rg * 32 + F.tid] = (int)base; }
        __syncthreads();
    }
}
__device__ __forceinline__ void moe_tables(Frame& F, int l, int nN) {
    REFRESH(F);
    volatile LAS int* tab = (volatile LAS int*)(F.lds + TAB_OFF);
    __syncthreads();
    if (F.tid == 0) { int t = 0;
#pragma unroll 1
        for (int e = 0; e < 32; ++e) { const int n = (int)__hip_atomic_load(F.ctl + CW_CNT + l * 32 + e, __ATOMIC_RELAXED, __HIP_MEMORY_SCOPE_AGENT), nt = (n + 255) >> 8; tab[352 + e] = t * 256;
            for (int i = 0; i < nt; ++i) tab[t + i] = e; t += nt; }
        tab[320] = t; }
    __syncthreads();
    if (nN > 0 && F.tid < 16) { int pm, pn; const int T = tab[320]; int w = -1;
        if (TileMap::map(F.tid, F.G, F.bid, T, nN, pm, pn)) w = pm | (pn << 12) | (tab[pm] << 16) | (nN << 24);
        tab[416 + F.tid] = w; }
    __syncthreads();
}
PHASE_FN void ph_moe_gather(Ctx cx, int l_) {
    Frame F = mkframe(cx); const int l = rfl(l_);
    REFRESH(F);
    volatile LAS int* tab = (volatile LAS int*)(F.lds + TAB_OFF);
    moe_tables(F, l, 0);
    const int gw = F.bid * NWAVES + F.wave, NGW = F.G * NWAVES;
    const int* TOPE = (const int*)(F.ws + WS_TOPE); const int* TOPR = (const int*)(F.ws + WS_TOPR); const int* BLKB = (const int*)(F.ws + WS_BLKB); int* SLOT = (int*)(F.ws + WS_SLOT);
    const bf16* HX = (const bf16*)(F.ws + WS_HX); bf16* HP = (bf16*)(F.ws + WS_HP);
    for (int row = gw; row < MT; row += NGW) {
        const u32x4 h0 = *(const u32x4*)(HX + (size_t)row * DM + 8 * F.lane), h1 = *(const u32x4*)(HX + (size_t)row * DM + 512 + 8 * F.lane);
#pragma unroll
        for (int k = 0; k < 4; ++k) { const int e = TOPE[row * 4 + k], slot = tab[352 + e] + BLKB[(row / RG_ROWS) * 32 + e] + TOPR[row * 4 + k];
            if (F.lane == 0) SLOT[row * 4 + k] = slot;
            *(u32x4*)(HP + (size_t)slot * DM + 8 * F.lane) = h0; *(u32x4*)(HP + (size_t)slot * DM + 512 + 8 * F.lane) = h1; }
    }
}
PHASE_FN void ph_ln2(Ctx cx, int l_) {
    Frame F = mkframe(cx); const ArgsP a = F.ap; const int l = rfl(l_);
    REFRESH(F);
    const int gw = F.bid * NWAVES + F.wave, NGW = F.G * NWAVES;
    float* X = (float*)(F.ws + WS_X); const bf16* Y = (const bf16*)(F.ws + WS_Y);
    const int* SLOT = (const int*)(F.ws + WS_SLOT); const float* TOPG = (const float*)(F.ws + WS_TOPG);
    const float* lng = a->in[I_LNG] + (size_t)(l * 2 + 1) * DM; const float* lnb = a->in[I_LNB] + (size_t)(l * 2 + 1) * DM;
    const bool poison = __hip_atomic_load(F.ctl + CW_BAR + XB_TMO, __ATOMIC_RELAXED, __HIP_MEMORY_SCOPE_AGENT) != 0u;
    for (int row = gw; row < MT; row += NGW) {
        const float* g2 = (const float*)(F.ws + WS_MOD) + ((size_t)l * 3 + mod_index(row)) * 6144 + 5120;
        f32x4 fx[4];
#pragma unroll
        for (int j = 0; j < 4; ++j) fx[j] = (f32x4){0.f, 0.f, 0.f, 0.f};
#pragma unroll
        for (int k = 0; k < 4; ++k) { const int slot = SLOT[row * 4 + k]; const float g = TOPG[row * 4 + k]; const bf16* yr = Y + (size_t)slot * DM + 4 * F.lane;
#pragma unroll
            for (int j = 0; j < 4; ++j) { const u32x2 w = *(const u32x2*)(yr + 256 * j); fx[j] += (f32x4){bflo(w.x), bfhi(w.x), bflo(w.y), bfhi(w.y)} * g; } }
        f32x4 v[4];
#pragma unroll
        for (int j = 0; j < 4; ++j) { const int c = 4 * F.lane + 256 * j; v[j] = *((const f32x4*)X + (size_t)row * 256 + F.lane + 64 * j) * DN_ALPHA + *(const f32x4*)(g2 + c) * fx[j]; }
        ln_inplace(v);
#pragma unroll
        for (int j = 0; j < 4; ++j) { const int c = 4 * F.lane + 256 * j; v[j] = v[j] * *(const f32x4*)(lng + c) + *(const f32x4*)(lnb + c); }
        if (l == DEPTH - 1) { if (row < MLAT) {
            if (poison) { const float qn = __builtin_nanf("");
#pragma unroll
                for (int j = 0; j < 4; ++j) v[j] = (f32x4){qn, qn, qn, qn}; }
#pragma unroll
            for (int j = 0; j < 4; ++j) *((f32x4*)a->out + (size_t)row * 256 + F.lane + 64 * j) = v[j]; } }
        else {
#pragma unroll
            for (int j = 0; j < 4; ++j) *((f32x4*)X + (size_t)row * 256 + F.lane + 64 * j) = v[j];
            modulate_store(F, l + 1, 0, row, v); decay_cols(F, l + 1, row, v); }
    }
}

PHASE_FN void ph_gemm_win(Ctx cx, int l_) {
    Frame F = mkframe(cx); const int l = rfl(l_); unsigned char* ws = F.ws;
    StaticOrder S{MT / 256, NP / 256, F.G, F.bid, 1024}; EpiWin E{(bf16*)(ws + WS_P)};
    pg8::gemm_phase<EpiWin, StaticOrder>(F.lds, 1024, (const char*)(ws + WS_HX), (const char*)(ws + WS_WIN) + (size_t)l * 8192 * 1024 * 2, S, E, F.wv);
}
PHASE_FN void ph_gemm_merge(Ctx cx, int l_) {
    Frame F = mkframe(cx); const int l = rfl(l_); unsigned char* ws = F.ws;
    MergeOrder S{F.G, F.bid}; EpiMerge E{(const bf16*)(ws + WS_P), (float*)(ws + WS_MACC), (bf16*)(ws + WS_MBF)};
    pg8::gemm_phase<EpiMerge, MergeOrder>(F.lds, 512, (const char*)(ws + WS_YA), (const char*)(ws + WS_WBR) + (size_t)l * 3 * 1024 * 512 * 2, S, E, F.wv);
}
PHASE_FN void ph_gemm_wout(Ctx cx, int l_) {
    Frame F = mkframe(cx); const int l = rfl(l_); unsigned char* ws = F.ws;
    StaticOrder S{MT / 256, 4, F.G, F.bid, 1024}; EpiWout E{(const float*)(ws + WS_X), (const float*)(ws + WS_MOD) + (size_t)l * 3 * 6144, (float*)(ws + WS_T)};
    pg8::gemm_phase<EpiWout, StaticOrder>(F.lds, 1024, (const char*)(ws + WS_MBF), (const char*)(ws + WS_WOUT) + (size_t)l * 1024 * 1024 * 2, S, E, F.wv);
}
PHASE_FN void ph_gemm_moe1(Ctx cx, int l_) {
    Frame F = mkframe(cx); const int l = rfl(l_); unsigned char* ws = F.ws; const ArgsP a = F.ap;
    moe_tables(F, l, 8);
    MoeOrder S{(const volatile LAS int*)(F.lds + TAB_OFF)}; EpiAct E{a->in[I_B1] + (size_t)l * 32 * 2048, (bf16*)(ws + WS_ACT)};
    pg8::gemm_phase<EpiAct, MoeOrder>(F.lds, 1024, (const char*)(ws + WS_HP), (const char*)(ws + WS_W1) + (size_t)l * 32 * 2048 * 1024 * 2, S, E, F.wv);
}
PHASE_FN void ph_gemm_moe2(Ctx cx, int l_) {
    Frame F = mkframe(cx); const int l = rfl(l_); unsigned char* ws = F.ws; const ArgsP a = F.ap;
    moe_tables(F, l, 4);
    MoeOrder S{(const volatile LAS int*)(F.lds + TAB_OFF)}; EpiY E{a->in[I_B2] + (size_t)l * 32 * 1024, (bf16*)(ws + WS_Y)};
    pg8::gemm_phase<EpiY, MoeOrder>(F.lds, 1024, (const char*)(ws + WS_ACT), (const char*)(ws + WS_W2) + (size_t)l * 32 * 1024 * 1024 * 2, S, E, F.wv);
}
constexpr int NPH_LAYER = 12, NPHASES = 2 + DEPTH * NPH_LAYER;
__global__ void __launch_bounds__(NTHREADS, 2) fwd_kernel(Args args) {
    extern __shared__ __attribute__((aligned(16))) unsigned char lds_raw[];
    LAS unsigned char* lds = (LAS unsigned char*)lds_raw;
    const int tid = threadIdx.x;
    volatile LAS unsigned* MISC = (volatile LAS unsigned*)(lds + MISC_OFF);
    for (int u = tid; u < (LDS_BYTES - LDSCTL_OFF) / 4; u += NTHREADS) ((LAS unsigned*)(lds + LDSCTL_OFF))[u] = 0u;
    __syncthreads();
    const int lo = args.ph_lo, hi = args.ph_hi;
    const bool multi = (hi - lo) > 1;
    unsigned* ctl = (unsigned*)(args.ws + WS_CTL);
    XcdBarrier bar; bar.bar = ctl + CW_BAR; bar.x = 0; bar.st = nullptr;
    if (multi) bar = xcd_barrier_post(ctl + CW_BAR, MISC + 8);
    Ctx cx; cx.lds = lds; cx.ws = args.ws; cx.ap = (ArgsP)__builtin_amdgcn_kernarg_segment_ptr(); cx.G = gridDim.x; cx.bid = blockIdx.x; cx.wv = __builtin_amdgcn_readfirstlane(tid >> 6);
#define IN(k) (lo <= (k) && (k) < hi)
#define SEAM(k) do { if (IN(k) && IN((k) + 1)) xcd_barrier(bar); } while (0)
    if (IN(0)) { p0_prologue(cx); SEAM(0); }
    if (IN(1)) { ph_lnmod0(cx); SEAM(1); }
    for (int l = 0; l < DEPTH; ++l) {
        const int pb = 2 + l * NPH_LAYER;
        if (IN(pb + 0)) { ph_gemm_win(cx, l); SEAM(pb + 0); }
        if (IN(pb + 1)) { ph_prep(cx, l);
#if USE_GDN_FAST
            ph_gdn_prep(cx, l);
#endif
#if USE_NA_MFMA
            ph_na_vt(cx, l);
#endif
            SEAM(pb + 1); }
        if (IN(pb + 2)) {
#if USE_GDN_FAST
            ph_gdn_chain(cx, l);
#else
            ph_gdn_chain_naive(cx, l);
#endif
            SEAM(pb + 2); }
        if (IN(pb + 3)) {
#if USE_DIFF_MFMA
            ph_diff_mfma(cx, l);
#else
            ph_diff_naive(cx, l);
#endif
#if USE_NA_MFMA
            ph_na_mfma(cx, l);
#else
            ph_na_naive(cx, l);
#endif
            SEAM(pb + 3); }
        if (IN(pb + 4)) { ph_combine(cx, l); SEAM(pb + 4); }
        if (IN(pb + 5)) { ph_gemm_merge(cx, l); SEAM(pb + 5); }
        if (IN(pb + 6)) { ph_gemm_wout(cx, l); SEAM(pb + 6); }
        if (IN(pb + 7)) { ph_ln1_router(cx, l); SEAM(pb + 7); }
        if (IN(pb + 8)) { ph_moe_gather(cx, l); SEAM(pb + 8); }
        if (IN(pb + 9)) { ph_gemm_moe1(cx, l); SEAM(pb + 9); }
        if (IN(pb + 10)) { ph_gemm_moe2(cx, l); SEAM(pb + 10); }
        if (IN(pb + 11)) { ph_ln2(cx, l); SEAM(pb + 11); }
    }
#undef IN
#undef SEAM
}

#ifndef MK_PER_PHASE
#define MK_PER_PHASE 0
#endif
extern "C" void kernel_launch(void* const* d_in, const int* in_sizes, int n_in, void* d_out, int out_size, void* d_ws, size_t ws_size, hipStream_t stream) {
    static int grid = 0;
    if (grid == 0) {
        if (n_in != 24 || out_size != MLAT * DM || ws_size < WS_END) { fprintf(stderr, "kernel_launch: unexpected shapes (n_in %d out %d ws %zu need %zu)\n", n_in, out_size, ws_size, (size_t)WS_END); grid = -1; return; }
        int dev = 0, cus = 0, per_cu = 0;
        if (hipGetDevice(&dev) != hipSuccess || hipDeviceGetAttribute(&cus, hipDeviceAttributeMultiprocessorCount, dev) != hipSuccess) { grid = -1; return; }
        if (hipFuncSetAttribute((const void*)fwd_kernel, hipFuncAttributeMaxDynamicSharedMemorySize, LDS_BYTES) != hipSuccess) { fprintf(stderr, "kernel_launch: hipFuncSetAttribute failed\n"); grid = -1; return; }
        if (hipOccupancyMaxActiveBlocksPerMultiprocessor(&per_cu, (const void*)fwd_kernel, NTHREADS, LDS_BYTES) != hipSuccess || per_cu < 1) { fprintf(stderr, "kernel_launch: occupancy query says %d\n", per_cu); }
        (void)hipGetLastError();
        grid = cus;
    }
    if (grid < 0) return;
    (void)hipMemsetAsync((char*)d_ws + WS_CTL, 0, CTL_ZERO_BYTES, stream);
    Args a{};
    for (int i = 0; i < 24; ++i) a.in[i] = (const float*)d_in[i];
    a.out = (float*)d_out; a.ws = (unsigned char*)d_ws;
#if MK_PER_PHASE
    for (int p = 0; p < NPHASES; ++p) { a.ph_lo = p; a.ph_hi = p + 1; hipLaunchKernelGGL(fwd_kernel, dim3(grid), dim3(NTHREADS), LDS_BYTES, stream, a); }
#else
    a.ph_lo = 0; a.ph_hi = NPHASES; hipLaunchKernelGGL(fwd_kernel, dim3(grid), dim3(NTHREADS), LDS_BYTES, stream, a);
#endif
    const hipError_t le = hipPeekAtLastError();
    if (le != hipSuccess) fprintf(stderr, "kernel_launch: launch failed: %s\n", hipGetErrorName(le));
}
```

```cpp
#define DUPK -1
#include <hip/hip_runtime.h>
#include <cstdio>
#include <cstdint>
#include <cmath>

#define GAS __attribute__((address_space(1)))
#define LAS __attribute__((address_space(3)))
typedef unsigned short bf16;
typedef float f32x4 __attribute__((ext_vector_type(4)));
typedef float f32x2 __attribute__((ext_vector_type(2)));
typedef unsigned u32x4 __attribute__((ext_vector_type(4)));
typedef unsigned u32x2 __attribute__((ext_vector_type(2)));
typedef short bf16x8 __attribute__((ext_vector_type(8)));

namespace pg8 {
#define PG8_LAS __attribute__((address_space(3)))
constexpr int BM = 256, BK = 64, HALF = 128, HTB = HALF * BK * 2, STAGE_BYTES = 8 * HTB, NXCD = 8, WGM = 8;
__host__ __device__ __forceinline__ int lds_byte(int r, int c) { const int st = (r >> 4) * 2 + (c >> 5), rr = r & 15, cc = c & 31, ob = rr * 64 + cc * 2; return st * 1024 + (ob ^ (((ob >> 9) & 1) << 5)); }
__host__ __device__ __forceinline__ void stage_rc(int b, int& R, int& C) { const int st = b / 1024, sb = b % 1024, swz = sb ^ (((sb >> 9) & 1) << 5); R = (st >> 1) * 16 + swz / 64; C = (st & 1) * 32 + (swz % 64) / 2; }
__host__ __device__ __forceinline__ int perm32(int rho) { const int n = rho >> 4, i = rho & 15; return 8 * (i >> 2) + 4 * n + (i & 3); }

struct Unit { int pm, pn, aux; unsigned aoff, boff; };

typedef float cvt_f32x2_t __attribute__((ext_vector_type(2))); typedef __bf16 cvt_bf16x2_t __attribute__((ext_vector_type(2)));
__device__ __forceinline__ unsigned cvt_pk_bf16(float lo, float hi) { cvt_f32x2_t v = {lo, hi}; cvt_bf16x2_t b = __builtin_convertvector(v, cvt_bf16x2_t); return __builtin_bit_cast(unsigned, b); }

template <class Epi, class Sched, bool ALIGN_EPI = true, bool SP2 = true>
__device__ __forceinline__ void gemm_phase(PG8_LAS unsigned char* lds, const int K, const char* Abase, const char* Bbase, const Sched& S, const Epi& E, const int wv) {
    int lane_; asm volatile("v_mbcnt_lo_u32_b32 %0, -1, 0\n\tv_mbcnt_hi_u32_b32 %0, -1, %0" : "=v"(lane_));
    const int wid = wv, lane = lane_, tid = wv * 64 + lane_, wr = wid >> 2, wc = wid & 3, fr = lane & 15, fq = lane >> 4;
    const int nt = K / BK;
    unsigned voffA[2], voffB[2];
#pragma unroll
    for (int i = 0; i < 2; ++i) { int R, C; stage_rc(tid * 16 + i * 8192, R, C); const int Rb = ((R & ~31) + perm32(R & 31));
        voffA[i] = (unsigned)(R * K + C) * 2u; voffB[i] = (unsigned)(Rb * K + C) * 2u; }
    const size_t kstep = (size_t)(BK * 2);
    const size_t hstep = (size_t)HALF * K * 2;
    const unsigned ldsw = (unsigned)wid * 1024u;
    const int aoff = lds_byte(wr * 64 + fr, fq * 8), boff = lds_byte(wc * 32 + fr, fq * 8);
#define PG8_SA(b, h) (((b) * 2 + (h)) * HTB)
#define PG8_SB(b, h) ((4 + (b) * 2 + (h)) * HTB)
#define PG8_STAGE(bufoff, gbase, voff) do { _Pragma("unroll") for (int _i = 0; _i < 2; ++_i) \
        __builtin_amdgcn_global_load_lds((const GAS unsigned*)((const char*)(gbase) + (voff)[_i]), (PG8_LAS unsigned*)(lds + (bufoff) + ldsw + _i * 8192), 16, 0, 0); } while (0)
#define PG8_LDA(dst, b, h) do { _Pragma("unroll") for (int m = 0; m < 4; ++m) _Pragma("unroll") for (int k = 0; k < 2; ++k) dst[m][k] = *(const PG8_LAS bf16x8*)(lds + PG8_SA(b, h) + aoff + m * 2048 + k * 1024); } while (0)
#define PG8_LDB(dst, b, h) do { _Pragma("unroll") for (int n = 0; n < 2; ++n) _Pragma("unroll") for (int k = 0; k < 2; ++k) dst[n][k] = *(const PG8_LAS bf16x8*)(lds + PG8_SB(b, h) + boff + n * 2048 + k * 1024); } while (0)
#define PG8_MMA(ai, bj, At, Bt) do { __builtin_amdgcn_s_setprio(1); _Pragma("unroll") for (int m = 0; m < 4; ++m) _Pragma("unroll") for (int n = 0; n < 2; ++n) _Pragma("unroll") for (int k = 0; k < 2; ++k) \
        acc[ai][bj][m][n] = __builtin_amdgcn_mfma_f32_16x16x32_bf16(Bt[n][k], At[m][k], acc[ai][bj][m][n], 0, 0, 0); __builtin_amdgcn_s_setprio(0); } while (0)
#define PG8_WAIT_V(n) asm volatile("s_waitcnt vmcnt(" #n ")" ::: "memory")
#define PG8_WAIT_L(n) asm volatile("s_waitcnt lgkmcnt(" #n ")" ::: "memory")
#define PG8_BAR __builtin_amdgcn_s_barrier()
#define PG8_SCHED __builtin_amdgcn_sched_barrier(0)
    Unit cur, nxt; int ui = 0;
    if (!S.next(0, cur)) return;
    f32x4 acc[2][2][4][2];
#pragma unroll
    for (int a = 0; a < 2; ++a)
#pragma unroll
        for (int b = 0; b < 2; ++b)
#pragma unroll
            for (int m = 0; m < 4; ++m)
#pragma unroll
                for (int n = 0; n < 2; ++n) acc[a][b][m][n] = (f32x4){0.f, 0.f, 0.f, 0.f};
    bf16x8 At[4][2], B0[2][2], B1[2][2];
    const char* cA = Abase + cur.aoff; const char* cB = Bbase + cur.boff;
    if constexpr (SP2) {
        PG8_STAGE(PG8_SB(0, 0), cB, voffB); PG8_STAGE(PG8_SB(0, 1), cB + hstep, voffB); PG8_STAGE(PG8_SA(0, 0), cA, voffA); PG8_STAGE(PG8_SA(0, 1), cA + hstep, voffA);
        if (wr == 1) PG8_BAR;
        PG8_WAIT_V(2); PG8_BAR;
        PG8_STAGE(PG8_SB(1, 0), cB + kstep, voffB); PG8_STAGE(PG8_SA(1, 0), cA + kstep, voffA); PG8_STAGE(PG8_SB(1, 1), cB + hstep + kstep, voffB);
        PG8_WAIT_V(6); PG8_BAR;
    } else {
        PG8_STAGE(PG8_SB(0, 0), cB, voffB); PG8_STAGE(PG8_SA(0, 0), cA, voffA); PG8_STAGE(PG8_SB(0, 1), cB + hstep, voffB); PG8_STAGE(PG8_SA(0, 1), cA + hstep, voffA);
        if (wr == 1) PG8_BAR;
        PG8_WAIT_V(4); PG8_BAR;
        PG8_STAGE(PG8_SB(1, 0), cB + kstep, voffB); PG8_STAGE(PG8_SA(1, 0), cA + kstep, voffA); PG8_STAGE(PG8_SB(1, 1), cB + hstep + kstep, voffB);
        PG8_WAIT_V(6); PG8_BAR;
    }
    for (;;) {
        const bool has_next = S.next(ui + 1, nxt);
        const char* nA = has_next ? Abase + nxt.aoff : cA; const char* nB = has_next ? Bbase + nxt.boff : cB;
        for (int t = 0; t < nt; t += 2) {
            const bool last = (t == nt - 2);
            const char* a1 = cA + (size_t)(t + 1) * kstep;
            const char* a2 = last ? nA : cA + (size_t)(t + 2) * kstep; const char* b2 = last ? nB : cB + (size_t)(t + 2) * kstep;
            const char* a3 = a2 + kstep; const char* b3 = b2 + kstep;
            if constexpr (SP2) {
            PG8_LDB(B0, 0, 0); PG8_LDB(B1, 0, 1); PG8_SCHED; PG8_LDA(At, 0, 0); PG8_STAGE(PG8_SA(1, 1), a1 + hstep, voffA);
            PG8_WAIT_V(8); PG8_WAIT_L(0); PG8_BAR; PG8_MMA(0, 0, At, B0); PG8_MMA(0, 1, At, B1); PG8_BAR; PG8_SCHED;
            PG8_LDA(At, 0, 1); PG8_STAGE(PG8_SB(0, 0), b2, voffB); PG8_STAGE(PG8_SB(0, 1), b2 + hstep, voffB); PG8_STAGE(PG8_SA(0, 0), a2, voffA);
            PG8_WAIT_V(8); PG8_WAIT_L(0); PG8_BAR; PG8_MMA(1, 0, At, B0); PG8_MMA(1, 1, At, B1); PG8_BAR; PG8_SCHED;
            PG8_LDB(B0, 1, 0); PG8_LDB(B1, 1, 1); PG8_SCHED; PG8_LDA(At, 1, 0); PG8_STAGE(PG8_SA(0, 1), a2 + hstep, voffA);
            PG8_WAIT_V(8); PG8_WAIT_L(0); PG8_BAR; PG8_MMA(0, 0, At, B0); PG8_MMA(0, 1, At, B1); PG8_BAR; PG8_SCHED;
            PG8_LDA(At, 1, 1); PG8_STAGE(PG8_SB(1, 0), b3, voffB); PG8_STAGE(PG8_SB(1, 1), b3 + hstep, voffB); PG8_STAGE(PG8_SA(1, 0), a3, voffA);
            PG8_WAIT_V(8); PG8_WAIT_L(0); PG8_BAR; PG8_MMA(1, 0, At, B0); PG8_MMA(1, 1, At, B1); PG8_BAR; PG8_SCHED;
            } else {
            PG8_LDB(B0, 0, 0); PG8_SCHED; PG8_LDA(At, 0, 0); PG8_STAGE(PG8_SA(1, 1), a1 + hstep, voffA);
            PG8_WAIT_L(8); PG8_BAR; PG8_WAIT_L(0); PG8_MMA(0, 0, At, B0); PG8_BAR; PG8_SCHED;
            PG8_LDB(B1, 0, 1); PG8_STAGE(PG8_SB(0, 0), b2, voffB);
            PG8_BAR; PG8_WAIT_L(0); PG8_MMA(0, 1, At, B1); PG8_BAR;
            PG8_LDA(At, 0, 1); PG8_STAGE(PG8_SA(0, 0), a2, voffA);
            PG8_BAR; PG8_WAIT_L(0); PG8_MMA(1, 0, At, B0); PG8_BAR; PG8_SCHED;
            PG8_STAGE(PG8_SB(0, 1), b2 + hstep, voffB);
            PG8_WAIT_V(6); PG8_BAR; PG8_MMA(1, 1, At, B1); PG8_BAR;
            PG8_LDB(B0, 1, 0); PG8_SCHED; PG8_LDA(At, 1, 0); PG8_STAGE(PG8_SA(0, 1), a2 + hstep, voffA);
            PG8_WAIT_L(8); PG8_BAR; PG8_WAIT_L(0); PG8_MMA(0, 0, At, B0); PG8_BAR; PG8_SCHED;
            PG8_LDB(B1, 1, 1); PG8_STAGE(PG8_SB(1, 0), b3, voffB);
            PG8_BAR; PG8_WAIT_L(0); PG8_MMA(0, 1, At, B1); PG8_BAR;
            PG8_LDA(At, 1, 1); PG8_STAGE(PG8_SA(1, 0), a3, voffA);
            PG8_BAR; PG8_WAIT_L(0); PG8_MMA(1, 0, At, B0); PG8_BAR; PG8_SCHED;
            PG8_STAGE(PG8_SB(1, 1), b3 + hstep, voffB);
            PG8_WAIT_V(6); PG8_BAR; PG8_MMA(1, 1, At, B1); PG8_BAR;
            }
        }
        if constexpr (ALIGN_EPI) { if (wr == 0) PG8_BAR; }
        E(acc, cur, wr, wc, fr, fq);
        if (!has_next) break;
#pragma unroll
        for (int a = 0; a < 2; ++a)
#pragma unroll
            for (int b = 0; b < 2; ++b)
#pragma unroll
                for (int m = 0; m < 4; ++m)
#pragma unroll
                    for (int n = 0; n < 2; ++n) acc[a][b][m][n] = (f32x4){0.f, 0.f, 0.f, 0.f};
        cur = nxt; cA = nA; cB = nB; ++ui;
        if constexpr (ALIGN_EPI) { if (wr == 1) PG8_BAR; }
    }
    PG8_WAIT_V(0);
    if constexpr (!ALIGN_EPI) { if (wr == 0) PG8_BAR; }
    PG8_BAR;
#undef PG8_SA
#undef PG8_SB
#undef PG8_STAGE
#undef PG8_LDA
#undef PG8_LDB
#undef PG8_MMA
#undef PG8_WAIT_V
#undef PG8_WAIT_L
#undef PG8_BAR
#undef PG8_SCHED
}
}
#ifndef USE_NA_MFMA
#define USE_NA_MFMA 1
#endif
#ifndef USE_GDN_FAST
#define USE_GDN_FAST 1
#endif
#ifndef USE_DIFF_MFMA
#define USE_DIFF_MFMA 1
#endif
constexpr int DM = 1024, BATCH = 2, SEQ = 8192, DEPTH = 4, CTXL = 256, GRIDW = 64;
constexpr int MLAT = BATCH * SEQ, MCTX = BATCH * CTXL, MT = MLAT + MCTX;
constexpr int NP = 8192;
constexpr int PC_GQ = 0, PC_GK = 512, PC_GV = 1024, PC_GZ = 1536, PC_DQ = 2048, PC_DK = 2560, PC_DV = 3072, PC_NQ = 3584, PC_NK = 4096, PC_NV = 4608, PC_GATE = 5120;
constexpr int D_IN = 8208, NEXP = 32, TOPK = 4, DEXP = 1024;
constexpr float LN_EPS = 1e-5f, RMS_EPS = 1e-6f;
constexpr float DN_ALPHA = 1.6817928305074292f;
constexpr int NWAVES = 8, NTHREADS = 512;
constexpr int RG_ROWS = 66, NRG = MT / RG_ROWS;
constexpr int RPAD = MT * TOPK + NEXP * 256;
constexpr int MAXTILES = RPAD / 256;

constexpr size_t MiB = 1u << 20;
constexpr size_t al256(size_t x) { return (x + 255) / 256 * 256; }
constexpr size_t WS_CTL = 0, CTL_ZERO_BYTES = 1 * MiB;
constexpr size_t WS_MOD = WS_CTL + CTL_ZERO_BYTES;
constexpr size_t WS_LAM = WS_MOD + al256((size_t)DEPTH * 3 * 6144 * 4);
constexpr size_t WS_WDEC = WS_LAM + 256;
constexpr size_t WS_WRT = WS_WDEC + (size_t)DEPTH * 16 * 1024 * 4;
constexpr size_t WS_WIN = WS_WRT + (size_t)DEPTH * 32 * 1024 * 4;
constexpr size_t WS_WBR = WS_WIN + (size_t)DEPTH * 8192 * 1024 * 2;
constexpr size_t WS_WOUT = WS_WBR + (size_t)DEPTH * 3 * 1024 * 512 * 2;
constexpr size_t WS_W1 = WS_WOUT + (size_t)DEPTH * 1024 * 1024 * 2;
constexpr size_t WS_W2 = WS_W1 + (size_t)DEPTH * 32 * 2048 * 1024 * 2;
constexpr size_t WS_X = WS_W2 + (size_t)DEPTH * 32 * 1024 * 1024 * 2;
constexpr size_t WS_HX = WS_X + (size_t)MT * DM * 4;
constexpr size_t WS_P = WS_HX + (size_t)MT * DM * 2;
constexpr size_t WS_DEC = WS_P + (size_t)MT * NP * 2;
constexpr size_t WS_QN = WS_DEC + (size_t)MT * 16 * 4;
constexpr size_t WS_KN = WS_QN + (size_t)MT * 512 * 4;
constexpr size_t WS_VV = WS_KN + (size_t)MT * 512 * 4;
constexpr size_t WS_OG = WS_VV + (size_t)MT * 512 * 4;
constexpr size_t WS_OD = WS_OG + (size_t)2 * MT * 512 * 4;
constexpr size_t WS_YA = WS_OD + (size_t)2 * MT * 512 * 4;
constexpr size_t WS_YB = WS_YA + (size_t)MT * 512 * 2;
constexpr size_t WS_YC = WS_YB + (size_t)MT * 512 * 2;
constexpr size_t WS_MACC = WS_YC + (size_t)MT * 512 * 2;
constexpr size_t WS_MBF = WS_MACC + (size_t)MT * DM * 4;
constexpr size_t WS_T = WS_MBF + (size_t)MT * DM * 2;
constexpr size_t WS_TOPE = WS_T + (size_t)MT * DM * 4;
constexpr size_t WS_TOPR = WS_TOPE + (size_t)MT * 4 * 4;
constexpr size_t WS_TOPG = WS_TOPR + (size_t)MT * 4 * 4;
constexpr size_t WS_SLOT = WS_TOPG + (size_t)MT * 4 * 4;
constexpr size_t WS_BLKB = WS_SLOT + (size_t)MT * 4 * 4;
constexpr size_t WS_HP = WS_BLKB + (size_t)NRG * 32 * 4;
constexpr size_t WS_ACT = WS_HP + (size_t)RPAD * 1024 * 2;
constexpr size_t WS_Y = WS_ACT + (size_t)RPAD * 1024 * 2;
constexpr size_t WS_REC = WS_Y + (size_t)RPAD * 1024 * 2;
constexpr size_t WS_U = WS_REC + (size_t)2 * 4 * 2 * 132 * 57344;
constexpr size_t WS_GL = WS_U + (size_t)2 * 4 * 2 * 132 * 16384;
constexpr size_t WS_VT = WS_GL + (size_t)2 * 4 * 2 * 132 * 4 + 256;
constexpr size_t WS_END = WS_VT + (size_t)2 * 8 * 64 * 8448 * 2;
constexpr int CW_BAR = 4096;
constexpr int CW_CNT = 16384;
constexpr int CW_Q = 20480;

constexpr int RING_BYTES = 131072;
constexpr int LDSCTL_OFF = RING_BYTES, MISC_OFF = LDSCTL_OFF + 2048;
constexpr int LDS_BYTES = 147456;

#define RLX_AGENT __ATOMIC_RELAXED, __HIP_MEMORY_SCOPE_AGENT
#define LDS_WAIT() asm volatile("s_waitcnt lgkmcnt(0)" ::: "memory")
#define VM_WAIT() asm volatile("s_waitcnt vmcnt(0)" ::: "memory")
__device__ __forceinline__ float bf2f(unsigned b) { return __uint_as_float(b << 16); }
__device__ __forceinline__ float bflo(unsigned w) { return __uint_as_float(w << 16); }
__device__ __forceinline__ float bfhi(unsigned w) { return __uint_as_float(w & 0xffff0000u); }
__device__ __forceinline__ unsigned f2bf(float f) { unsigned u = __float_as_uint(f); return (u + 0x7fffu + ((u >> 16) & 1u)) >> 16; }
__device__ __forceinline__ unsigned pk2(float lo, float hi) { return pg8::cvt_pk_bf16(lo, hi); }
__device__ __forceinline__ float siluf(float x) { return x / (1.f + __expf(-x)); }
__device__ __forceinline__ float sigmf(float x) { return 1.f / (1.f + __expf(-x)); }

#define XB_TMO      128
#define XB_XCNT(j)  (256  + 64 * (j))
#define XB_XSUB(j)  (1280 + 64 * (j))
#define XB_XGEN(j)  (2304 + 64 * (j))
#define XB_TOP      3328
#define XB_TOPGEN   3392
#define XCD_BAR_WORDS 3456
#define XB_SPIN_CAP (1u << 22)
__device__ __forceinline__ unsigned xb_ld(unsigned* p)              { return __hip_atomic_load(p, __ATOMIC_RELAXED, __HIP_MEMORY_SCOPE_AGENT); }
__device__ __forceinline__ unsigned xb_add(unsigned* p, unsigned v) { return __hip_atomic_fetch_add(p, v, __ATOMIC_RELAXED, __HIP_MEMORY_SCOPE_AGENT); }
__device__ __forceinline__ unsigned xb_xcc_id() { return (unsigned)__builtin_amdgcn_s_getreg((3 << 11) | 20) & 0xFu; }
#define XB_SPIN(cond, bar) do { unsigned _sp = 0; while (cond) { __builtin_amdgcn_s_sleep(1); \
    if ((++_sp & 255u) == 0u) { if (xb_ld(&(bar)[XB_TMO])) break; if (_sp > XB_SPIN_CAP) { atomicAdd(&(bar)[XB_TMO], 1u); break; } } } } while (0)
struct XcdBarrier { unsigned* bar; unsigned x; volatile LAS unsigned* st; };
__device__ __forceinline__ XcdBarrier xcd_barrier_post(unsigned* bar, volatile LAS unsigned* st) {
    XcdBarrier b; b.bar = bar; b.x = xb_xcc_id(); b.st = st;
    if (threadIdx.x == 0) (void)xb_add(&bar[XB_XCNT(b.x)], 1u);
    return b;
}
__device__ __forceinline__ void xcd_barrier_complete(unsigned* bar, unsigned x, unsigned& nloc, unsigned& nx) {
    const unsigned G = gridDim.x * gridDim.y * gridDim.z;
    unsigned sum, cnt, mine, sp = 0u;
    for (;;) {
        sum = 0u; cnt = 0u; mine = 0u;
#pragma unroll
        for (unsigned j = 0; j < 16; ++j) { const unsigned c = xb_ld(&bar[XB_XCNT(j)]); sum += c; cnt += (c > 0u) ? 1u : 0u; mine = (j == x) ? c : mine; }
        if (sum == G) break;
        __builtin_amdgcn_s_sleep(1);
        if ((++sp & 255u) == 0u) { if (xb_ld(&bar[XB_TMO])) break; if (sp > XB_SPIN_CAP) { atomicAdd(&bar[XB_TMO], 1u); break; } }
    }
    nloc = mine > 0u ? mine : 1u; nx = cnt > 0u ? cnt : 1u;
}
__device__ __forceinline__ void xcd_barrier(const XcdBarrier& b) {
#ifdef BAR_BRUTE
    __builtin_amdgcn_fence(__ATOMIC_RELEASE, "agent");
#endif
    asm volatile("s_waitcnt vmcnt(0)" ::: "memory");
    __syncthreads();
    if (threadIdx.x == 0) {
        unsigned* bar = b.bar;
        __builtin_amdgcn_s_waitcnt(0);
        unsigned nloc = b.st[0], nx = b.st[1];
        if (nloc == 0u) { xcd_barrier_complete(bar, b.x, nloc, nx); b.st[0] = nloc; b.st[1] = nx; }
        const unsigned old = xb_add(&bar[XB_XSUB(b.x)], 1u);
        const unsigned gen = old / nloc;
        if (old + 1u == (gen + 1u) * nloc) {
            __builtin_amdgcn_fence(__ATOMIC_RELEASE, "agent");
            asm volatile("s_waitcnt vmcnt(0)" ::: "memory");
            const unsigned og = xb_add(&bar[XB_TOP], 1u);
            const unsigned tg = og / nx;
            if (og + 1u == (tg + 1u) * nx) xb_add(&bar[XB_TOPGEN], 1u);
            else XB_SPIN(xb_ld(&bar[XB_TOPGEN]) == tg, bar);
            __builtin_amdgcn_fence(__ATOMIC_ACQUIRE, "agent");
            xb_add(&bar[XB_XGEN(b.x)], 1u);
            asm volatile("s_waitcnt vmcnt(0)" ::: "memory");
        } else {
            XB_SPIN(xb_ld(&bar[XB_XGEN(b.x)]) == gen, bar);
            __builtin_amdgcn_fence(__ATOMIC_ACQUIRE, "agent");
            asm volatile("s_waitcnt vmcnt(0)" ::: "memory");
        }
    }
    __syncthreads();
#ifdef BAR_BRUTE
    __builtin_amdgcn_fence(__ATOMIC_ACQUIRE, "agent");
    asm volatile("s_waitcnt vmcnt(0)" ::: "memory");
    __syncthreads();
#endif
}

struct Args { const float* in[24]; float* out; unsigned char* ws; int ph_lo, ph_hi; };
enum { I_X = 0, I_C, I_CTX, I_CCTX, I_WADA, I_BADA, I_WIN, I_CONVW, I_ALOG, I_DTB, I_GNW, I_DLAM, I_DNW, I_RPB, I_WBR, I_WOUT, I_LNG, I_LNB, I_WR, I_BR, I_W1, I_B1, I_W2, I_B2 };
typedef const __attribute__((address_space(4))) Args* ArgsP;
struct Ctx { LAS unsigned char* lds; unsigned char* ws; ArgsP ap; int G, bid, wv; };
#define PHASE_FN __device__ __forceinline__
__device__ __forceinline__ int rfl(int v) { return __builtin_amdgcn_readfirstlane(v); }
struct Frame {
    ArgsP ap;
    LAS unsigned char* lds;
    unsigned* ctl;
    unsigned char* ws;
    int tid, lane, wave, G, bid, wv;
};
#define REFRESH(F) do { int l_; asm volatile("v_mbcnt_lo_u32_b32 %0, -1, 0\n\tv_mbcnt_hi_u32_b32 %0, -1, %0" : "=v"(l_)); (F).lane = l_; (F).wave = (F).wv; (F).tid = (F).wv * 64 + l_; } while (0)
__device__ __forceinline__ Frame mkframe(const Ctx& c) {
    Frame F;
    F.lds = (LAS unsigned char*)(size_t)(unsigned)rfl((int)(unsigned)(size_t)c.lds);
    { const unsigned long long w = (unsigned long long)c.ws; F.ws = (unsigned char*)(((unsigned long long)(unsigned)rfl((int)(unsigned)(w >> 32)) << 32) | (unsigned)rfl((int)(unsigned)w)); }
    { const unsigned long long w = (unsigned long long)c.ap; F.ap = (ArgsP)(((unsigned long long)(unsigned)rfl((int)(unsigned)(w >> 32)) << 32) | (unsigned)rfl((int)(unsigned)w)); }
    F.ctl = (unsigned*)F.ws; F.G = rfl(c.G); F.bid = rfl(c.bid); F.wv = rfl(c.wv); F.wave = F.wv; F.lane = 0; F.tid = 0;
    return F;
}
__device__ __forceinline__ float wave_sum(float v) {
#pragma unroll
    for (int o = 1; o < 64; o <<= 1) v += __shfl_xor(v, o);
    return v;
}
__device__ __forceinline__ float wave_max(float v) {
#pragma unroll
    for (int o = 1; o < 64; o <<= 1) v = fmaxf(v, __shfl_xor(v, o));
    return v;
}
__device__ __forceinline__ int mod_index(int row) { return row < MLAT ? (row >> 13) : 2; }
static_assert(WS_YB == WS_YA + (size_t)MT * 512 * 2 && WS_YC == WS_YB + (size_t)MT * 512 * 2, "YA|YB|YC contiguous");
__device__ __forceinline__ void transpose_item(const float* W, int ldw, int K, int src_col0, bf16* WT, int dst_row0, int k0, LAS float* scr, int lane) {
#pragma unroll 8
    for (int i = 0; i < 32; ++i) { const int kk = 2 * i + (lane >> 5); scr[kk * 33 + (lane & 31)] = W[(size_t)(k0 + kk) * ldw + src_col0 + (lane & 31)]; }
    LDS_WAIT(); asm volatile("" ::: "memory");
    const int c = lane & 7;
#pragma unroll
    for (int j = 0; j < 4; ++j) { const int n = (lane >> 3) + 8 * j; const LAS float* s = scr + (8 * c) * 33 + n;
        u32x4 o; o.x = pk2(s[0 * 33], s[1 * 33]); o.y = pk2(s[2 * 33], s[3 * 33]); o.z = pk2(s[4 * 33], s[5 * 33]); o.w = pk2(s[6 * 33], s[7 * 33]);
        *(u32x4*)(WT + (size_t)(dst_row0 + n) * K + k0 + 8 * c) = o; }
    LDS_WAIT(); asm volatile("" ::: "memory");
}
constexpr int IT_WIN = DEPTH * 16 * 256, IT_WBR = DEPTH * 3 * 8 * 32, IT_WOUT = DEPTH * 16 * 32, IT_W1 = DEPTH * 32 * 16 * 64, IT_W2 = DEPTH * 32 * 16 * 32;
constexpr int IT_ALL = IT_WIN + IT_WBR + IT_WOUT + IT_W1 + IT_W2;

PHASE_FN void p0_prologue(Ctx cx) {
    Frame F = mkframe(cx); const ArgsP a = F.ap;
    REFRESH(F);
    unsigned char* ws = F.ws;
    LAS float* scr = (LAS float*)(F.lds + F.wave * 16384);
    const int gw = F.bid * NWAVES + F.wave, NGW = F.G * NWAVES;
    for (int it = gw; it < IT_ALL; it += NGW) {
        int r = it;
        if (r < IT_WIN) { const int l = r / 4096, q = r % 4096, kb = q / 256, nb = q % 256, d0 = 32 * nb, s0 = d0 + (d0 >= 2048 ? 16 : 0);
            transpose_item(a->in[I_WIN] + (size_t)l * 1024 * D_IN, D_IN, 1024, s0, (bf16*)(ws + WS_WIN) + (size_t)l * 8192 * 1024, d0, 64 * kb, scr, F.lane); continue; }
        r -= IT_WIN;
        if (r < IT_WBR) { const int mi = r / 256, q = r % 256, kb = q / 32, nb = q % 32;
            transpose_item(a->in[I_WBR] + (size_t)mi * 512 * 1024, 1024, 512, 32 * nb, (bf16*)(ws + WS_WBR) + (size_t)mi * 1024 * 512, 32 * nb, 64 * kb, scr, F.lane); continue; }
        r -= IT_WBR;
        if (r < IT_WOUT) { const int l = r / 512, q = r % 512, kb = q / 32, nb = q % 32;
            transpose_item(a->in[I_WOUT] + (size_t)l * 1024 * 1024, 1024, 1024, 32 * nb, (bf16*)(ws + WS_WOUT) + (size_t)l * 1024 * 1024, 32 * nb, 64 * kb, scr, F.lane); continue; }
        r -= IT_WOUT;
        if (r < IT_W1) { const int mi = r / 1024, q = r % 1024, kb = q / 64, nb = q % 64, d0 = 32 * nb, pn = d0 >> 8, bj = (d0 >> 7) & 1, j = d0 & 127, s0 = 1024 * bj + 128 * pn + j;
            transpose_item(a->in[I_W1] + (size_t)mi * 1024 * 2048, 2048, 1024, s0, (bf16*)(ws + WS_W1) + (size_t)mi * 2048 * 1024, d0, 64 * kb, scr, F.lane); continue; }
        r -= IT_W1;
        { const int mi = r / 512, q = r % 512, kb = q / 32, nb = q % 32;
            transpose_item(a->in[I_W2] + (size_t)mi * 1024 * 1024, 1024, 1024, 32 * nb, (bf16*)(ws + WS_W2) + (size_t)mi * 1024 * 1024, 32 * nb, 64 * kb, scr, F.lane); }
    }
    const size_t gt = (size_t)F.bid * NTHREADS + F.tid, NGT = (size_t)F.G * NTHREADS;
    { float* wd = (float*)(ws + WS_WDEC);
      for (size_t i = gt; i < (size_t)DEPTH * 16 * 1024; i += NGT) { const int l = (int)(i >> 14), c = (int)(i >> 10) & 15, k = (int)i & 1023; wd[i] = a->in[I_WIN][((size_t)l * 1024 + k) * D_IN + 2048 + c]; }
      float* wr = (float*)(ws + WS_WRT);
      for (size_t i = gt; i < (size_t)DEPTH * 32 * 1024; i += NGT) { const int l = (int)(i >> 15), e = (int)(i >> 10) & 31, k = (int)i & 1023; wr[i] = a->in[I_WR][((size_t)l * 1024 + k) * 32 + e]; } }
    { f32x4* X4 = (f32x4*)(ws + WS_X); const f32x4* x4 = (const f32x4*)a->in[I_X]; const f32x4* c4 = (const f32x4*)a->in[I_CTX];
      for (size_t i = gt; i < (size_t)MT * 256; i += NGT) X4[i] = i < (size_t)MLAT * 256 ? x4[i] : c4[i - (size_t)MLAT * 256]; }
    if (F.bid == 0 && F.wave < DEPTH) { const int l = F.wave; const float* lv = a->in[I_DLAM] + l * 256;
        const float s1 = wave_sum(lv[F.lane] * lv[64 + F.lane]), s2 = wave_sum(lv[128 + F.lane] * lv[192 + F.lane]);
        if (F.lane == 0) ((float*)(ws + WS_LAM))[l] = expf(s1) - expf(s2) + (0.8f - 0.6f * expf(-0.3f * (float)l)); }
    { LAS float* red = (LAS float*)(F.lds);
      float* MOD = (float*)(ws + WS_MOD);
      __syncthreads();
      for (int it = F.bid; it < DEPTH * 96; it += F.G) {
        const int l = it / 96, n = (it % 96) * 64 + F.lane; const float* wa = a->in[I_WADA] + (size_t)l * 1024 * 6144 + n;
        float a0 = 0.f, a1 = 0.f, a2 = 0.f;
        for (int k = F.wave * 128; k < F.wave * 128 + 128; ++k) { const float w = wa[(size_t)k * 6144];
            a0 += siluf(a->in[I_C][k]) * w; a1 += siluf(a->in[I_C][1024 + k]) * w; a2 += siluf(a->in[I_CCTX][k]) * w; }
        red[(F.wave * 3 + 0) * 64 + F.lane] = a0; red[(F.wave * 3 + 1) * 64 + F.lane] = a1; red[(F.wave * 3 + 2) * 64 + F.lane] = a2;
        __syncthreads();
        if (F.tid < 192) { const int i = F.tid >> 6, c = F.tid & 63; float s = 0.f;
#pragma unroll
            for (int w = 0; w < 8; ++w) s += red[(w * 3 + i) * 64 + c];
            const int nn = (it % 96) * 64 + c; MOD[((size_t)l * 3 + i) * 6144 + nn] = s + a->in[I_BADA][l * 6144 + nn]; }
        __syncthreads();
      } }
}

__device__ __forceinline__ void ln_inplace(f32x4 (&v)[4]) {
    float s = 0.f;
#pragma unroll
    for (int j = 0; j < 4; ++j) s += (v[j].x + v[j].y) + (v[j].z + v[j].w);
    const float mean = wave_sum(s) * (1.f / DM); float s2 = 0.f;
#pragma unroll
    for (int j = 0; j < 4; ++j) { v[j] = v[j] - mean; s2 += (v[j].x * v[j].x + v[j].y * v[j].y) + (v[j].z * v[j].z + v[j].w * v[j].w); }
    const float rstd = 1.f / sqrtf(wave_sum(s2) * (1.f / DM) + LN_EPS);
#pragma unroll
    for (int j = 0; j < 4; ++j) v[j] = v[j] * rstd;
}
__device__ __forceinline__ void modulate_store(const Frame& F, int l, int which, int row, f32x4 (&v)[4]) {
    ln_inplace(v);
    const float* mod = (const float*)(F.ws + WS_MOD) + ((size_t)l * 3 + mod_index(row)) * 6144 + which * 3072;
    bf16* hx = (bf16*)(F.ws + WS_HX) + (size_t)row * DM;
#pragma unroll
    for (int j = 0; j < 4; ++j) { const int c = 4 * F.lane + 256 * j; const f32x4 sh = *(const f32x4*)(mod + c), sc = *(const f32x4*)(mod + 1024 + c);
        v[j] = v[j] * (sc + 1.f) + sh;
        u32x2 o; o.x = pk2(v[j].x, v[j].y); o.y = pk2(v[j].z, v[j].w); *(u32x2*)(hx + c) = o; }
}
__device__ __forceinline__ void stage_wdec(const Frame& F, int l) {
    const f32x4* src = (const f32x4*)((const float*)(F.ws + WS_WDEC) + (size_t)l * 16 * 1024); LAS f32x4* dst = (LAS f32x4*)F.lds;
    __syncthreads();
    for (int i = F.tid; i < 16 * 256; i += NTHREADS) dst[i] = src[i];
    __syncthreads();
}
__device__ __forceinline__ void decay_cols(const Frame& F, int l, int row, const f32x4 (&h)[4]) {
    const LAS float* wd = (const LAS float*)F.lds; float* dec = (float*)(F.ws + WS_DEC) + (size_t)row * 16;
    float p[16];
#pragma unroll
    for (int i = 0; i < 16; ++i) { float s = 0.f;
#pragma unroll
        for (int j = 0; j < 4; ++j) { const f32x4 w = *(const LAS f32x4*)(wd + i * 1024 + 4 * F.lane + 256 * j); s += (h[j].x * w.x + h[j].y * w.y) + (h[j].z * w.z + h[j].w * w.w); }
        p[i] = s; if ((i & 7) == 7) asm volatile("" ::: "memory"); }
#pragma unroll
    for (int i2 = 0; i2 < 8; ++i2) { const bool up = (F.lane & 32) != 0; const float send = up ? p[i2] : p[i2 + 8], keep = up ? p[i2 + 8] : p[i2]; p[i2] = keep + __shfl_xor(send, 32); }
#pragma unroll
    for (int i2 = 0; i2 < 4; ++i2) { const bool up = (F.lane & 16) != 0; const float send = up ? p[i2] : p[i2 + 4], keep = up ? p[i2 + 4] : p[i2]; p[i2] = keep + __shfl_xor(send, 16); }
#pragma unroll
    for (int i2 = 0; i2 < 2; ++i2) { const bool up = (F.lane & 8) != 0; const float send = up ? p[i2] : p[i2 + 2], keep = up ? p[i2 + 2] : p[i2]; p[i2] = keep + __shfl_xor(send, 8); }
    { const bool up = (F.lane & 4) != 0; const float send = up ? p[0] : p[1], keep = up ? p[1] : p[0]; p[0] = keep + __shfl_xor(send, 4); }
    p[0] += __shfl_xor(p[0], 2); p[0] += __shfl_xor(p[0], 1);
    if ((F.lane & 3) == 0) dec[F.lane >> 2] = p[0];
}

PHASE_FN void ph_lnmod0(Ctx cx) {
    Frame F = mkframe(cx);
    REFRESH(F);
    const int gw = F.bid * NWAVES + F.wave, NGW = F.G * NWAVES;
    stage_wdec(F, 0);
    for (int row = gw; row < MT; row += NGW) { f32x4 v[4]; const f32x4* xr = (const f32x4*)(F.ws + WS_X) + (size_t)row * 256 + F.lane;
#pragma unroll
        for (int j = 0; j < 4; ++j) v[j] = xr[64 * j];
        modulate_store(F, 0, 0, row, v); decay_cols(F, 0, row, v); }
}

struct TileMap {
    __device__ static __forceinline__ bool map(int i, int G, int c, int nM, int nN, int& pm, int& pn) {
        const int nwg = nM * nN; const long L = (long)i * G + c; if (L >= nwg) return false;
        int wgid = (int)L; { const int q = nwg / 8, r = nwg % 8, xcd = wgid % 8, off = wgid / 8; wgid = (xcd < r ? xcd * (q + 1) : r * (q + 1) + (xcd - r) * q) + off; }
        const int nig = 8 * nN, gid = wgid / nig, fm = gid * 8, gsz = (nM - fm) < 8 ? (nM - fm) : 8;
        pm = fm + ((wgid % nig) % gsz); pn = (wgid % nig) / gsz; return true; }
};
struct StaticOrder { int nM, nN, G, c, K;
    __device__ __forceinline__ bool next(int i, pg8::Unit& u) const { if (!TileMap::map(i, G, c, nM, nN, u.pm, u.pn)) return false; u.aux = 0;
        u.aoff = (unsigned)u.pm * 256u * (unsigned)K * 2u; u.boff = (unsigned)u.pn * 256u * (unsigned)K * 2u; return true; } };
struct MergeOrder { int G, c;
    __device__ __forceinline__ bool next(int i, pg8::Unit& u) const { const int br = i % 3; if (!TileMap::map(i / 3, G, c, MT / 256, 4, u.pm, u.pn)) return false; u.aux = br;
        u.aoff = (unsigned)br * (unsigned)(MT * 512 * 2) + (unsigned)u.pm * (256u * 512u * 2u); u.boff = ((unsigned)br * 1024u + (unsigned)u.pn * 256u) * (512u * 2u); return true; } };
struct MoeOrder { const volatile LAS int* tab;
    __device__ __forceinline__ bool next(int i, pg8::Unit& u) const { const int w = tab[416 + i]; if (w < 0) return false; u.pm = w & 0xfff; u.pn = (w >> 12) & 0xf; u.aux = (w >> 16) & 0xff; const int nN = (w >> 24) & 0xf;
        u.aoff = (unsigned)u.pm * (256u * 1024u * 2u); u.boff = (unsigned)((u.aux * nN + u.pn) * 256) * (1024u * 2u); return true; } };

struct EpiWin { bf16* P;
    __device__ __forceinline__ void operator()(const f32x4 (&acc)[2][2][4][2], const pg8::Unit& u, int wr, int wc, int fr, int fq) const {
        const int row0 = u.pm * 256 + wr * 64 + fr, col0 = u.pn * 256 + wc * 32 + 8 * fq; const bool sg = u.pn >= 20;
#pragma unroll
        for (int ai = 0; ai < 2; ++ai)
#pragma unroll
            for (int m = 0; m < 4; ++m) { bf16* rowp = P + (size_t)(row0 + ai * 128 + m * 16) * NP + col0;
#pragma unroll
                for (int bj = 0; bj < 2; ++bj) { f32x4 v0 = acc[ai][bj][m][0], v1 = acc[ai][bj][m][1];
                    if (sg) {
#pragma unroll
                        for (int q = 0; q < 4; ++q) { v0[q] = sigmf(v0[q]); v1[q] = sigmf(v1[q]); } }
                    u32x4 w; w.x = pk2(v0[0], v0[1]); w.y = pk2(v0[2], v0[3]); w.z = pk2(v1[0], v1[1]); w.w = pk2(v1[2], v1[3]);
                    *(u32x4*)(rowp + bj * 128) = w; } }
    } };
struct EpiMerge { const bf16* P; float* MACC; bf16* MBF;
    __device__ __forceinline__ void operator()(const f32x4 (&acc)[2][2][4][2], const pg8::Unit& u, int wr, int wc, int fr, int fq) const {
        const int row0 = u.pm * 256 + wr * 64 + fr, col0 = u.pn * 256 + wc * 32 + 8 * fq, br = u.aux;
#pragma unroll
        for (int ai = 0; ai < 2; ++ai)
#pragma unroll
            for (int m = 0; m < 4; ++m) { const size_t row = (size_t)(row0 + ai * 128 + m * 16);
#pragma unroll
                for (int bj = 0; bj < 2; ++bj) { const int col = col0 + bj * 128;
                    const u32x4 g = *(const u32x4*)(P + row * NP + PC_GATE + 1024 * br + col);
                    f32x4 v0 = acc[ai][bj][m][0], v1 = acc[ai][bj][m][1];
                    v0[0] *= bflo(g.x); v0[1] *= bfhi(g.x); v0[2] *= bflo(g.y); v0[3] *= bfhi(g.y); v1[0] *= bflo(g.z); v1[1] *= bfhi(g.z); v1[2] *= bflo(g.w); v1[3] *= bfhi(g.w);
                    float* mp = MACC + row * DM + col;
                    if (br > 0) { v0 = v0 + *(const f32x4*)mp; v1 = v1 + *(const f32x4*)(mp + 4); }
                    if (br < 2) { *(f32x4*)mp = v0; *(f32x4*)(mp + 4) = v1; }
                    else { u32x4 w; w.x = pk2(v0[0], v0[1]); w.y = pk2(v0[2], v0[3]); w.z = pk2(v1[0], v1[1]); w.w = pk2(v1[2], v1[3]); *(u32x4*)(MBF + row * DM + col) = w; } } }
    } };
struct EpiWout { const float* X; const float* MODL; float* T;
    __device__ __forceinline__ void operator()(const f32x4 (&acc)[2][2][4][2], const pg8::Unit& u, int wr, int wc, int fr, int fq) const {
        const int row0 = u.pm * 256 + wr * 64 + fr, col0 = u.pn * 256 + wc * 32 + 8 * fq; const float* g1 = MODL + (size_t)(u.pm < 64 ? (u.pm >> 5) : 2) * 6144 + 2048;
#pragma unroll
        for (int bj = 0; bj < 2; ++bj) { const int col = col0 + bj * 128; const f32x4 ga = *(const f32x4*)(g1 + col), gb = *(const f32x4*)(g1 + col + 4);
#pragma unroll
            for (int ai = 0; ai < 2; ++ai)
#pragma unroll
                for (int m = 0; m < 4; ++m) { const size_t o = (size_t)(row0 + ai * 128 + m * 16) * DM + col;
                    const f32x4 xa = *(const f32x4*)(X + o), xb = *(const f32x4*)(X + o + 4);
                    *(f32x4*)(T + o) = xa * DN_ALPHA + ga * acc[ai][bj][m][0]; *(f32x4*)(T + o + 4) = xb * DN_ALPHA + gb * acc[ai][bj][m][1]; } }
    } };
struct EpiAct { const float* B1; bf16* ACT;
    __device__ __forceinline__ void operator()(const f32x4 (&acc)[2][2][4][2], const pg8::Unit& u, int wr, int wc, int fr, int fq) const {
        const int row0 = u.pm * 256 + wr * 64 + fr, cc = u.pn * 128 + wc * 32 + 8 * fq; const float* b = B1 + (size_t)u.aux * 2048;
        const f32x4 bg0 = *(const f32x4*)(b + cc), bg1 = *(const f32x4*)(b + cc + 4), bl0 = *(const f32x4*)(b + 1024 + cc), bl1 = *(const f32x4*)(b + 1024 + cc + 4);
#pragma unroll
        for (int ai = 0; ai < 2; ++ai)
#pragma unroll
            for (int m = 0; m < 4; ++m) { const size_t row = (size_t)(row0 + ai * 128 + m * 16);
                f32x4 g0 = acc[ai][0][m][0] + bg0, g1 = acc[ai][0][m][1] + bg1, l0 = acc[ai][1][m][0] + bl0, l1 = acc[ai][1][m][1] + bl1; float r[8];
#pragma unroll
                for (int q = 0; q < 4; ++q) { const float xg = fminf(g0[q], 7.f), xl = fminf(fmaxf(l0[q], -7.f), 7.f); r[q] = xg * sigmf(1.702f * xg) * (xl + 1.f);
                    const float yg = fminf(g1[q], 7.f), yl = fminf(fmaxf(l1[q], -7.f), 7.f); r[4 + q] = yg * sigmf(1.702f * yg) * (yl + 1.f); }
                u32x4 w; w.x = pk2(r[0], r[1]); w.y = pk2(r[2], r[3]); w.z = pk2(r[4], r[5]); w.w = pk2(r[6], r[7]);
                *(u32x4*)(ACT + row * 1024 + cc) = w; }
    } };
struct EpiY { const float* B2; bf16* Y;
    __device__ __forceinline__ void operator()(const f32x4 (&acc)[2][2][4][2], const pg8::Unit& u, int wr, int wc, int fr, int fq) const {
        const int row0 = u.pm * 256 + wr * 64 + fr, col0 = u.pn * 256 + wc * 32 + 8 * fq; const float* b = B2 + (size_t)u.aux * 1024;
#pragma unroll
        for (int bj = 0; bj < 2; ++bj) { const int col = col0 + bj * 128; const f32x4 ba = *(const f32x4*)(b + col), bb = *(const f32x4*)(b + col + 4);
#pragma unroll
            for (int ai = 0; ai < 2; ++ai)
#pragma unroll
                for (int m = 0; m < 4; ++m) { const size_t row = (size_t)(row0 + ai * 128 + m * 16); const f32x4 v0 = acc[ai][bj][m][0] + ba, v1 = acc[ai][bj][m][1] + bb;
                    u32x4 w; w.x = pk2(v0[0], v0[1]); w.y = pk2(v0[2], v0[3]); w.z = pk2(v1[0], v1[1]); w.w = pk2(v1[2], v1[3]); *(u32x4*)(Y + row * 1024 + col) = w; } }
    } };
PHASE_FN void ph_prep(Ctx cx, int l_) {
    Frame F = mkframe(cx); const ArgsP a = F.ap; const int l = rfl(l_);
    REFRESH(F);
    const int gw = F.bid * NWAVES + F.wave, NGW = F.G * NWAVES;
    bf16* P = (bf16*)(F.ws + WS_P);
    for (int row = gw; row < MLAT; row += NGW) {
        const int t = row & (SEQ - 1), j = F.lane & 31, f = j & 15; const float pos = (float)(j < 16 ? (t >> 6) : (t & 63));
        const float inv = exp2f(-(float)f * (13.287712379549449f / 16.f));
        const float ang = pos * inv, rev = ang * 0.15915494309189535f, fr = rev - floorf(rev);
        const float cs = __builtin_amdgcn_cosf(fr), sn = __builtin_amdgcn_sinf(fr);
        bf16* pr = P + (size_t)row * NP + PC_DQ;
#pragma unroll
        for (int it = 0; it < 8; ++it) { const int blk = 2 * it + (F.lane >> 5); bf16* p = pr + blk * 64 + j;
            const float x1 = bf2f(p[0]), x2 = bf2f(p[32]); p[0] = (bf16)f2bf(x1 * cs - x2 * sn); p[32] = (bf16)f2bf(x2 * cs + x1 * sn); }
    }
#if !USE_GDN_FAST
    float* QN = (float*)(F.ws + WS_QN); float* KN = (float*)(F.ws + WS_KN); float* VV = (float*)(F.ws + WS_VV);
    const float* cw = a->in[I_CONVW] + (size_t)l * 3 * 1536;
    for (int row = gw; row < MT; row += NGW) {
        const bool lat = row < MLAT; const int t = lat ? (row & (SEQ - 1)) : ((row - MLAT) & (CTXL - 1)), L = lat ? SEQ : CTXL; const bool hm = t > 0, hp = t < L - 1;
        const bf16* p0 = P + (size_t)row * NP;
#pragma unroll
        for (int wh = 0; wh < 3; ++wh)
#pragma unroll
            for (int h = 0; h < 4; ++h) { const int c = wh * 512 + h * 128 + 2 * F.lane;
                const unsigned x0 = *(const unsigned*)(p0 + c), xm = hm ? *(const unsigned*)(p0 - NP + c) : 0u, xp = hp ? *(const unsigned*)(p0 + NP + c) : 0u;
                const f32x2 w0 = *(const f32x2*)(cw + c), w1 = *(const f32x2*)(cw + 1536 + c), w2 = *(const f32x2*)(cw + 3072 + c);
                float y0 = bflo(xm) * w0.x + bflo(x0) * w1.x + bflo(xp) * w2.x, y1 = bfhi(xm) * w0.y + bfhi(x0) * w1.y + bfhi(xp) * w2.y;
                y0 = siluf(y0); y1 = siluf(y1);
                if (wh < 2) { const float ss = wave_sum(y0 * y0 + y1 * y1), sc = (1.f / sqrtf(ss + RMS_EPS)) * (wh == 0 ? 0.08838834764831845f : 1.f); y0 *= sc; y1 *= sc; }
                float* o = (wh == 0 ? QN : wh == 1 ? KN : VV) + (size_t)row * 512 + h * 128 + 2 * F.lane; *(f32x2*)o = (f32x2){y0, y1}; }
    }
#endif
}

PHASE_FN void ph_gdn_chain_naive(Ctx cx, int l_) {
    Frame F = mkframe(cx); const ArgsP a = F.ap; const int l = rfl(l_);
    REFRESH(F);
    LAS float* kq = (LAS float*)F.lds;
    const float* QN = (const float*)(F.ws + WS_QN); const float* KN = (const float*)(F.ws + WS_KN); const float* VV = (const float*)(F.ws + WS_VV);
    const float* DEC = (const float*)(F.ws + WS_DEC); float* OG = (float*)(F.ws + WS_OG);
    for (int it = F.bid; it < 16; it += F.G) {
        const int b = it >> 3, h = (it >> 1) & 3, d = it & 1, v = (F.tid >> 1) & 127, hf = F.tid & 1;
        const float al = expf(a->in[I_ALOG][(l * 2 + d) * 4 + h]), dtb = a->in[I_DTB][(l * 2 + d) * 4 + h];
        float S[64];
#pragma unroll
        for (int k = 0; k < 64; ++k) S[k] = 0.f;
        __syncthreads();
        for (int step = 0; step < CTXL + SEQ; ++step) {
            int row; if (step < CTXL) { const int pos = d ? CTXL - 1 - step : step; row = MLAT + b * CTXL + pos; } else { const int tt = step - CTXL, pos = d ? SEQ - 1 - tt : tt; row = b * SEQ + pos; }
            LAS float* buf = kq + (step & 1) * 256;
            if (F.tid >= 256) { if (F.tid < 384) buf[F.tid - 256] = KN[(size_t)row * 512 + h * 128 + F.tid - 256]; else buf[F.tid - 256] = QN[(size_t)row * 512 + h * 128 + F.tid - 384]; }
            __syncthreads();
            if (F.tid < 256) {
                const float av = DEC[(size_t)row * 16 + 8 * d + h] + dtb, bb = DEC[(size_t)row * 16 + 8 * d + 4 + h];
                const float sp = av > 20.f ? av : log1pf(expf(av)); const float eg = expf(-al * sp), beta = sigmf(bb);
                const float vt = VV[(size_t)row * 512 + h * 128 + v];
                const LAS float* kb = buf + 64 * hf; const LAS float* qb = buf + 128 + 64 * hf;
                float kS = 0.f;
#pragma unroll
                for (int k4 = 0; k4 < 16; ++k4) { const f32x4 kk = *(const LAS f32x4*)(kb + 4 * k4); kS += (kk.x * S[4 * k4] + kk.y * S[4 * k4 + 1]) + (kk.z * S[4 * k4 + 2] + kk.w * S[4 * k4 + 3]); }
                kS += __shfl_xor(kS, 1);
                const float vn = beta * (vt - eg * kS); float o = 0.f;
#pragma unroll
                for (int k4 = 0; k4 < 16; ++k4) { const f32x4 kk = *(const LAS f32x4*)(kb + 4 * k4), qq = *(const LAS f32x4*)(qb + 4 * k4);
                    S[4 * k4] = eg * S[4 * k4] + kk.x * vn; S[4 * k4 + 1] = eg * S[4 * k4 + 1] + kk.y * vn; S[4 * k4 + 2] = eg * S[4 * k4 + 2] + kk.z * vn; S[4 * k4 + 3] = eg * S[4 * k4 + 3] + kk.w * vn;
                    o += (qq.x * S[4 * k4] + qq.y * S[4 * k4 + 1]) + (qq.z * S[4 * k4 + 2] + qq.w * S[4 * k4 + 3]); }
                o += __shfl_xor(o, 1);
                if (hf == 0) OG[((size_t)d * MT + row) * 512 + h * 128 + v] = o;
            }
        }
        __syncthreads();
    }
}

PHASE_FN void ph_diff_naive(Ctx cx, int l_) {
    Frame F = mkframe(cx); const int l = rfl(l_);
    REFRESH(F);
    LAS float* Kf = (LAS float*)F.lds;
    LAS float* Vf = (LAS float*)(F.lds + 16384);
    const bf16* P = (const bf16*)(F.ws + WS_P); float* OD = (float*)(F.ws + WS_OD);
    for (int it = F.bid; it < 512 + 16; it += F.G) {
        int b, h, m, q0, t0, t1;
        if (it < 512) { b = it >> 8; h = (it >> 6) & 3; m = (it >> 5) & 1; q0 = b * SEQ + (it & 31) * 256; t0 = 0; t1 = 132; }
        else { const int j = it - 512; b = j >> 3; h = (j >> 1) & 3; m = j & 1; q0 = MLAT + b * CTXL; t0 = 128; t1 = 132; }
        const int qi = F.tid & 255, eh = F.tid >> 8;
        float q[64], o[64];
        { const bf16* qp = P + (size_t)(q0 + qi) * NP + PC_DQ + h * 128 + m * 64;
#pragma unroll
          for (int d8 = 0; d8 < 8; ++d8) { const u32x4 w = *(const u32x4*)(qp + 8 * d8); q[8 * d8] = bflo(w.x) * 0.125f; q[8 * d8 + 1] = bfhi(w.x) * 0.125f; q[8 * d8 + 2] = bflo(w.y) * 0.125f; q[8 * d8 + 3] = bfhi(w.y) * 0.125f;
              q[8 * d8 + 4] = bflo(w.z) * 0.125f; q[8 * d8 + 5] = bfhi(w.z) * 0.125f; q[8 * d8 + 6] = bflo(w.w) * 0.125f; q[8 * d8 + 7] = bfhi(w.w) * 0.125f; } }
#pragma unroll
        for (int e = 0; e < 64; ++e) o[e] = 0.f;
        float mx = -1e30f, ls = 0.f;
        for (int t = t0; t < t1; ++t) {
            const int krow0 = t < 128 ? b * SEQ + 64 * t : MLAT + b * CTXL + 64 * (t - 128);
            __syncthreads();
            { const int key = F.tid >> 3, c8 = (F.tid & 7) * 8; const bf16* kp = P + (size_t)(krow0 + key) * NP + PC_DK + h * 128 + m * 64 + c8; const u32x4 w = *(const u32x4*)kp;
              LAS float* kd = Kf + key * 64 + c8; *(LAS f32x4*)kd = (f32x4){bflo(w.x), bfhi(w.x), bflo(w.y), bfhi(w.y)}; *(LAS f32x4*)(kd + 4) = (f32x4){bflo(w.z), bfhi(w.z), bflo(w.w), bfhi(w.w)};
              const int c16 = (F.tid & 7) * 16; const bf16* vp = P + (size_t)(krow0 + key) * NP + PC_DV + h * 128 + c16; const u32x4 w0 = *(const u32x4*)vp, w1 = *(const u32x4*)(vp + 8);
              LAS float* vd = Vf + key * 128 + c16; *(LAS f32x4*)vd = (f32x4){bflo(w0.x), bfhi(w0.x), bflo(w0.y), bfhi(w0.y)}; *(LAS f32x4*)(vd + 4) = (f32x4){bflo(w0.z), bfhi(w0.z), bflo(w0.w), bfhi(w0.w)};
              *(LAS f32x4*)(vd + 8) = (f32x4){bflo(w1.x), bfhi(w1.x), bflo(w1.y), bfhi(w1.y)}; *(LAS f32x4*)(vd + 12) = (f32x4){bflo(w1.z), bfhi(w1.z), bflo(w1.w), bfhi(w1.w)}; }
            __syncthreads();
            for (int kk = 0; kk < 64; ++kk) {
                float s = 0.f;
#pragma unroll
                for (int d4 = 0; d4 < 16; ++d4) { const f32x4 kv = *(const LAS f32x4*)(Kf + kk * 64 + 4 * d4); s += (q[4 * d4] * kv.x + q[4 * d4 + 1] * kv.y) + (q[4 * d4 + 2] * kv.z + q[4 * d4 + 3] * kv.w); }
                const float mn = fmaxf(mx, s), corr = __expf(mx - mn), p = __expf(s - mn); mx = mn; ls = ls * corr + p;
#pragma unroll
                for (int e4 = 0; e4 < 16; ++e4) { const f32x4 vv = *(const LAS f32x4*)(Vf + kk * 128 + eh * 64 + 4 * e4);
                    o[4 * e4] = o[4 * e4] * corr + p * vv.x; o[4 * e4 + 1] = o[4 * e4 + 1] * corr + p * vv.y; o[4 * e4 + 2] = o[4 * e4 + 2] * corr + p * vv.z; o[4 * e4 + 3] = o[4 * e4 + 3] * corr + p * vv.w; }
            }
        }
        const float il = 1.f / ls; float* op = OD + ((size_t)m * MT + q0 + qi) * 512 + h * 128 + eh * 64;
#pragma unroll
        for (int e4 = 0; e4 < 16; ++e4) *(f32x4*)(op + 4 * e4) = (f32x4){o[4 * e4] * il, o[4 * e4 + 1] * il, o[4 * e4 + 2] * il, o[4 * e4 + 3] * il};
    }
    __syncthreads();
}

__device__ __forceinline__ void na_key(const bf16* kp, const bf16* vp, const float (&q)[64], float bias, float& mx, float& ls, float (&o)[64]) {
    float s = 0.f;
#pragma unroll
    for (int d8 = 0; d8 < 8; ++d8) { const u32x4 w = *(const u32x4*)(kp + 8 * d8);
        s += (q[8 * d8] * bflo(w.x) + q[8 * d8 + 1] * bfhi(w.x)) + (q[8 * d8 + 2] * bflo(w.y) + q[8 * d8 + 3] * bfhi(w.y)) + (q[8 * d8 + 4] * bflo(w.z) + q[8 * d8 + 5] * bfhi(w.z)) + (q[8 * d8 + 6] * bflo(w.w) + q[8 * d8 + 7] * bfhi(w.w)); }
    s += bias;
    const float mn = fmaxf(mx, s), corr = __expf(mx - mn), p = __expf(s - mn); mx = mn; ls = ls * corr + p;
#pragma unroll
    for (int d8 = 0; d8 < 8; ++d8) { const u32x4 w = *(const u32x4*)(vp + 8 * d8);
        o[8 * d8] = o[8 * d8] * corr + p * bflo(w.x); o[8 * d8 + 1] = o[8 * d8 + 1] * corr + p * bfhi(w.x); o[8 * d8 + 2] = o[8 * d8 + 2] * corr + p * bflo(w.y); o[8 * d8 + 3] = o[8 * d8 + 3] * corr + p * bfhi(w.y);
        o[8 * d8 + 4] = o[8 * d8 + 4] * corr + p * bflo(w.z); o[8 * d8 + 5] = o[8 * d8 + 5] * corr + p * bfhi(w.z); o[8 * d8 + 6] = o[8 * d8 + 6] * corr + p * bflo(w.w); o[8 * d8 + 7] = o[8 * d8 + 7] * corr + p * bfhi(w.w); }
}
PHASE_FN void ph_na_naive(Ctx cx, int l_) {
    Frame F = mkframe(cx); const ArgsP a = F.ap; const int l = rfl(l_);
    REFRESH(F);
    const bf16* P = (const bf16*)(F.ws + WS_P); bf16* YC = (bf16*)(F.ws + WS_YC);
    const int gt = F.bid * NTHREADS + F.tid, NGT = F.G * NTHREADS;
    for (int idx = gt; idx < 8 * MT; idx += NGT) {
        int b, h, qrow, t; bool lat = idx < 8 * MLAT;
        if (lat) { b = idx >> 16; h = (idx >> 13) & 7; t = idx & (SEQ - 1); qrow = b * SEQ + t; } else { const int j = idx - 8 * MLAT; b = j >> 11; h = (j >> 8) & 7; t = j & 255; qrow = MLAT + b * CTXL + t; }
        float q[64], o[64];
        { const bf16* qp = P + (size_t)qrow * NP + PC_NQ + h * 64;
#pragma unroll
          for (int d8 = 0; d8 < 8; ++d8) { const u32x4 w = *(const u32x4*)(qp + 8 * d8); q[8 * d8] = bflo(w.x) * 0.125f; q[8 * d8 + 1] = bfhi(w.x) * 0.125f; q[8 * d8 + 2] = bflo(w.y) * 0.125f; q[8 * d8 + 3] = bfhi(w.y) * 0.125f;
              q[8 * d8 + 4] = bflo(w.z) * 0.125f; q[8 * d8 + 5] = bfhi(w.z) * 0.125f; q[8 * d8 + 6] = bflo(w.w) * 0.125f; q[8 * d8 + 7] = bfhi(w.w) * 0.125f; } }
#pragma unroll
        for (int e = 0; e < 64; ++e) o[e] = 0.f;
        float mx = -1e30f, ls = 0.f;
        if (lat) { const int r = t >> 6, c = t & 63; const int r0 = min(max(r - 4, 0), 120), c0 = min(max(c - 8, 0), 48);
            const float* rp = a->in[I_RPB] + ((size_t)l * 8 + h) * 15 * 31;
            for (int kr = 0; kr < 8; ++kr) for (int kc = 0; kc < 16; ++kc) { const int krow = b * SEQ + (r0 + kr) * 64 + c0 + kc;
                const float bias = rp[(r0 + kr - r + 7) * 31 + (c0 + kc - c + 15)];
                na_key(P + (size_t)krow * NP + PC_NK + h * 64, P + (size_t)krow * NP + PC_NV + h * 64, q, bias, mx, ls, o); } }
        for (int j = 0; j < CTXL; ++j) { const int krow = MLAT + b * CTXL + j; na_key(P + (size_t)krow * NP + PC_NK + h * 64, P + (size_t)krow * NP + PC_NV + h * 64, q, 0.f, mx, ls, o); }
        const float il = 1.f / ls; bf16* op = YC + (size_t)qrow * 512 + h * 64;
#pragma unroll
        for (int d8 = 0; d8 < 8; ++d8) { u32x4 w; w.x = pk2(o[8 * d8] * il, o[8 * d8 + 1] * il); w.y = pk2(o[8 * d8 + 2] * il, o[8 * d8 + 3] * il); w.z = pk2(o[8 * d8 + 4] * il, o[8 * d8 + 5] * il); w.w = pk2(o[8 * d8 + 6] * il, o[8 * d8 + 7] * il);
            *(u32x4*)(op + 8 * d8) = w; }
    }
}

__device__ __forceinline__ float grp16_sum(float v) { v += __shfl_xor(v, 1); v += __shfl_xor(v, 2); v += __shfl_xor(v, 4); v += __shfl_xor(v, 8); return v; }
PHASE_FN void ph_combine(Ctx cx, int l_) {
    Frame F = mkframe(cx); const ArgsP a = F.ap; const int l = rfl(l_);
    REFRESH(F);
    const int gw = F.bid * NWAVES + F.wave, NGW = F.G * NWAVES;
    const float* OG = (const float*)(F.ws + WS_OG); const float* OD = (const float*)(F.ws + WS_OD); const bf16* P = (const bf16*)(F.ws + WS_P);
    bf16* YA = (bf16*)(F.ws + WS_YA); bf16* YB = (bf16*)(F.ws + WS_YB);
    const float lam = ((const float*)(F.ws + WS_LAM))[l], omli = 1.f - (0.8f - 0.6f * expf(-0.3f * (float)l));
    const float* gnw = a->in[I_GNW] + l * 128; const float* dnw = a->in[I_DNW] + l * 128;
    for (int row = gw; row < MT; row += NGW) {
        const int c = 8 * F.lane, ch = c & 127;
        { const float* p0 = OG + (size_t)row * 512 + c; const float* p1 = p0 + (size_t)MT * 512;
          const f32x4 a0 = *(const f32x4*)p0 + *(const f32x4*)p1, a1 = *(const f32x4*)(p0 + 4) + *(const f32x4*)(p1 + 4);
          float ss = (a0.x * a0.x + a0.y * a0.y) + (a0.z * a0.z + a0.w * a0.w) + (a1.x * a1.x + a1.y * a1.y) + (a1.z * a1.z + a1.w * a1.w);
          const float rs = 1.f / sqrtf(grp16_sum(ss) * (1.f / 128.f) + RMS_EPS);
          const u32x4 z = *(const u32x4*)(P + (size_t)row * NP + PC_GZ + c); const f32x4 w0 = *(const f32x4*)(gnw + ch), w1 = *(const f32x4*)(gnw + ch + 4);
          u32x4 o; o.x = pk2(a0.x * rs * w0.x * siluf(bflo(z.x)), a0.y * rs * w0.y * siluf(bfhi(z.x))); o.y = pk2(a0.z * rs * w0.z * siluf(bflo(z.y)), a0.w * rs * w0.w * siluf(bfhi(z.y)));
          o.z = pk2(a1.x * rs * w1.x * siluf(bflo(z.z)), a1.y * rs * w1.y * siluf(bfhi(z.z))); o.w = pk2(a1.z * rs * w1.z * siluf(bflo(z.w)), a1.w * rs * w1.w * siluf(bfhi(z.w)));
          *(u32x4*)(YA + (size_t)row * 512 + c) = o; }
#if !USE_DIFF_MFMA
        { const float* p0 = OD + (size_t)row * 512 + c; const float* p1 = p0 + (size_t)MT * 512;
          const f32x4 a0 = *(const f32x4*)p0 - *(const f32x4*)p1 * lam, a1 = *(const f32x4*)(p0 + 4) - *(const f32x4*)(p1 + 4) * lam;
          float ss = (a0.x * a0.x + a0.y * a0.y) + (a0.z * a0.z + a0.w * a0.w) + (a1.x * a1.x + a1.y * a1.y) + (a1.z * a1.z + a1.w * a1.w);
          const float rs = (1.f / sqrtf(grp16_sum(ss) * (1.f / 128.f) + RMS_EPS)) * omli;
          const f32x4 w0 = *(const f32x4*)(dnw + ch), w1 = *(const f32x4*)(dnw + ch + 4);
          u32x4 o; o.x = pk2(a0.x * rs * w0.x, a0.y * rs * w0.y); o.y = pk2(a0.z * rs * w0.z, a0.w * rs * w0.w); o.z = pk2(a1.x * rs * w1.x, a1.y * rs * w1.y); o.w = pk2(a1.z * rs * w1.z, a1.w * rs * w1.w);
          *(u32x4*)(YB + (size_t)row * 512 + c) = o; }
#endif
    }
}
namespace dattn {
using s16x4  = __attribute__((ext_vector_type(4))) short;
using f32x16 = __attribute__((ext_vector_type(16))) float;
constexpr int KVBLK = 64;
constexpr float SCALE = 0.125f, THR = 8.f;
constexpr int SHM_V = KVBLK * 128 * 2, SHM_K = KVBLK * 128 * 2, SHM_ATTN = 2 * SHM_V + 2 * SHM_K + 8 * 64 * 4;
#define DA_KSWZ(row, colB) ((row) * 256 + ((colB) ^ (((row) & 7) << 4)))
#define DA_SBAR() __builtin_amdgcn_sched_barrier(0)
__device__ __forceinline__ int crow(int r, int hi) { return (r & 3) + 8 * (r >> 2) + 4 * hi; }
__device__ __forceinline__ unsigned cvtpk(float lo, float hi) { return pg8::cvt_pk_bf16(lo, hi); }
__device__ __forceinline__ void partialSM(f32x16& p0, f32x16& p1, float& m_reg, float& mn, float& alpha) {
  constexpr float C = SCALE * 1.4426950408889634f;
  float pmax = p0[0];
#pragma unroll
  for (int r = 1; r < 16; ++r) pmax = fmaxf(pmax, p0[r]);
#pragma unroll
  for (int r = 0; r < 16; ++r) pmax = fmaxf(pmax, p1[r]);
  { auto rr = __builtin_amdgcn_permlane32_swap(__float_as_uint(pmax), __float_as_uint(pmax), false, false);
    pmax = fmaxf(__uint_as_float(rr[0]), __uint_as_float(rr[1])); }
  if (__builtin_expect(__all(pmax - m_reg <= THR / SCALE), 1)) { mn = m_reg; alpha = 1.f; }
  else { mn = fmaxf(m_reg, pmax); alpha = __builtin_amdgcn_exp2f((m_reg - mn) * C); m_reg = mn; }
  const float mnC = -mn * C;
#pragma unroll
  for (int r = 0; r < 16; ++r) p0[r] = fmaf(p0[r], C, mnC);
#pragma unroll
  for (int r = 0; r < 16; ++r) p1[r] = fmaf(p1[r], C, mnC);
#pragma unroll
  for (int r = 0; r < 16; ++r) p0[r] = __builtin_amdgcn_exp2f(p0[r]);
}
__device__ __forceinline__ void finishSM(f32x16& p0, f32x16& p1, float alpha, float& l_reg, bf16x8& pa0, bf16x8& pa1, bf16x8& pa2, bf16x8& pa3) {
#pragma unroll
  for (int r = 0; r < 16; ++r) p1[r] = __builtin_amdgcn_exp2f(p1[r]);
  float ps = 0;
#pragma unroll
  for (int r = 0; r < 16; ++r) ps += p0[r];
#pragma unroll
  for (int r = 0; r < 16; ++r) ps += p1[r];
  { auto rr = __builtin_amdgcn_permlane32_swap(__float_as_uint(ps), __float_as_uint(ps), false, false);
    ps = __uint_as_float(rr[0]) + __uint_as_float(rr[1]); }
  l_reg = l_reg * alpha + ps;
#define DA_PK4(P, BASE, OUT) do { unsigned a0 = cvtpk(P[BASE + 0], P[BASE + 1]), a1 = cvtpk(P[BASE + 2], P[BASE + 3]);   \
    unsigned b0 = cvtpk(P[BASE + 4], P[BASE + 5]), b1 = cvtpk(P[BASE + 6], P[BASE + 7]);                              \
    auto r0 = __builtin_amdgcn_permlane32_swap(a0, b0, false, false); auto r1 = __builtin_amdgcn_permlane32_swap(a1, b1, false, false); \
    u32x4 w = {r0[0], r1[0], r0[1], r1[1]}; OUT = *reinterpret_cast<bf16x8*>(&w); } while (0)
  DA_PK4(p0, 0, pa0); DA_PK4(p0, 8, pa1); DA_PK4(p1, 0, pa2); DA_PK4(p1, 8, pa3);
#undef DA_PK4
}
__device__ __forceinline__ void qkt(f32x16& p0, f32x16& p1, const LAS char* Ks, const bf16x8* qr, int r32, int hi, int m) {
  p0 = f32x16{}; p1 = f32x16{};
#pragma unroll
  for (int d0 = 0; d0 < 4; ++d0) { const int cb = (m * 64 + d0 * 16 + hi * 8) * 2;
    const bf16x8 b0 = *reinterpret_cast<const LAS bf16x8*>(Ks + DA_KSWZ(r32, cb));
    const bf16x8 b1 = *reinterpret_cast<const LAS bf16x8*>(Ks + DA_KSWZ(32 + r32, cb));
    p0 = __builtin_amdgcn_mfma_f32_32x32x16_bf16(b0, qr[d0], p0, 0, 0, 0);
    p1 = __builtin_amdgcn_mfma_f32_32x32x16_bf16(b1, qr[d0], p1, 0, 0, 0); }
}
__device__ __forceinline__ int v_st(int k, int c) { const int kk = (k & ~0xC) | ((k & 4) << 1) | ((k & 8) >> 1); return ((kk >> 3) * 4 + (c >> 5)) * 512 + ((kk & 7) * 32 + (c & 31)) * 2; }
__device__ __forceinline__ int v_rd_base(int lane) { return ((lane & 3) << 3) | (((lane >> 2) & 3) << 6) | (((lane >> 4) & 1) << 5) | (((lane >> 5) & 1) << 8); }
constexpr int v_rd_off(int d0, int ks, int half) { return d0 * 512 + ks * 4096 + half * 2048; }
template <int OFF> __device__ __forceinline__ s16x4 tr_read(int vb) { s16x4 r; asm volatile("ds_read_b64_tr_b16 %0, %1 offset:%2" : "=&v"(r) : "v"(vb), "i"(OFF) : "memory"); return r; }
template <int D0> __device__ __forceinline__ void pv_one(f32x16& od, int vb, bf16x8 pa0, bf16x8 pa1, bf16x8 pa2, bf16x8 pa3) {
  const s16x4 l0 = tr_read<v_rd_off(D0, 0, 0)>(vb), h0 = tr_read<v_rd_off(D0, 0, 1)>(vb), l1 = tr_read<v_rd_off(D0, 1, 0)>(vb), h1 = tr_read<v_rd_off(D0, 1, 1)>(vb);
  const s16x4 l2 = tr_read<v_rd_off(D0, 2, 0)>(vb), h2 = tr_read<v_rd_off(D0, 2, 1)>(vb), l3 = tr_read<v_rd_off(D0, 3, 0)>(vb), h3 = tr_read<v_rd_off(D0, 3, 1)>(vb);
  asm volatile("s_waitcnt lgkmcnt(0)" ::: "memory"); DA_SBAR();
#define DA_PK(L, H) (bf16x8){L[0], L[1], L[2], L[3], H[0], H[1], H[2], H[3]}
  od = __builtin_amdgcn_mfma_f32_32x32x16_bf16(pa0, DA_PK(l0, h0), od, 0, 0, 0);
  od = __builtin_amdgcn_mfma_f32_32x32x16_bf16(pa1, DA_PK(l1, h1), od, 0, 0, 0);
  od = __builtin_amdgcn_mfma_f32_32x32x16_bf16(pa2, DA_PK(l2, h2), od, 0, 0, 0);
  od = __builtin_amdgcn_mfma_f32_32x32x16_bf16(pa3, DA_PK(l3, h3), od, 0, 0, 0);
#undef DA_PK
}
__device__ __forceinline__ void pv_d0(f32x16* o, int vb, bf16x8 pa0, bf16x8 pa1, bf16x8 pa2, bf16x8 pa3) {
  pv_one<0>(o[0], vb, pa0, pa1, pa2, pa3); pv_one<1>(o[1], vb, pa0, pa1, pa2, pa3); pv_one<2>(o[2], vb, pa0, pa1, pa2, pa3); pv_one<3>(o[3], vb, pa0, pa1, pa2, pa3);
}

__device__ __forceinline__ void unit(const bf16* __restrict__ P, bf16* __restrict__ YB, const float* __restrict__ nw, float lam, float omli,
                                     int b, int h, int qrow0, int t0, int NT, LAS char* lds, int wid, int lane) {
  const int tid = wid * 64 + lane, r32 = lane & 31, hi = lane >> 5, m = wid >> 2, wq = wid & 3;
  LAS char* V_lds = lds; LAS char* K_lds = lds + 2 * SHM_V;
  LAS float* ws = (LAS float*)(lds + 2 * SHM_V + 2 * SHM_K) + wid * 64; LAS float* li_l = ws; LAS float* al_l = ws + 32;
  float m_reg = -1e30f, l_reg = 0; f32x16 o[4] = {}; bf16x8 qr[4];
  { const bf16* Qw = P + (size_t)(qrow0 + wq * 32 + r32) * NP + PC_DQ + h * 128 + m * 64 + hi * 8;
#pragma unroll
    for (int d0 = 0; d0 < 4; ++d0) qr[d0] = *reinterpret_cast<const bf16x8*>(Qw + d0 * 16); }
  const int sr = tid >> 4, sc = (tid & 15) * 8, vst0 = v_st(sr, sc), vst1 = v_st(32 + sr, sc);
  const int vb0 = (int)(uintptr_t)V_lds + v_rd_base(lane);
  const bf16* Kcol = P + PC_DK + h * 128 + sc; const bf16* Vcol = P + PC_DV + h * 128 + sc;
  bf16x8 vs0, vs1, ks0, ks1;
#define DA_KROW(j) ((size_t)(((j) + t0) < 128 ? b * SEQ + 64 * ((j) + t0) : MLAT + b * CTXL + 64 * ((j) + t0 - 128)))
#define DA_SLOAD(j) do { const size_t k0_ = DA_KROW(j); vs0 = *reinterpret_cast<const bf16x8*>(Vcol + (k0_ + sr) * NP); vs1 = *reinterpret_cast<const bf16x8*>(Vcol + (k0_ + 32 + sr) * NP); \
    ks0 = *reinterpret_cast<const bf16x8*>(Kcol + (k0_ + sr) * NP); ks1 = *reinterpret_cast<const bf16x8*>(Kcol + (k0_ + 32 + sr) * NP); } while (0)
#define DA_SWRITE(bb) do { *(LAS bf16x8*)(V_lds + (bb) * SHM_V + vst0) = vs0; *(LAS bf16x8*)(V_lds + (bb) * SHM_V + vst1) = vs1; const int kc = sc * 2; \
    *(LAS bf16x8*)(K_lds + (bb) * SHM_K + DA_KSWZ(sr, kc)) = ks0; *(LAS bf16x8*)(K_lds + (bb) * SHM_K + DA_KSWZ(32 + sr, kc)) = ks1; } while (0)
#define DA_RESC(a) do { if (__any((a) < 1.f)) { if (hi == 0) al_l[r32] = (a); asm volatile("s_waitcnt lgkmcnt(0)" ::: "memory"); \
    _Pragma("unroll") for (int d = 0; d < 4; ++d) _Pragma("unroll") for (int r = 0; r < 16; ++r) o[d][r] *= al_l[crow(r, hi)]; } } while (0)
  f32x16 pA0, pA1, pB0, pB1; float mnA, mnB, alA, alB; bf16x8 pa0, pa1, pa2, pa3;
  DA_SLOAD(0); asm volatile("s_waitcnt vmcnt(0)" ::: "memory"); DA_SWRITE(0); __syncthreads();
  qkt(pA0, pA1, K_lds, qr, r32, hi, m); partialSM(pA0, pA1, m_reg, mnA, alA);
  DA_SLOAD(1);
  asm volatile("s_waitcnt vmcnt(0)" ::: "memory"); DA_SWRITE(1); __syncthreads();
  for (int j = 1; j + 1 < NT; j += 2) {
    DA_SBAR(); qkt(pB0, pB1, K_lds + SHM_K, qr, r32, hi, m);
    finishSM(pA0, pA1, alA, l_reg, pa0, pa1, pa2, pa3); DA_SBAR();
    DA_SLOAD(j + 1); DA_SBAR();
    pv_d0(o, vb0, pa0, pa1, pa2, pa3); partialSM(pB0, pB1, m_reg, mnB, alB);
    __syncthreads(); asm volatile("s_waitcnt vmcnt(0)" ::: "memory"); DA_SWRITE(0);
    DA_RESC(alB); __syncthreads();
    DA_SBAR(); qkt(pA0, pA1, K_lds, qr, r32, hi, m);
    finishSM(pB0, pB1, alB, l_reg, pa0, pa1, pa2, pa3); DA_SBAR();
    DA_SLOAD(j + 2); DA_SBAR();
    pv_d0(o, vb0 + SHM_V, pa0, pa1, pa2, pa3); partialSM(pA0, pA1, m_reg, mnA, alA);
    __syncthreads(); asm volatile("s_waitcnt vmcnt(0)" ::: "memory"); DA_SWRITE(1);
    DA_RESC(alA); __syncthreads();
  }
  DA_SBAR(); qkt(pB0, pB1, K_lds + SHM_K, qr, r32, hi, m);
  finishSM(pA0, pA1, alA, l_reg, pa0, pa1, pa2, pa3); DA_SBAR();
  pv_d0(o, vb0, pa0, pa1, pa2, pa3); partialSM(pB0, pB1, m_reg, mnB, alB);
  __syncthreads(); DA_RESC(alB);
  finishSM(pB0, pB1, alB, l_reg, pa0, pa1, pa2, pa3); DA_SBAR();
  pv_d0(o, vb0 + SHM_V, pa0, pa1, pa2, pa3);
  if (hi == 0) li_l[r32] = l_reg; asm volatile("s_waitcnt lgkmcnt(0)" ::: "memory");
  float rli[16];
#pragma unroll
  for (int r = 0; r < 16; ++r) rli[r] = __builtin_amdgcn_rcpf(li_l[crow(r, hi)]);
  __syncthreads();
  LAS float* X = (LAS float*)lds;
  if (m == 1) {
#pragma unroll
    for (int r = 0; r < 16; ++r) { const int row = wq * 32 + crow(r, hi);
#pragma unroll
      for (int d0 = 0; d0 < 4; ++d0) X[row * 132 + d0 * 32 + r32] = o[d0][r] * rli[r]; } }
  __syncthreads();
  if (m == 0) {
#pragma unroll
    for (int r = 0; r < 16; ++r) { const int row = wq * 32 + crow(r, hi);
#pragma unroll
      for (int d0 = 0; d0 < 4; ++d0) { LAS float* p = X + row * 132 + d0 * 32 + r32; *p = o[d0][r] * rli[r] - lam * *p; } }
    asm volatile("s_waitcnt lgkmcnt(0)" ::: "memory");
    const int row = wq * 32 + (lane >> 1), hf = lane & 1; const LAS float* xr = X + row * 132 + hf * 64;
    f32x4 v[16]; float ss = 0.f;
#pragma unroll
    for (int i = 0; i < 16; ++i) { v[i] = *(const LAS f32x4*)(xr + 4 * i); ss += (v[i].x * v[i].x + v[i].y * v[i].y) + (v[i].z * v[i].z + v[i].w * v[i].w); }
    ss += __shfl_xor(ss, 1);
    const float rs = (1.f / sqrtf(ss * (1.f / 128.f) + RMS_EPS)) * omli;
    bf16* op = YB + (size_t)(qrow0 + row) * 512 + h * 128 + hf * 64; const float* wp = nw + hf * 64;
#pragma unroll
    for (int i = 0; i < 8; ++i) { const f32x4 w0 = *(const f32x4*)(wp + 8 * i), w1 = *(const f32x4*)(wp + 8 * i + 4); const f32x4 a0 = v[2 * i] * rs * w0, a1 = v[2 * i + 1] * rs * w1;
      u32x4 w; w.x = cvtpk(a0.x, a0.y); w.y = cvtpk(a0.z, a0.w); w.z = cvtpk(a1.x, a1.y); w.w = cvtpk(a1.z, a1.w); *(u32x4*)(op + 8 * i) = w; }
  }
  __syncthreads();
#undef DA_KROW
#undef DA_SLOAD
#undef DA_SWRITE
#undef DA_RESC
}
#undef DA_KSWZ
#undef DA_SBAR
}

PHASE_FN void ph_diff_mfma(Ctx cx, int l_) {
    Frame F = mkframe(cx); const ArgsP a = F.ap; const int l = rfl(l_);
    REFRESH(F);
    const bf16* P = (const bf16*)(F.ws + WS_P); bf16* YB = (bf16*)(F.ws + WS_YB);
    const float lam = ((const float*)(F.ws + WS_LAM))[l], omli = 1.f - (0.8f - 0.6f * expf(-0.3f * (float)l));
    const float* nw = a->in[I_DNW] + l * 128;
    for (int it = F.bid; it < 512 + 16; it += F.G) {
        int b, h, q0, t0, NT;
        if (it < 512) { b = it >> 8; h = (it >> 6) & 3; q0 = b * SEQ + (it & 63) * 128; t0 = 0; NT = 132; }
        else { const int j = it - 512; b = j >> 3; h = (j >> 1) & 3; q0 = MLAT + b * CTXL + (j & 1) * 128; t0 = 128; NT = 4; }
        dattn::unit(P, YB, nw, lam, omli, b, h, q0, t0, NT, (LAS char*)F.lds, F.wave, F.lane);
    }
}
namespace gdn {
using f32x16 = __attribute__((ext_vector_type(16))) float;
constexpr int REC_BYTES = 57344, U_BYTES = 16384, OFF_NEGW = 0, OFF_QG = 16384, OFF_KT = 32768, OFF_QK = 49152, NSTEP = 132;
constexpr int QS = 0, KS = 17408, VS = 34816, L0 = 52224, A0 = 84992, SC = 117760;
__device__ __forceinline__ unsigned pk(float lo, float hi) { return pg8::cvt_pk_bf16(lo, hi); }
__device__ __forceinline__ float ldbf(const LAS unsigned short* p) { return __uint_as_float(((unsigned)*p) << 16); }

__device__ __forceinline__ void prep_item(const Frame& F, const ArgsP a, int l, int item) {
    const int b = item / (NSTEP * 4), rem = item % (NSTEP * 4), cn = rem >> 2, h = rem & 3;
    const bool isctx = cn < 4; const int row0 = isctx ? MLAT + b * CTXL + 64 * cn : b * SEQ + 64 * (cn - 4), t0 = isctx ? 64 * cn : 64 * (cn - 4), L = isctx ? CTXL : SEQ;
    const bf16* P = (const bf16*)(F.ws + WS_P); const float* DEC = (const float*)(F.ws + WS_DEC);
    LAS unsigned char* lds = F.lds; const int lane = F.lane, wave = F.wave, tid = F.tid;
    LAS unsigned short* Qs = (LAS unsigned short*)(lds + QS); LAS unsigned short* Ks = (LAS unsigned short*)(lds + KS); LAS unsigned short* Vs = (LAS unsigned short*)(lds + VS);
    LAS float* GC = (LAS float*)(lds + SC); LAS float* BE = GC + 128; LAS float* EG = GC + 256; LAS float* ET = GC + 384;
    { const float* cw = a->in[I_CONVW] + (size_t)l * 3 * 1536;
#pragma unroll 1
      for (int ii = 0; ii < 8; ++ii) { const int i = wave * 8 + ii, t = t0 + i; const bool hm = t > 0, hp = t < L - 1; const bf16* p0 = P + (size_t)(row0 + i) * NP;
#pragma unroll
        for (int wh = 0; wh < 3; ++wh) { const int c = wh * 512 + h * 128 + 2 * lane;
            const unsigned x0 = *(const unsigned*)(p0 + c), xm = hm ? *(const unsigned*)(p0 - NP + c) : 0u, xp = hp ? *(const unsigned*)(p0 + NP + c) : 0u;
            const f32x2 w0 = *(const f32x2*)(cw + c), w1 = *(const f32x2*)(cw + 1536 + c), w2 = *(const f32x2*)(cw + 3072 + c);
            float y0 = bflo(xm) * w0.x + bflo(x0) * w1.x + bflo(xp) * w2.x, y1 = bfhi(xm) * w0.y + bfhi(x0) * w1.y + bfhi(xp) * w2.y;
            y0 = siluf(y0); y1 = siluf(y1);
            if (wh < 2) { const float ss = wave_sum(y0 * y0 + y1 * y1), sc = (1.f / sqrtf(ss + RMS_EPS)) * (wh == 0 ? 0.08838834764831845f : 1.f); y0 *= sc; y1 *= sc; }
            LAS unsigned short* dst = (wh == 0 ? Qs : wh == 1 ? Ks : Vs) + i * 136 + 2 * lane; *(LAS unsigned*)dst = pk(y0, y1); } } }
    if (wave < 2) { const int d = wave, t = d ? 63 - lane : lane; const size_t row = (size_t)(row0 + t);
        const float al = expf(a->in[I_ALOG][(l * 2 + d) * 4 + h]), av = DEC[row * 16 + 8 * d + h] + a->in[I_DTB][(l * 2 + d) * 4 + h], bb = DEC[row * 16 + 8 * d + 4 + h];
        const float sp = av > 20.f ? av : log1pf(expf(av)); float gc = -al * sp;
#pragma unroll
        for (int o = 1; o < 64; o <<= 1) { const float v = __shfl_up(gc, o); if (lane >= o) gc += v; }
        const float gl = __shfl(gc, 63);
        GC[d * 64 + lane] = gc; BE[d * 64 + lane] = sigmf(bb); EG[d * 64 + lane] = expf(gc); ET[d * 64 + lane] = expf(gl - gc);
        if (lane == 63) { const int step = d ? (cn < 4 ? 3 - cn : 135 - cn) : cn; ((float*)(F.ws + WS_GL))[((b * 4 + h) * 2 + d) * NSTEP + step] = expf(gl); } }
    __syncthreads();
    { const int mat = wave >> 2, mi = wave & 3, fr = lane & 15, fq = lane >> 4; const LAS unsigned short* As = mat ? Qs : Ks;
#pragma unroll 1
      for (int nj = 0; nj < 4; ++nj) { f32x4 acc = {0.f, 0.f, 0.f, 0.f};
#pragma unroll
        for (int ks = 0; ks < 4; ++ks) { const bf16x8 af = *(const LAS bf16x8*)(As + (16 * mi + fr) * 136 + 32 * ks + 8 * fq), bfr = *(const LAS bf16x8*)(Ks + (16 * nj + fr) * 136 + 32 * ks + 8 * fq);
            acc = __builtin_amdgcn_mfma_f32_16x16x32_bf16(af, bfr, acc, 0, 0, 0); }
#pragma unroll
        for (int r = 0; r < 4; ++r) { const int ti = 16 * mi + 4 * fq + r, tj = 16 * nj + fr;
#pragma unroll
            for (int d = 0; d < 2; ++d) { const int i = d ? 63 - ti : ti, j = d ? 63 - tj : tj; const bool keep = mat ? (i >= j) : (i > j);
                float v = 0.f; if (keep) { v = acc[r] * __expf(fminf(GC[d * 64 + i] - GC[d * 64 + j], 0.f)); if (!mat) v *= BE[d * 64 + i]; }
                ((LAS float*)(lds + (mat ? A0 : L0) + d * 16384))[i * 64 + j] = v; } } } }
    __syncthreads();
    const int d = __builtin_amdgcn_readfirstlane(tid >> 8), c = tid & 255, cc = c & 127; const bool isw = __builtin_amdgcn_readfirstlane(c >> 7) != 0;
    float x[64];
    { const LAS float* Ld = (const LAS float*)(lds + L0 + d * 16384); const LAS unsigned short* src = (isw ? Ks : Vs) + cc;
#pragma unroll
      for (int i = 0; i < 64; ++i) x[i] = 0.f;
#pragma unroll
      for (int i = 0; i < 64; ++i) { const int t = d ? 63 - i : i; float acc = ldbf(src + t * 136) * BE[d * 64 + i] * (isw ? EG[d * 64 + i] : 1.f);
#pragma unroll
          for (int j4 = 0; j4 < (i + 3) / 4; ++j4) { const f32x4 lv = *(const LAS f32x4*)(Ld + i * 64 + 4 * j4);
              acc -= lv.x * x[4 * j4]; if (4 * j4 + 1 < i) acc -= lv.y * x[4 * j4 + 1]; if (4 * j4 + 2 < i) acc -= lv.z * x[4 * j4 + 2]; if (4 * j4 + 3 < i) acc -= lv.w * x[4 * j4 + 3]; }
          asm volatile("" : "+v"(acc) :: "memory"); x[i] = acc; } }
    const int step = d ? (cn < 4 ? 3 - cn : 135 - cn) : cn; const size_t ridx = (size_t)((b * 4 + h) * 2 + d) * NSTEP + step;
    unsigned char* rec = F.ws + WS_REC + ridx * REC_BYTES;
    if (!isw) {
        unsigned char* ub = F.ws + WS_U + ridx * U_BYTES; const int nt = cc >> 5, col = cc & 31;
#pragma unroll
        for (int mt = 0; mt < 2; ++mt)
#pragma unroll
            for (int hi = 0; hi < 2; ++hi) { u32x4 w0, w1; const int ib = 32 * mt + 4 * hi;
                w0.x = pk(x[ib + 0], x[ib + 1]); w0.y = pk(x[ib + 2], x[ib + 3]); w0.z = pk(x[ib + 8], x[ib + 9]); w0.w = pk(x[ib + 10], x[ib + 11]);
                w1.x = pk(x[ib + 16], x[ib + 17]); w1.y = pk(x[ib + 18], x[ib + 19]); w1.z = pk(x[ib + 24], x[ib + 25]); w1.w = pk(x[ib + 26], x[ib + 27]);
                u32x4* dst = (u32x4*)(ub + (size_t)(((mt * 4 + nt) * 64 + hi * 32 + col) * 32)); dst[0] = w0; dst[1] = w1; } }
    __syncthreads();
    LAS unsigned short* Xw = (LAS unsigned short*)(lds + L0 + d * 16384);
    if (isw) {
#pragma unroll
        for (int i = 0; i < 64; ++i) Xw[i * 128 + cc] = (unsigned short)(pk(-x[i], 0.f) & 0xffffu); }
    __syncthreads();
    { const int u2 = tid & 255; const LAS float* Ad = (const LAS float*)(lds + A0 + d * 16384);
#pragma unroll
      for (int q = 0; q < 4; ++q) { const int s = u2 + 256 * q, f = s >> 6, ln = s & 63, r32 = ln & 31, hi = ln >> 5;
          { const int mt = f >> 3, ks = f & 7, i = 32 * mt + r32, t = d ? 63 - i : i, k0 = 16 * ks + 4 * hi;
            const u32x2 wa = *(const LAS u32x2*)(Xw + i * 128 + k0), wb = *(const LAS u32x2*)(Xw + i * 128 + k0 + 8);
            *(u32x4*)(rec + OFF_NEGW + s * 16) = (u32x4){wa.x, wa.y, wb.x, wb.y};
            const float eg = EG[d * 64 + i]; const u32x2 qa = *(const LAS u32x2*)(Qs + t * 136 + k0), qb = *(const LAS u32x2*)(Qs + t * 136 + k0 + 8);
            *(u32x4*)(rec + OFF_QG + s * 16) = (u32x4){pk(bflo(qa.x) * eg, bfhi(qa.x) * eg), pk(bflo(qa.y) * eg, bfhi(qa.y) * eg), pk(bflo(qb.x) * eg, bfhi(qb.x) * eg), pk(bflo(qb.y) * eg, bfhi(qb.y) * eg)}; }
          { const int mtS = f >> 2, ks = f & 3, dk = 32 * mtS + r32; float kv[8];
#pragma unroll
            for (int j = 0; j < 8; ++j) { const int i = 16 * ks + 8 * (j >> 2) + 4 * hi + (j & 3), t = d ? 63 - i : i; kv[j] = ldbf(Ks + t * 136 + dk) * ET[d * 64 + i]; }
            *(u32x4*)(rec + OFF_KT + s * 16) = (u32x4){pk(kv[0], kv[1]), pk(kv[2], kv[3]), pk(kv[4], kv[5]), pk(kv[6], kv[7])}; } }
#pragma unroll
      for (int q = 0; q < 2; ++q) { const int s = u2 + 256 * q, f = s >> 6, ln = s & 63, r32 = ln & 31, hi = ln >> 5, mt = f >> 2, ks = f & 3, i = 32 * mt + r32, j0 = 16 * ks + 4 * hi;
          const f32x4 va = *(const LAS f32x4*)(Ad + i * 64 + j0), vb = *(const LAS f32x4*)(Ad + i * 64 + j0 + 8);
          *(u32x4*)(rec + OFF_QK + s * 16) = (u32x4){pk(va.x, va.y), pk(va.z, va.w), pk(vb.x, vb.y), pk(vb.z, vb.w)}; } }
    __syncthreads();
}

__device__ __forceinline__ bf16x8 pack8(const f32x16& v, int s) {
    u32x4 p; p.x = pk(v[8 * s], v[8 * s + 1]); p.y = pk(v[8 * s + 2], v[8 * s + 3]); p.z = pk(v[8 * s + 4], v[8 * s + 5]); p.w = pk(v[8 * s + 6], v[8 * s + 7]); return __builtin_bit_cast(bf16x8, p); }
#define GDN_MFMA(a, b, c) __builtin_amdgcn_mfma_f32_32x32x16_bf16((a), (b), (c), 0, 0, 0)
#define GDN_FRAG(buf, off, f) (*(const LAS bf16x8*)((buf) + (off) + (f) * 1024 + lane * 16))
__device__ __forceinline__ void chain(const Frame& F, int b, int h, int d) {
    const int lane = F.lane, wave = F.wave, r32 = lane & 31, hi = lane >> 5, nt = wave & 3; const bool comp = wave < 4;
    LAS unsigned char* lds = F.lds;
    const size_t rbase = (size_t)((b * 4 + h) * 2 + d) * NSTEP;
    const unsigned char* recs = F.ws + WS_REC + rbase * REC_BYTES; const unsigned char* us = F.ws + WS_U + rbase * U_BYTES; const float* gls = (const float*)(F.ws + WS_GL) + rbase;
    float* OGu = (float*)(F.ws + WS_OG) + (size_t)d * MT * 512 + h * 128 + nt * 32;
    const int olane = (d ? -2048 * hi : 2048 * hi) + r32;
    f32x16 S[4]; bf16x8 Sb[8];
#pragma unroll
    for (int i = 0; i < 4; ++i) S[i] = f32x16{};
#pragma unroll
    for (int i = 0; i < 8; ++i) Sb[i] = bf16x8{};
#define GDN_DMA(step, bufi) do { const unsigned char* src_ = recs + (size_t)(step) * REC_BYTES + lane * 16; LAS unsigned char* dst_ = lds + (bufi) * REC_BYTES; \
        _Pragma("unroll") for (int p_ = 0; p_ < 7; ++p_) __builtin_amdgcn_global_load_lds((const GAS unsigned*)(src_ + (wave * 7 + p_) * 1024), (LAS unsigned*)(dst_ + (wave * 7 + p_) * 1024), 16, 0, 0); } while (0)
    GDN_DMA(0, 0);
    asm volatile("s_waitcnt vmcnt(0)" ::: "memory"); __syncthreads();
#pragma unroll 1
    for (int step = 0; step < NSTEP; ++step) {
        const LAS unsigned char* buf = lds + (step & 1) * REC_BYTES;
        if (step + 1 < NSTEP) GDN_DMA(step + 1, (step + 1) & 1);
        if (comp) {
            const float egl = gls[step];
            f32x16 Vp[2];
#pragma unroll
            for (int mt = 0; mt < 2; ++mt) { const u32x4* up = (const u32x4*)(us + (size_t)step * U_BYTES + (size_t)(((mt * 4 + nt) * 64 + lane) * 32)); const u32x4 w0 = up[0], w1 = up[1];
                Vp[mt] = (f32x16){bflo(w0.x), bfhi(w0.x), bflo(w0.y), bfhi(w0.y), bflo(w0.z), bfhi(w0.z), bflo(w0.w), bfhi(w0.w), bflo(w1.x), bfhi(w1.x), bflo(w1.y), bfhi(w1.y), bflo(w1.z), bfhi(w1.z), bflo(w1.w), bfhi(w1.w)}; }
#pragma unroll
            for (int ks = 0; ks < 8; ++ks) {
#pragma unroll
                for (int mt = 0; mt < 2; ++mt) Vp[mt] = GDN_MFMA(GDN_FRAG(buf, OFF_NEGW, mt * 8 + ks), Sb[ks], Vp[mt]);
                if ((ks & 3) == 3) asm volatile("" ::: "memory"); }
            bf16x8 Vb[4];
            Vb[0] = pack8(Vp[0], 0); Vb[1] = pack8(Vp[0], 1); Vb[2] = pack8(Vp[1], 0); Vb[3] = pack8(Vp[1], 1);
            const int cn = d ? (step < 4 ? 3 - step : 135 - step) : step; const size_t orow0 = cn < 4 ? (size_t)(MLAT + b * CTXL + 64 * cn) : (size_t)(b * SEQ + 64 * (cn - 4));
#pragma unroll
            for (int mt = 0; mt < 2; ++mt) { f32x16 O = f32x16{};
#pragma unroll
                for (int ks = 0; ks < 8; ++ks) { O = GDN_MFMA(GDN_FRAG(buf, OFF_QG, mt * 8 + ks), Sb[ks], O); if ((ks & 3) == 3) asm volatile("" ::: "memory"); }
#pragma unroll
                for (int ks = 0; ks < 4; ++ks) O = GDN_MFMA(GDN_FRAG(buf, OFF_QK, mt * 4 + ks), Vb[ks], O);
#pragma unroll
                for (int r = 0; r < 16; ++r) { const int iu = 32 * mt + (r & 3) + 8 * (r >> 2), tu = d ? 63 - iu : iu; (OGu + (orow0 + tu) * 512)[olane] = O[r]; } }
#pragma unroll
            for (int mtS = 0; mtS < 4; ++mtS) {
#pragma unroll
                for (int r = 0; r < 16; ++r) S[mtS][r] *= egl;
#pragma unroll
                for (int ks = 0; ks < 4; ++ks) S[mtS] = GDN_MFMA(GDN_FRAG(buf, OFF_KT, mtS * 4 + ks), Vb[ks], S[mtS]);
                Sb[2 * mtS] = pack8(S[mtS], 0); Sb[2 * mtS + 1] = pack8(S[mtS], 1); asm volatile("" ::: "memory"); }
        }
        asm volatile("s_waitcnt vmcnt(0)" ::: "memory"); __syncthreads();
    }
#undef GDN_DMA
}
#undef GDN_MFMA
#undef GDN_FRAG
}

PHASE_FN void ph_gdn_prep(Ctx cx, int l_) {
    Frame F = mkframe(cx); const ArgsP a = F.ap; const int l = rfl(l_);
    REFRESH(F);
    for (int it = F.bid; it < BATCH * gdn::NSTEP * 4; it += F.G) { REFRESH(F); gdn::prep_item(F, a, l, it); }
}
PHASE_FN void ph_gdn_chain(Ctx cx, int l_) {
    Frame F = mkframe(cx); const int l = rfl(l_);
    REFRESH(F);
    for (int it = F.bid; it < 16; it += F.G) gdn::chain(F, it >> 3, (it >> 1) & 3, it & 1);
}
namespace na {
constexpr int VTL = SEQ + CTXL;
constexpr float C2 = 0.125f * 1.4426950408889634f, L2E = 1.4426950408889634f;
template <bool LOCAL>
__device__ __forceinline__ void group(const bf16* kp0, const bf16* vt, const bf16x8 (&qf)[2], const float* rprow, int cmin, int cq, int kc0, int lane, float& mrun, float& lrun, f32x4 (&o)[4]) {
    const int m = lane & 15, kq = lane >> 4;
    const bf16* ka = kp0 + (size_t)(8 * (m >> 2) + (m & 3)) * NP + 8 * kq;
    f32x4 sa = {0.f, 0.f, 0.f, 0.f}, sb = {0.f, 0.f, 0.f, 0.f};
#pragma unroll
    for (int s = 0; s < 2; ++s) { const bf16x8 a0 = *(const bf16x8*)(ka + 32 * s), a1 = *(const bf16x8*)(ka + 4 * NP + 32 * s);
        sa = __builtin_amdgcn_mfma_f32_16x16x32_bf16(a0, qf[s], sa, 0, 0, 0); sb = __builtin_amdgcn_mfma_f32_16x16x32_bf16(a1, qf[s], sb, 0, 0, 0); }
    float t[8];
#pragma unroll
    for (int j = 0; j < 4; ++j) { t[j] = sa[j] * C2; t[4 + j] = sb[j] * C2; }
    if (LOCAL) {
#pragma unroll
        for (int j = 0; j < 8; ++j) { const int kc = kc0 + 8 * kq + j; const bool ok = (kc >= cmin) && (kc < cmin + 16); const int bi = min(max(kc - cq + 15, 0), 30);
            t[j] = ok ? t[j] + rprow[bi] * L2E : -1e30f; } }
    float gm = fmaxf(fmaxf(fmaxf(t[0], t[1]), fmaxf(t[2], t[3])), fmaxf(fmaxf(t[4], t[5]), fmaxf(t[6], t[7])));
    gm = fmaxf(gm, __shfl_xor(gm, 16)); gm = fmaxf(gm, __shfl_xor(gm, 32));
    const float mn = fmaxf(mrun, gm), corr = __builtin_amdgcn_exp2f(mrun - mn); mrun = mn;
    float ps = 0.f;
#pragma unroll
    for (int j = 0; j < 8; ++j) { t[j] = __builtin_amdgcn_exp2f(t[j] - mn); ps += t[j]; }
    ps += __shfl_xor(ps, 16); ps += __shfl_xor(ps, 32);
    lrun = lrun * corr + ps;
    u32x4 pw; pw.x = pg8::cvt_pk_bf16(t[0], t[1]); pw.y = pg8::cvt_pk_bf16(t[2], t[3]); pw.z = pg8::cvt_pk_bf16(t[4], t[5]); pw.w = pg8::cvt_pk_bf16(t[6], t[7]);
    const bf16x8 pf = __builtin_bit_cast(bf16x8, pw);
    const bf16* va = vt + (size_t)m * VTL + 8 * kq;
#pragma unroll
    for (int dt = 0; dt < 4; ++dt) { const bf16x8 vf = *(const bf16x8*)(va + (size_t)(16 * dt) * VTL); o[dt] = o[dt] * corr; o[dt] = __builtin_amdgcn_mfma_f32_16x16x32_bf16(vf, pf, o[dt], 0, 0, 0); }
}
}

PHASE_FN void ph_na_vt(Ctx cx, int l_) {
    Frame F = mkframe(cx); REFRESH(F);
    const bf16* P = (const bf16*)(F.ws + WS_P); bf16* VT = (bf16*)(F.ws + WS_VT);
    LAS unsigned char* tile = F.lds + F.wave * 9216;
    const int gw = F.bid * NWAVES + F.wave, NGW = F.G * NWAVES, lane = F.lane;
    for (int it = gw; it < BATCH * 8 * 132; it += NGW) {
        const int b = it / (8 * 132), rem = it % (8 * 132), h = rem / 132, tb = rem % 132;
        const size_t row0 = tb < 128 ? (size_t)(b * SEQ + 64 * tb) : (size_t)(MLAT + b * CTXL + 64 * (tb - 128));
        const bf16* src = P + (row0 + lane) * NP + PC_NV + h * 64;
#pragma unroll
        for (int c = 0; c < 8; ++c) *(LAS u32x4*)(tile + lane * 144 + 16 * c) = *(const u32x4*)(src + 8 * c);
        LDS_WAIT(); asm volatile("" ::: "memory");
        bf16* dst = VT + ((size_t)((b * 8 + h) * 64 + lane)) * na::VTL + 64 * tb;
#pragma unroll
        for (int c = 0; c < 8; ++c) { unsigned w[4];
#pragma unroll
            for (int q = 0; q < 4; ++q) { const unsigned lo = *(const LAS unsigned short*)(tile + (8 * c + 2 * q) * 144 + 2 * lane), hi = *(const LAS unsigned short*)(tile + (8 * c + 2 * q + 1) * 144 + 2 * lane); w[q] = lo | (hi << 16); }
            *(u32x4*)(dst + 8 * c) = (u32x4){w[0], w[1], w[2], w[3]}; }
        LDS_WAIT(); asm volatile("" ::: "memory");
    }
}

constexpr int NA_NLAT = BATCH * 8 * 128 * 4, NA_NCTX = BATCH * 8 * 16, NA_ITEMS = NA_NLAT + NA_NCTX;
__device__ __forceinline__ void na_wave_item(const Frame& F, const ArgsP a, int l, int it) {
    const bf16* P = (const bf16*)(F.ws + WS_P); const bf16* VT = (const bf16*)(F.ws + WS_VT); bf16* YC = (bf16*)(F.ws + WS_YC);
    const int lane = F.lane, qi = lane & 15, kq = lane >> 4;
    const bool lat = it < NA_NLAT; int b, h, r = 0, n = 0, qrow;
    if (lat) { b = it >> 12; h = (it >> 9) & 7; r = (it >> 2) & 127; n = it & 3; qrow = b * SEQ + r * 64 + 16 * n + qi; }
    else { const int j = it - NA_NLAT; b = j >> 7; h = (j >> 4) & 7; qrow = MLAT + b * CTXL + 16 * (j & 15) + qi; }
    bf16x8 qf[2];
    { const bf16* qp = P + (size_t)qrow * NP + PC_NQ + h * 64 + 8 * kq; qf[0] = *(const bf16x8*)qp; qf[1] = *(const bf16x8*)(qp + 32); }
    f32x4 o[4];
#pragma unroll
    for (int dt = 0; dt < 4; ++dt) o[dt] = (f32x4){0.f, 0.f, 0.f, 0.f};
    float mrun = -1e30f, lrun = 0.f;
    const bf16* Kb = P + PC_NK + h * 64; const bf16* VTh = VT + (size_t)((b * 8 + h) * 64) * na::VTL;
    if (lat) { const int r0 = min(max(r - 4, 0), 120), kc0 = min(max(16 * n - 8, 0), 32), cq = 16 * n + qi, cmin = min(max(cq - 8, 0), 48);
        const float* rp = a->in[I_RPB] + ((size_t)l * 8 + h) * 15 * 31;
#pragma unroll 1
        for (int kr = 0; kr < 8; ++kr) { const int tok = (r0 + kr) * 64 + kc0;
            na::group<true>(Kb + (size_t)(b * SEQ + tok) * NP, VTh + tok, qf, rp + (r0 + kr - r + 7) * 31, cmin, cq, kc0, lane, mrun, lrun, o); } }
#pragma unroll 1
    for (int g = 0; g < 8; ++g) na::group<false>(Kb + (size_t)(MLAT + b * CTXL + 32 * g) * NP, VTh + SEQ + 32 * g, qf, nullptr, 0, 0, 0, lane, mrun, lrun, o);
    const float il = 1.f / lrun; bf16* op = YC + (size_t)qrow * 512 + h * 64 + 4 * kq;
#pragma unroll
    for (int dt = 0; dt < 4; ++dt) { u32x2 w; w.x = pg8::cvt_pk_bf16(o[dt][0] * il, o[dt][1] * il); w.y = pg8::cvt_pk_bf16(o[dt][2] * il, o[dt][3] * il); *(u32x2*)(op + 16 * dt) = w; }
}
PHASE_FN void ph_na_mfma(Ctx cx, int l_) {
    Frame F = mkframe(cx); const ArgsP a = F.ap; const int l = rfl(l_); REFRESH(F);
    const int gw = F.bid * NWAVES + F.wave, NGW = F.G * NWAVES;
    for (int it = gw; it < NA_ITEMS; it += NGW) na_wave_item(F, a, l, it);
}

PHASE_FN void ph_mixers(Ctx cx, int l_) {
    Frame F = mkframe(cx); const ArgsP a = F.ap; const int l = rfl(l_);
    volatile LAS int* qw = (volatile LAS int*)(F.lds + MISC_OFF + 64);
    constexpr int N_CH = 16, N_DF = 528, N_NA = (NA_ITEMS + 7) / 8, N_ALL = N_CH + N_DF + N_NA;
    const float lam = ((const float*)(F.ws + WS_LAM))[l], omli = 1.f - (0.8f - 0.6f * expf(-0.3f * (float)l));
    for (;;) {
        REFRESH(F);
        __syncthreads();
        if (F.tid == 0) *qw = (int)__hip_atomic_fetch_add(F.ctl + CW_Q + 64 * l, 1u, __ATOMIC_RELAXED, __HIP_MEMORY_SCOPE_AGENT);
        __syncthreads();
        const int idx = rfl(*qw);
        if (idx >= N_ALL) break;
        if (idx < N_CH) gdn::chain(F, idx >> 3, (idx >> 1) & 3, idx & 1);
        else if (idx < N_CH + N_DF) { const int it = idx - N_CH; int b, h, q0, t0, NT;
            if (it < 512) { b = it >> 8; h = (it >> 6) & 3; q0 = b * SEQ + (it & 63) * 128; t0 = 0; NT = 132; }
            else { const int j = it - 512; b = j >> 3; h = (j >> 1) & 3; q0 = MLAT + b * CTXL + (j & 1) * 128; t0 = 128; NT = 4; }
            dattn::unit((const bf16*)(F.ws + WS_P), (bf16*)(F.ws + WS_YB), a->in[I_DNW] + l * 128, lam, omli, b, h, q0, t0, NT, (LAS char*)F.lds, F.wave, F.lane); }
        else { const int it = (idx - N_CH - N_DF) * 8 + F.wave; if (it < NA_ITEMS) na_wave_item(F, a, l, it); }
    }
}
constexpr int TAB_OFF = LDSCTL_OFF;
PHASE_FN void ph_ln1_router(Ctx cx, int l_) {
    Frame F = mkframe(cx); const ArgsP a = F.ap; const int l = rfl(l_);
    REFRESH(F);
    volatile LAS int* tab = (volatile LAS int*)(F.lds + TAB_OFF);
    const float* T = (const float*)(F.ws + WS_T); float* X = (float*)(F.ws + WS_X);
    { const f32x4* src = (const f32x4*)((const float*)(F.ws + WS_WRT) + (size_t)l * 32 * 1024); LAS f32x4* dst = (LAS f32x4*)F.lds;
      __syncthreads(); for (int i = F.tid; i < 32 * 256; i += NTHREADS) dst[i] = src[i]; __syncthreads(); }
    const LAS float* wrT = (const LAS float*)F.lds;
    const float* lng = a->in[I_LNG] + (size_t)(l * 2 + 0) * DM; const float* lnb = a->in[I_LNB] + (size_t)(l * 2 + 0) * DM;
    int* TOPE = (int*)(F.ws + WS_TOPE); int* TOPR = (int*)(F.ws + WS_TOPR); float* TOPG = (float*)(F.ws + WS_TOPG); int* BLKB = (int*)(F.ws + WS_BLKB);
    for (int rg = F.bid; rg < NRG; rg += F.G) {
        if (F.tid < 32) tab[384 + F.tid] = 0;
        __syncthreads();
        for (int i = F.wave; i < RG_ROWS; i += NWAVES) {
            const int row = rg * RG_ROWS + i; f32x4 v[4];
            const f32x4* tr = (const f32x4*)T + (size_t)row * 256 + F.lane;
#pragma unroll
            for (int j = 0; j < 4; ++j) v[j] = tr[64 * j];
            ln_inplace(v);
#pragma unroll
            for (int j = 0; j < 4; ++j) { const int c = 4 * F.lane + 256 * j; v[j] = v[j] * *(const f32x4*)(lng + c) + *(const f32x4*)(lnb + c); *((f32x4*)X + (size_t)row * 256 + F.lane + 64 * j) = v[j]; }
            modulate_store(F, l, 1, row, v);
            float p[32];
#pragma unroll
            for (int e = 0; e < 32; ++e) { float s = 0.f;
#pragma unroll
                for (int j = 0; j < 4; ++j) { const f32x4 w = *(const LAS f32x4*)(wrT + e * 1024 + 4 * F.lane + 256 * j); s += (v[j].x * w.x + v[j].y * w.y) + (v[j].z * w.z + v[j].w * w.w); }
                p[e] = s; if ((e & 7) == 7) asm volatile("" ::: "memory"); }
#pragma unroll
            for (int i2 = 0; i2 < 16; ++i2) { const bool up = (F.lane & 32) != 0; const float send = up ? p[i2] : p[i2 + 16], keep = up ? p[i2 + 16] : p[i2]; p[i2] = keep + __shfl_xor(send, 32); }
#pragma unroll
            for (int i2 = 0; i2 < 8; ++i2) { const bool up = (F.lane & 16) != 0; const float send = up ? p[i2] : p[i2 + 8], keep = up ? p[i2 + 8] : p[i2]; p[i2] = keep + __shfl_xor(send, 16); }
#pragma unroll
            for (int i2 = 0; i2 < 4; ++i2) { const bool up = (F.lane & 8) != 0; const float send = up ? p[i2] : p[i2 + 4], keep = up ? p[i2 + 4] : p[i2]; p[i2] = keep + __shfl_xor(send, 8); }
#pragma unroll
            for (int i2 = 0; i2 < 2; ++i2) { const bool up = (F.lane & 4) != 0; const float send = up ? p[i2] : p[i2 + 2], keep = up ? p[i2 + 2] : p[i2]; p[i2] = keep + __shfl_xor(send, 4); }
            { const bool up = (F.lane & 2) != 0; const float send = up ? p[0] : p[1], keep = up ? p[1] : p[0]; p[0] = keep + __shfl_xor(send, 2); }
            p[0] += __shfl_xor(p[0], 1);
            const int me = F.lane >> 1; float lg = p[0] + a->in[I_BR][l * 32 + me];
            int te[4]; float tv[4];
#pragma unroll
            for (int k = 0; k < 4; ++k) { float bv = lg; int be = me;
#pragma unroll
                for (int o = 1; o < 64; o <<= 1) { const float ov = __shfl_xor(bv, o); const int oe = __shfl_xor(be, o); if (ov > bv || (ov == bv && oe < be)) { bv = ov; be = oe; } }
                te[k] = be; tv[k] = bv; if (me == be) lg = -3.0e38f; }
            const float e1 = __expf(tv[1] - tv[0]), e2 = __expf(tv[2] - tv[0]), e3 = __expf(tv[3] - tv[0]), isum = 1.f / (1.f + e1 + e2 + e3);
            if (F.lane < 4) { const int k = F.lane; const int e = k == 0 ? te[0] : k == 1 ? te[1] : k == 2 ? te[2] : te[3]; const float g = (k == 0 ? 1.f : k == 1 ? e1 : k == 2 ? e2 : e3) * isum;
                const int lr = __hip_atomic_fetch_add((LAS int*)&tab[384 + e], 1, __ATOMIC_RELAXED, __HIP_MEMORY_SCOPE_WORKGROUP);
                TOPE[row * 4 + k] = e; TOPR[row * 4 + k] = lr; TOPG[row * 4 + k] = g; }
        }
        __syncthreads();
        if (F.tid < 32) { const int n = tab[384 + F.tid]; const unsigned base = __hip_atomic_fetch_add(F.ctl + CW_CNT + l * 32 + F.tid, (unsigned)n, __ATOMIC_RELAXED, __HIP_MEMORY_SCOPE_AGENT); BLKB[rg * 32 + F.tid] = (int)base; }
        __syncthreads();
    }
}
__device__ __forceinline__ void moe_tables(Frame& F, int l, int nN) {
    REFRESH(F);
    volatile LAS int* tab = (volatile LAS int*)(F.lds + TAB_OFF);
    __syncthreads();
    if (F.tid == 0) { int t = 0;
#pragma unroll 1
        for (int e = 0; e < 32; ++e) { const int n = (int)__hip_atomic_load(F.ctl + CW_CNT + l * 32 + e, __ATOMIC_RELAXED, __HIP_MEMORY_SCOPE_AGENT), nt = (n + 255) >> 8; tab[352 + e] = t * 256;
            for (int i = 0; i < nt; ++i) tab[t + i] = e; t += nt; }
        tab[320] = t; }
    __syncthreads();
    if (nN > 0 && F.tid < 16) { int pm, pn; const int T = tab[320]; int w = -1;
        if (TileMap::map(F.tid, F.G, F.bid, T, nN, pm, pn)) w = pm | (pn << 12) | (tab[pm] << 16) | (nN << 24);
        tab[416 + F.tid] = w; }
    __syncthreads();
}
PHASE_FN void ph_moe_gather(Ctx cx, int l_) {
    Frame F = mkframe(cx); const int l = rfl(l_);
    REFRESH(F);
    volatile LAS int* tab = (volatile LAS int*)(F.lds + TAB_OFF);
    moe_tables(F, l, 0);
    const int gw = F.bid * NWAVES + F.wave, NGW = F.G * NWAVES;
    const int* TOPE = (const int*)(F.ws + WS_TOPE); const int* TOPR = (const int*)(F.ws + WS_TOPR); const int* BLKB = (const int*)(F.ws + WS_BLKB); int* SLOT = (int*)(F.ws + WS_SLOT);
    const bf16* HX = (const bf16*)(F.ws + WS_HX); bf16* HP = (bf16*)(F.ws + WS_HP);
    for (int row = gw; row < MT; row += NGW) {
        const u32x4 h0 = *(const u32x4*)(HX + (size_t)row * DM + 8 * F.lane), h1 = *(const u32x4*)(HX + (size_t)row * DM + 512 + 8 * F.lane);
#pragma unroll
        for (int k = 0; k < 4; ++k) { const int e = TOPE[row * 4 + k], slot = tab[352 + e] + BLKB[(row / RG_ROWS) * 32 + e] + TOPR[row * 4 + k];
            if (F.lane == 0) SLOT[row * 4 + k] = slot;
            *(u32x4*)(HP + (size_t)slot * DM + 8 * F.lane) = h0; *(u32x4*)(HP + (size_t)slot * DM + 512 + 8 * F.lane) = h1; }
    }
}
PHASE_FN void ph_ln2(Ctx cx, int l_) {
    Frame F = mkframe(cx); const ArgsP a = F.ap; const int l = rfl(l_);
    REFRESH(F);
    const int gw = F.bid * NWAVES + F.wave, NGW = F.G * NWAVES;
    float* X = (float*)(F.ws + WS_X); const bf16* Y = (const bf16*)(F.ws + WS_Y);
    const int* SLOT = (const int*)(F.ws + WS_SLOT); const float* TOPG = (const float*)(F.ws + WS_TOPG);
    const float* lng = a->in[I_LNG] + (size_t)(l * 2 + 1) * DM; const float* lnb = a->in[I_LNB] + (size_t)(l * 2 + 1) * DM;
    if (l < DEPTH - 1) stage_wdec(F, l + 1);
    const bool poison = __hip_atomic_load(F.ctl + CW_BAR + XB_TMO, __ATOMIC_RELAXED, __HIP_MEMORY_SCOPE_AGENT) != 0u;
    for (int row = gw; row < MT; row += NGW) {
        const float* g2 = (const float*)(F.ws + WS_MOD) + ((size_t)l * 3 + mod_index(row)) * 6144 + 5120;
        f32x4 fx[4];
#pragma unroll
        for (int j = 0; j < 4; ++j) fx[j] = (f32x4){0.f, 0.f, 0.f, 0.f};
#pragma unroll
        for (int k = 0; k < 4; ++k) { const int slot = SLOT[row * 4 + k]; const float g = TOPG[row * 4 + k]; const bf16* yr = Y + (size_t)slot * DM + 4 * F.lane;
#pragma unroll
            for (int j = 0; j < 4; ++j) { const u32x2 w = *(const u32x2*)(yr + 256 * j); fx[j] += (f32x4){bflo(w.x), bfhi(w.x), bflo(w.y), bfhi(w.y)} * g; } }
        f32x4 v[4];
#pragma unroll
        for (int j = 0; j < 4; ++j) { const int c = 4 * F.lane + 256 * j; v[j] = *((const f32x4*)X + (size_t)row * 256 + F.lane + 64 * j) * DN_ALPHA + *(const f32x4*)(g2 + c) * fx[j]; }
        ln_inplace(v);
#pragma unroll
        for (int j = 0; j < 4; ++j) { const int c = 4 * F.lane + 256 * j; v[j] = v[j] * *(const f32x4*)(lng + c) + *(const f32x4*)(lnb + c); }
        if (l == DEPTH - 1) { if (row < MLAT) {
            if (poison) { const float qn = __builtin_nanf("");
#pragma unroll
                for (int j = 0; j < 4; ++j) v[j] = (f32x4){qn, qn, qn, qn}; }
#pragma unroll
            for (int j = 0; j < 4; ++j) *((f32x4*)a->out + (size_t)row * 256 + F.lane + 64 * j) = v[j]; } }
        else {
#pragma unroll
            for (int j = 0; j < 4; ++j) *((f32x4*)X + (size_t)row * 256 + F.lane + 64 * j) = v[j];
            modulate_store(F, l + 1, 0, row, v); decay_cols(F, l + 1, row, v); }
    }
}

PHASE_FN void ph_gemm_win(Ctx cx, int l_) {
    Frame F = mkframe(cx); const int l = rfl(l_); unsigned char* ws = F.ws;
    StaticOrder S{MT / 256, NP / 256, F.G, F.bid, 1024}; EpiWin E{(bf16*)(ws + WS_P)};
    pg8::gemm_phase<EpiWin, StaticOrder>(F.lds, 1024, (const char*)(ws + WS_HX), (const char*)(ws + WS_WIN) + (size_t)l * 8192 * 1024 * 2, S, E, F.wv);
}
PHASE_FN void ph_gemm_merge(Ctx cx, int l_) {
    Frame F = mkframe(cx); const int l = rfl(l_); unsigned char* ws = F.ws;
    MergeOrder S{F.G, F.bid}; EpiMerge E{(const bf16*)(ws + WS_P), (float*)(ws + WS_MACC), (bf16*)(ws + WS_MBF)};
    pg8::gemm_phase<EpiMerge, MergeOrder>(F.lds, 512, (const char*)(ws + WS_YA), (const char*)(ws + WS_WBR) + (size_t)l * 3 * 1024 * 512 * 2, S, E, F.wv);
}
PHASE_FN void ph_gemm_wout(Ctx cx, int l_) {
    Frame F = mkframe(cx); const int l = rfl(l_); unsigned char* ws = F.ws;
    StaticOrder S{MT / 256, 4, F.G, F.bid, 1024}; EpiWout E{(const float*)(ws + WS_X), (const float*)(ws + WS_MOD) + (size_t)l * 3 * 6144, (float*)(ws + WS_T)};
    pg8::gemm_phase<EpiWout, StaticOrder>(F.lds, 1024, (const char*)(ws + WS_MBF), (const char*)(ws + WS_WOUT) + (size_t)l * 1024 * 1024 * 2, S, E, F.wv);
}
PHASE_FN void ph_gemm_moe1(Ctx cx, int l_) {
    Frame F = mkframe(cx); const int l = rfl(l_); unsigned char* ws = F.ws; const ArgsP a = F.ap;
    moe_tables(F, l, 8);
    MoeOrder S{(const volatile LAS int*)(F.lds + TAB_OFF)}; EpiAct E{a->in[I_B1] + (size_t)l * 32 * 2048, (bf16*)(ws + WS_ACT)};
    pg8::gemm_phase<EpiAct, MoeOrder>(F.lds, 1024, (const char*)(ws + WS_HP), (const char*)(ws + WS_W1) + (size_t)l * 32 * 2048 * 1024 * 2, S, E, F.wv);
}
PHASE_FN void ph_gemm_moe2(Ctx cx, int l_) {
    Frame F = mkframe(cx); const int l = rfl(l_); unsigned char* ws = F.ws; const ArgsP a = F.ap;
    moe_tables(F, l, 4);
    MoeOrder S{(const volatile LAS int*)(F.lds + TAB_OFF)}; EpiY E{a->in[I_B2] + (size_t)l * 32 * 1024, (bf16*)(ws + WS_Y)};
    pg8::gemm_phase<EpiY, MoeOrder>(F.lds, 1024, (const char*)(ws + WS_ACT), (const char*)(ws + WS_W2) + (size_t)l * 32 * 1024 * 1024 * 2, S, E, F.wv);
}
constexpr int NPH_LAYER = 12, NPHASES = 2 + DEPTH * NPH_LAYER;
__global__ void __launch_bounds__(NTHREADS, 2) fwd_kernel(Args args) {
    extern __shared__ __attribute__((aligned(16))) unsigned char lds_raw[];
    LAS unsigned char* lds = (LAS unsigned char*)lds_raw;
    const int tid = threadIdx.x;
    volatile LAS unsigned* MISC = (volatile LAS unsigned*)(lds + MISC_OFF);
    for (int u = tid; u < (LDS_BYTES - LDSCTL_OFF) / 4; u += NTHREADS) ((LAS unsigned*)(lds + LDSCTL_OFF))[u] = 0u;
    __syncthreads();
    const int lo = args.ph_lo, hi = args.ph_hi;
    const bool multi = (hi - lo) > 1;
    unsigned* ctl = (unsigned*)(args.ws + WS_CTL);
    XcdBarrier bar; bar.bar = ctl + CW_BAR; bar.x = 0; bar.st = nullptr;
    if (multi) bar = xcd_barrier_post(ctl + CW_BAR, MISC + 8);
    Ctx cx; cx.lds = lds; cx.ws = args.ws; cx.ap = (ArgsP)__builtin_amdgcn_kernarg_segment_ptr(); cx.G = gridDim.x; cx.bid = blockIdx.x; cx.wv = __builtin_amdgcn_readfirstlane(tid >> 6);
#ifndef ONLYP
#define ONLYP -1
#endif
#define ENP(k) (ONLYP < 0 || ONLYP == (k))
#ifndef DUPK
#define DUPK -1
#endif
#define DUP(k, call) do { if (DUPK == (k)) { call; } } while (0)
#define IN(k) (lo <= (k) && (k) < hi)
#ifdef DUPBAR
#define SEAM(k) do { if (IN(k) && IN((k) + 1)) { xcd_barrier(bar); xcd_barrier(bar); } } while (0)
#else
#define SEAM(k) do { if (IN(k) && IN((k) + 1)) xcd_barrier(bar); } while (0)
#endif
    if (IN(0)) { if (ENP(100)) p0_prologue(cx); DUP(100, p0_prologue(cx)); SEAM(0); }
    if (IN(1)) { if (ENP(101)) ph_lnmod0(cx); SEAM(1); }
    for (int l = 0; l < DEPTH; ++l) {
        const int pb = 2 + l * NPH_LAYER;
        if (IN(pb + 0)) { if (ENP(0)) ph_gemm_win(cx, l); DUP(0, ph_gemm_win(cx, l)); SEAM(pb + 0); }
        if (IN(pb + 1)) { if (ENP(11)) ph_prep(cx, l);
#if USE_GDN_FAST
            if (ENP(1)) ph_gdn_prep(cx, l); DUP(1, ph_gdn_prep(cx, l));
#endif
#if USE_NA_MFMA
            if (ENP(12)) ph_na_vt(cx, l);
#endif
            SEAM(pb + 1); }
        if (IN(pb + 2)) { SEAM(pb + 2); }
        if (IN(pb + 3)) { if (ENP(3)) ph_mixers(cx, l); DUP(3, ph_mixers(cx, l)); SEAM(pb + 3); }
        if (IN(pb + 4)) { if (ENP(13)) ph_combine(cx, l); SEAM(pb + 4); }
        if (IN(pb + 5)) { if (ENP(5)) ph_gemm_merge(cx, l); DUP(5, ph_gemm_merge(cx, l)); SEAM(pb + 5); }
        if (IN(pb + 6)) { if (ENP(6)) ph_gemm_wout(cx, l); DUP(6, ph_gemm_wout(cx, l)); SEAM(pb + 6); }
        if (IN(pb + 7)) { if (ENP(7)) ph_ln1_router(cx, l); SEAM(pb + 7); }
        if (IN(pb + 8)) { if (ENP(8)) ph_moe_gather(cx, l); DUP(8, ph_moe_gather(cx, l)); SEAM(pb + 8); }
        if (IN(pb + 9)) { if (ENP(9)) ph_gemm_moe1(cx, l); DUP(9, ph_gemm_moe1(cx, l)); SEAM(pb + 9); }
        if (IN(pb + 10)) { if (ENP(10)) ph_gemm_moe2(cx, l); DUP(10, ph_gemm_moe2(cx, l)); SEAM(pb + 10); }
        if (IN(pb + 11)) { if (ENP(14)) ph_ln2(cx, l); SEAM(pb + 11); }
    }
#undef IN
#undef SEAM
}

#ifndef MK_PER_PHASE
#define MK_PER_PHASE 0
#endif
extern "C" void kernel_launch(void* const* d_in, const int* in_sizes, int n_in, void* d_out, int out_size, void* d_ws, size_t ws_size, hipStream_t stream) {
    static int grid = 0;
    if (grid == 0) {
        if (n_in != 24 || out_size != MLAT * DM || ws_size < WS_END) { fprintf(stderr, "kernel_launch: unexpected shapes (n_in %d out %d ws %zu need %zu)\n", n_in, out_size, ws_size, (size_t)WS_END); grid = -1; return; }
        int dev = 0, cus = 0, per_cu = 0;
        if (hipGetDevice(&dev) != hipSuccess || hipDeviceGetAttribute(&cus, hipDeviceAttributeMultiprocessorCount, dev) != hipSuccess) { grid = -1; return; }
        if (hipFuncSetAttribute((const void*)fwd_kernel, hipFuncAttributeMaxDynamicSharedMemorySize, LDS_BYTES) != hipSuccess) { fprintf(stderr, "kernel_launch: hipFuncSetAttribute failed\n"); grid = -1; return; }
        if (hipOccupancyMaxActiveBlocksPerMultiprocessor(&per_cu, (const void*)fwd_kernel, NTHREADS, LDS_BYTES) != hipSuccess || per_cu < 1) { fprintf(stderr, "kernel_launch: occupancy query says %d\n", per_cu); }
        (void)hipGetLastError();
        grid = cus;
    }
    if (grid < 0) return;
    (void)hipMemsetAsync((char*)d_ws + WS_CTL, 0, CTL_ZERO_BYTES, stream);
    Args a{};
    for (int i = 0; i < 24; ++i) a.in[i] = (const float*)d_in[i];
    a.out = (float*)d_out; a.ws = (unsigned char*)d_ws;
#if MK_PER_PHASE
    for (int p = 0; p < NPHASES; ++p) { a.ph_lo = p; a.ph_hi = p + 1; hipLaunchKernelGGL(fwd_kernel, dim3(grid), dim3(NTHREADS), LDS_BYTES, stream, a); }
#else
    a.ph_lo = 0; a.ph_hi = NPHASES; hipLaunchKernelGGL(fwd_kernel, dim3(grid), dim3(NTHREADS), LDS_BYTES, stream, a);
#endif
    const hipError_t le = hipPeekAtLastError();
    if (le != hipSuccess) fprintf(stderr, "kernel_launch: launch failed: %s\n", hipGetErrorName(le));
}
```

```cpp
#include <hip/hip_runtime.h>
#include <cstdio>
#include <cstdint>
#include <cmath>

#define GAS __attribute__((address_space(1)))
#define LAS __attribute__((address_space(3)))
typedef unsigned short bf16;
typedef float f32x4 __attribute__((ext_vector_type(4)));
typedef float f32x2 __attribute__((ext_vector_type(2)));
typedef unsigned u32x4 __attribute__((ext_vector_type(4)));
typedef unsigned u32x2 __attribute__((ext_vector_type(2)));
typedef short bf16x8 __attribute__((ext_vector_type(8)));

namespace pg8 {
#define PG8_LAS __attribute__((address_space(3)))
constexpr int BM = 256, BK = 64, HALF = 128, HTB = HALF * BK * 2, STAGE_BYTES = 8 * HTB, NXCD = 8, WGM = 8;
__host__ __device__ __forceinline__ int lds_byte(int r, int c) { const int st = (r >> 4) * 2 + (c >> 5), rr = r & 15, cc = c & 31, ob = rr * 64 + cc * 2; return st * 1024 + (ob ^ (((ob >> 9) & 1) << 5)); }
__host__ __device__ __forceinline__ void stage_rc(int b, int& R, int& C) { const int st = b / 1024, sb = b % 1024, swz = sb ^ (((sb >> 9) & 1) << 5); R = (st >> 1) * 16 + swz / 64; C = (st & 1) * 32 + (swz % 64) / 2; }
__host__ __device__ __forceinline__ int perm32(int rho) { const int n = rho >> 4, i = rho & 15; return 8 * (i >> 2) + 4 * n + (i & 3); }

struct Unit { int pm, pn, aux; unsigned aoff, boff; };

typedef float cvt_f32x2_t __attribute__((ext_vector_type(2))); typedef __bf16 cvt_bf16x2_t __attribute__((ext_vector_type(2)));
__device__ __forceinline__ unsigned cvt_pk_bf16(float lo, float hi) { cvt_f32x2_t v = {lo, hi}; cvt_bf16x2_t b = __builtin_convertvector(v, cvt_bf16x2_t); return __builtin_bit_cast(unsigned, b); }

template <class Epi, class Sched, bool ALIGN_EPI = true, bool SP2 = true, bool GATHER = false>
__device__ __forceinline__ void gemm_phase(PG8_LAS unsigned char* lds, const int K, const char* Abase, const char* Bbase, const Sched& S, const Epi& E, const int wv, const int* rowtok = nullptr, const int pitch_ = 0) {
    int lane_; asm volatile("v_mbcnt_lo_u32_b32 %0, -1, 0\n\tv_mbcnt_hi_u32_b32 %0, -1, %0" : "=v"(lane_));
    const int wid = wv, lane = lane_, tid = wv * 64 + lane_, wr = wid >> 2, wc = wid & 3, fr = lane & 15, fq = lane >> 4;
    const int nt = K / BK, PT = pitch_ ? pitch_ : K;
    unsigned voffA[2], voffB[2]; int gR[2]; unsigned gC[2]; unsigned cvA[2][2], nvA[2][2];
#pragma unroll
    for (int i = 0; i < 2; ++i) { int R, C; stage_rc(tid * 16 + i * 8192, R, C); const int Rb = ((R & ~31) + perm32(R & 31));
        voffA[i] = (unsigned)(R * PT + C) * 2u; voffB[i] = (unsigned)(Rb * PT + C) * 2u; gR[i] = R; gC[i] = (unsigned)C * 2u; }
    const size_t kstep = (size_t)(BK * 2);
    const size_t hstep = (size_t)HALF * PT * 2;
    const unsigned ldsw = (unsigned)wid * 1024u;
    const int aoff = lds_byte(wr * 64 + fr, fq * 8), boff = lds_byte(wc * 32 + fr, fq * 8);
#define PG8_SA(b, h) (((b) * 2 + (h)) * HTB)
#define PG8_SB(b, h) ((4 + (b) * 2 + (h)) * HTB)
#define PG8_STAGE(bufoff, gbase, voff) do { _Pragma("unroll") for (int _i = 0; _i < 2; ++_i) \
        __builtin_amdgcn_global_load_lds((const GAS unsigned*)((const char*)(gbase) + (voff)[_i]), (PG8_LAS unsigned*)(lds + (bufoff) + ldsw + _i * 8192), 16, 0, 0); } while (0)
#define PG8_STAGEA(bufoff, gbase, H, NX) do { _Pragma("unroll") for (int _i = 0; _i < 2; ++_i) { \
        const unsigned vo_ = GATHER ? ((NX) ? nvA[H][_i] : cvA[H][_i]) : voffA[_i]; const char* gb_ = GATHER ? (const char*)(gbase) : (const char*)(gbase) + ((H) ? hstep : (size_t)0); \
        __builtin_amdgcn_global_load_lds((const GAS unsigned*)(gb_ + vo_), (PG8_LAS unsigned*)(lds + (bufoff) + ldsw + _i * 8192), 16, 0, 0); } } while (0)
#define PG8_GLOAD(dst, pm_) do { if constexpr (GATHER) { _Pragma("unroll") for (int _h = 0; _h < 2; ++_h) _Pragma("unroll") for (int _i = 0; _i < 2; ++_i) dst[_h][_i] = (unsigned)rowtok[(pm_) * 256 + 128 * _h + gR[_i]] + gC[_i]; } } while (0)
#define PG8_LDA(dst, b, h) do { _Pragma("unroll") for (int m = 0; m < 4; ++m) _Pragma("unroll") for (int k = 0; k < 2; ++k) dst[m][k] = *(const PG8_LAS bf16x8*)(lds + PG8_SA(b, h) + aoff + m * 2048 + k * 1024); } while (0)
#define PG8_LDB(dst, b, h) do { _Pragma("unroll") for (int n = 0; n < 2; ++n) _Pragma("unroll") for (int k = 0; k < 2; ++k) dst[n][k] = *(const PG8_LAS bf16x8*)(lds + PG8_SB(b, h) + boff + n * 2048 + k * 1024); } while (0)
#define PG8_MMA(ai, bj, At, Bt) do { __builtin_amdgcn_s_setprio(1); _Pragma("unroll") for (int m = 0; m < 4; ++m) _Pragma("unroll") for (int n = 0; n < 2; ++n) _Pragma("unroll") for (int k = 0; k < 2; ++k) \
        acc[ai][bj][m][n] = __builtin_amdgcn_mfma_f32_16x16x32_bf16(Bt[n][k], At[m][k], acc[ai][bj][m][n], 0, 0, 0); __builtin_amdgcn_s_setprio(0); } while (0)
#define PG8_WAIT_V(n) asm volatile("s_waitcnt vmcnt(" #n ")" ::: "memory")
#define PG8_WAIT_L(n) asm volatile("s_waitcnt lgkmcnt(" #n ")" ::: "memory")
#define PG8_BAR __builtin_amdgcn_s_barrier()
#define PG8_SCHED __builtin_amdgcn_sched_barrier(0)
    Unit cur, nxt; int ui = 0;
    if (!S.next(0, cur)) return;
    f32x4 acc[2][2][4][2];
#pragma unroll
    for (int a = 0; a < 2; ++a)
#pragma unroll
        for (int b = 0; b < 2; ++b)
#pragma unroll
            for (int m = 0; m < 4; ++m)
#pragma unroll
                for (int n = 0; n < 2; ++n) acc[a][b][m][n] = (f32x4){0.f, 0.f, 0.f, 0.f};
    bf16x8 At[4][2], B0[2][2], B1[2][2];
    const char* cA = Abase + cur.aoff; const char* cB = Bbase + cur.boff;
    PG8_GLOAD(cvA, cur.pm);
    if constexpr (SP2) {
        PG8_STAGE(PG8_SB(0, 0), cB, voffB); PG8_STAGE(PG8_SB(0, 1), cB + hstep, voffB); PG8_STAGEA(PG8_SA(0, 0), cA, 0, false); PG8_STAGEA(PG8_SA(0, 1), cA, 1, false);
        if (wr == 1) PG8_BAR;
        PG8_WAIT_V(2); PG8_BAR;
        PG8_STAGE(PG8_SB(1, 0), cB + kstep, voffB); PG8_STAGEA(PG8_SA(1, 0), cA + kstep, 0, false); PG8_STAGE(PG8_SB(1, 1), cB + hstep + kstep, voffB);
        PG8_WAIT_V(6); PG8_BAR;
    } else {
        PG8_STAGE(PG8_SB(0, 0), cB, voffB); PG8_STAGEA(PG8_SA(0, 0), cA, 0, false); PG8_STAGE(PG8_SB(0, 1), cB + hstep, voffB); PG8_STAGEA(PG8_SA(0, 1), cA, 1, false);
        if (wr == 1) PG8_BAR;
        PG8_WAIT_V(4); PG8_BAR;
        PG8_STAGE(PG8_SB(1, 0), cB + kstep, voffB); PG8_STAGEA(PG8_SA(1, 0), cA + kstep, 0, false); PG8_STAGE(PG8_SB(1, 1), cB + hstep + kstep, voffB);
        PG8_WAIT_V(6); PG8_BAR;
    }
    for (;;) {
        const bool has_next = S.next(ui + 1, nxt);
        if constexpr (GATHER) { if (has_next) { PG8_GLOAD(nvA, nxt.pm); } else { _Pragma("unroll") for (int _h = 0; _h < 2; ++_h) _Pragma("unroll") for (int _i = 0; _i < 2; ++_i) nvA[_h][_i] = cvA[_h][_i]; } }
        const char* nA = has_next ? Abase + nxt.aoff : cA; const char* nB = has_next ? Bbase + nxt.boff : cB;
        for (int t = 0; t < nt; t += 2) {
            const bool last = (t == nt - 2);
            const char* a1 = cA + (size_t)(t + 1) * kstep;
            const char* a2 = last ? nA : cA + (size_t)(t + 2) * kstep; const char* b2 = last ? nB : cB + (size_t)(t + 2) * kstep;
            const char* a3 = a2 + kstep; const char* b3 = b2 + kstep;
            if constexpr (SP2) {
            PG8_LDB(B0, 0, 0); PG8_LDB(B1, 0, 1); PG8_SCHED; PG8_LDA(At, 0, 0); PG8_STAGEA(PG8_SA(1, 1), a1, 1, false);
            PG8_WAIT_V(8); PG8_WAIT_L(0); PG8_BAR; PG8_MMA(0, 0, At, B0); PG8_MMA(0, 1, At, B1); PG8_BAR; PG8_SCHED;
            PG8_LDA(At, 0, 1); PG8_STAGE(PG8_SB(0, 0), b2, voffB); PG8_STAGE(PG8_SB(0, 1), b2 + hstep, voffB); PG8_STAGEA(PG8_SA(0, 0), a2, 0, last);
            PG8_WAIT_V(8); PG8_WAIT_L(0); PG8_BAR; PG8_MMA(1, 0, At, B0); PG8_MMA(1, 1, At, B1); PG8_BAR; PG8_SCHED;
            PG8_LDB(B0, 1, 0); PG8_LDB(B1, 1, 1); PG8_SCHED; PG8_LDA(At, 1, 0); PG8_STAGEA(PG8_SA(0, 1), a2, 1, last);
            PG8_WAIT_V(8); PG8_WAIT_L(0); PG8_BAR; PG8_MMA(0, 0, At, B0); PG8_MMA(0, 1, At, B1); PG8_BAR; PG8_SCHED;
            PG8_LDA(At, 1, 1); PG8_STAGE(PG8_SB(1, 0), b3, voffB); PG8_STAGE(PG8_SB(1, 1), b3 + hstep, voffB); PG8_STAGEA(PG8_SA(1, 0), a3, 0, last);
            PG8_WAIT_V(8); PG8_WAIT_L(0); PG8_BAR; PG8_MMA(1, 0, At, B0); PG8_MMA(1, 1, At, B1); PG8_BAR; PG8_SCHED;
            } else {
            PG8_LDB(B0, 0, 0); PG8_SCHED; PG8_LDA(At, 0, 0); PG8_STAGEA(PG8_SA(1, 1), a1, 1, false);
            PG8_WAIT_L(8); PG8_BAR; PG8_WAIT_L(0); PG8_MMA(0, 0, At, B0); PG8_BAR; PG8_SCHED;
            PG8_LDB(B1, 0, 1); PG8_STAGE(PG8_SB(0, 0), b2, voffB);
            PG8_BAR; PG8_WAIT_L(0); PG8_MMA(0, 1, At, B1); PG8_BAR;
            PG8_LDA(At, 0, 1); PG8_STAGEA(PG8_SA(0, 0), a2, 0, last);
            PG8_BAR; PG8_WAIT_L(0); PG8_MMA(1, 0, At, B0); PG8_BAR; PG8_SCHED;
            PG8_STAGE(PG8_SB(0, 1), b2 + hstep, voffB);
            PG8_WAIT_V(6); PG8_BAR; PG8_MMA(1, 1, At, B1); PG8_BAR;
            PG8_LDB(B0, 1, 0); PG8_SCHED; PG8_LDA(At, 1, 0); PG8_STAGEA(PG8_SA(0, 1), a2, 1, last);
            PG8_WAIT_L(8); PG8_BAR; PG8_WAIT_L(0); PG8_MMA(0, 0, At, B0); PG8_BAR; PG8_SCHED;
            PG8_LDB(B1, 1, 1); PG8_STAGE(PG8_SB(1, 0), b3, voffB);
            PG8_BAR; PG8_WAIT_L(0); PG8_MMA(0, 1, At, B1); PG8_BAR;
            PG8_LDA(At, 1, 1); PG8_STAGEA(PG8_SA(1, 0), a3, 0, last);
            PG8_BAR; PG8_WAIT_L(0); PG8_MMA(1, 0, At, B0); PG8_BAR; PG8_SCHED;
            PG8_STAGE(PG8_SB(1, 1), b3 + hstep, voffB);
            PG8_WAIT_V(6); PG8_BAR; PG8_MMA(1, 1, At, B1); PG8_BAR;
            }
        }
        if constexpr (ALIGN_EPI) { if (wr == 0) PG8_BAR; }
        E(acc, cur, wr, wc, fr, fq);
        if (!has_next) break;
#pragma unroll
        for (int a = 0; a < 2; ++a)
#pragma unroll
            for (int b = 0; b < 2; ++b)
#pragma unroll
                for (int m = 0; m < 4; ++m)
#pragma unroll
                    for (int n = 0; n < 2; ++n) acc[a][b][m][n] = (f32x4){0.f, 0.f, 0.f, 0.f};
        cur = nxt; cA = nA; cB = nB; ++ui;
        if constexpr (GATHER) { _Pragma("unroll") for (int _h = 0; _h < 2; ++_h) _Pragma("unroll") for (int _i = 0; _i < 2; ++_i) cvA[_h][_i] = nvA[_h][_i]; }
        if constexpr (ALIGN_EPI) { if (wr == 1) PG8_BAR; }
    }
    PG8_WAIT_V(0);
    if constexpr (!ALIGN_EPI) { if (wr == 0) PG8_BAR; }
    PG8_BAR;
#undef PG8_SA
#undef PG8_SB
#undef PG8_STAGE
#undef PG8_STAGEA
#undef PG8_GLOAD
#undef PG8_LDA
#undef PG8_LDB
#undef PG8_MMA
#undef PG8_WAIT_V
#undef PG8_WAIT_L
#undef PG8_BAR
#undef PG8_SCHED
}
}
#ifndef USE_NA_MFMA
#define USE_NA_MFMA 1
#endif
#ifndef USE_GDN_FAST
#define USE_GDN_FAST 1
#endif
#ifndef USE_DIFF_MFMA
#define USE_DIFF_MFMA 1
#endif
constexpr int DM = 1024, BATCH = 2, SEQ = 8192, DEPTH = 4, CTXL = 256, GRIDW = 64;
constexpr int MLAT = BATCH * SEQ, MCTX = BATCH * CTXL, MT = MLAT + MCTX;
constexpr int NP = 8192;
constexpr int PC_GQ = 0, PC_GK = 512, PC_GV = 1024, PC_GZ = 1536, PC_DQ = 2048, PC_DK = 2560, PC_DV = 3072, PC_NQ = 3584, PC_NK = 4096, PC_NV = 4608, PC_GATE = 5120;
constexpr int D_IN = 8208, NEXP = 32, TOPK = 4, DEXP = 1024;
constexpr float LN_EPS = 1e-5f, RMS_EPS = 1e-6f;
constexpr float DN_ALPHA = 1.6817928305074292f;
constexpr int NWAVES = 8, NTHREADS = 512;
constexpr int RG_ROWS = 66, NRG = MT / RG_ROWS;
constexpr int RPAD = MT * TOPK + NEXP * 256;
constexpr int MAXTILES = RPAD / 256;

constexpr size_t MiB = 1u << 20;
constexpr size_t al256(size_t x) { return (x + 255) / 256 * 256; }
constexpr size_t WS_CTL = 0, CTL_ZERO_BYTES = 1 * MiB;
constexpr size_t WS_MOD = WS_CTL + CTL_ZERO_BYTES;
constexpr size_t WS_LAM = WS_MOD + al256((size_t)DEPTH * 3 * 6144 * 4);
constexpr size_t WS_WDEC = WS_LAM + 256;
constexpr size_t WS_WRT = WS_WDEC + (size_t)DEPTH * 16 * 1024 * 4;
constexpr size_t WS_WIN = WS_WRT + (size_t)DEPTH * 32 * 1024 * 4;
constexpr size_t WS_WBR = WS_WIN + (size_t)DEPTH * 8192 * 1024 * 2;
constexpr size_t WS_WOUT = WS_WBR + (size_t)DEPTH * 3 * 1024 * 512 * 2;
constexpr size_t WS_W1 = WS_WOUT + (size_t)DEPTH * 1024 * 1024 * 2;
constexpr size_t WS_W2 = WS_W1 + (size_t)DEPTH * 32 * 2048 * 1024 * 2;
constexpr size_t WS_X = WS_W2 + (size_t)DEPTH * 32 * 1024 * 1024 * 2;
constexpr size_t WS_HX = WS_X + (size_t)MT * DM * 4;
constexpr size_t WS_P = WS_HX + (size_t)MT * DM * 2;
constexpr size_t WS_DEC = WS_P + (size_t)MT * NP * 2;
constexpr size_t WS_QN = WS_DEC + (size_t)MT * 16 * 4;
constexpr size_t WS_KN = WS_QN + (size_t)MT * 512 * 4;
constexpr size_t WS_VV = WS_KN + (size_t)MT * 512 * 4;
constexpr size_t WS_OG = WS_VV + (size_t)MT * 512 * 4;
constexpr size_t WS_OD = WS_OG + (size_t)2 * MT * 512 * 4;
constexpr size_t WS_YA = WS_OD + (size_t)2 * MT * 512 * 4;
constexpr size_t WS_YB = WS_YA + (size_t)MT * 512 * 2;
constexpr size_t WS_YC = WS_YB + (size_t)MT * 512 * 2;
constexpr size_t WS_MACC = WS_YC + (size_t)MT * 512 * 2;
constexpr size_t WS_MBF = WS_MACC + (size_t)MT * DM * 4;
constexpr size_t WS_T = WS_MBF + (size_t)MT * DM * 2;
constexpr size_t WS_TOPE = WS_T + (size_t)MT * DM * 4;
constexpr size_t WS_TOPR = WS_TOPE + (size_t)MT * 4 * 4;
constexpr size_t WS_TOPG = WS_TOPR + (size_t)MT * 4 * 4;
constexpr size_t WS_SLOT = WS_TOPG + (size_t)MT * 4 * 4;
constexpr size_t WS_BLKB = WS_SLOT + (size_t)MT * 4 * 4;
constexpr size_t WS_HP = WS_BLKB + (size_t)NRG * 32 * 4;
constexpr size_t WS_ACT = WS_HP + (size_t)RPAD * 1024 * 2;
constexpr size_t WS_Y = WS_ACT + (size_t)RPAD * 1024 * 2;
constexpr size_t WS_REC = WS_Y + (size_t)RPAD * 1024 * 2;
constexpr size_t WS_U = WS_REC + (size_t)2 * 4 * 2 * 132 * 57344;
constexpr size_t WS_GL = WS_U + (size_t)2 * 4 * 2 * 132 * 16384;
constexpr size_t WS_VT = WS_GL + (size_t)2 * 4 * 2 * 132 * 4 + 256;
constexpr size_t WS_ROWTOK = WS_VT + (size_t)2 * 8 * 64 * 8448 * 2;
constexpr size_t WS_CPART = WS_ROWTOK + (size_t)RPAD * 4;
constexpr size_t WS_DQ = WS_CPART + (size_t)3 * MCTX * DM * 2;
constexpr size_t WS_END = WS_DQ + (size_t)4 * MCTX * DM * 2;
constexpr int CW_BAR = 4096;
constexpr int CW_CNT = 16384;
constexpr int CW_Q = 20480;

constexpr int RING_BYTES = 131072;
constexpr int LDSCTL_OFF = RING_BYTES, MISC_OFF = LDSCTL_OFF + 2048;
constexpr int LDS_BYTES = 147456;

#define RLX_AGENT __ATOMIC_RELAXED, __HIP_MEMORY_SCOPE_AGENT
#define LDS_WAIT() asm volatile("s_waitcnt lgkmcnt(0)" ::: "memory")
#define VM_WAIT() asm volatile("s_waitcnt vmcnt(0)" ::: "memory")
__device__ __forceinline__ float bf2f(unsigned b) { return __uint_as_float(b << 16); }
__device__ __forceinline__ float bflo(unsigned w) { return __uint_as_float(w << 16); }
__device__ __forceinline__ float bfhi(unsigned w) { return __uint_as_float(w & 0xffff0000u); }
__device__ __forceinline__ unsigned f2bf(float f) { unsigned u = __float_as_uint(f); return (u + 0x7fffu + ((u >> 16) & 1u)) >> 16; }
__device__ __forceinline__ unsigned pk2(float lo, float hi) { return pg8::cvt_pk_bf16(lo, hi); }
__device__ __forceinline__ float siluf(float x) { return x / (1.f + __expf(-x)); }
__device__ __forceinline__ float sigmf(float x) { return 1.f / (1.f + __expf(-x)); }

#define XB_TMO      128
#define XB_XCNT(j)  (256  + 64 * (j))
#define XB_XSUB(j)  (1280 + 64 * (j))
#define XB_XGEN(j)  (2304 + 64 * (j))
#define XB_TOP      3328
#define XB_TOPGEN   3392
#define XCD_BAR_WORDS 3456
#define XB_SPIN_CAP (1u << 22)
__device__ __forceinline__ unsigned xb_ld(unsigned* p)              { return __hip_atomic_load(p, __ATOMIC_RELAXED, __HIP_MEMORY_SCOPE_AGENT); }
__device__ __forceinline__ unsigned xb_add(unsigned* p, unsigned v) { return __hip_atomic_fetch_add(p, v, __ATOMIC_RELAXED, __HIP_MEMORY_SCOPE_AGENT); }
__device__ __forceinline__ unsigned xb_xcc_id() { return (unsigned)__builtin_amdgcn_s_getreg((3 << 11) | 20) & 0xFu; }
#define XB_SPIN(cond, bar) do { unsigned _sp = 0; while (cond) { __builtin_amdgcn_s_sleep(1); \
    if ((++_sp & 255u) == 0u) { if (xb_ld(&(bar)[XB_TMO])) break; if (_sp > XB_SPIN_CAP) { atomicAdd(&(bar)[XB_TMO], 1u); break; } } } } while (0)
struct XcdBarrier { unsigned* bar; unsigned x; volatile LAS unsigned* st; };
__device__ __forceinline__ XcdBarrier xcd_barrier_post(unsigned* bar, volatile LAS unsigned* st) {
    XcdBarrier b; b.bar = bar; b.x = xb_xcc_id(); b.st = st;
    if (threadIdx.x == 0) (void)xb_add(&bar[XB_XCNT(b.x)], 1u);
    return b;
}
__device__ __forceinline__ void xcd_barrier_complete(unsigned* bar, unsigned x, unsigned& nloc, unsigned& nx) {
    const unsigned G = gridDim.x * gridDim.y * gridDim.z;
    unsigned sum, cnt, mine, sp = 0u;
    for (;;) {
        sum = 0u; cnt = 0u; mine = 0u;
#pragma unroll
        for (unsigned j = 0; j < 16; ++j) { const unsigned c = xb_ld(&bar[XB_XCNT(j)]); sum += c; cnt += (c > 0u) ? 1u : 0u; mine = (j == x) ? c : mine; }
        if (sum == G) break;
        __builtin_amdgcn_s_sleep(1);
        if ((++sp & 255u) == 0u) { if (xb_ld(&bar[XB_TMO])) break; if (sp > XB_SPIN_CAP) { atomicAdd(&bar[XB_TMO], 1u); break; } }
    }
    nloc = mine > 0u ? mine : 1u; nx = cnt > 0u ? cnt : 1u;
}
__device__ __forceinline__ void xcd_barrier(const XcdBarrier& b) {
#ifdef BAR_BRUTE
    __builtin_amdgcn_fence(__ATOMIC_RELEASE, "agent");
#endif
    asm volatile("s_waitcnt vmcnt(0)" ::: "memory");
    __syncthreads();
    if (threadIdx.x == 0) {
        unsigned* bar = b.bar;
        __builtin_amdgcn_s_waitcnt(0);
        unsigned nloc = b.st[0], nx = b.st[1];
        if (nloc == 0u) { xcd_barrier_complete(bar, b.x, nloc, nx); b.st[0] = nloc; b.st[1] = nx; }
        const unsigned old = xb_add(&bar[XB_XSUB(b.x)], 1u);
        const unsigned gen = old / nloc;
        if (old + 1u == (gen + 1u) * nloc) {
            __builtin_amdgcn_fence(__ATOMIC_RELEASE, "agent");
            asm volatile("s_waitcnt vmcnt(0)" ::: "memory");
            const unsigned og = xb_add(&bar[XB_TOP], 1u);
            const unsigned tg = og / nx;
            if (og + 1u == (tg + 1u) * nx) xb_add(&bar[XB_TOPGEN], 1u);
            else XB_SPIN(xb_ld(&bar[XB_TOPGEN]) == tg, bar);
            __builtin_amdgcn_fence(__ATOMIC_ACQUIRE, "agent");
            xb_add(&bar[XB_XGEN(b.x)], 1u);
            asm volatile("s_waitcnt vmcnt(0)" ::: "memory");
        } else {
            XB_SPIN(xb_ld(&bar[XB_XGEN(b.x)]) == gen, bar);
            __builtin_amdgcn_fence(__ATOMIC_ACQUIRE, "agent");
            asm volatile("s_waitcnt vmcnt(0)" ::: "memory");
        }
    }
    __syncthreads();
#ifdef BAR_BRUTE
    __builtin_amdgcn_fence(__ATOMIC_ACQUIRE, "agent");
    asm volatile("s_waitcnt vmcnt(0)" ::: "memory");
    __syncthreads();
#endif
}

struct Args { const float* in[24]; float* out; unsigned char* ws; int ph_lo, ph_hi; };
enum { I_X = 0, I_C, I_CTX, I_CCTX, I_WADA, I_BADA, I_WIN, I_CONVW, I_ALOG, I_DTB, I_GNW, I_DLAM, I_DNW, I_RPB, I_WBR, I_WOUT, I_LNG, I_LNB, I_WR, I_BR, I_W1, I_B1, I_W2, I_B2 };
typedef const __attribute__((address_space(4))) Args* ArgsP;
struct Ctx { LAS unsigned char* lds; unsigned char* ws; ArgsP ap; int G, bid, wv; };
#define AIN(i) ((const float*)(const GAS float*)(a->in[i]))
#define AOUT ((float*)(GAS float*)(a->out))
#define XROW0(row) ((row) < MLAT ? AIN(I_X) + (size_t)(row) * DM : AIN(I_CTX) + (size_t)((row) - MLAT) * DM)
#define PHASE_FN __device__ __forceinline__
__device__ __forceinline__ int rfl(int v) { return __builtin_amdgcn_readfirstlane(v); }
struct Frame {
    ArgsP ap;
    LAS unsigned char* lds;
    unsigned* ctl;
    GAS unsigned char* ws;
    int tid, lane, wave, G, bid, wv;
};
#define REFRESH(F) do { int l_; asm volatile("v_mbcnt_lo_u32_b32 %0, -1, 0\n\tv_mbcnt_hi_u32_b32 %0, -1, %0" : "=v"(l_)); (F).lane = l_; (F).wave = (F).wv; (F).tid = (F).wv * 64 + l_; } while (0)
__device__ __forceinline__ Frame mkframe(const Ctx& c) {
    Frame F;
    F.lds = (LAS unsigned char*)(size_t)(unsigned)rfl((int)(unsigned)(size_t)c.lds);
    { const unsigned long long w = (unsigned long long)c.ws; F.ws = (GAS unsigned char*)(((unsigned long long)(unsigned)rfl((int)(unsigned)(w >> 32)) << 32) | (unsigned)rfl((int)(unsigned)w)); }
    { const unsigned long long w = (unsigned long long)c.ap; F.ap = (ArgsP)(((unsigned long long)(unsigned)rfl((int)(unsigned)(w >> 32)) << 32) | (unsigned)rfl((int)(unsigned)w)); }
    F.ctl = (unsigned*)(GAS unsigned*)F.ws; F.G = rfl(c.G); F.bid = rfl(c.bid); F.wv = rfl(c.wv); F.wave = F.wv; F.lane = 0; F.tid = 0;
    return F;
}
__device__ __forceinline__ int lane_id() { return (int)__builtin_amdgcn_mbcnt_hi(~0u, __builtin_amdgcn_mbcnt_lo(~0u, 0u)); }
template <int CTRL> __device__ __forceinline__ float dppf(float v) { return __builtin_bit_cast(float, __builtin_amdgcn_update_dpp(0, __builtin_bit_cast(int, v), CTRL, 0xF, 0xF, true)); }
template <int K> __device__ __forceinline__ float xorl(float v) {
    if constexpr (K == 1) return dppf<0xB1>(v);
    else if constexpr (K == 2) return dppf<0x4E>(v);
    else if constexpr (K == 4 || K == 8) { const float up = dppf<0x100 + K>(v), dn = dppf<0x110 + K>(v); return (lane_id() & K) ? dn : up; }
    else if constexpr (K == 16) { const auto r = __builtin_amdgcn_permlane16_swap(__float_as_uint(v), __float_as_uint(v), false, false); return (lane_id() & 16) ? __uint_as_float(r[0]) : __uint_as_float(r[1]); }
    else { const auto r = __builtin_amdgcn_permlane32_swap(__float_as_uint(v), __float_as_uint(v), false, false); return (lane_id() & 32) ? __uint_as_float(r[0]) : __uint_as_float(r[1]); }
}
__device__ __forceinline__ float wave_sum(float v) {
    v += xorl<1>(v); v += xorl<2>(v); v += xorl<4>(v); v += xorl<8>(v);
    { const auto r = __builtin_amdgcn_permlane16_swap(__float_as_uint(v), __float_as_uint(v), false, false); v = __uint_as_float(r[0]) + __uint_as_float(r[1]); }
    { const auto r = __builtin_amdgcn_permlane32_swap(__float_as_uint(v), __float_as_uint(v), false, false); v = __uint_as_float(r[0]) + __uint_as_float(r[1]); }
    return v;
}
__device__ __forceinline__ float wave_max(float v) {
    v = fmaxf(v, xorl<1>(v)); v = fmaxf(v, xorl<2>(v)); v = fmaxf(v, xorl<4>(v)); v = fmaxf(v, xorl<8>(v)); v = fmaxf(v, xorl<16>(v)); v = fmaxf(v, xorl<32>(v));
    return v;
}
__device__ __forceinline__ int mod_index(int row) { return row < MLAT ? (row >> 13) : 2; }
static_assert(WS_YB == WS_YA + (size_t)MT * 512 * 2 && WS_YC == WS_YB + (size_t)MT * 512 * 2, "YA|YB|YC contiguous");
struct ConvItem { const float* W; bf16* WT; int ldw, K, src_col0, dst_row0, k0; };
__device__ __forceinline__ void conv_load(const ConvItem& c, f32x4 (&wv)[8], int lane) {
#pragma unroll
    for (int i = 0; i < 8; ++i) { const int kk = 8 * i + (lane >> 3); wv[i] = *(const f32x4*)(c.W + (size_t)(c.k0 + kk) * c.ldw + c.src_col0 + 4 * (lane & 7)); }
}
__device__ __forceinline__ void conv_finish(const ConvItem& cI, const f32x4 (&wv)[8], LAS float* scr, int lane) {
#pragma unroll
    for (int i = 0; i < 8; ++i) { const int kk = 8 * i + (lane >> 3); LAS float* d = scr + kk * 33 + 4 * (lane & 7); d[0] = wv[i].x; d[1] = wv[i].y; d[2] = wv[i].z; d[3] = wv[i].w; }
    LDS_WAIT(); asm volatile("" ::: "memory");
    const int c = lane & 7;
#pragma unroll
    for (int j = 0; j < 4; ++j) { const int n = (lane >> 3) + 8 * j; const LAS float* s = scr + (8 * c) * 33 + n;
        u32x4 o; o.x = pk2(s[0 * 33], s[1 * 33]); o.y = pk2(s[2 * 33], s[3 * 33]); o.z = pk2(s[4 * 33], s[5 * 33]); o.w = pk2(s[6 * 33], s[7 * 33]);
        *(u32x4*)(cI.WT + (size_t)(cI.dst_row0 + n) * cI.K + cI.k0 + 8 * c) = o; }
    LDS_WAIT(); asm volatile("" ::: "memory");
}
constexpr int ITL_WIN = 16 * 256, ITL_WBR = 3 * 8 * 32, ITL_WOUT = 16 * 32, ITL_W1 = 32 * 16 * 64, ITL_W2 = 32 * 16 * 32, ITL_ALL = ITL_WIN + ITL_WBR + ITL_WOUT + ITL_W1 + ITL_W2, ITL_PRE = ITL_WIN + ITL_WBR + ITL_WOUT;
__device__ __forceinline__ ConvItem conv_decode(const Frame& F, const ArgsP a, int l, int it) {
    GAS unsigned char* ws = F.ws; int r = it; ConvItem c;
    if (r < ITL_WIN) { const int kb = r / 256, nb = r % 256, d0 = 32 * nb, s0 = d0 + (d0 >= 2048 ? 16 : 0);
        c.W = AIN(I_WIN) + (size_t)l * 1024 * D_IN; c.ldw = D_IN; c.K = 1024; c.src_col0 = s0; c.WT = (bf16*)(ws + WS_WIN) + (size_t)l * 8192 * 1024; c.dst_row0 = d0; c.k0 = 64 * kb; return c; }
    r -= ITL_WIN;
    if (r < ITL_WBR) { const int mi = l * 3 + r / 256, q = r % 256, kb = q / 32, nb = q % 32;
        c.W = AIN(I_WBR) + (size_t)mi * 512 * 1024; c.ldw = 1024; c.K = 512; c.src_col0 = 32 * nb; c.WT = (bf16*)(ws + WS_WBR) + (size_t)mi * 1024 * 512; c.dst_row0 = 32 * nb; c.k0 = 64 * kb; return c; }
    r -= ITL_WBR;
    if (r < ITL_WOUT) { const int kb = r / 32, nb = r % 32;
        c.W = AIN(I_WOUT) + (size_t)l * 1024 * 1024; c.ldw = 1024; c.K = 1024; c.src_col0 = 32 * nb; c.WT = (bf16*)(ws + WS_WOUT) + (size_t)l * 1024 * 1024; c.dst_row0 = 32 * nb; c.k0 = 64 * kb; return c; }
    r -= ITL_WOUT;
    if (r < ITL_W1) { const int mi = l * 32 + r / 1024, q = r % 1024, kb = q / 64, nb = q % 64, d0 = 32 * nb, pn = d0 >> 8, bj = (d0 >> 7) & 1, j = d0 & 127, s0 = 1024 * bj + 128 * pn + j;
        c.W = AIN(I_W1) + (size_t)mi * 1024 * 2048; c.ldw = 2048; c.K = 1024; c.src_col0 = s0; c.WT = (bf16*)(ws + WS_W1) + (size_t)mi * 2048 * 1024; c.dst_row0 = d0; c.k0 = 64 * kb; return c; }
    r -= ITL_W1;
    { const int mi = l * 32 + r / 512, q = r % 512, kb = q / 32, nb = q % 32;
        c.W = AIN(I_W2) + (size_t)mi * 1024 * 1024; c.ldw = 1024; c.K = 1024; c.src_col0 = 32 * nb; c.WT = (bf16*)(ws + WS_W2) + (size_t)mi * 1024 * 1024; c.dst_row0 = 32 * nb; c.k0 = 64 * kb; return c; }
}
__device__ __forceinline__ void conv_run(const Frame& F, const ArgsP a, int l, int it0, int stride, int count, LAS float* scr) {
    f32x4 wA[8], wB[8], wC[8], wD[8];
    ConvItem cA = conv_decode(F, a, l, it0), cB = cA, cC = cA, cD = cA; conv_load(cA, wA, F.lane);
    if (1 < count) { cB = conv_decode(F, a, l, it0 + stride); conv_load(cB, wB, F.lane); }
    if (2 < count) { cC = conv_decode(F, a, l, it0 + 2 * stride); conv_load(cC, wC, F.lane); }
    if (3 < count) { cD = conv_decode(F, a, l, it0 + 3 * stride); conv_load(cD, wD, F.lane); }
#pragma unroll 1
    for (int n = 0; n < count; n += 4) {
        conv_finish(cA, wA, scr, F.lane);
        if (n + 4 < count) { cA = conv_decode(F, a, l, it0 + (n + 4) * stride); conv_load(cA, wA, F.lane); }
        if (n + 1 < count) { conv_finish(cB, wB, scr, F.lane);
            if (n + 5 < count) { cB = conv_decode(F, a, l, it0 + (n + 5) * stride); conv_load(cB, wB, F.lane); } }
        if (n + 2 < count) { conv_finish(cC, wC, scr, F.lane);
            if (n + 6 < count) { cC = conv_decode(F, a, l, it0 + (n + 6) * stride); conv_load(cC, wC, F.lane); } }
        if (n + 3 < count) { conv_finish(cD, wD, scr, F.lane);
            if (n + 7 < count) { cD = conv_decode(F, a, l, it0 + (n + 7) * stride); conv_load(cD, wD, F.lane); } }
    }
}

PHASE_FN void p0_prologue(Ctx cx) {
    Frame F = mkframe(cx); const ArgsP a = F.ap;
    REFRESH(F);
    GAS unsigned char* ws = F.ws;
    LAS float* scr = (LAS float*)(F.lds + F.wave * 16384);
    const int gw = F.bid * NWAVES + F.wave, NGW = F.G * NWAVES;
    if (gw < ITL_PRE) conv_run(F, a, 0, gw, NGW, (ITL_PRE - gw + NGW - 1) / NGW, scr);
    const size_t gt = (size_t)F.bid * NTHREADS + F.tid, NGT = (size_t)F.G * NTHREADS;
    { float* wd = (float*)(ws + WS_WDEC);
      for (size_t i = gt; i < (size_t)DEPTH * 16 * 1024; i += NGT) { const int l = (int)(i >> 14), c = (int)(i >> 10) & 15, k = (int)i & 1023; wd[i] = AIN(I_WIN)[((size_t)l * 1024 + k) * D_IN + 2048 + c]; }
      float* wr = (float*)(ws + WS_WRT);
      for (size_t i = gt; i < (size_t)DEPTH * 32 * 1024; i += NGT) { const int l = (int)(i >> 15), e = (int)(i >> 10) & 31, k = (int)i & 1023; wr[i] = AIN(I_WR)[((size_t)l * 1024 + k) * 32 + e]; } }
    if (F.bid == 0 && F.wave < DEPTH) { const int l = F.wave; const float* lv = AIN(I_DLAM) + l * 256;
        const float s1 = wave_sum(lv[F.lane] * lv[64 + F.lane]), s2 = wave_sum(lv[128 + F.lane] * lv[192 + F.lane]);
        if (F.lane == 0) ((float*)(ws + WS_LAM))[l] = expf(s1) - expf(s2) + (0.8f - 0.6f * expf(-0.3f * (float)l)); }
    { LAS float* sc = (LAS float*)(F.lds);
      LAS float* red = sc + 3072;
      float* MOD = (float*)(ws + WS_MOD);
      __syncthreads();
      for (int i = F.tid; i < 3072; i += NTHREADS) sc[i] = siluf(i < 2048 ? AIN(I_C)[i] : AIN(I_CCTX)[i - 2048]);
      __syncthreads();
      for (int it = F.bid; it < DEPTH * 48; it += F.G) {
        const int l = it / 48, n0 = (it % 48) * 128; const float* wa = AIN(I_WADA) + (size_t)l * 1024 * 6144 + n0 + 2 * F.lane;
        f32x2 a0 = {0.f, 0.f}, a1 = {0.f, 0.f}, a2 = {0.f, 0.f};
#pragma unroll 32
        for (int k = F.wave * 128; k < F.wave * 128 + 128; ++k) { const f32x2 w = *(const f32x2*)(wa + (size_t)k * 6144);
            const float s0 = sc[k], s1 = sc[1024 + k], s2 = sc[2048 + k]; a0 += w * s0; a1 += w * s1; a2 += w * s2; }
        *(LAS f32x2*)(red + (F.wave * 3 + 0) * 128 + 2 * F.lane) = a0; *(LAS f32x2*)(red + (F.wave * 3 + 1) * 128 + 2 * F.lane) = a1; *(LAS f32x2*)(red + (F.wave * 3 + 2) * 128 + 2 * F.lane) = a2;
        __syncthreads();
        if (F.tid < 384) { const int i = F.tid >> 7, c = F.tid & 127; float s = 0.f;
#pragma unroll
            for (int w = 0; w < 8; ++w) s += red[(w * 3 + i) * 128 + c];
            MOD[((size_t)l * 3 + i) * 6144 + n0 + c] = s + AIN(I_BADA)[l * 6144 + n0 + c]; }
        __syncthreads();
      } }
}

__device__ __forceinline__ void ln_inplace(f32x4 (&v)[4]) {
    float s = 0.f;
#pragma unroll
    for (int j = 0; j < 4; ++j) s += (v[j].x + v[j].y) + (v[j].z + v[j].w);
    const float mean = wave_sum(s) * (1.f / DM); float s2 = 0.f;
#pragma unroll
    for (int j = 0; j < 4; ++j) { v[j] = v[j] - mean; s2 += (v[j].x * v[j].x + v[j].y * v[j].y) + (v[j].z * v[j].z + v[j].w * v[j].w); }
    const float rstd = 1.f / sqrtf(wave_sum(s2) * (1.f / DM) + LN_EPS);
#pragma unroll
    for (int j = 0; j < 4; ++j) v[j] = v[j] * rstd;
}
__device__ __forceinline__ void modulate_store(const Frame& F, int l, int which, int row, f32x4 (&v)[4]) {
    ln_inplace(v);
    const float* mod = (const float*)(F.ws + WS_MOD) + ((size_t)l * 3 + mod_index(row)) * 6144 + which * 3072;
    bf16* hx = (bf16*)(F.ws + WS_HX) + (size_t)row * DM;
#pragma unroll
    for (int j = 0; j < 4; ++j) { const int c = 4 * F.lane + 256 * j; const f32x4 sh = *(const f32x4*)(mod + c), sc = *(const f32x4*)(mod + 1024 + c);
        v[j] = v[j] * (sc + 1.f) + sh;
        u32x2 o; o.x = pk2(v[j].x, v[j].y); o.y = pk2(v[j].z, v[j].w); *(u32x2*)(hx + c) = o; }
}
__device__ __forceinline__ void stage_wdec(const Frame& F, int l) {
    const f32x4* src = (const f32x4*)((const float*)(F.ws + WS_WDEC) + (size_t)l * 16 * 1024); LAS f32x4* dst = (LAS f32x4*)F.lds;
    __syncthreads();
    for (int i = F.tid; i < 16 * 256; i += NTHREADS) dst[i] = src[i];
    __syncthreads();
}
__device__ __forceinline__ void decay_cols(const Frame& F, int l, int row, const f32x4 (&h)[4]) {
    const LAS float* wd = (const LAS float*)F.lds; float* dec = (float*)(F.ws + WS_DEC) + (size_t)row * 16;
    float p[16];
#pragma unroll
    for (int i = 0; i < 16; ++i) { float s = 0.f;
#pragma unroll
        for (int j = 0; j < 4; ++j) { const f32x4 w = *(const LAS f32x4*)(wd + i * 1024 + 4 * F.lane + 256 * j); s += (h[j].x * w.x + h[j].y * w.y) + (h[j].z * w.z + h[j].w * w.w); }
        p[i] = s; if ((i & 7) == 7) asm volatile("" ::: "memory"); }
#pragma unroll
    for (int i2 = 0; i2 < 8; ++i2) { const bool up = (F.lane & 32) != 0; const float send = up ? p[i2] : p[i2 + 8], keep = up ? p[i2 + 8] : p[i2]; p[i2] = keep + xorl<32>(send); }
#pragma unroll
    for (int i2 = 0; i2 < 4; ++i2) { const bool up = (F.lane & 16) != 0; const float send = up ? p[i2] : p[i2 + 4], keep = up ? p[i2 + 4] : p[i2]; p[i2] = keep + xorl<16>(send); }
#pragma unroll
    for (int i2 = 0; i2 < 2; ++i2) { const bool up = (F.lane & 8) != 0; const float send = up ? p[i2] : p[i2 + 2], keep = up ? p[i2 + 2] : p[i2]; p[i2] = keep + xorl<8>(send); }
    { const bool up = (F.lane & 4) != 0; const float send = up ? p[0] : p[1], keep = up ? p[1] : p[0]; p[0] = keep + xorl<4>(send); }
    p[0] += xorl<2>(p[0]); p[0] += xorl<1>(p[0]);
    if ((F.lane & 3) == 0) dec[F.lane >> 2] = p[0];
}

__device__ __forceinline__ void decay_cols2(const Frame& F, int rowA, const f32x4 (&hA)[4], int rowB, const f32x4 (&hB)[4]) {
    const LAS float* wd = (const LAS float*)F.lds;
    float p[16], q[16];
#pragma unroll
    for (int i = 0; i < 16; ++i) { f32x2 s = {0.f, 0.f}, t = {0.f, 0.f};
#pragma unroll
        for (int j = 0; j < 4; ++j) { const f32x4 w = *(const LAS f32x4*)(wd + i * 1024 + 4 * F.lane + 256 * j); const f32x2 wl = {w.x, w.y}, wh = {w.z, w.w};
            s += (f32x2){hA[j].x, hA[j].y} * wl; s += (f32x2){hA[j].z, hA[j].w} * wh; t += (f32x2){hB[j].x, hB[j].y} * wl; t += (f32x2){hB[j].z, hB[j].w} * wh; }
        p[i] = s.x + s.y; q[i] = t.x + t.y; if ((i & 7) == 7) asm volatile("" ::: "memory"); }
#define DEC_BFLY(p) do { \
    _Pragma("unroll") for (int i2 = 0; i2 < 8; ++i2) { const bool up = (F.lane & 32) != 0; const float send = up ? p[i2] : p[i2 + 8], keep = up ? p[i2 + 8] : p[i2]; p[i2] = keep + xorl<32>(send); } \
    _Pragma("unroll") for (int i2 = 0; i2 < 4; ++i2) { const bool up = (F.lane & 16) != 0; const float send = up ? p[i2] : p[i2 + 4], keep = up ? p[i2 + 4] : p[i2]; p[i2] = keep + xorl<16>(send); } \
    _Pragma("unroll") for (int i2 = 0; i2 < 2; ++i2) { const bool up = (F.lane & 8) != 0; const float send = up ? p[i2] : p[i2 + 2], keep = up ? p[i2 + 2] : p[i2]; p[i2] = keep + xorl<8>(send); } \
    { const bool up = (F.lane & 4) != 0; const float send = up ? p[0] : p[1], keep = up ? p[1] : p[0]; p[0] = keep + xorl<4>(send); } \
    p[0] += xorl<2>(p[0]); p[0] += xorl<1>(p[0]); } while (0)
    DEC_BFLY(p); DEC_BFLY(q);
#undef DEC_BFLY
    if ((F.lane & 3) == 0) { ((float*)(F.ws + WS_DEC) + (size_t)rowA * 16)[F.lane >> 2] = p[0]; ((float*)(F.ws + WS_DEC) + (size_t)rowB * 16)[F.lane >> 2] = q[0]; }
}

PHASE_FN void ph_lnmod0(Ctx cx) {
    Frame F = mkframe(cx);
    REFRESH(F);
    const int gw = F.bid * NWAVES + F.wave, NGW = F.G * NWAVES;
    stage_wdec(F, 0);
    const ArgsP a = F.ap;
    f32x4 nv[4], pv[4]; bool havep = false; int prow = 0;
#pragma unroll
    for (int j = 0; j < 4; ++j) pv[j] = (f32x4){0.f, 0.f, 0.f, 0.f};
    if (gw < MT) { const f32x4* xr = (const f32x4*)XROW0(gw) + F.lane;
#pragma unroll
        for (int j = 0; j < 4; ++j) nv[j] = xr[64 * j]; }
    for (int row = gw; row < MT; row += NGW) { f32x4 v[4];
#pragma unroll
        for (int j = 0; j < 4; ++j) v[j] = nv[j];
        if (row + NGW < MT) { const f32x4* xr = (const f32x4*)XROW0(row + NGW) + F.lane;
#pragma unroll
            for (int j = 0; j < 4; ++j) nv[j] = xr[64 * j]; }
        modulate_store(F, 0, 0, row, v);
        if (havep) { decay_cols2(F, prow, pv, row, v); havep = false; }
        else { havep = true; prow = row;
#pragma unroll
            for (int j = 0; j < 4; ++j) pv[j] = v[j]; } }
    if (havep) decay_cols(F, 0, prow, pv);
}

struct TileMap {
    __device__ static __forceinline__ bool map(int i, int G, int c, int nM, int nN, int& pm, int& pn) {
        const int nwg = nM * nN; const long L = (long)i * G + c; if (L >= nwg) return false;
        int wgid = (int)L; { const int q = nwg / 8, r = nwg % 8, xcd = wgid % 8, off = wgid / 8; wgid = (xcd < r ? xcd * (q + 1) : r * (q + 1) + (xcd - r) * q) + off; }
        const int nig = 8 * nN, gid = wgid / nig, fm = gid * 8, gsz = (nM - fm) < 8 ? (nM - fm) : 8;
        pm = fm + ((wgid % nig) % gsz); pn = (wgid % nig) / gsz; return true; }
};
struct StaticOrder { int nM, nN, G, c, K;
    __device__ __forceinline__ bool next(int i, pg8::Unit& u) const { if (!TileMap::map(i, G, c, nM, nN, u.pm, u.pn)) return false; u.aux = 0;
        u.aoff = (unsigned)u.pm * 256u * (unsigned)K * 2u; u.boff = (unsigned)u.pn * 256u * (unsigned)K * 2u; return true; } };
struct MergeOrder { int G, c, nctx;
    __device__ __forceinline__ bool next(int i, pg8::Unit& u) const {
        const int nlat = c < 256 ? (256 - c + G - 1) / G : 0;
        if (i < 3 * nlat) { const int br = i % 3; TileMap::map(i / 3, G, c, MLAT / 256, 4, u.pm, u.pn); u.aux = br;
            u.aoff = (unsigned)br * (unsigned)(MT * 512 * 2) + (unsigned)u.pm * (256u * 512u * 2u); u.boff = ((unsigned)br * 1024u + (unsigned)u.pn * 256u) * (512u * 2u); return true; }
        const int v = c + (i - 3 * nlat) * G; if (v >= nctx) return false;
        const int ct = v / 3, br = v % 3; u.pm = MLAT / 256 + (ct >> 2); u.pn = ct & 3; u.aux = 4 + br;
        u.aoff = (unsigned)br * (unsigned)(MT * 512 * 2) + (unsigned)u.pm * (256u * 512u * 2u); u.boff = ((unsigned)br * 1024u + (unsigned)u.pn * 256u) * (512u * 2u); return true; } };
struct MoeOrder { const volatile LAS int* tab; int gather;
    __device__ __forceinline__ bool next(int i, pg8::Unit& u) const { const int w = tab[416 + i]; if (w < 0) return false; u.pm = w & 0xfff; u.pn = (w >> 12) & 0xf; u.aux = (w >> 16) & 0xff; const int nN = (w >> 24) & 0xf;
        u.aoff = gather ? 0u : (unsigned)u.pm * (256u * 1024u * 2u); u.boff = (unsigned)((u.aux * nN + u.pn) * 256) * (1024u * 2u); return true; } };

struct EpiWin { bf16* P;
    __device__ __forceinline__ void operator()(const f32x4 (&acc)[2][2][4][2], const pg8::Unit& u, int wr, int wc, int fr, int fq) const {
        const int row0 = u.pm * 256 + wr * 64 + fr, col0 = u.pn * 256 + wc * 32 + 8 * fq; const bool sg = u.pn >= 20;
#pragma unroll
        for (int ai = 0; ai < 2; ++ai)
#pragma unroll
            for (int m = 0; m < 4; ++m) { bf16* rowp = P + (size_t)(row0 + ai * 128 + m * 16) * NP + col0;
#pragma unroll
                for (int bj = 0; bj < 2; ++bj) { f32x4 v0 = acc[ai][bj][m][0], v1 = acc[ai][bj][m][1];
                    if (sg) {
#pragma unroll
                        for (int q = 0; q < 4; ++q) { v0[q] = sigmf(v0[q]); v1[q] = sigmf(v1[q]); } }
                    u32x4 w; w.x = pk2(v0[0], v0[1]); w.y = pk2(v0[2], v0[3]); w.z = pk2(v1[0], v1[1]); w.w = pk2(v1[2], v1[3]);
                    *(u32x4*)(rowp + bj * 128) = w; } }
    } };
struct EpiMerge { const bf16* P; bf16* MACC; bf16* MBF; bf16* CPART;
    __device__ __forceinline__ void operator()(const f32x4 (&acc)[2][2][4][2], const pg8::Unit& u, int wr, int wc, int fr, int fq) const {
        const int row0 = u.pm * 256 + wr * 64 + fr, col0 = u.pn * 256 + wc * 32 + 8 * fq; const bool isctx = u.aux >= 4; const int br = u.aux & 3;
        bf16* dstb = isctx ? CPART + (size_t)br * MCTX * DM - (size_t)MLAT * DM : (br < 2 ? MACC : MBF);
#pragma unroll
        for (int ai = 0; ai < 2; ++ai) {
            u32x4 g[4][2], mc[4][2];
#pragma unroll
            for (int m = 0; m < 4; ++m)
#pragma unroll
                for (int bj = 0; bj < 2; ++bj) { const size_t row = (size_t)(row0 + ai * 128 + m * 16); const int col = col0 + bj * 128;
                    g[m][bj] = *(const u32x4*)(P + row * NP + PC_GATE + 1024 * br + col);
                    if (br > 0 && !isctx) mc[m][bj] = *(const u32x4*)(MACC + row * DM + col); else mc[m][bj] = (u32x4){0u, 0u, 0u, 0u}; }
#pragma unroll
            for (int m = 0; m < 4; ++m)
#pragma unroll
                for (int bj = 0; bj < 2; ++bj) { const size_t row = (size_t)(row0 + ai * 128 + m * 16); const int col = col0 + bj * 128; const u32x4 gg = g[m][bj], mm = mc[m][bj];
                    const f32x4 v0 = acc[ai][bj][m][0], v1 = acc[ai][bj][m][1]; u32x4 w;
                    w.x = pk2(v0[0] * bflo(gg.x) + bflo(mm.x), v0[1] * bfhi(gg.x) + bfhi(mm.x)); w.y = pk2(v0[2] * bflo(gg.y) + bflo(mm.y), v0[3] * bfhi(gg.y) + bfhi(mm.y));
                    w.z = pk2(v1[0] * bflo(gg.z) + bflo(mm.z), v1[1] * bfhi(gg.z) + bfhi(mm.z)); w.w = pk2(v1[2] * bflo(gg.w) + bflo(mm.w), v1[3] * bfhi(gg.w) + bfhi(mm.w));
                    *(u32x4*)(dstb + row * DM + col) = w; }
            asm volatile("" ::: "memory");
        }
    } };
struct EpiWout { bf16* Dm;
    __device__ __forceinline__ void operator()(const f32x4 (&acc)[2][2][4][2], const pg8::Unit& u, int wr, int wc, int fr, int fq) const {
        const int row0 = u.pm * 256 + wr * 64 + fr, col0 = u.pn * 256 + wc * 32 + 8 * fq;
#pragma unroll
        for (int ai = 0; ai < 2; ++ai)
#pragma unroll
            for (int m = 0; m < 4; ++m) { bf16* rowp = Dm + (size_t)(row0 + ai * 128 + m * 16) * DM + col0;
#pragma unroll
                for (int bj = 0; bj < 2; ++bj) { const f32x4 v0 = acc[ai][bj][m][0], v1 = acc[ai][bj][m][1];
                    u32x4 w; w.x = pk2(v0[0], v0[1]); w.y = pk2(v0[2], v0[3]); w.z = pk2(v1[0], v1[1]); w.w = pk2(v1[2], v1[3]); *(u32x4*)(rowp + bj * 128) = w; } }
    } };
struct WoutCtxOrder { int G, c;
    __device__ __forceinline__ bool next(int i, pg8::Unit& u) const { const int v = c + i * G; if (v >= 32) return false; const int ct = v >> 2, kq = v & 3;
        u.pm = MLAT / 256 + (ct >> 2); u.pn = ct & 3; u.aux = kq; u.aoff = (unsigned)u.pm * (256u * 1024u * 2u) + (unsigned)kq * 512u; u.boff = (unsigned)u.pn * (256u * 1024u * 2u) + (unsigned)kq * 512u; return true; } };
struct EpiWoutCtx { bf16* Dq;
    __device__ __forceinline__ void operator()(const f32x4 (&acc)[2][2][4][2], const pg8::Unit& u, int wr, int wc, int fr, int fq) const {
        const int row0 = (u.pm - MLAT / 256) * 256 + wr * 64 + fr, col0 = u.pn * 256 + wc * 32 + 8 * fq; bf16* base = Dq + (size_t)u.aux * MCTX * DM;
#pragma unroll
        for (int ai = 0; ai < 2; ++ai)
#pragma unroll
            for (int m = 0; m < 4; ++m) { bf16* rowp = base + (size_t)(row0 + ai * 128 + m * 16) * DM + col0;
#pragma unroll
                for (int bj = 0; bj < 2; ++bj) { const f32x4 v0 = acc[ai][bj][m][0], v1 = acc[ai][bj][m][1];
                    u32x4 w; w.x = pk2(v0[0], v0[1]); w.y = pk2(v0[2], v0[3]); w.z = pk2(v1[0], v1[1]); w.w = pk2(v1[2], v1[3]); *(u32x4*)(rowp + bj * 128) = w; } }
    } };
struct EpiAct { const float* B1; bf16* ACT;
    __device__ __forceinline__ void operator()(const f32x4 (&acc)[2][2][4][2], const pg8::Unit& u, int wr, int wc, int fr, int fq) const {
        const int row0 = u.pm * 256 + wr * 64 + fr, cc = u.pn * 128 + wc * 32 + 8 * fq; const float* b = B1 + (size_t)u.aux * 2048;
        const f32x4 bg0 = *(const f32x4*)(b + cc), bg1 = *(const f32x4*)(b + cc + 4), bl0 = *(const f32x4*)(b + 1024 + cc), bl1 = *(const f32x4*)(b + 1024 + cc + 4);
#pragma unroll
        for (int ai = 0; ai < 2; ++ai)
#pragma unroll
            for (int m = 0; m < 4; ++m) { const size_t row = (size_t)(row0 + ai * 128 + m * 16);
                f32x4 g0 = acc[ai][0][m][0] + bg0, g1 = acc[ai][0][m][1] + bg1, l0 = acc[ai][1][m][0] + bl0, l1 = acc[ai][1][m][1] + bl1; float r[8];
#pragma unroll
                for (int q = 0; q < 4; ++q) { const float xg = fminf(g0[q], 7.f), xl = fminf(fmaxf(l0[q], -7.f), 7.f); r[q] = xg * sigmf(1.702f * xg) * (xl + 1.f);
                    const float yg = fminf(g1[q], 7.f), yl = fminf(fmaxf(l1[q], -7.f), 7.f); r[4 + q] = yg * sigmf(1.702f * yg) * (yl + 1.f); }
                u32x4 w; w.x = pk2(r[0], r[1]); w.y = pk2(r[2], r[3]); w.z = pk2(r[4], r[5]); w.w = pk2(r[6], r[7]);
                *(u32x4*)(ACT + row * 1024 + cc) = w; }
    } };
struct EpiY { const float* B2; bf16* Y;
    __device__ __forceinline__ void operator()(const f32x4 (&acc)[2][2][4][2], const pg8::Unit& u, int wr, int wc, int fr, int fq) const {
        const int row0 = u.pm * 256 + wr * 64 + fr, col0 = u.pn * 256 + wc * 32 + 8 * fq; const float* b = B2 + (size_t)u.aux * 1024;
#pragma unroll
        for (int bj = 0; bj < 2; ++bj) { const int col = col0 + bj * 128; const f32x4 ba = *(const f32x4*)(b + col), bb = *(const f32x4*)(b + col + 4);
#pragma unroll
            for (int ai = 0; ai < 2; ++ai)
#pragma unroll
                for (int m = 0; m < 4; ++m) { const size_t row = (size_t)(row0 + ai * 128 + m * 16); const f32x4 v0 = acc[ai][bj][m][0] + ba, v1 = acc[ai][bj][m][1] + bb;
                    u32x4 w; w.x = pk2(v0[0], v0[1]); w.y = pk2(v0[2], v0[3]); w.z = pk2(v1[0], v1[1]); w.w = pk2(v1[2], v1[3]); *(u32x4*)(Y + row * 1024 + col) = w; } }
    } };
PHASE_FN void ph_prep(Ctx cx, int l_) {
    Frame F = mkframe(cx); const ArgsP a = F.ap; const int l = rfl(l_);
    REFRESH(F);
    const int gw = F.bid * NWAVES + F.wave, NGW = F.G * NWAVES;
    bf16* P = (bf16*)(F.ws + WS_P);
    { const int blk = F.lane >> 2, j8 = F.lane & 3; float inv[8];
#pragma unroll
      for (int i = 0; i < 8; ++i) inv[i] = exp2f(-(float)(8 * (j8 & 1) + i) * (13.287712379549449f / 16.f)) * 0.15915494309189535f;
      for (int row = gw; row < MLAT; row += NGW) {
        const int t = row & (SEQ - 1); const float pos = (float)(j8 < 2 ? (t >> 6) : (t & 63));
        bf16* p = P + (size_t)row * NP + PC_DQ + blk * 64 + 8 * j8;
        const u32x4 w1 = *(const u32x4*)p, w2 = *(const u32x4*)(p + 32);
        float x1[8] = {bflo(w1.x), bfhi(w1.x), bflo(w1.y), bfhi(w1.y), bflo(w1.z), bfhi(w1.z), bflo(w1.w), bfhi(w1.w)};
        float x2[8] = {bflo(w2.x), bfhi(w2.x), bflo(w2.y), bfhi(w2.y), bflo(w2.z), bfhi(w2.z), bflo(w2.w), bfhi(w2.w)};
        float y1[8], y2[8];
#pragma unroll
        for (int i = 0; i < 8; ++i) { const float rev = pos * inv[i], fr = rev - floorf(rev), cs = __builtin_amdgcn_cosf(fr), sn = __builtin_amdgcn_sinf(fr);
            y1[i] = x1[i] * cs - x2[i] * sn; y2[i] = x2[i] * cs + x1[i] * sn; }
        *(u32x4*)p = (u32x4){pk2(y1[0], y1[1]), pk2(y1[2], y1[3]), pk2(y1[4], y1[5]), pk2(y1[6], y1[7])};
        *(u32x4*)(p + 32) = (u32x4){pk2(y2[0], y2[1]), pk2(y2[2], y2[3]), pk2(y2[4], y2[5]), pk2(y2[6], y2[7])};
      } }
#if !USE_GDN_FAST
    float* QN = (float*)(F.ws + WS_QN); float* KN = (float*)(F.ws + WS_KN); float* VV = (float*)(F.ws + WS_VV);
    const float* cw = AIN(I_CONVW) + (size_t)l * 3 * 1536;
    for (int row = gw; row < MT; row += NGW) {
        const bool lat = row < MLAT; const int t = lat ? (row & (SEQ - 1)) : ((row - MLAT) & (CTXL - 1)), L = lat ? SEQ : CTXL; const bool hm = t > 0, hp = t < L - 1;
        const bf16* p0 = P + (size_t)row * NP;
#pragma unroll
        for (int wh = 0; wh < 3; ++wh)
#pragma unroll
            for (int h = 0; h < 4; ++h) { const int c = wh * 512 + h * 128 + 2 * F.lane;
                const unsigned x0 = *(const unsigned*)(p0 + c), xm = hm ? *(const unsigned*)(p0 - NP + c) : 0u, xp = hp ? *(const unsigned*)(p0 + NP + c) : 0u;
                const f32x2 w0 = *(const f32x2*)(cw + c), w1 = *(const f32x2*)(cw + 1536 + c), w2 = *(const f32x2*)(cw + 3072 + c);
                float y0 = bflo(xm) * w0.x + bflo(x0) * w1.x + bflo(xp) * w2.x, y1 = bfhi(xm) * w0.y + bfhi(x0) * w1.y + bfhi(xp) * w2.y;
                y0 = siluf(y0); y1 = siluf(y1);
                if (wh < 2) { const float ss = wave_sum(y0 * y0 + y1 * y1), sc = (1.f / sqrtf(ss + RMS_EPS)) * (wh == 0 ? 0.08838834764831845f : 1.f); y0 *= sc; y1 *= sc; }
                float* o = (wh == 0 ? QN : wh == 1 ? KN : VV) + (size_t)row * 512 + h * 128 + 2 * F.lane; *(f32x2*)o = (f32x2){y0, y1}; }
    }
#endif
}

PHASE_FN void ph_gdn_chain_naive(Ctx cx, int l_) {
    Frame F = mkframe(cx); const ArgsP a = F.ap; const int l = rfl(l_);
    REFRESH(F);
    LAS float* kq = (LAS float*)F.lds;
    const float* QN = (const float*)(F.ws + WS_QN); const float* KN = (const float*)(F.ws + WS_KN); const float* VV = (const float*)(F.ws + WS_VV);
    const float* DEC = (const float*)(F.ws + WS_DEC); float* OG = (float*)(F.ws + WS_OG);
    for (int it = F.bid; it < 16; it += F.G) {
        const int b = it >> 3, h = (it >> 1) & 3, d = it & 1, v = (F.tid >> 1) & 127, hf = F.tid & 1;
        const float al = expf(AIN(I_ALOG)[(l * 2 + d) * 4 + h]), dtb = AIN(I_DTB)[(l * 2 + d) * 4 + h];
        float S[64];
#pragma unroll
        for (int k = 0; k < 64; ++k) S[k] = 0.f;
        __syncthreads();
        for (int step = 0; step < CTXL + SEQ; ++step) {
            int row; if (step < CTXL) { const int pos = d ? CTXL - 1 - step : step; row = MLAT + b * CTXL + pos; } else { const int tt = step - CTXL, pos = d ? SEQ - 1 - tt : tt; row = b * SEQ + pos; }
            LAS float* buf = kq + (step & 1) * 256;
            if (F.tid >= 256) { if (F.tid < 384) buf[F.tid - 256] = KN[(size_t)row * 512 + h * 128 + F.tid - 256]; else buf[F.tid - 256] = QN[(size_t)row * 512 + h * 128 + F.tid - 384]; }
            __syncthreads();
            if (F.tid < 256) {
                const float av = DEC[(size_t)row * 16 + 8 * d + h] + dtb, bb = DEC[(size_t)row * 16 + 8 * d + 4 + h];
                const float sp = av > 20.f ? av : log1pf(expf(av)); const float eg = expf(-al * sp), beta = sigmf(bb);
                const float vt = VV[(size_t)row * 512 + h * 128 + v];
                const LAS float* kb = buf + 64 * hf; const LAS float* qb = buf + 128 + 64 * hf;
                float kS = 0.f;
#pragma unroll
                for (int k4 = 0; k4 < 16; ++k4) { const f32x4 kk = *(const LAS f32x4*)(kb + 4 * k4); kS += (kk.x * S[4 * k4] + kk.y * S[4 * k4 + 1]) + (kk.z * S[4 * k4 + 2] + kk.w * S[4 * k4 + 3]); }
                kS += xorl<1>(kS);
                const float vn = beta * (vt - eg * kS); float o = 0.f;
#pragma unroll
                for (int k4 = 0; k4 < 16; ++k4) { const f32x4 kk = *(const LAS f32x4*)(kb + 4 * k4), qq = *(const LAS f32x4*)(qb + 4 * k4);
                    S[4 * k4] = eg * S[4 * k4] + kk.x * vn; S[4 * k4 + 1] = eg * S[4 * k4 + 1] + kk.y * vn; S[4 * k4 + 2] = eg * S[4 * k4 + 2] + kk.z * vn; S[4 * k4 + 3] = eg * S[4 * k4 + 3] + kk.w * vn;
                    o += (qq.x * S[4 * k4] + qq.y * S[4 * k4 + 1]) + (qq.z * S[4 * k4 + 2] + qq.w * S[4 * k4 + 3]); }
                o += xorl<1>(o);
                if (hf == 0) OG[((size_t)d * MT + row) * 512 + h * 128 + v] = o;
            }
        }
        __syncthreads();
    }
}

PHASE_FN void ph_diff_naive(Ctx cx, int l_) {
    Frame F = mkframe(cx); const int l = rfl(l_);
    REFRESH(F);
    LAS float* Kf = (LAS float*)F.lds;
    LAS float* Vf = (LAS float*)(F.lds + 16384);
    const bf16* P = (const bf16*)(F.ws + WS_P); float* OD = (float*)(F.ws + WS_OD);
    for (int it = F.bid; it < 512 + 16; it += F.G) {
        int b, h, m, q0, t0, t1;
        if (it < 512) { b = it >> 8; h = (it >> 6) & 3; m = (it >> 5) & 1; q0 = b * SEQ + (it & 31) * 256; t0 = 0; t1 = 132; }
        else { const int j = it - 512; b = j >> 3; h = (j >> 1) & 3; m = j & 1; q0 = MLAT + b * CTXL; t0 = 128; t1 = 132; }
        const int qi = F.tid & 255, eh = F.tid >> 8;
        float q[64], o[64];
        { const bf16* qp = P + (size_t)(q0 + qi) * NP + PC_DQ + h * 128 + m * 64;
#pragma unroll
          for (int d8 = 0; d8 < 8; ++d8) { const u32x4 w = *(const u32x4*)(qp + 8 * d8); q[8 * d8] = bflo(w.x) * 0.125f; q[8 * d8 + 1] = bfhi(w.x) * 0.125f; q[8 * d8 + 2] = bflo(w.y) * 0.125f; q[8 * d8 + 3] = bfhi(w.y) * 0.125f;
              q[8 * d8 + 4] = bflo(w.z) * 0.125f; q[8 * d8 + 5] = bfhi(w.z) * 0.125f; q[8 * d8 + 6] = bflo(w.w) * 0.125f; q[8 * d8 + 7] = bfhi(w.w) * 0.125f; } }
#pragma unroll
        for (int e = 0; e < 64; ++e) o[e] = 0.f;
        float mx = -1e30f, ls = 0.f;
        for (int t = t0; t < t1; ++t) {
            const int krow0 = t < 128 ? b * SEQ + 64 * t : MLAT + b * CTXL + 64 * (t - 128);
            __syncthreads();
            { const int key = F.tid >> 3, c8 = (F.tid & 7) * 8; const bf16* kp = P + (size_t)(krow0 + key) * NP + PC_DK + h * 128 + m * 64 + c8; const u32x4 w = *(const u32x4*)kp;
              LAS float* kd = Kf + key * 64 + c8; *(LAS f32x4*)kd = (f32x4){bflo(w.x), bfhi(w.x), bflo(w.y), bfhi(w.y)}; *(LAS f32x4*)(kd + 4) = (f32x4){bflo(w.z), bfhi(w.z), bflo(w.w), bfhi(w.w)};
              const int c16 = (F.tid & 7) * 16; const bf16* vp = P + (size_t)(krow0 + key) * NP + PC_DV + h * 128 + c16; const u32x4 w0 = *(const u32x4*)vp, w1 = *(const u32x4*)(vp + 8);
              LAS float* vd = Vf + key * 128 + c16; *(LAS f32x4*)vd = (f32x4){bflo(w0.x), bfhi(w0.x), bflo(w0.y), bfhi(w0.y)}; *(LAS f32x4*)(vd + 4) = (f32x4){bflo(w0.z), bfhi(w0.z), bflo(w0.w), bfhi(w0.w)};
              *(LAS f32x4*)(vd + 8) = (f32x4){bflo(w1.x), bfhi(w1.x), bflo(w1.y), bfhi(w1.y)}; *(LAS f32x4*)(vd + 12) = (f32x4){bflo(w1.z), bfhi(w1.z), bflo(w1.w), bfhi(w1.w)}; }
            __syncthreads();
            for (int kk = 0; kk < 64; ++kk) {
                float s = 0.f;
#pragma unroll
                for (int d4 = 0; d4 < 16; ++d4) { const f32x4 kv = *(const LAS f32x4*)(Kf + kk * 64 + 4 * d4); s += (q[4 * d4] * kv.x + q[4 * d4 + 1] * kv.y) + (q[4 * d4 + 2] * kv.z + q[4 * d4 + 3] * kv.w); }
                const float mn = fmaxf(mx, s), corr = __expf(mx - mn), p = __expf(s - mn); mx = mn; ls = ls * corr + p;
#pragma unroll
                for (int e4 = 0; e4 < 16; ++e4) { const f32x4 vv = *(const LAS f32x4*)(Vf + kk * 128 + eh * 64 + 4 * e4);
                    o[4 * e4] = o[4 * e4] * corr + p * vv.x; o[4 * e4 + 1] = o[4 * e4 + 1] * corr + p * vv.y; o[4 * e4 + 2] = o[4 * e4 + 2] * corr + p * vv.z; o[4 * e4 + 3] = o[4 * e4 + 3] * corr + p * vv.w; }
            }
        }
        const float il = 1.f / ls; float* op = OD + ((size_t)m * MT + q0 + qi) * 512 + h * 128 + eh * 64;
#pragma unroll
        for (int e4 = 0; e4 < 16; ++e4) *(f32x4*)(op + 4 * e4) = (f32x4){o[4 * e4] * il, o[4 * e4 + 1] * il, o[4 * e4 + 2] * il, o[4 * e4 + 3] * il};
    }
    __syncthreads();
}

__device__ __forceinline__ void na_key(const bf16* kp, const bf16* vp, const float (&q)[64], float bias, float& mx, float& ls, float (&o)[64]) {
    float s = 0.f;
#pragma unroll
    for (int d8 = 0; d8 < 8; ++d8) { const u32x4 w = *(const u32x4*)(kp + 8 * d8);
        s += (q[8 * d8] * bflo(w.x) + q[8 * d8 + 1] * bfhi(w.x)) + (q[8 * d8 + 2] * bflo(w.y) + q[8 * d8 + 3] * bfhi(w.y)) + (q[8 * d8 + 4] * bflo(w.z) + q[8 * d8 + 5] * bfhi(w.z)) + (q[8 * d8 + 6] * bflo(w.w) + q[8 * d8 + 7] * bfhi(w.w)); }
    s += bias;
    const float mn = fmaxf(mx, s), corr = __expf(mx - mn), p = __expf(s - mn); mx = mn; ls = ls * corr + p;
#pragma unroll
    for (int d8 = 0; d8 < 8; ++d8) { const u32x4 w = *(const u32x4*)(vp + 8 * d8);
        o[8 * d8] = o[8 * d8] * corr + p * bflo(w.x); o[8 * d8 + 1] = o[8 * d8 + 1] * corr + p * bfhi(w.x); o[8 * d8 + 2] = o[8 * d8 + 2] * corr + p * bflo(w.y); o[8 * d8 + 3] = o[8 * d8 + 3] * corr + p * bfhi(w.y);
        o[8 * d8 + 4] = o[8 * d8 + 4] * corr + p * bflo(w.z); o[8 * d8 + 5] = o[8 * d8 + 5] * corr + p * bfhi(w.z); o[8 * d8 + 6] = o[8 * d8 + 6] * corr + p * bflo(w.w); o[8 * d8 + 7] = o[8 * d8 + 7] * corr + p * bfhi(w.w); }
}
PHASE_FN void ph_na_naive(Ctx cx, int l_) {
    Frame F = mkframe(cx); const ArgsP a = F.ap; const int l = rfl(l_);
    REFRESH(F);
    const bf16* P = (const bf16*)(F.ws + WS_P); bf16* YC = (bf16*)(F.ws + WS_YC);
    const int gt = F.bid * NTHREADS + F.tid, NGT = F.G * NTHREADS;
    for (int idx = gt; idx < 8 * MT; idx += NGT) {
        int b, h, qrow, t; bool lat = idx < 8 * MLAT;
        if (lat) { b = idx >> 16; h = (idx >> 13) & 7; t = idx & (SEQ - 1); qrow = b * SEQ + t; } else { const int j = idx - 8 * MLAT; b = j >> 11; h = (j >> 8) & 7; t = j & 255; qrow = MLAT + b * CTXL + t; }
        float q[64], o[64];
        { const bf16* qp = P + (size_t)qrow * NP + PC_NQ + h * 64;
#pragma unroll
          for (int d8 = 0; d8 < 8; ++d8) { const u32x4 w = *(const u32x4*)(qp + 8 * d8); q[8 * d8] = bflo(w.x) * 0.125f; q[8 * d8 + 1] = bfhi(w.x) * 0.125f; q[8 * d8 + 2] = bflo(w.y) * 0.125f; q[8 * d8 + 3] = bfhi(w.y) * 0.125f;
              q[8 * d8 + 4] = bflo(w.z) * 0.125f; q[8 * d8 + 5] = bfhi(w.z) * 0.125f; q[8 * d8 + 6] = bflo(w.w) * 0.125f; q[8 * d8 + 7] = bfhi(w.w) * 0.125f; } }
#pragma unroll
        for (int e = 0; e < 64; ++e) o[e] = 0.f;
        float mx = -1e30f, ls = 0.f;
        if (lat) { const int r = t >> 6, c = t & 63; const int r0 = min(max(r - 4, 0), 120), c0 = min(max(c - 8, 0), 48);
            const float* rp = AIN(I_RPB) + ((size_t)l * 8 + h) * 15 * 31;
            for (int kr = 0; kr < 8; ++kr) for (int kc = 0; kc < 16; ++kc) { const int krow = b * SEQ + (r0 + kr) * 64 + c0 + kc;
                const float bias = rp[(r0 + kr - r + 7) * 31 + (c0 + kc - c + 15)];
                na_key(P + (size_t)krow * NP + PC_NK + h * 64, P + (size_t)krow * NP + PC_NV + h * 64, q, bias, mx, ls, o); } }
        for (int j = 0; j < CTXL; ++j) { const int krow = MLAT + b * CTXL + j; na_key(P + (size_t)krow * NP + PC_NK + h * 64, P + (size_t)krow * NP + PC_NV + h * 64, q, 0.f, mx, ls, o); }
        const float il = 1.f / ls; bf16* op = YC + (size_t)qrow * 512 + h * 64;
#pragma unroll
        for (int d8 = 0; d8 < 8; ++d8) { u32x4 w; w.x = pk2(o[8 * d8] * il, o[8 * d8 + 1] * il); w.y = pk2(o[8 * d8 + 2] * il, o[8 * d8 + 3] * il); w.z = pk2(o[8 * d8 + 4] * il, o[8 * d8 + 5] * il); w.w = pk2(o[8 * d8 + 6] * il, o[8 * d8 + 7] * il);
            *(u32x4*)(op + 8 * d8) = w; }
    }
}

__device__ __forceinline__ float grp16_sum(float v) { v += xorl<1>(v); v += xorl<2>(v); v += xorl<4>(v); v += xorl<8>(v); return v; }
PHASE_FN void ph_combine(Ctx cx, int l_) {
    Frame F = mkframe(cx); const ArgsP a = F.ap; const int l = rfl(l_);
    REFRESH(F);
    const int gw = F.bid * NWAVES + F.wave, NGW = F.G * NWAVES;
    const float* OG = (const float*)(F.ws + WS_OG); const float* OD = (const float*)(F.ws + WS_OD); const bf16* P = (const bf16*)(F.ws + WS_P);
    bf16* YA = (bf16*)(F.ws + WS_YA); bf16* YB = (bf16*)(F.ws + WS_YB);
    const float lam = ((const float*)(F.ws + WS_LAM))[l], omli = 1.f - (0.8f - 0.6f * expf(-0.3f * (float)l));
    const float* gnw = AIN(I_GNW) + l * 128; const float* dnw = AIN(I_DNW) + l * 128;
    const int MR = l == DEPTH - 1 ? MLAT : MT;
    const int c = 8 * F.lane, ch = c & 127;
    const f32x4 w0 = *(const f32x4*)(gnw + ch), w1 = *(const f32x4*)(gnw + ch + 4);
    f32x4 nf0 = {0.f, 0.f, 0.f, 0.f}, nf1 = nf0, nb0 = nf0, nb1 = nf0; u32x4 nz = {0u, 0u, 0u, 0u};
#define CMB_LOAD(r) do { const float* p0 = OG + (size_t)(r) * 512 + c; const float* p1 = p0 + (size_t)MT * 512; nf0 = *(const f32x4*)p0; nf1 = *(const f32x4*)(p0 + 4); nb0 = *(const f32x4*)p1; nb1 = *(const f32x4*)(p1 + 4); \
        nz = *(const u32x4*)(P + (size_t)(r) * NP + PC_GZ + c); } while (0)
    if (gw < MR) CMB_LOAD(gw);
    for (int row = gw; row < MR; row += NGW) {
        { const f32x4 a0 = nf0 + nb0, a1 = nf1 + nb1; const u32x4 z = nz;
          if (row + NGW < MR) CMB_LOAD(row + NGW);
          float ss = (a0.x * a0.x + a0.y * a0.y) + (a0.z * a0.z + a0.w * a0.w) + (a1.x * a1.x + a1.y * a1.y) + (a1.z * a1.z + a1.w * a1.w);
          const float rs = 1.f / sqrtf(grp16_sum(ss) * (1.f / 128.f) + RMS_EPS);
          u32x4 o; o.x = pk2(a0.x * rs * w0.x * siluf(bflo(z.x)), a0.y * rs * w0.y * siluf(bfhi(z.x))); o.y = pk2(a0.z * rs * w0.z * siluf(bflo(z.y)), a0.w * rs * w0.w * siluf(bfhi(z.y)));
          o.z = pk2(a1.x * rs * w1.x * siluf(bflo(z.z)), a1.y * rs * w1.y * siluf(bfhi(z.z))); o.w = pk2(a1.z * rs * w1.z * siluf(bflo(z.w)), a1.w * rs * w1.w * siluf(bfhi(z.w)));
          *(u32x4*)(YA + (size_t)row * 512 + c) = o; }
#if !USE_DIFF_MFMA
        { const float* p0 = OD + (size_t)row * 512 + c; const float* p1 = p0 + (size_t)MT * 512;
          const f32x4 a0 = *(const f32x4*)p0 - *(const f32x4*)p1 * lam, a1 = *(const f32x4*)(p0 + 4) - *(const f32x4*)(p1 + 4) * lam;
          float ss = (a0.x * a0.x + a0.y * a0.y) + (a0.z * a0.z + a0.w * a0.w) + (a1.x * a1.x + a1.y * a1.y) + (a1.z * a1.z + a1.w * a1.w);
          const float rs = (1.f / sqrtf(grp16_sum(ss) * (1.f / 128.f) + RMS_EPS)) * omli;
          const f32x4 w0 = *(const f32x4*)(dnw + ch), w1 = *(const f32x4*)(dnw + ch + 4);
          u32x4 o; o.x = pk2(a0.x * rs * w0.x, a0.y * rs * w0.y); o.y = pk2(a0.z * rs * w0.z, a0.w * rs * w0.w); o.z = pk2(a1.x * rs * w1.x, a1.y * rs * w1.y); o.w = pk2(a1.z * rs * w1.z, a1.w * rs * w1.w);
          *(u32x4*)(YB + (size_t)row * 512 + c) = o; }
#endif
    }
#undef CMB_LOAD
}
namespace dattn {
using s16x4  = __attribute__((ext_vector_type(4))) short;
using f32x16 = __attribute__((ext_vector_type(16))) float;
constexpr int KVBLK = 64;
constexpr float SCALE = 0.125f, THR = 8.f;
constexpr int SHM_V = KVBLK * 128 * 2, SHM_K = KVBLK * 128 * 2, SHM_ATTN = 2 * SHM_V + 2 * SHM_K + 8 * 64 * 4;
#define DA_KSWZ(row, colB) ((row) * 256 + ((colB) ^ (((row) & 7) << 4)))
#define DA_SBAR() __builtin_amdgcn_sched_barrier(0)
__device__ __forceinline__ int crow(int r, int hi) { return (r & 3) + 8 * (r >> 2) + 4 * hi; }
__device__ __forceinline__ unsigned cvtpk(float lo, float hi) { return pg8::cvt_pk_bf16(lo, hi); }
__device__ __forceinline__ void partialSM(f32x16& p0, f32x16& p1, float& m_reg, float& mn, float& alpha) {
  constexpr float C = SCALE * 1.4426950408889634f;
  float pmax = p0[0];
#pragma unroll
  for (int r = 1; r < 16; ++r) pmax = fmaxf(pmax, p0[r]);
#pragma unroll
  for (int r = 0; r < 16; ++r) pmax = fmaxf(pmax, p1[r]);
  { auto rr = __builtin_amdgcn_permlane32_swap(__float_as_uint(pmax), __float_as_uint(pmax), false, false);
    pmax = fmaxf(__uint_as_float(rr[0]), __uint_as_float(rr[1])); }
  if (__builtin_expect(__all(pmax - m_reg <= THR / SCALE), 1)) { mn = m_reg; alpha = 1.f; }
  else { mn = fmaxf(m_reg, pmax); alpha = __builtin_amdgcn_exp2f((m_reg - mn) * C); m_reg = mn; }
  const float mnC = -mn * C;
#pragma unroll
  for (int r = 0; r < 16; ++r) p0[r] = fmaf(p0[r], C, mnC);
#pragma unroll
  for (int r = 0; r < 16; ++r) p1[r] = fmaf(p1[r], C, mnC);
#pragma unroll
  for (int r = 0; r < 16; ++r) p0[r] = __builtin_amdgcn_exp2f(p0[r]);
}
__device__ __forceinline__ void finishSM(f32x16& p0, f32x16& p1, float alpha, float& l_reg, bf16x8& pa0, bf16x8& pa1, bf16x8& pa2, bf16x8& pa3) {
#pragma unroll
  for (int r = 0; r < 16; ++r) p1[r] = __builtin_amdgcn_exp2f(p1[r]);
  float ps = 0;
#pragma unroll
  for (int r = 0; r < 16; ++r) ps += p0[r];
#pragma unroll
  for (int r = 0; r < 16; ++r) ps += p1[r];
  { auto rr = __builtin_amdgcn_permlane32_swap(__float_as_uint(ps), __float_as_uint(ps), false, false);
    ps = __uint_as_float(rr[0]) + __uint_as_float(rr[1]); }
  l_reg = l_reg * alpha + ps;
#define DA_PK4(P, BASE, OUT) do { unsigned a0 = cvtpk(P[BASE + 0], P[BASE + 1]), a1 = cvtpk(P[BASE + 2], P[BASE + 3]);   \
    unsigned b0 = cvtpk(P[BASE + 4], P[BASE + 5]), b1 = cvtpk(P[BASE + 6], P[BASE + 7]);                              \
    auto r0 = __builtin_amdgcn_permlane32_swap(a0, b0, false, false); auto r1 = __builtin_amdgcn_permlane32_swap(a1, b1, false, false); \
    u32x4 w = {r0[0], r1[0], r0[1], r1[1]}; OUT = *reinterpret_cast<bf16x8*>(&w); } while (0)
  DA_PK4(p0, 0, pa0); DA_PK4(p0, 8, pa1); DA_PK4(p1, 0, pa2); DA_PK4(p1, 8, pa3);
#undef DA_PK4
}
__device__ __forceinline__ void qkt(f32x16& p0, f32x16& p1, const LAS char* Ks, const bf16x8* qr, int r32, int hi, int m) {
  p0 = f32x16{}; p1 = f32x16{};
#pragma unroll
  for (int d0 = 0; d0 < 4; ++d0) { const int cb = (m * 64 + d0 * 16 + hi * 8) * 2;
    const bf16x8 b0 = *reinterpret_cast<const LAS bf16x8*>(Ks + DA_KSWZ(r32, cb));
    const bf16x8 b1 = *reinterpret_cast<const LAS bf16x8*>(Ks + DA_KSWZ(32 + r32, cb));
    p0 = __builtin_amdgcn_mfma_f32_32x32x16_bf16(b0, qr[d0], p0, 0, 0, 0);
    p1 = __builtin_amdgcn_mfma_f32_32x32x16_bf16(b1, qr[d0], p1, 0, 0, 0); }
}
__device__ __forceinline__ int v_st(int k, int c) { const int kk = (k & ~0xC) | ((k & 4) << 1) | ((k & 8) >> 1); return ((kk >> 3) * 4 + (c >> 5)) * 512 + ((kk & 7) * 32 + (c & 31)) * 2; }
__device__ __forceinline__ int v_rd_base(int lane) { return ((lane & 3) << 3) | (((lane >> 2) & 3) << 6) | (((lane >> 4) & 1) << 5) | (((lane >> 5) & 1) << 8); }
constexpr int v_rd_off(int d0, int ks, int half) { return d0 * 512 + ks * 4096 + half * 2048; }
template <int OFF> __device__ __forceinline__ s16x4 tr_read(int vb) { s16x4 r; asm volatile("ds_read_b64_tr_b16 %0, %1 offset:%2" : "=&v"(r) : "v"(vb), "i"(OFF) : "memory"); return r; }
template <int D0> __device__ __forceinline__ void pv_one(f32x16& od, int vb, bf16x8 pa0, bf16x8 pa1, bf16x8 pa2, bf16x8 pa3) {
  const s16x4 l0 = tr_read<v_rd_off(D0, 0, 0)>(vb), h0 = tr_read<v_rd_off(D0, 0, 1)>(vb), l1 = tr_read<v_rd_off(D0, 1, 0)>(vb), h1 = tr_read<v_rd_off(D0, 1, 1)>(vb);
  const s16x4 l2 = tr_read<v_rd_off(D0, 2, 0)>(vb), h2 = tr_read<v_rd_off(D0, 2, 1)>(vb), l3 = tr_read<v_rd_off(D0, 3, 0)>(vb), h3 = tr_read<v_rd_off(D0, 3, 1)>(vb);
  asm volatile("s_waitcnt lgkmcnt(0)" ::: "memory"); DA_SBAR();
#define DA_PK(L, H) (bf16x8){L[0], L[1], L[2], L[3], H[0], H[1], H[2], H[3]}
  od = __builtin_amdgcn_mfma_f32_32x32x16_bf16(pa0, DA_PK(l0, h0), od, 0, 0, 0);
  od = __builtin_amdgcn_mfma_f32_32x32x16_bf16(pa1, DA_PK(l1, h1), od, 0, 0, 0);
  od = __builtin_amdgcn_mfma_f32_32x32x16_bf16(pa2, DA_PK(l2, h2), od, 0, 0, 0);
  od = __builtin_amdgcn_mfma_f32_32x32x16_bf16(pa3, DA_PK(l3, h3), od, 0, 0, 0);
#undef DA_PK
}
__device__ __forceinline__ void pv_d0(f32x16* o, int vb, bf16x8 pa0, bf16x8 pa1, bf16x8 pa2, bf16x8 pa3) {
  pv_one<0>(o[0], vb, pa0, pa1, pa2, pa3); pv_one<1>(o[1], vb, pa0, pa1, pa2, pa3); pv_one<2>(o[2], vb, pa0, pa1, pa2, pa3); pv_one<3>(o[3], vb, pa0, pa1, pa2, pa3);
}

__device__ __forceinline__ void unit(const bf16* __restrict__ P, bf16* __restrict__ YB, const float* __restrict__ nw, float lam, float omli,
                                     int b, int h, int qrow0, int t0, int NT, LAS char* lds, int wid, int lane) {
  const int tid = wid * 64 + lane, r32 = lane & 31, hi = lane >> 5, m = wid >> 2, wq = wid & 3;
  LAS char* V_lds = lds; LAS char* K_lds = lds + 2 * SHM_V;
  LAS float* ws = (LAS float*)(lds + 2 * SHM_V + 2 * SHM_K) + wid * 64; LAS float* li_l = ws; LAS float* al_l = ws + 32;
  float m_reg = -1e30f, l_reg = 0; f32x16 o[4] = {}; bf16x8 qr[4];
  { const bf16* Qw = P + (size_t)(qrow0 + wq * 32 + r32) * NP + PC_DQ + h * 128 + m * 64 + hi * 8;
#pragma unroll
    for (int d0 = 0; d0 < 4; ++d0) qr[d0] = *reinterpret_cast<const bf16x8*>(Qw + d0 * 16); }
  const int sr = tid >> 4, sc = (tid & 15) * 8, vst0 = v_st(sr, sc), vst1 = v_st(32 + sr, sc);
  const int vb0 = (int)(uintptr_t)V_lds + v_rd_base(lane);
  const bf16* Kcol = P + PC_DK + h * 128 + sc; const bf16* Vcol = P + PC_DV + h * 128 + sc;
  bf16x8 vsE0, vsE1, ksE0, ksE1, vsO0, vsO1, ksO0, ksO1;
#define DA_KROW(j) ((size_t)(((j) + t0) < 128 ? b * SEQ + 64 * ((j) + t0) : MLAT + b * CTXL + 64 * ((j) + t0 - 128)))
#define DA_SLOAD(S, j) do { const size_t k0_ = DA_KROW(j); vs##S##0 = *reinterpret_cast<const bf16x8*>(Vcol + (k0_ + sr) * NP); vs##S##1 = *reinterpret_cast<const bf16x8*>(Vcol + (k0_ + 32 + sr) * NP); \
    ks##S##0 = *reinterpret_cast<const bf16x8*>(Kcol + (k0_ + sr) * NP); ks##S##1 = *reinterpret_cast<const bf16x8*>(Kcol + (k0_ + 32 + sr) * NP); } while (0)
#define DA_SWRITE(bb, S) do { *(LAS bf16x8*)(V_lds + (bb) * SHM_V + vst0) = vs##S##0; *(LAS bf16x8*)(V_lds + (bb) * SHM_V + vst1) = vs##S##1; const int kc = sc * 2; \
    *(LAS bf16x8*)(K_lds + (bb) * SHM_K + DA_KSWZ(sr, kc)) = ks##S##0; *(LAS bf16x8*)(K_lds + (bb) * SHM_K + DA_KSWZ(32 + sr, kc)) = ks##S##1; } while (0)
#define DA_SWAIT() asm volatile("s_waitcnt vmcnt(4)" ::: "memory")
#define DA_RESC(a) do { if (__any((a) < 1.f)) { if (hi == 0) al_l[r32] = (a); asm volatile("s_waitcnt lgkmcnt(0)" ::: "memory"); \
    _Pragma("unroll") for (int d = 0; d < 4; ++d) _Pragma("unroll") for (int r = 0; r < 16; ++r) o[d][r] *= al_l[crow(r, hi)]; } } while (0)
  f32x16 pA0, pA1, pB0, pB1; float mnA, mnB, alA, alB; bf16x8 pa0, pa1, pa2, pa3;
  DA_SLOAD(E, 0); asm volatile("s_waitcnt vmcnt(0)" ::: "memory"); DA_SWRITE(0, E); __syncthreads();
  qkt(pA0, pA1, K_lds, qr, r32, hi, m); partialSM(pA0, pA1, m_reg, mnA, alA);
  DA_SLOAD(O, 1); if (2 < NT) DA_SLOAD(E, 2);
  DA_SWAIT(); DA_SWRITE(1, O); __syncthreads();
  for (int j = 1; j + 1 < NT; j += 2) {
    DA_SBAR(); qkt(pB0, pB1, K_lds + SHM_K, qr, r32, hi, m);
    finishSM(pA0, pA1, alA, l_reg, pa0, pa1, pa2, pa3); DA_SBAR();
    DA_SLOAD(O, j + 2); DA_SBAR();
    pv_d0(o, vb0, pa0, pa1, pa2, pa3); partialSM(pB0, pB1, m_reg, mnB, alB);
    __syncthreads(); DA_SWAIT(); DA_SWRITE(0, E);
    DA_RESC(alB); __syncthreads();
    DA_SBAR(); qkt(pA0, pA1, K_lds, qr, r32, hi, m);
    finishSM(pB0, pB1, alB, l_reg, pa0, pa1, pa2, pa3); DA_SBAR();
    if (j + 3 < NT) DA_SLOAD(E, j + 3); DA_SBAR();
    pv_d0(o, vb0 + SHM_V, pa0, pa1, pa2, pa3); partialSM(pA0, pA1, m_reg, mnA, alA);
    __syncthreads(); DA_SWAIT(); DA_SWRITE(1, O);
    DA_RESC(alA); __syncthreads();
  }
  DA_SBAR(); qkt(pB0, pB1, K_lds + SHM_K, qr, r32, hi, m);
  finishSM(pA0, pA1, alA, l_reg, pa0, pa1, pa2, pa3); DA_SBAR();
  pv_d0(o, vb0, pa0, pa1, pa2, pa3); partialSM(pB0, pB1, m_reg, mnB, alB);
  __syncthreads(); DA_RESC(alB);
  finishSM(pB0, pB1, alB, l_reg, pa0, pa1, pa2, pa3); DA_SBAR();
  pv_d0(o, vb0 + SHM_V, pa0, pa1, pa2, pa3);
  if (hi == 0) li_l[r32] = l_reg; asm volatile("s_waitcnt lgkmcnt(0)" ::: "memory");
  float rli[16];
#pragma unroll
  for (int r = 0; r < 16; ++r) rli[r] = __builtin_amdgcn_rcpf(li_l[crow(r, hi)]);
  __syncthreads();
  LAS float* X = (LAS float*)lds;
  if (m == 1) {
#pragma unroll
    for (int r = 0; r < 16; ++r) { const int row = wq * 32 + crow(r, hi);
#pragma unroll
      for (int d0 = 0; d0 < 4; ++d0) X[row * 132 + d0 * 32 + r32] = o[d0][r] * rli[r]; } }
  __syncthreads();
  if (m == 0) {
#pragma unroll
    for (int r = 0; r < 16; ++r) { const int row = wq * 32 + crow(r, hi);
#pragma unroll
      for (int d0 = 0; d0 < 4; ++d0) { LAS float* p = X + row * 132 + d0 * 32 + r32; *p = o[d0][r] * rli[r] - lam * *p; } }
    asm volatile("s_waitcnt lgkmcnt(0)" ::: "memory");
    const int row = wq * 32 + (lane >> 1), hf = lane & 1; const LAS float* xr = X + row * 132 + hf * 64;
    f32x4 v[16]; float ss = 0.f;
#pragma unroll
    for (int i = 0; i < 16; ++i) { v[i] = *(const LAS f32x4*)(xr + 4 * i); ss += (v[i].x * v[i].x + v[i].y * v[i].y) + (v[i].z * v[i].z + v[i].w * v[i].w); }
    ss += xorl<1>(ss);
    const float rs = (1.f / sqrtf(ss * (1.f / 128.f) + RMS_EPS)) * omli;
    bf16* op = YB + (size_t)(qrow0 + row) * 512 + h * 128 + hf * 64; const float* wp = nw + hf * 64;
#pragma unroll
    for (int i = 0; i < 8; ++i) { const f32x4 w0 = *(const f32x4*)(wp + 8 * i), w1 = *(const f32x4*)(wp + 8 * i + 4); const f32x4 a0 = v[2 * i] * rs * w0, a1 = v[2 * i + 1] * rs * w1;
      u32x4 w; w.x = cvtpk(a0.x, a0.y); w.y = cvtpk(a0.z, a0.w); w.z = cvtpk(a1.x, a1.y); w.w = cvtpk(a1.z, a1.w); *(u32x4*)(op + 8 * i) = w; }
  }
  __syncthreads();
#undef DA_KROW
#undef DA_SLOAD
#undef DA_SWRITE
#undef DA_SWAIT
#undef DA_RESC
}
__device__ __forceinline__ void unit3(const bf16* __restrict__ P, bf16* __restrict__ YB, const float* __restrict__ nw, float lam, float omli,
                                     int b, int h, int qrow0, int t0, int NT, LAS char* lds, int wid, int lane) {
  const int tid = wid * 64 + lane, r32 = lane & 31, hi = lane >> 5, m = wid >> 2, wq = wid & 3;
  LAS char* V_lds = lds; LAS char* K_lds = lds + 3 * SHM_V;
  LAS float* ws = (LAS float*)(lds + 3 * SHM_V + 3 * SHM_K) + wid * 64; LAS float* li_l = ws; LAS float* al_l = ws + 32;
  float m_reg = -1e30f, l_reg = 0; f32x16 o[4] = {}; bf16x8 qr[4];
  { const bf16* Qw = P + (size_t)(qrow0 + wq * 32 + r32) * NP + PC_DQ + h * 128 + m * 64 + hi * 8;
#pragma unroll
    for (int d0 = 0; d0 < 4; ++d0) qr[d0] = *reinterpret_cast<const bf16x8*>(Qw + d0 * 16); }
  const int sr = tid >> 4, sc = (tid & 15) * 8, vst0 = v_st(sr, sc), vst1 = v_st(32 + sr, sc);
  const int vb0 = (int)(uintptr_t)V_lds + v_rd_base(lane);
  const bf16* Kcol = P + PC_DK + h * 128 + sc; const bf16* Vcol = P + PC_DV + h * 128 + sc;
  bf16x8 vsE0, vsE1, ksE0, ksE1, vsO0, vsO1, ksO0, ksO1;
#define DA_KROW(j) ((size_t)(((j) + t0) < 128 ? b * SEQ + 64 * ((j) + t0) : MLAT + b * CTXL + 64 * ((j) + t0 - 128)))
#define DA_SLOAD(S, j) do { const size_t k0_ = DA_KROW(j); vs##S##0 = *reinterpret_cast<const bf16x8*>(Vcol + (k0_ + sr) * NP); vs##S##1 = *reinterpret_cast<const bf16x8*>(Vcol + (k0_ + 32 + sr) * NP); \
    ks##S##0 = *reinterpret_cast<const bf16x8*>(Kcol + (k0_ + sr) * NP); ks##S##1 = *reinterpret_cast<const bf16x8*>(Kcol + (k0_ + 32 + sr) * NP); } while (0)
#define DA_SWRITE(bb, S) do { *(LAS bf16x8*)(V_lds + (bb) * SHM_V + vst0) = vs##S##0; *(LAS bf16x8*)(V_lds + (bb) * SHM_V + vst1) = vs##S##1; const int kc = sc * 2; \
    *(LAS bf16x8*)(K_lds + (bb) * SHM_K + DA_KSWZ(sr, kc)) = ks##S##0; *(LAS bf16x8*)(K_lds + (bb) * SHM_K + DA_KSWZ(32 + sr, kc)) = ks##S##1; } while (0)
#define DA_SWRITE3(so, S) do { *(LAS bf16x8*)(V_lds + (so) + vst0) = vs##S##0; *(LAS bf16x8*)(V_lds + (so) + vst1) = vs##S##1; const int kc = sc * 2; \
    *(LAS bf16x8*)(K_lds + (so) + DA_KSWZ(sr, kc)) = ks##S##0; *(LAS bf16x8*)(K_lds + (so) + DA_KSWZ(32 + sr, kc)) = ks##S##1; } while (0)
#define DA_SWAIT() asm volatile("s_waitcnt vmcnt(4)" ::: "memory")
#define DA_RESC(a) do { if (__any((a) < 1.f)) { if (hi == 0) al_l[r32] = (a); asm volatile("s_waitcnt lgkmcnt(0)" ::: "memory"); \
    _Pragma("unroll") for (int d = 0; d < 4; ++d) _Pragma("unroll") for (int r = 0; r < 16; ++r) o[d][r] *= al_l[crow(r, hi)]; } } while (0)
  f32x16 pA0, pA1, pB0, pB1; float mnA, mnB, alA, alB; bf16x8 pa0, pa1, pa2, pa3;
  int sl_prev = 0, sl_cur = SHM_V, sl_next = 2 * SHM_V;
#define DA_ROT() do { const int t_ = sl_prev; sl_prev = sl_cur; sl_cur = sl_next; sl_next = t_; } while (0)
  DA_SLOAD(E, 0); asm volatile("s_waitcnt vmcnt(0)" ::: "memory"); DA_SWRITE(0, E); __syncthreads();
  qkt(pA0, pA1, K_lds, qr, r32, hi, m); partialSM(pA0, pA1, m_reg, mnA, alA);
  DA_SLOAD(O, 1); if (2 < NT) DA_SLOAD(E, 2);
  DA_SWAIT(); DA_SWRITE3(SHM_V, O); __syncthreads();
  for (int j = 1; j + 1 < NT; j += 2) {
    DA_SBAR(); qkt(pB0, pB1, K_lds + sl_cur, qr, r32, hi, m);
    finishSM(pA0, pA1, alA, l_reg, pa0, pa1, pa2, pa3); DA_SBAR();
    DA_SLOAD(O, j + 2); DA_SBAR();
    pv_d0(o, vb0 + sl_prev, pa0, pa1, pa2, pa3); partialSM(pB0, pB1, m_reg, mnB, alB);
    DA_SWAIT(); DA_SWRITE3(sl_next, E);
    DA_RESC(alB); __syncthreads(); DA_ROT();
    DA_SBAR(); qkt(pA0, pA1, K_lds + sl_cur, qr, r32, hi, m);
    finishSM(pB0, pB1, alB, l_reg, pa0, pa1, pa2, pa3); DA_SBAR();
    if (j + 3 < NT) DA_SLOAD(E, j + 3); DA_SBAR();
    pv_d0(o, vb0 + sl_prev, pa0, pa1, pa2, pa3); partialSM(pA0, pA1, m_reg, mnA, alA);
    DA_SWAIT(); DA_SWRITE3(sl_next, O);
    DA_RESC(alA); __syncthreads(); DA_ROT();
  }
  DA_SBAR(); qkt(pB0, pB1, K_lds + sl_cur, qr, r32, hi, m);
  finishSM(pA0, pA1, alA, l_reg, pa0, pa1, pa2, pa3); DA_SBAR();
  pv_d0(o, vb0 + sl_prev, pa0, pa1, pa2, pa3); partialSM(pB0, pB1, m_reg, mnB, alB);
  DA_RESC(alB);
  finishSM(pB0, pB1, alB, l_reg, pa0, pa1, pa2, pa3); DA_SBAR();
  pv_d0(o, vb0 + sl_cur, pa0, pa1, pa2, pa3);
#undef DA_ROT
  if (hi == 0) li_l[r32] = l_reg; asm volatile("s_waitcnt lgkmcnt(0)" ::: "memory");
  float rli[16];
#pragma unroll
  for (int r = 0; r < 16; ++r) rli[r] = __builtin_amdgcn_rcpf(li_l[crow(r, hi)]);
  __syncthreads();
  LAS float* X = (LAS float*)lds;
  if (m == 1) {
#pragma unroll
    for (int r = 0; r < 16; ++r) { const int row = wq * 32 + crow(r, hi);
#pragma unroll
      for (int d0 = 0; d0 < 4; ++d0) X[row * 132 + d0 * 32 + r32] = o[d0][r] * rli[r]; } }
  __syncthreads();
  if (m == 0) {
#pragma unroll
    for (int r = 0; r < 16; ++r) { const int row = wq * 32 + crow(r, hi);
#pragma unroll
      for (int d0 = 0; d0 < 4; ++d0) { LAS float* p = X + row * 132 + d0 * 32 + r32; *p = o[d0][r] * rli[r] - lam * *p; } }
    asm volatile("s_waitcnt lgkmcnt(0)" ::: "memory");
    const int row = wq * 32 + (lane >> 1), hf = lane & 1; const LAS float* xr = X + row * 132 + hf * 64;
    f32x4 v[16]; float ss = 0.f;
#pragma unroll
    for (int i = 0; i < 16; ++i) { v[i] = *(const LAS f32x4*)(xr + 4 * i); ss += (v[i].x * v[i].x + v[i].y * v[i].y) + (v[i].z * v[i].z + v[i].w * v[i].w); }
    ss += xorl<1>(ss);
    const float rs = (1.f / sqrtf(ss * (1.f / 128.f) + RMS_EPS)) * omli;
    bf16* op = YB + (size_t)(qrow0 + row) * 512 + h * 128 + hf * 64; const float* wp = nw + hf * 64;
#pragma unroll
    for (int i = 0; i < 8; ++i) { const f32x4 w0 = *(const f32x4*)(wp + 8 * i), w1 = *(const f32x4*)(wp + 8 * i + 4); const f32x4 a0 = v[2 * i] * rs * w0, a1 = v[2 * i + 1] * rs * w1;
      u32x4 w; w.x = cvtpk(a0.x, a0.y); w.y = cvtpk(a0.z, a0.w); w.z = cvtpk(a1.x, a1.y); w.w = cvtpk(a1.z, a1.w); *(u32x4*)(op + 8 * i) = w; }
  }
  __syncthreads();
#undef DA_KROW
#undef DA_SLOAD
#undef DA_SWRITE
#undef DA_SWAIT
#undef DA_SWRITE3
#undef DA_RESC
}
__device__ __forceinline__ void unit64(const bf16* __restrict__ P, bf16* __restrict__ YB, const float* __restrict__ nw, float lam, float omli,
                                       int b, int h, int qrow0, int t0, int NT, LAS char* lds, int wid, int lane) {
  const int tid = wid * 64 + lane, r32 = lane & 31, hi = lane >> 5, kp = wid >> 2, m = (wid >> 1) & 1, rb = wid & 1, NS = NT >> 1;
  LAS char* Vw = lds + kp * 16384; LAS char* Kw = lds + 32768 + kp * 16384;
  LAS float* ws = (LAS float*)(lds + 131072 + 4096) + wid * 64; LAS float* li_l = ws; LAS float* al_l = ws + 32;
  float m_reg = -1e30f, l_reg = 0; f32x16 o[4] = {}; bf16x8 qr[4];
  { const bf16* Qw = P + (size_t)(qrow0 + rb * 32 + r32) * NP + PC_DQ + h * 128 + m * 64 + hi * 8;
#pragma unroll
    for (int d0 = 0; d0 < 4; ++d0) qr[d0] = *reinterpret_cast<const bf16x8*>(Qw + d0 * 16); }
  const int sr = tid >> 4, sc = (tid & 15) * 8, vst0 = v_st(sr, sc), vst1 = v_st(32 + sr, sc);
  const int vb0 = (int)(uintptr_t)Vw + v_rd_base(lane);
  const bf16* Kcol = P + PC_DK + h * 128 + sc; const bf16* Vcol = P + PC_DV + h * 128 + sc;
  bf16x8 vsa0, vsa1, ksa0, ksa1, vsb0, vsb1, ksb0, ksb1;
#define DA_KROW(t) ((size_t)(((t) + t0) < 128 ? b * SEQ + 64 * ((t) + t0) : MLAT + b * CTXL + 64 * ((t) + t0 - 128)))
#define DA_SLOAD(j) do { const size_t ka_ = DA_KROW(2 * (j)), kb_ = DA_KROW(2 * (j) + 1); \
    vsa0 = *reinterpret_cast<const bf16x8*>(Vcol + (ka_ + sr) * NP); vsa1 = *reinterpret_cast<const bf16x8*>(Vcol + (ka_ + 32 + sr) * NP); ksa0 = *reinterpret_cast<const bf16x8*>(Kcol + (ka_ + sr) * NP); ksa1 = *reinterpret_cast<const bf16x8*>(Kcol + (ka_ + 32 + sr) * NP); \
    vsb0 = *reinterpret_cast<const bf16x8*>(Vcol + (kb_ + sr) * NP); vsb1 = *reinterpret_cast<const bf16x8*>(Vcol + (kb_ + 32 + sr) * NP); ksb0 = *reinterpret_cast<const bf16x8*>(Kcol + (kb_ + sr) * NP); ksb1 = *reinterpret_cast<const bf16x8*>(Kcol + (kb_ + 32 + sr) * NP); } while (0)
#define DA_SWRITE(bb) do { LAS char* B_ = lds + (bb) * 65536; const int kc = sc * 2; \
    *(LAS bf16x8*)(B_ + vst0) = vsa0; *(LAS bf16x8*)(B_ + vst1) = vsa1; *(LAS bf16x8*)(B_ + 16384 + vst0) = vsb0; *(LAS bf16x8*)(B_ + 16384 + vst1) = vsb1; \
    *(LAS bf16x8*)(B_ + 32768 + DA_KSWZ(sr, kc)) = ksa0; *(LAS bf16x8*)(B_ + 32768 + DA_KSWZ(32 + sr, kc)) = ksa1; *(LAS bf16x8*)(B_ + 49152 + DA_KSWZ(sr, kc)) = ksb0; *(LAS bf16x8*)(B_ + 49152 + DA_KSWZ(32 + sr, kc)) = ksb1; } while (0)
#define DA_RESC(a) do { if (__any((a) < 1.f)) { if (hi == 0) al_l[r32] = (a); asm volatile("s_waitcnt lgkmcnt(0)" ::: "memory"); \
    _Pragma("unroll") for (int d = 0; d < 4; ++d) _Pragma("unroll") for (int r = 0; r < 16; ++r) o[d][r] *= al_l[crow(r, hi)]; } } while (0)
  f32x16 pA0, pA1, pB0, pB1; float mnA, mnB, alA, alB; bf16x8 pa0, pa1, pa2, pa3;
  DA_SLOAD(0); asm volatile("s_waitcnt vmcnt(0)" ::: "memory"); DA_SWRITE(0); __syncthreads();
  qkt(pA0, pA1, Kw, qr, r32, hi, m); partialSM(pA0, pA1, m_reg, mnA, alA);
  DA_SLOAD(1);
  asm volatile("s_waitcnt vmcnt(0)" ::: "memory"); DA_SWRITE(1); __syncthreads();
  for (int j = 1; j + 1 < NS; j += 2) {
    DA_SBAR(); qkt(pB0, pB1, Kw + 65536, qr, r32, hi, m);
    finishSM(pA0, pA1, alA, l_reg, pa0, pa1, pa2, pa3); DA_SBAR();
    DA_SLOAD(j + 1); DA_SBAR();
    pv_d0(o, vb0, pa0, pa1, pa2, pa3); partialSM(pB0, pB1, m_reg, mnB, alB);
    __syncthreads(); asm volatile("s_waitcnt vmcnt(0)" ::: "memory"); DA_SWRITE(0);
    DA_RESC(alB); __syncthreads();
    DA_SBAR(); qkt(pA0, pA1, Kw, qr, r32, hi, m);
    finishSM(pB0, pB1, alB, l_reg, pa0, pa1, pa2, pa3); DA_SBAR();
    DA_SLOAD(j + 2); DA_SBAR();
    pv_d0(o, vb0 + 65536, pa0, pa1, pa2, pa3); partialSM(pA0, pA1, m_reg, mnA, alA);
    __syncthreads(); asm volatile("s_waitcnt vmcnt(0)" ::: "memory"); DA_SWRITE(1);
    DA_RESC(alA); __syncthreads();
  }
  DA_SBAR(); qkt(pB0, pB1, Kw + 65536, qr, r32, hi, m);
  finishSM(pA0, pA1, alA, l_reg, pa0, pa1, pa2, pa3); DA_SBAR();
  pv_d0(o, vb0, pa0, pa1, pa2, pa3); partialSM(pB0, pB1, m_reg, mnB, alB);
  __syncthreads(); DA_RESC(alB);
  finishSM(pB0, pB1, alB, l_reg, pa0, pa1, pa2, pa3); DA_SBAR();
  pv_d0(o, vb0 + 65536, pa0, pa1, pa2, pa3);
  __syncthreads();
  LAS float* XP = (LAS float*)lds + (wid & 3) * 4096;
  LAS float* MLP = (LAS float*)(lds + 65536) + (wid & 3) * 64;
  if (kp == 1) {
#pragma unroll
    for (int d0 = 0; d0 < 4; ++d0)
#pragma unroll
      for (int r = 0; r < 16; ++r) XP[(d0 * 16 + r) * 64 + lane] = o[d0][r];
    if (hi == 0) { MLP[2 * r32] = m_reg; MLP[2 * r32 + 1] = l_reg; } }
  __syncthreads();
  float rli[16];
  if (kp == 0) {
    constexpr float C = SCALE * 1.4426950408889634f;
    const float m1 = MLP[2 * r32], l1 = MLP[2 * r32 + 1], ms = fmaxf(m_reg, m1), a0 = __builtin_amdgcn_exp2f((m_reg - ms) * C), a1 = __builtin_amdgcn_exp2f((m1 - ms) * C);
    l_reg = l_reg * a0 + l1 * a1;
    if (hi == 0) { al_l[r32] = a0; li_l[r32] = a1; } asm volatile("s_waitcnt lgkmcnt(0)" ::: "memory");
#pragma unroll
    for (int r = 0; r < 16; ++r) { const float f0 = al_l[crow(r, hi)], f1 = li_l[crow(r, hi)];
#pragma unroll
      for (int d0 = 0; d0 < 4; ++d0) o[d0][r] = o[d0][r] * f0 + XP[(d0 * 16 + r) * 64 + lane] * f1; }
    asm volatile("s_waitcnt lgkmcnt(0)" ::: "memory");
    if (hi == 0) li_l[r32] = l_reg; asm volatile("s_waitcnt lgkmcnt(0)" ::: "memory");
#pragma unroll
    for (int r = 0; r < 16; ++r) rli[r] = __builtin_amdgcn_rcpf(li_l[crow(r, hi)]); }
  __syncthreads();
  LAS float* X = (LAS float*)lds;
  if (kp == 0 && m == 1) {
#pragma unroll
    for (int r = 0; r < 16; ++r) { const int row = rb * 32 + crow(r, hi);
#pragma unroll
      for (int d0 = 0; d0 < 4; ++d0) X[row * 132 + d0 * 32 + r32] = o[d0][r] * rli[r]; } }
  __syncthreads();
  if (kp == 0 && m == 0) {
#pragma unroll
    for (int r = 0; r < 16; ++r) { const int row = rb * 32 + crow(r, hi);
#pragma unroll
      for (int d0 = 0; d0 < 4; ++d0) { LAS float* p = X + row * 132 + d0 * 32 + r32; *p = o[d0][r] * rli[r] - lam * *p; } }
    asm volatile("s_waitcnt lgkmcnt(0)" ::: "memory");
    const int row = rb * 32 + (lane >> 1), hf = lane & 1; const LAS float* xr = X + row * 132 + hf * 64;
    f32x4 v[16]; float ss = 0.f;
#pragma unroll
    for (int i = 0; i < 16; ++i) { v[i] = *(const LAS f32x4*)(xr + 4 * i); ss += (v[i].x * v[i].x + v[i].y * v[i].y) + (v[i].z * v[i].z + v[i].w * v[i].w); }
    ss += xorl<1>(ss);
    const float rs = (1.f / sqrtf(ss * (1.f / 128.f) + RMS_EPS)) * omli;
    bf16* op = YB + (size_t)(qrow0 + row) * 512 + h * 128 + hf * 64; const float* wp = nw + hf * 64;
#pragma unroll
    for (int i = 0; i < 8; ++i) { const f32x4 w0 = *(const f32x4*)(wp + 8 * i), w1 = *(const f32x4*)(wp + 8 * i + 4); const f32x4 a0 = v[2 * i] * rs * w0, a1 = v[2 * i + 1] * rs * w1;
      u32x4 w; w.x = cvtpk(a0.x, a0.y); w.y = cvtpk(a0.z, a0.w); w.z = cvtpk(a1.x, a1.y); w.w = cvtpk(a1.z, a1.w); *(u32x4*)(op + 8 * i) = w; }
  }
  __syncthreads();
#undef DA_KROW
#undef DA_SLOAD
#undef DA_SWRITE
#undef DA_RESC
}
#undef DA_KSWZ
#undef DA_SBAR
}

PHASE_FN void ph_diff_mfma(Ctx cx, int l_) {
    Frame F = mkframe(cx); const ArgsP a = F.ap; const int l = rfl(l_);
    REFRESH(F);
    const bf16* P = (const bf16*)(F.ws + WS_P); bf16* YB = (bf16*)(F.ws + WS_YB);
    const float lam = ((const float*)(F.ws + WS_LAM))[l], omli = 1.f - (0.8f - 0.6f * expf(-0.3f * (float)l));
    const float* nw = AIN(I_DNW) + l * 128;
    for (int it = F.bid; it < 512 + 16; it += F.G) {
        int b, h, q0, t0, NT;
        if (it < 512) { b = it >> 8; h = (it >> 6) & 3; q0 = b * SEQ + (it & 63) * 128; t0 = 0; NT = 132; }
        else { const int j = it - 512; b = j >> 3; h = (j >> 1) & 3; q0 = MLAT + b * CTXL + (j & 1) * 128; t0 = 128; NT = 4; }
        dattn::unit(P, YB, nw, lam, omli, b, h, q0, t0, NT, (LAS char*)F.lds, F.wave, F.lane);
    }
}
namespace gdn {
using f32x16 = __attribute__((ext_vector_type(16))) float;
constexpr int REC_BYTES = 57344, U_BYTES = 16384, OFF_NEGW = 0, OFF_QG = 16384, OFF_KT = 32768, OFF_QK = 49152, NSTEP = 132;
constexpr int QS = 0, KS = 17408, VS = 34816, L0 = 52224, A0 = 84992, SC = 117760;
__device__ __forceinline__ unsigned pk(float lo, float hi) { return pg8::cvt_pk_bf16(lo, hi); }
__device__ __forceinline__ float ldbf(const LAS unsigned short* p) { return __uint_as_float(((unsigned)*p) << 16); }

__device__ __forceinline__ void prep_item(const Frame& F, const ArgsP a, int l, int item) {
    const int b = item / (NSTEP * 4), rem = item % (NSTEP * 4), cn = rem >> 2, h = rem & 3;
    const bool isctx = cn < 4; const int row0 = isctx ? MLAT + b * CTXL + 64 * cn : b * SEQ + 64 * (cn - 4), t0 = isctx ? 64 * cn : 64 * (cn - 4), L = isctx ? CTXL : SEQ;
    const bf16* P = (const bf16*)(F.ws + WS_P); const float* DEC = (const float*)(F.ws + WS_DEC);
    LAS unsigned char* lds = F.lds; const int lane = F.lane, wave = F.wave, tid = F.tid;
    LAS unsigned short* Qs = (LAS unsigned short*)(lds + QS); LAS unsigned short* Ks = (LAS unsigned short*)(lds + KS); LAS unsigned short* Vs = (LAS unsigned short*)(lds + VS);
    LAS float* GC = (LAS float*)(lds + SC); LAS float* BE = GC + 128; LAS float* EG = GC + 256; LAS float* ET = GC + 384;
    { const float* cw = AIN(I_CONVW) + (size_t)l * 3 * 1536;
      unsigned xr[3][10];
#pragma unroll
      for (int wh = 0; wh < 3; ++wh) { const int c = wh * 512 + h * 128 + 2 * lane;
#pragma unroll
        for (int q = 0; q < 10; ++q) { const int i = wave * 8 + q - 1, t = t0 + i; xr[wh][q] = (t >= 0 && t < L) ? *(const unsigned*)(P + (size_t)(row0 + i) * NP + c) : 0u; } }
#pragma unroll
      for (int wh = 0; wh < 3; ++wh) { const int c = wh * 512 + h * 128 + 2 * lane;
        const f32x2 w0 = *(const f32x2*)(cw + c), w1 = *(const f32x2*)(cw + 1536 + c), w2 = *(const f32x2*)(cw + 3072 + c);
#pragma unroll
        for (int ii = 0; ii < 8; ++ii) { const int i = wave * 8 + ii;
            float y0 = bflo(xr[wh][ii]) * w0.x + bflo(xr[wh][ii + 1]) * w1.x + bflo(xr[wh][ii + 2]) * w2.x, y1 = bfhi(xr[wh][ii]) * w0.y + bfhi(xr[wh][ii + 1]) * w1.y + bfhi(xr[wh][ii + 2]) * w2.y;
            y0 = siluf(y0); y1 = siluf(y1);
            if (wh < 2) { const float ss = wave_sum(y0 * y0 + y1 * y1), sc = (1.f / sqrtf(ss + RMS_EPS)) * (wh == 0 ? 0.08838834764831845f : 1.f); y0 *= sc; y1 *= sc; }
            LAS unsigned short* dst = (wh == 0 ? Qs : wh == 1 ? Ks : Vs) + i * 136 + 2 * lane; *(LAS unsigned*)dst = pk(y0, y1); } } }
    if (wave < 2) { const int d = wave, t = d ? 63 - lane : lane; const size_t row = (size_t)(row0 + t);
        const float al = expf(AIN(I_ALOG)[(l * 2 + d) * 4 + h]), av = DEC[row * 16 + 8 * d + h] + AIN(I_DTB)[(l * 2 + d) * 4 + h], bb = DEC[row * 16 + 8 * d + 4 + h];
        const float ye = __expf(fminf(av, 20.f)), sp = av > 20.f ? av : (ye < 1e-2f ? ye * (1.f - ye * (0.5f - ye * 0.33333334f)) : __logf(1.f + ye)); float gc = -al * sp;
#pragma unroll
        for (int o = 1; o < 64; o <<= 1) { const float v = __shfl_up(gc, o); if (lane >= o) gc += v; }
        const float gl = __shfl(gc, 63);
        GC[d * 64 + lane] = gc; BE[d * 64 + lane] = sigmf(bb); EG[d * 64 + lane] = expf(gc); ET[d * 64 + lane] = expf(gl - gc);
        if (lane == 63) { const int step = d ? (cn < 4 ? 3 - cn : 135 - cn) : cn; ((float*)(F.ws + WS_GL))[((b * 4 + h) * 2 + d) * NSTEP + step] = expf(gl); } }
    __syncthreads();
    { const int mat = wave >> 2, mi = wave & 3, fr = lane & 15, fq = lane >> 4; const LAS unsigned short* As = mat ? Qs : Ks;
#pragma unroll 1
      for (int nj = 0; nj < 4; ++nj) { f32x4 acc = {0.f, 0.f, 0.f, 0.f};
#pragma unroll
        for (int ks = 0; ks < 4; ++ks) { const bf16x8 af = *(const LAS bf16x8*)(As + (16 * mi + fr) * 136 + 32 * ks + 8 * fq), bfr = *(const LAS bf16x8*)(Ks + (16 * nj + fr) * 136 + 32 * ks + 8 * fq);
            acc = __builtin_amdgcn_mfma_f32_16x16x32_bf16(af, bfr, acc, 0, 0, 0); }
#pragma unroll
        for (int r = 0; r < 4; ++r) { const int ti = 16 * mi + 4 * fq + r, tj = 16 * nj + fr;
#pragma unroll
            for (int d = 0; d < 2; ++d) { const int i = d ? 63 - ti : ti, j = d ? 63 - tj : tj; const bool keep = mat ? (i >= j) : (i > j);
                float v = 0.f; if (keep) { v = acc[r] * __expf(fminf(GC[d * 64 + i] - GC[d * 64 + j], 0.f)); if (!mat) v *= BE[d * 64 + i]; }
                ((LAS float*)(lds + (mat ? A0 : L0) + d * 16384))[i * 64 + j] = v; } } } }
    __syncthreads();
    const int d = __builtin_amdgcn_readfirstlane(tid >> 8), c = tid & 255, cc = c & 127; const bool isw = __builtin_amdgcn_readfirstlane(c >> 7) != 0;
    float x[64];
    { const LAS float* Ld = (const LAS float*)(lds + L0 + d * 16384); const LAS unsigned short* src = (isw ? Ks : Vs) + cc;
#pragma unroll
      for (int i = 0; i < 64; ++i) x[i] = 0.f;
#pragma unroll
      for (int i = 0; i < 64; ++i) { const int t = d ? 63 - i : i; float acc = ldbf(src + t * 136) * BE[d * 64 + i] * (isw ? EG[d * 64 + i] : 1.f);
#pragma unroll
          for (int j4 = 0; j4 < (i + 3) / 4; ++j4) { const f32x4 lv = *(const LAS f32x4*)(Ld + i * 64 + 4 * j4);
              acc -= lv.x * x[4 * j4]; if (4 * j4 + 1 < i) acc -= lv.y * x[4 * j4 + 1]; if (4 * j4 + 2 < i) acc -= lv.z * x[4 * j4 + 2]; if (4 * j4 + 3 < i) acc -= lv.w * x[4 * j4 + 3]; }
          asm volatile("" : "+v"(acc) :: "memory"); x[i] = acc; } }
    const int step = d ? (cn < 4 ? 3 - cn : 135 - cn) : cn; const size_t ridx = (size_t)((b * 4 + h) * 2 + d) * NSTEP + step;
    unsigned char* rec = (unsigned char*)(F.ws + WS_REC + ridx * REC_BYTES);
    if (!isw) {
        unsigned char* ub = (unsigned char*)(F.ws + WS_U + ridx * U_BYTES); const int nt = cc >> 5, col = cc & 31;
#pragma unroll
        for (int mt = 0; mt < 2; ++mt)
#pragma unroll
            for (int hi = 0; hi < 2; ++hi) { u32x4 w0, w1; const int ib = 32 * mt + 4 * hi;
                w0.x = pk(x[ib + 0], x[ib + 1]); w0.y = pk(x[ib + 2], x[ib + 3]); w0.z = pk(x[ib + 8], x[ib + 9]); w0.w = pk(x[ib + 10], x[ib + 11]);
                w1.x = pk(x[ib + 16], x[ib + 17]); w1.y = pk(x[ib + 18], x[ib + 19]); w1.z = pk(x[ib + 24], x[ib + 25]); w1.w = pk(x[ib + 26], x[ib + 27]);
                u32x4* dst = (u32x4*)(ub + (size_t)(((mt * 4 + nt) * 64 + hi * 32 + col) * 32)); dst[0] = w0; dst[1] = w1; } }
    __syncthreads();
    LAS unsigned short* Xw = (LAS unsigned short*)(lds + L0 + d * 16384);
    if (isw) {
#pragma unroll
        for (int i = 0; i < 64; ++i) Xw[i * 128 + cc] = (unsigned short)(pk(-x[i], 0.f) & 0xffffu); }
    __syncthreads();
    { const int u2 = tid & 255; const LAS float* Ad = (const LAS float*)(lds + A0 + d * 16384);
#pragma unroll
      for (int q = 0; q < 4; ++q) { const int s = u2 + 256 * q, f = s >> 6, ln = s & 63, r32 = ln & 31, hi = ln >> 5;
          { const int mt = f >> 3, ks = f & 7, i = 32 * mt + r32, t = d ? 63 - i : i, k0 = 16 * ks + 4 * hi;
            const u32x2 wa = *(const LAS u32x2*)(Xw + i * 128 + k0), wb = *(const LAS u32x2*)(Xw + i * 128 + k0 + 8);
            *(u32x4*)(rec + OFF_NEGW + s * 16) = (u32x4){wa.x, wa.y, wb.x, wb.y};
            const float eg = EG[d * 64 + i]; const u32x2 qa = *(const LAS u32x2*)(Qs + t * 136 + k0), qb = *(const LAS u32x2*)(Qs + t * 136 + k0 + 8);
            *(u32x4*)(rec + OFF_QG + s * 16) = (u32x4){pk(bflo(qa.x) * eg, bfhi(qa.x) * eg), pk(bflo(qa.y) * eg, bfhi(qa.y) * eg), pk(bflo(qb.x) * eg, bfhi(qb.x) * eg), pk(bflo(qb.y) * eg, bfhi(qb.y) * eg)}; }
          { const int mtS = f >> 2, ks = f & 3, dk = 32 * mtS + r32; float kv[8];
#pragma unroll
            for (int j = 0; j < 8; ++j) { const int i = 16 * ks + 8 * (j >> 2) + 4 * hi + (j & 3), t = d ? 63 - i : i; kv[j] = ldbf(Ks + t * 136 + dk) * ET[d * 64 + i]; }
            *(u32x4*)(rec + OFF_KT + s * 16) = (u32x4){pk(kv[0], kv[1]), pk(kv[2], kv[3]), pk(kv[4], kv[5]), pk(kv[6], kv[7])}; } }
#pragma unroll
      for (int q = 0; q < 2; ++q) { const int s = u2 + 256 * q, f = s >> 6, ln = s & 63, r32 = ln & 31, hi = ln >> 5, mt = f >> 2, ks = f & 3, i = 32 * mt + r32, j0 = 16 * ks + 4 * hi;
          const f32x4 va = *(const LAS f32x4*)(Ad + i * 64 + j0), vb = *(const LAS f32x4*)(Ad + i * 64 + j0 + 8);
          *(u32x4*)(rec + OFF_QK + s * 16) = (u32x4){pk(va.x, va.y), pk(va.z, va.w), pk(vb.x, vb.y), pk(vb.z, vb.w)}; } }
    __syncthreads();
}

__device__ __forceinline__ bf16x8 pack8(const f32x16& v, int s) {
    u32x4 p; p.x = pk(v[8 * s], v[8 * s + 1]); p.y = pk(v[8 * s + 2], v[8 * s + 3]); p.z = pk(v[8 * s + 4], v[8 * s + 5]); p.w = pk(v[8 * s + 6], v[8 * s + 7]); return __builtin_bit_cast(bf16x8, p); }
#define GDN_MFMA(a, b, c) __builtin_amdgcn_mfma_f32_32x32x16_bf16((a), (b), (c), 0, 0, 0)
#define GDN_FRAG(buf, off, f) (*(const LAS bf16x8*)((buf) + (off) + (f) * 1024 + lane * 16))
__device__ __forceinline__ void chain(const Frame& F, int b, int h, int d) {
    const int lane = F.lane, wave = F.wave, r32 = lane & 31, hi = lane >> 5, nt = wave & 3; const bool comp = wave < 4;
    LAS unsigned char* lds = F.lds;
    const size_t rbase = (size_t)((b * 4 + h) * 2 + d) * NSTEP;
    const unsigned char* recs = (const unsigned char*)(F.ws + WS_REC + rbase * REC_BYTES); const unsigned char* us = (const unsigned char*)(F.ws + WS_U + rbase * U_BYTES); const float* gls = (const float*)(F.ws + WS_GL) + rbase;
    float* OGu = (float*)(F.ws + WS_OG) + (size_t)d * MT * 512 + h * 128 + nt * 32;
    const int olane = (d ? -2048 * hi : 2048 * hi) + r32;
    f32x16 S[4]; bf16x8 Sb[8];
#pragma unroll
    for (int i = 0; i < 4; ++i) S[i] = f32x16{};
#pragma unroll
    for (int i = 0; i < 8; ++i) Sb[i] = bf16x8{};
#define GDN_DMA(step, bufi) do { const unsigned char* src_ = recs + (size_t)(step) * REC_BYTES + lane * 16; LAS unsigned char* dst_ = lds + (bufi) * REC_BYTES; \
        _Pragma("unroll") for (int p_ = 0; p_ < 14; ++p_) __builtin_amdgcn_global_load_lds((const GAS unsigned*)(src_ + ((wave - 4) * 14 + p_) * 1024), (LAS unsigned*)(dst_ + ((wave - 4) * 14 + p_) * 1024), 16, 0, 0); } while (0)
#define GDN_ULOAD(step) do { _Pragma("unroll") for (int mt_ = 0; mt_ < 2; ++mt_) { const u32x4* up_ = (const u32x4*)(us + (size_t)(step) * U_BYTES + (size_t)(((mt_ * 4 + nt) * 64 + lane) * 32)); un[2 * mt_] = up_[0]; un[2 * mt_ + 1] = up_[1]; } } while (0)
    u32x4 un[4];
#pragma unroll
    for (int i = 0; i < 4; ++i) un[i] = (u32x4){0u, 0u, 0u, 0u};
    float egn = 0.f;
    if (comp) { GDN_ULOAD(0); egn = gls[0]; } else { GDN_DMA(0, 0); asm volatile("s_waitcnt vmcnt(0)" ::: "memory"); }
    __syncthreads();
#pragma unroll 1
    for (int step = 0; step < NSTEP; ++step) {
        const LAS unsigned char* buf = lds + (step & 1) * REC_BYTES;
        if (!comp) { if (step + 1 < NSTEP) GDN_DMA(step + 1, (step + 1) & 1); }
        else {
            const float egl = egn;
            f32x16 Vp[2];
#pragma unroll
            for (int mt = 0; mt < 2; ++mt) { const u32x4 w0 = un[2 * mt], w1 = un[2 * mt + 1];
                Vp[mt] = (f32x16){bflo(w0.x), bfhi(w0.x), bflo(w0.y), bfhi(w0.y), bflo(w0.z), bfhi(w0.z), bflo(w0.w), bfhi(w0.w), bflo(w1.x), bfhi(w1.x), bflo(w1.y), bfhi(w1.y), bflo(w1.z), bfhi(w1.z), bflo(w1.w), bfhi(w1.w)}; }
#pragma unroll
            for (int mtS = 0; mtS < 4; ++mtS)
#pragma unroll
                for (int r = 0; r < 16; ++r) S[mtS][r] *= egl;
            asm volatile("" : "+v"(Vp[0]), "+v"(Vp[1]), "+v"(S[0]), "+v"(S[1]), "+v"(S[2]), "+v"(S[3]) :: "memory");
            if (step + 1 < NSTEP) { GDN_ULOAD(step + 1); egn = gls[step + 1]; }
#pragma unroll
            for (int ks = 0; ks < 8; ++ks) {
#pragma unroll
                for (int mt = 0; mt < 2; ++mt) Vp[mt] = GDN_MFMA(GDN_FRAG(buf, OFF_NEGW, mt * 8 + ks), Sb[ks], Vp[mt]);
                if ((ks & 3) == 3) asm volatile("" ::: "memory"); }
            bf16x8 Vb[4];
            Vb[0] = pack8(Vp[0], 0); Vb[1] = pack8(Vp[0], 1); Vb[2] = pack8(Vp[1], 0); Vb[3] = pack8(Vp[1], 1);
            const int cn = d ? (step < 4 ? 3 - step : 135 - step) : step; const size_t orow0 = cn < 4 ? (size_t)(MLAT + b * CTXL + 64 * cn) : (size_t)(b * SEQ + 64 * (cn - 4));
#pragma unroll
            for (int mt = 0; mt < 2; ++mt) { f32x16 O = f32x16{};
#pragma unroll
                for (int ks = 0; ks < 8; ++ks) { O = GDN_MFMA(GDN_FRAG(buf, OFF_QG, mt * 8 + ks), Sb[ks], O); if ((ks & 3) == 3) asm volatile("" ::: "memory"); }
#pragma unroll
                for (int ks = 0; ks < 4; ++ks) O = GDN_MFMA(GDN_FRAG(buf, OFF_QK, mt * 4 + ks), Vb[ks], O);
#pragma unroll
                for (int r = 0; r < 16; ++r) { const int iu = 32 * mt + (r & 3) + 8 * (r >> 2), tu = d ? 63 - iu : iu; (OGu + (orow0 + tu) * 512)[olane] = O[r]; } }
#pragma unroll
            for (int mtS = 0; mtS < 4; ++mtS) {
#pragma unroll
                for (int ks = 0; ks < 4; ++ks) S[mtS] = GDN_MFMA(GDN_FRAG(buf, OFF_KT, mtS * 4 + ks), Vb[ks], S[mtS]);
                Sb[2 * mtS] = pack8(S[mtS], 0); Sb[2 * mtS + 1] = pack8(S[mtS], 1); asm volatile("" ::: "memory"); }
        }
        if (!comp) asm volatile("s_waitcnt vmcnt(0)" ::: "memory");
        asm volatile("s_waitcnt lgkmcnt(0)" ::: "memory"); __builtin_amdgcn_s_barrier(); asm volatile("" ::: "memory");
    }
    __syncthreads();
#undef GDN_DMA
#undef GDN_ULOAD
}
#undef GDN_MFMA
#undef GDN_FRAG
}

PHASE_FN void ph_gdn_prep(Ctx cx, int l_) {
    Frame F = mkframe(cx); const ArgsP a = F.ap; const int l = rfl(l_);
    REFRESH(F);
    for (int it = F.bid; it < BATCH * gdn::NSTEP * 4; it += F.G) { REFRESH(F); gdn::prep_item(F, a, l, it); }
}
PHASE_FN void ph_gdn_chain(Ctx cx, int l_) {
    Frame F = mkframe(cx); const int l = rfl(l_);
    REFRESH(F);
    for (int it = F.bid; it < 16; it += F.G) gdn::chain(F, it >> 3, (it >> 1) & 3, it & 1);
}
namespace na {
constexpr int VTL = SEQ + CTXL;
constexpr float C2 = 0.125f * 1.4426950408889634f, L2E = 1.4426950408889634f;
struct KV { bf16x8 k[4]; bf16x8 v[4]; };
__device__ __forceinline__ KV load_group(const bf16* kp0, const bf16* vt, int lane) {
    const int m = lane & 15, kq = lane >> 4; KV r;
    const bf16* ka = kp0 + (size_t)(8 * (m >> 2) + (m & 3)) * NP + 8 * kq;
    r.k[0] = *(const bf16x8*)ka; r.k[1] = *(const bf16x8*)(ka + 4 * NP); r.k[2] = *(const bf16x8*)(ka + 32); r.k[3] = *(const bf16x8*)(ka + 4 * NP + 32);
    const bf16* va = vt + (size_t)m * VTL + 8 * kq;
#pragma unroll
    for (int dt = 0; dt < 4; ++dt) r.v[dt] = *(const bf16x8*)(va + (size_t)(16 * dt) * VTL);
    return r;
}
constexpr int NA_LK = 4096, NA_LV = NA_LK + 256 * 144;
__device__ __forceinline__ KV load_group_lds(const LAS unsigned char* lds, int g, int lane) {
    const int m = lane & 15, kq = lane >> 4; KV r;
    const LAS unsigned char* ka = lds + NA_LK + (32 * g + 8 * (m >> 2) + (m & 3)) * 144 + 16 * kq;
    r.k[0] = *(const LAS bf16x8*)ka; r.k[1] = *(const LAS bf16x8*)(ka + 4 * 144); r.k[2] = *(const LAS bf16x8*)(ka + 64); r.k[3] = *(const LAS bf16x8*)(ka + 4 * 144 + 64);
    const LAS unsigned char* va = lds + NA_LV + m * 528 + (32 * g + 8 * kq) * 2;
#pragma unroll
    for (int dt = 0; dt < 4; ++dt) r.v[dt] = *(const LAS bf16x8*)(va + 16 * dt * 528);
    return r;
}
__device__ __forceinline__ void group(const KV& kv, const bf16x8 (&qf)[2], bool local, const LAS float* rprow, int cmin, int cq, int kc0, int lane, float& mrun, float& lrun, f32x4 (&o)[4]) {
    const int kq = lane >> 4;
    f32x4 sa = {0.f, 0.f, 0.f, 0.f}, sb = {0.f, 0.f, 0.f, 0.f};
    sa = __builtin_amdgcn_mfma_f32_16x16x32_bf16(kv.k[0], qf[0], sa, 0, 0, 0); sb = __builtin_amdgcn_mfma_f32_16x16x32_bf16(kv.k[1], qf[0], sb, 0, 0, 0);
    sa = __builtin_amdgcn_mfma_f32_16x16x32_bf16(kv.k[2], qf[1], sa, 0, 0, 0); sb = __builtin_amdgcn_mfma_f32_16x16x32_bf16(kv.k[3], qf[1], sb, 0, 0, 0);
    float t[8];
#pragma unroll
    for (int j = 0; j < 4; ++j) { t[j] = sa[j] * C2; t[4 + j] = sb[j] * C2; }
    if (local) {
#pragma unroll
        for (int j = 0; j < 8; ++j) { const int kc = kc0 + 8 * kq + j; const bool ok = (kc >= cmin) && (kc < cmin + 16); const int bi = min(max(kc - cq + 15, 0), 30);
            t[j] = ok ? t[j] + rprow[bi] * L2E : -1e30f; } }
    float gm = fmaxf(fmaxf(fmaxf(t[0], t[1]), fmaxf(t[2], t[3])), fmaxf(fmaxf(t[4], t[5]), fmaxf(t[6], t[7])));
    gm = fmaxf(gm, xorl<16>(gm)); gm = fmaxf(gm, xorl<32>(gm));
    const float mn = fmaxf(mrun, gm), corr = __builtin_amdgcn_exp2f(mrun - mn); mrun = mn;
    float ps = 0.f;
#pragma unroll
    for (int j = 0; j < 8; ++j) { t[j] = __builtin_amdgcn_exp2f(t[j] - mn); ps += t[j]; }
    ps += xorl<16>(ps); ps += xorl<32>(ps);
    lrun = lrun * corr + ps;
    u32x4 pw; pw.x = pg8::cvt_pk_bf16(t[0], t[1]); pw.y = pg8::cvt_pk_bf16(t[2], t[3]); pw.z = pg8::cvt_pk_bf16(t[4], t[5]); pw.w = pg8::cvt_pk_bf16(t[6], t[7]);
    const bf16x8 pf = __builtin_bit_cast(bf16x8, pw);
#pragma unroll
    for (int dt = 0; dt < 4; ++dt) { o[dt] = o[dt] * corr; o[dt] = __builtin_amdgcn_mfma_f32_16x16x32_bf16(kv.v[dt], pf, o[dt], 0, 0, 0); }
}
}

__device__ __forceinline__ void vt_item(const Frame& F, int it) {
    const bf16* P = (const bf16*)(F.ws + WS_P); bf16* VT = (bf16*)(F.ws + WS_VT);
    LAS unsigned char* tile = F.lds + F.wave * 9216; const int lane = F.lane;
    const int b = it / (8 * 132), rem = it % (8 * 132), h = rem / 132, tb = rem % 132;
    const size_t row0 = tb < 128 ? (size_t)(b * SEQ + 64 * tb) : (size_t)(MLAT + b * CTXL + 64 * (tb - 128));
    const bf16* src = P + (row0 + lane) * NP + PC_NV + h * 64;
#pragma unroll
    for (int c = 0; c < 8; ++c) *(LAS u32x4*)(tile + lane * 144 + 16 * c) = *(const u32x4*)(src + 8 * c);
    LDS_WAIT(); asm volatile("" ::: "memory");
    bf16* dst = VT + ((size_t)((b * 8 + h) * 64 + lane)) * na::VTL + 64 * tb;
#pragma unroll
    for (int c = 0; c < 8; ++c) { unsigned w[4];
#pragma unroll
        for (int q = 0; q < 4; ++q) { const unsigned lo = *(const LAS unsigned short*)(tile + (8 * c + 2 * q) * 144 + 2 * lane), hi = *(const LAS unsigned short*)(tile + (8 * c + 2 * q + 1) * 144 + 2 * lane); w[q] = lo | (hi << 16); }
        *(u32x4*)(dst + 8 * c) = (u32x4){w[0], w[1], w[2], w[3]}; }
    LDS_WAIT(); asm volatile("" ::: "memory");
}
__device__ __forceinline__ void rope_row(const Frame& F, int row) {
    const int blk = F.lane >> 2, j8 = F.lane & 3; bf16* P = (bf16*)(F.ws + WS_P);
    const int t = row & (SEQ - 1); const float pos = (float)(j8 < 2 ? (t >> 6) : (t & 63));
    bf16* p = P + (size_t)row * NP + PC_DQ + blk * 64 + 8 * j8;
    const u32x4 w1 = *(const u32x4*)p, w2 = *(const u32x4*)(p + 32);
    float x1[8] = {bflo(w1.x), bfhi(w1.x), bflo(w1.y), bfhi(w1.y), bflo(w1.z), bfhi(w1.z), bflo(w1.w), bfhi(w1.w)};
    float x2[8] = {bflo(w2.x), bfhi(w2.x), bflo(w2.y), bfhi(w2.y), bflo(w2.z), bfhi(w2.z), bflo(w2.w), bfhi(w2.w)};
    float y1[8], y2[8];
#pragma unroll
    for (int i = 0; i < 8; ++i) { const float inv = exp2f(-(float)(8 * (j8 & 1) + i) * (13.287712379549449f / 16.f)) * 0.15915494309189535f;
        const float rev = pos * inv, fr = rev - floorf(rev), cs = __builtin_amdgcn_cosf(fr), sn = __builtin_amdgcn_sinf(fr);
        y1[i] = x1[i] * cs - x2[i] * sn; y2[i] = x2[i] * cs + x1[i] * sn; }
    *(u32x4*)p = (u32x4){pk2(y1[0], y1[1]), pk2(y1[2], y1[3]), pk2(y1[4], y1[5]), pk2(y1[6], y1[7])};
    *(u32x4*)(p + 32) = (u32x4){pk2(y2[0], y2[1]), pk2(y2[2], y2[3]), pk2(y2[4], y2[5]), pk2(y2[6], y2[7])};
}
PHASE_FN void ph_prepq(Ctx cx, int l_) {
    Frame F = mkframe(cx); const ArgsP a = F.ap; const int l = rfl(l_);
    volatile LAS int* qw = (volatile LAS int*)(F.lds + MISC_OFF + 64);
    constexpr int N_G = BATCH * gdn::NSTEP * 4, N_R = MLAT / 32, N_V = BATCH * 8 * 132 / 8, N_ALL = N_G + N_R + N_V;
    for (;;) {
        REFRESH(F);
        __syncthreads();
        if (F.tid == 0) *qw = (int)__hip_atomic_fetch_add(F.ctl + CW_Q + 64 * (8 + l), 1u, __ATOMIC_RELAXED, __HIP_MEMORY_SCOPE_AGENT);
        __syncthreads();
        const int idx = rfl(*qw);
        if (idx >= N_ALL) break;
        if (idx < N_G) gdn::prep_item(F, a, l, idx);
        else if (idx < N_G + N_R) { const int r0 = (idx - N_G) * 32 + F.wave * 4;
#pragma unroll
            for (int q = 0; q < 4; ++q) rope_row(F, r0 + q); }
        else vt_item(F, (idx - N_G - N_R) * 8 + F.wave);
    }
}

constexpr int NA_NLAT = BATCH * 8 * 128 * 4, NA_NCTX = BATCH * 8 * 16, NA_ITEMS = NA_NLAT + NA_NCTX;
__device__ __forceinline__ void na_wave_item(const Frame& F, const LAS float* rp, int it) {
    const bf16* P = (const bf16*)(F.ws + WS_P); const bf16* VT = (const bf16*)(F.ws + WS_VT); bf16* YC = (bf16*)(F.ws + WS_YC);
    const int lane = F.lane, qi = lane & 15, kq = lane >> 4;
    const bool lat = it < NA_NLAT; int b, h, r = 0, n = 0, qrow;
    if (lat) { b = it >> 12; h = (it >> 9) & 7; r = (it >> 2) & 127; n = it & 3; qrow = b * SEQ + r * 64 + 16 * n + qi; }
    else { const int j = it - NA_NLAT; b = j >> 7; h = (j >> 4) & 7; qrow = MLAT + b * CTXL + 16 * (j & 15) + qi; }
    bf16x8 qf[2];
    { const bf16* qp = P + (size_t)qrow * NP + PC_NQ + h * 64 + 8 * kq; qf[0] = *(const bf16x8*)qp; qf[1] = *(const bf16x8*)(qp + 32); }
    f32x4 o[4];
#pragma unroll
    for (int dt = 0; dt < 4; ++dt) o[dt] = (f32x4){0.f, 0.f, 0.f, 0.f};
    float mrun = -1e30f, lrun = 0.f;
    const bf16* Kb = P + PC_NK + h * 64; const bf16* VTh = VT + (size_t)((b * 8 + h) * 64) * na::VTL;
    const int r0 = min(max(r - 4, 0), 120), kc0 = min(max(16 * n - 8, 0), 32), cq = 16 * n + qi, cmin = min(max(cq - 8, 0), 48);
#define NA_KP(g) ((g) < 8 ? Kb + (size_t)(b * SEQ + (r0 + (g)) * 64 + kc0) * NP : Kb + (size_t)(MLAT + b * CTXL + 32 * ((g) - 8)) * NP)
#define NA_VP(g) ((g) < 8 ? VTh + (r0 + (g)) * 64 + kc0 : VTh + SEQ + 32 * ((g) - 8))
    const LAS unsigned char* ldsb = (const LAS unsigned char*)F.lds;
    if (lat) {
        na::KV w0 = na::load_group(NA_KP(0), NA_VP(0), lane), w1 = na::load_group(NA_KP(1), NA_VP(1), lane), w2 = na::load_group(NA_KP(2), NA_VP(2), lane);
#pragma unroll
        for (int g = 0; g < 8; ++g) {
            na::KV nw = w2;
            if (g + 3 < 8) nw = na::load_group(NA_KP(g + 3), NA_VP(g + 3), lane);
            na::group(w0, qf, true, rp + (r0 + g - r + 7) * 31, cmin, cq, kc0, lane, mrun, lrun, o);
            w0 = w1; w1 = w2; w2 = nw;
            asm volatile("" ::: "memory");
        }
    }
#pragma unroll 2
    for (int g = 0; g < 8; ++g) { const na::KV w = na::load_group_lds(ldsb, g, lane); na::group(w, qf, false, rp, cmin, cq, kc0, lane, mrun, lrun, o); }
#undef NA_KP
#undef NA_VP
    const float il = 1.f / lrun; bf16* op = YC + (size_t)qrow * 512 + h * 64 + 4 * kq;
#pragma unroll
    for (int dt = 0; dt < 4; ++dt) { u32x2 w; w.x = pg8::cvt_pk_bf16(o[dt][0] * il, o[dt][1] * il); w.y = pg8::cvt_pk_bf16(o[dt][2] * il, o[dt][3] * il); *(u32x2*)(op + 16 * dt) = w; }
}
PHASE_FN void ph_mixers(Ctx cx, int l_) {
    Frame F = mkframe(cx); const ArgsP a = F.ap; const int l = rfl(l_);
    volatile LAS int* qw = (volatile LAS int*)(F.lds + MISC_OFF + 64);
#ifndef NA_REP
#define NA_REP 1
#endif
    constexpr int N_FULL = 480, N_HALF = 2 * (512 - N_FULL), N_CH = 16, N_DF = N_FULL + N_HALF + 16, N_NA = (NA_ITEMS + 7) / 8, N_CV = ITL_ALL / 64, N_WORK = N_CH + N_DF + NA_REP * N_NA;
    constexpr int CV_START = N_FULL;
    constexpr int N_CV0 = (ITL_ALL - ITL_PRE) / 64;
    const int ncv = (l < DEPTH - 1 ? N_CV : 0) + (l == 0 ? N_CV0 : 0), N_ALL = N_WORK + ncv;
    const int cvs = l == 0 ? 0 : CV_START, nwk = N_WORK - N_CH - cvs, pairs = ncv < nwk ? ncv : nwk;
    const float lam = ((const float*)(F.ws + WS_LAM))[l], omli = 1.f - (0.8f - 0.6f * expf(-0.3f * (float)l));
    int staged = -1;
#ifdef TCLS
    unsigned long long tc0_ = __builtin_amdgcn_s_memrealtime(), tcacc_ = 0; int tcls_ = -1;
#endif
    for (;;) {
        REFRESH(F);
        __syncthreads();
        if (F.tid == 0) *qw = (int)__hip_atomic_fetch_add(F.ctl + CW_Q + 64 * l, 1u, __ATOMIC_RELAXED, __HIP_MEMORY_SCOPE_AGENT);
        __syncthreads();
        int idx = rfl(*qw);
#ifdef TCLS
        { const unsigned long long tn_ = __builtin_amdgcn_s_memrealtime(); if (tcls_ == TCLS) tcacc_ += tn_ - tc0_; tc0_ = tn_; tcls_ = -1; }
#endif
        if (idx >= N_ALL) break;
        { const int p = idx - N_CH - cvs; if (p >= 0) { int ck = -1;
              if (p < 2 * pairs) { if (p & 1) ck = p >> 1; else idx = N_CH + cvs + (p >> 1); }
              else if (ncv > nwk) ck = p - pairs; else idx = N_CH + cvs + p - pairs;
              if (ck >= 0) { LAS float* scr = (LAS float*)(F.lds + F.wave * 16384);
#ifdef TCLS
                  tcls_ = 5;
#endif
                  const bool own = l == 0 && ck < N_CV0;
                  conv_run(F, a, own ? 0 : l + 1, (own ? ITL_PRE + ck * 64 : (ck - (l == 0 ? N_CV0 : 0)) * 64) + F.wave, 8, 8, scr); staged = -1;
                  continue; } } }
        if (idx < N_CH + N_DF) staged = -1;
#ifdef TCLS
        tcls_ = idx < N_CH ? 0 : idx < N_CH + N_FULL ? 1 : idx < N_CH + N_FULL + N_HALF ? 2 : idx < N_CH + N_DF ? 3 : 4;
#endif
#ifdef TCHAIN
        if (idx < N_CH) { const unsigned long long t0_ = __builtin_amdgcn_s_memrealtime(); gdn::chain(F, idx >> 3, (idx >> 1) & 3, idx & 1);
            if (idx == TCHAIN && F.tid == 0) *(unsigned long long*)(F.ctl + 30000) += __builtin_amdgcn_s_memrealtime() - t0_; }
#else
        if (idx < N_CH) gdn::chain(F, idx >> 3, (idx >> 1) & 3, idx & 1);
#endif
        else if (idx < N_CH + N_DF) { const int it = idx - N_CH;
            if (it < N_FULL) { const int b = it >> 8, h = (it >> 6) & 3, q0 = b * SEQ + (it & 63) * 128;
                dattn::unit3((const bf16*)(F.ws + WS_P), (bf16*)(F.ws + WS_YB), AIN(I_DNW) + l * 128, lam, omli, b, h, q0, 0, 132, (LAS char*)F.lds, F.wave, F.lane); }
            else if (it < N_FULL + N_HALF) { const int j = it - N_FULL, u = N_FULL + (j >> 1), b = u >> 8, h = (u >> 6) & 3, q0 = b * SEQ + (u & 63) * 128 + (j & 1) * 64;
                dattn::unit64((const bf16*)(F.ws + WS_P), (bf16*)(F.ws + WS_YB), AIN(I_DNW) + l * 128, lam, omli, b, h, q0, 0, 132, (LAS char*)F.lds, F.wave, F.lane); }
            else if (l < DEPTH - 1) { const int j = it - N_FULL - N_HALF, b = j >> 3, h = (j >> 1) & 3, q0 = MLAT + b * CTXL + (j & 1) * 128;
                dattn::unit((const bf16*)(F.ws + WS_P), (bf16*)(F.ws + WS_YB), AIN(I_DNW) + l * 128, lam, omli, b, h, q0, 128, 4, (LAS char*)F.lds, F.wave, F.lane); } }
        else { const int it0 = ((idx - N_CH - N_DF) % N_NA) * 8, it = it0 + F.wave; const int h = it0 < NA_NLAT ? (it0 >> 9) & 7 : ((it0 - NA_NLAT) >> 4) & 7;
            const int bq = it0 < NA_NLAT ? it0 >> 12 : (it0 - NA_NLAT) >> 7;
            LAS float* rpl = (LAS float*)F.lds;
            if (F.tid < 465) rpl[F.tid] = AIN(I_RPB)[((size_t)l * 8 + h) * 465 + F.tid];
            if (staged != bq * 8 + h) { staged = bq * 8 + h;
                const bf16* Pk = (const bf16*)(F.ws + WS_P) + (size_t)(MLAT + bq * CTXL) * NP + PC_NK + h * 64;
#pragma unroll
                for (int q = 0; q < 4; ++q) { const int e = F.tid + 512 * q, row = e >> 3, c = e & 7; *(LAS u32x4*)(F.lds + na::NA_LK + row * 144 + 16 * c) = *(const u32x4*)(Pk + (size_t)row * NP + 8 * c); }
                const bf16* Vt = (const bf16*)(F.ws + WS_VT) + (size_t)((bq * 8 + h) * 64) * na::VTL + SEQ;
#pragma unroll
                for (int q = 0; q < 4; ++q) { const int e = F.tid + 512 * q, d = e >> 5, c = e & 31; *(LAS u32x4*)(F.lds + na::NA_LV + d * 528 + 16 * c) = *(const u32x4*)(Vt + (size_t)d * na::VTL + 8 * c); } }
            __syncthreads();
            if (it < (l < DEPTH - 1 ? NA_ITEMS : NA_NLAT)) na_wave_item(F, rpl, it); }
    }
#ifdef TCLS
    if (F.tid == 0 && tcacc_) __hip_atomic_fetch_add((unsigned long long*)(F.ctl + 30000), tcacc_, __ATOMIC_RELAXED, __HIP_MEMORY_SCOPE_AGENT);
#endif
}
constexpr int TAB_OFF = LDSCTL_OFF;
PHASE_FN void ph_ln1_router(Ctx cx, int l_) {
    Frame F = mkframe(cx); const ArgsP a = F.ap; const int l = rfl(l_);
    REFRESH(F);
    volatile LAS int* tab = (volatile LAS int*)(F.lds + TAB_OFF);
    const bf16* Dm = (const bf16*)(F.ws + WS_T); bf16* X = (bf16*)(F.ws + WS_X);
    { const f32x4* src = (const f32x4*)((const float*)(F.ws + WS_WRT) + (size_t)l * 32 * 1024); LAS f32x4* dst = (LAS f32x4*)F.lds;
      __syncthreads(); for (int i = F.tid; i < 32 * 256; i += NTHREADS) dst[i] = src[i]; __syncthreads(); }
    const LAS float* wrT = (const LAS float*)F.lds;
    const float* lng = AIN(I_LNG) + (size_t)(l * 2 + 0) * DM; const float* lnb = AIN(I_LNB) + (size_t)(l * 2 + 0) * DM;
    int* TOPE = (int*)(F.ws + WS_TOPE); int* TOPR = (int*)(F.ws + WS_TOPR); float* TOPG = (float*)(F.ws + WS_TOPG); int* BLKB = (int*)(F.ws + WS_BLKB);
    const int MR = l == DEPTH - 1 ? MLAT : MT;
    { int* ROWTOK = (int*)(F.ws + WS_ROWTOK); for (int i = F.bid * NTHREADS + F.tid; i < RPAD; i += F.G * NTHREADS) ROWTOK[i] = 0; }
    for (int rg = F.bid; rg < NRG; rg += F.G) {
        if (F.tid < 32) tab[384 + F.tid] = 0;
        __syncthreads();
        f32x4 nv[4]; u32x2 nb[4], nd[4];
        { const int r0 = rg * RG_ROWS + F.wave;
#pragma unroll
          for (int j = 0; j < 4; ++j) { nv[j] = (f32x4){0.f, 0.f, 0.f, 0.f}; nb[j] = (u32x2){0u, 0u};
              if (l == 0) nv[j] = *((const f32x4*)XROW0(r0) + F.lane + 64 * j); else nb[j] = *(const u32x2*)(X + (size_t)r0 * DM + 4 * F.lane + 256 * j); nd[j] = *(const u32x2*)(Dm + (size_t)r0 * DM + 4 * F.lane + 256 * j); } }
        const bf16* Dq = (const bf16*)(F.ws + WS_DQ);
        for (int i = F.wave; i < RG_ROWS; i += 2 * NWAVES) {
            if (rg * RG_ROWS + i >= MR) break;
            const bool two = i + NWAVES < RG_ROWS && rg * RG_ROWS + i + NWAVES < MR;
            f32x4 v[4], u[4];
#pragma unroll
            for (int j = 0; j < 4; ++j) u[j] = (f32x4){0.f, 0.f, 0.f, 0.f};
#pragma unroll 1
            for (int rr = 0; rr < (two ? 2 : 1); ++rr) { const int row = rg * RG_ROWS + i + rr * NWAVES;
                if (rr) {
#pragma unroll
                    for (int j = 0; j < 4; ++j) u[j] = v[j]; }
            const float* g1 = (const float*)(F.ws + WS_MOD) + ((size_t)l * 3 + mod_index(row)) * 6144 + 2048;
#pragma unroll
                for (int j = 0; j < 4; ++j) { const f32x4 gg = *(const f32x4*)(g1 + 4 * F.lane + 256 * j); const u32x2 w = nd[j];
                    f32x4 dd = (f32x4){bflo(w.x), bfhi(w.x), bflo(w.y), bfhi(w.y)};
                    if (row >= MLAT) { dd = (f32x4){0.f, 0.f, 0.f, 0.f};
#pragma unroll
                        for (int q = 0; q < 4; ++q) { const u32x2 pw = *(const u32x2*)(Dq + ((size_t)q * MCTX + (row - MLAT)) * DM + 4 * F.lane + 256 * j); dd += (f32x4){bflo(pw.x), bfhi(pw.x), bflo(pw.y), bfhi(pw.y)}; } }
                    const f32x4 xv = l == 0 ? nv[j] : (f32x4){bflo(nb[j].x), bfhi(nb[j].x), bflo(nb[j].y), bfhi(nb[j].y)};
                    v[j] = xv * DN_ALPHA + gg * dd; }
                if (i + (rr + 1) * NWAVES < RG_ROWS) { const int nr = row + NWAVES;
#pragma unroll
                    for (int j = 0; j < 4; ++j) { if (l == 0) nv[j] = *((const f32x4*)XROW0(nr) + F.lane + 64 * j); else nb[j] = *(const u32x2*)(X + (size_t)nr * DM + 4 * F.lane + 256 * j); nd[j] = *(const u32x2*)(Dm + (size_t)nr * DM + 4 * F.lane + 256 * j); } }
                ln_inplace(v);
#pragma unroll
                for (int j = 0; j < 4; ++j) { const int c = 4 * F.lane + 256 * j; v[j] = v[j] * *(const f32x4*)(lng + c) + *(const f32x4*)(lnb + c); *(u32x2*)(X + (size_t)row * DM + c) = (u32x2){pk2(v[j].x, v[j].y), pk2(v[j].z, v[j].w)}; }
                modulate_store(F, l, 1, row, v);

            }
            if (two) {
#pragma unroll
                for (int j = 0; j < 4; ++j) { const f32x4 t = v[j]; v[j] = u[j]; u[j] = t; } }
            float p[32], q[32];
#pragma unroll
            for (int e = 0; e < 32; ++e) { f32x2 s = {0.f, 0.f}, t = {0.f, 0.f};
#pragma unroll
                for (int j = 0; j < 4; ++j) { const f32x4 w = *(const LAS f32x4*)(wrT + e * 1024 + 4 * F.lane + 256 * j); const f32x2 wl = {w.x, w.y}, wh = {w.z, w.w};
                    s += (f32x2){v[j].x, v[j].y} * wl; s += (f32x2){v[j].z, v[j].w} * wh; t += (f32x2){u[j].x, u[j].y} * wl; t += (f32x2){u[j].z, u[j].w} * wh; }
                p[e] = s.x + s.y; q[e] = t.x + t.y; if ((e & 7) == 7) asm volatile("" ::: "memory"); }
#define LN1_BFLY(p) do { \
            _Pragma("unroll") for (int i2 = 0; i2 < 16; ++i2) { const bool up = (F.lane & 32) != 0; const float send = up ? p[i2] : p[i2 + 16], keep = up ? p[i2 + 16] : p[i2]; p[i2] = keep + xorl<32>(send); } \
            _Pragma("unroll") for (int i2 = 0; i2 < 8; ++i2) { const bool up = (F.lane & 16) != 0; const float send = up ? p[i2] : p[i2 + 8], keep = up ? p[i2 + 8] : p[i2]; p[i2] = keep + xorl<16>(send); } \
            _Pragma("unroll") for (int i2 = 0; i2 < 4; ++i2) { const bool up = (F.lane & 8) != 0; const float send = up ? p[i2] : p[i2 + 4], keep = up ? p[i2 + 4] : p[i2]; p[i2] = keep + xorl<8>(send); } \
            _Pragma("unroll") for (int i2 = 0; i2 < 2; ++i2) { const bool up = (F.lane & 4) != 0; const float send = up ? p[i2] : p[i2 + 2], keep = up ? p[i2 + 2] : p[i2]; p[i2] = keep + xorl<4>(send); } \
            { const bool up = (F.lane & 2) != 0; const float send = up ? p[0] : p[1], keep = up ? p[1] : p[0]; p[0] = keep + xorl<2>(send); } \
            p[0] += xorl<1>(p[0]); } while (0)
            LN1_BFLY(p); LN1_BFLY(q);
#undef LN1_BFLY
#pragma unroll 1
            for (int rr = 0; rr < (two ? 2 : 1); ++rr) { const int row = rg * RG_ROWS + i + rr * NWAVES;
            const int me = F.lane >> 1; float lg = (rr ? q[0] : p[0]) + AIN(I_BR)[l * 32 + me];
                int rank = 0;
#pragma unroll
                for (int e = 0; e < 32; ++e) { const float sv = __builtin_bit_cast(float, __builtin_amdgcn_readlane(__builtin_bit_cast(int, lg), 2 * e)); rank += (sv > lg || (sv == lg && e < me)) ? 1 : 0; }
                int te[4]; float tv[4];
#pragma unroll
                for (int k = 0; k < 4; ++k) { const unsigned long long mk = __ballot(rank == k); const int ln = (int)__builtin_ctzll(mk); te[k] = ln >> 1; tv[k] = __builtin_bit_cast(float, __builtin_amdgcn_readlane(__builtin_bit_cast(int, lg), ln)); }
                const float e1 = __expf(tv[1] - tv[0]), e2 = __expf(tv[2] - tv[0]), e3 = __expf(tv[3] - tv[0]), isum = 1.f / (1.f + e1 + e2 + e3);
                if (F.lane < 4) { const int k = F.lane; const int e = k == 0 ? te[0] : k == 1 ? te[1] : k == 2 ? te[2] : te[3]; const float g = (k == 0 ? 1.f : k == 1 ? e1 : k == 2 ? e2 : e3) * isum;
                    const int lr = __hip_atomic_fetch_add((LAS int*)&tab[384 + e], 1, __ATOMIC_RELAXED, __HIP_MEMORY_SCOPE_WORKGROUP);
                    TOPE[row * 4 + k] = e; TOPR[row * 4 + k] = lr; TOPG[row * 4 + k] = g; }
            }
        }
        __syncthreads();
        if (F.tid < 32) { const int n = tab[384 + F.tid]; const unsigned base = __hip_atomic_fetch_add(F.ctl + CW_CNT + l * 32 + F.tid, (unsigned)n, __ATOMIC_RELAXED, __HIP_MEMORY_SCOPE_AGENT); BLKB[rg * 32 + F.tid] = (int)base; }
        __syncthreads();
    }
}
__device__ __forceinline__ void moe_tables(Frame& F, int l, int nN) {
    REFRESH(F);
    volatile LAS int* tab = (volatile LAS int*)(F.lds + TAB_OFF);
    __syncthreads();
    if (F.wave == 0) {
        const int e = F.lane & 31; const int n = (int)__hip_atomic_load(F.ctl + CW_CNT + l * 32 + e, __ATOMIC_RELAXED, __HIP_MEMORY_SCOPE_AGENT), nt = F.lane < 32 ? (n + 255) >> 8 : 0;
        int inc = nt;
#pragma unroll
        for (int o = 1; o < 32; o <<= 1) { const int v = __shfl_up(inc, o); if (F.lane >= o) inc += v; }
        const int t = inc - nt;
        if (F.lane < 32) { tab[352 + e] = t * 256;
#pragma unroll 1
            for (int i = 0; i < nt; ++i) tab[t + i] = e; }
        if (F.lane == 31) tab[320] = inc; }
    __syncthreads();
    if (nN > 0 && F.tid < 16) { int pm, pn; const int T = tab[320]; int w = -1;
        if (TileMap::map(F.tid, F.G, F.bid, T, nN, pm, pn)) w = pm | (pn << 12) | (tab[pm] << 16) | (nN << 24);
        tab[416 + F.tid] = w; }
    __syncthreads();
}
PHASE_FN void ph_moe_gather(Ctx cx, int l_) {
    Frame F = mkframe(cx); const int l = rfl(l_);
    REFRESH(F);
    volatile LAS int* tab = (volatile LAS int*)(F.lds + TAB_OFF);
    moe_tables(F, l, 0);
    const int gw = F.bid * NWAVES + F.wave, NGW = F.G * NWAVES;
    const int* TOPE = (const int*)(F.ws + WS_TOPE); const int* TOPR = (const int*)(F.ws + WS_TOPR); const int* BLKB = (const int*)(F.ws + WS_BLKB); int* SLOT = (int*)(F.ws + WS_SLOT);
    const bf16* HX = (const bf16*)(F.ws + WS_HX); bf16* HP = (bf16*)(F.ws + WS_HP);
    const int MR = l == DEPTH - 1 ? MLAT : MT;
    int* ROWTOK = (int*)(F.ws + WS_ROWTOK);
    for (int e4 = (int)((size_t)F.bid * NTHREADS + F.tid); e4 < MR * 4; e4 += F.G * NTHREADS) { const int row = e4 >> 2, e = TOPE[e4];
        const int slot = tab[352 + e] + BLKB[(row / RG_ROWS) * 32 + e] + TOPR[e4]; SLOT[e4] = slot; ROWTOK[slot] = row * (DM * 2); }
}
PHASE_FN void ph_ln2(Ctx cx, int l_) {
    Frame F = mkframe(cx); const ArgsP a = F.ap; const int l = rfl(l_);
    REFRESH(F);
    const int gw = F.bid * NWAVES + F.wave, NGW = F.G * NWAVES;
    bf16* X = (bf16*)(F.ws + WS_X); const bf16* Y = (const bf16*)(F.ws + WS_Y);
    const int* SLOT = (const int*)(F.ws + WS_SLOT); const float* TOPG = (const float*)(F.ws + WS_TOPG);
    const float* lng = AIN(I_LNG) + (size_t)(l * 2 + 1) * DM; const float* lnb = AIN(I_LNB) + (size_t)(l * 2 + 1) * DM;
    if (l < DEPTH - 1) stage_wdec(F, l + 1);
    const bool poison = __hip_atomic_load(F.ctl + CW_BAR + XB_TMO, __ATOMIC_RELAXED, __HIP_MEMORY_SCOPE_AGENT) != 0u;
    const int MR = l == DEPTH - 1 ? MLAT : MT;
    u32x2 xr[4], nx[4]; u32x2 yw[4][4], ny[4][4]; float cg = 0.f, g1 = 0.f; int s1 = 0;
#pragma unroll
    for (int j = 0; j < 4; ++j) { xr[j] = (u32x2){0u, 0u}; nx[j] = xr[j];
#pragma unroll
        for (int k = 0; k < 4; ++k) { yw[k][j] = (u32x2){0u, 0u}; ny[k][j] = yw[k][j]; } }
    if (gw < MR) { const int s0 = SLOT[gw * 4 + (F.lane & 3)]; cg = TOPG[gw * 4 + (F.lane & 3)];
#pragma unroll
        for (int j = 0; j < 4; ++j) xr[j] = *(const u32x2*)(X + (size_t)gw * DM + 4 * F.lane + 256 * j);
#pragma unroll
        for (int k = 0; k < 4; ++k) { const bf16* yr = Y + (size_t)__builtin_amdgcn_readlane(s0, k) * DM + 4 * F.lane;
#pragma unroll
            for (int j = 0; j < 4; ++j) yw[k][j] = *(const u32x2*)(yr + 256 * j); }
        if (gw + NGW < MR) { s1 = SLOT[(gw + NGW) * 4 + (F.lane & 3)]; g1 = TOPG[(gw + NGW) * 4 + (F.lane & 3)]; } }
    f32x4 pv[4]; bool havep = false; int prow = 0;
#pragma unroll
    for (int j = 0; j < 4; ++j) pv[j] = (f32x4){0.f, 0.f, 0.f, 0.f};
    for (int row = gw; row < MR; row += NGW) {
        const float* g2 = (const float*)(F.ws + WS_MOD) + ((size_t)l * 3 + mod_index(row)) * 6144 + 5120;
        int s2 = 0; float g2n = 0.f;
        if (row + NGW < MR) { const int nr = row + NGW;
#pragma unroll
            for (int j = 0; j < 4; ++j) nx[j] = *(const u32x2*)(X + (size_t)nr * DM + 4 * F.lane + 256 * j);
#pragma unroll
            for (int k = 0; k < 4; ++k) { const bf16* yr = Y + (size_t)__builtin_amdgcn_readlane(s1, k) * DM + 4 * F.lane;
#pragma unroll
                for (int j = 0; j < 4; ++j) ny[k][j] = *(const u32x2*)(yr + 256 * j); }
            if (nr + NGW < MR) { s2 = SLOT[(nr + NGW) * 4 + (F.lane & 3)]; g2n = TOPG[(nr + NGW) * 4 + (F.lane & 3)]; } }
        float gk[4];
#pragma unroll
        for (int k = 0; k < 4; ++k) gk[k] = __builtin_bit_cast(float, __builtin_amdgcn_readlane(__builtin_bit_cast(int, cg), k));
        f32x4 fx[4];
#pragma unroll
        for (int j = 0; j < 4; ++j) fx[j] = (f32x4){0.f, 0.f, 0.f, 0.f};
#pragma unroll
        for (int k = 0; k < 4; ++k)
#pragma unroll
            for (int j = 0; j < 4; ++j) { const u32x2 w = yw[k][j]; fx[j] += (f32x4){bflo(w.x), bfhi(w.x), bflo(w.y), bfhi(w.y)} * gk[k]; }
        f32x4 v[4];
#pragma unroll
        for (int j = 0; j < 4; ++j) { const int c = 4 * F.lane + 256 * j; v[j] = (f32x4){bflo(xr[j].x), bfhi(xr[j].x), bflo(xr[j].y), bfhi(xr[j].y)} * DN_ALPHA + *(const f32x4*)(g2 + c) * fx[j]; }
        ln_inplace(v);
#pragma unroll
        for (int j = 0; j < 4; ++j) { const int c = 4 * F.lane + 256 * j; v[j] = v[j] * *(const f32x4*)(lng + c) + *(const f32x4*)(lnb + c); }
        if (l == DEPTH - 1) { if (row < MLAT) {
            if (poison) { const float qn = __builtin_nanf("");
#pragma unroll
                for (int j = 0; j < 4; ++j) v[j] = (f32x4){qn, qn, qn, qn}; }
#pragma unroll
            for (int j = 0; j < 4; ++j) *((f32x4*)AOUT + (size_t)row * 256 + F.lane + 64 * j) = v[j]; } }
        else {
#pragma unroll
            for (int j = 0; j < 4; ++j) *(u32x2*)(X + (size_t)row * DM + 4 * F.lane + 256 * j) = (u32x2){pk2(v[j].x, v[j].y), pk2(v[j].z, v[j].w)};
            modulate_store(F, l + 1, 0, row, v);
            if (havep) { decay_cols2(F, prow, pv, row, v); havep = false; }
            else { havep = true; prow = row;
#pragma unroll
                for (int j = 0; j < 4; ++j) pv[j] = v[j]; } }
#pragma unroll
        for (int j = 0; j < 4; ++j) { xr[j] = nx[j];
#pragma unroll
            for (int k = 0; k < 4; ++k) yw[k][j] = ny[k][j]; }
        cg = g1; s1 = s2; g1 = g2n;
    }
    if (havep) decay_cols(F, l + 1, prow, pv);
}

PHASE_FN void ph_gemm_win(Ctx cx, int l_) {
    Frame F = mkframe(cx); const int l = rfl(l_); GAS unsigned char* ws = F.ws;
    StaticOrder S{MT / 256, NP / 256, F.G, F.bid, 1024}; EpiWin E{(bf16*)(ws + WS_P)};
    pg8::gemm_phase<EpiWin, StaticOrder>(F.lds, 1024, (const char*)(ws + WS_HX), (const char*)(ws + WS_WIN) + (size_t)l * 8192 * 1024 * 2, S, E, F.wv);
}
PHASE_FN void ph_gemm_merge(Ctx cx, int l_) {
    Frame F = mkframe(cx); const int l = rfl(l_); GAS unsigned char* ws = F.ws;
    MergeOrder S{F.G, F.bid, l == DEPTH - 1 ? 0 : 24}; EpiMerge E{(const bf16*)(ws + WS_P), (bf16*)(ws + WS_MACC), (bf16*)(ws + WS_MBF), (bf16*)(ws + WS_CPART)};
    pg8::gemm_phase<EpiMerge, MergeOrder>(F.lds, 512, (const char*)(ws + WS_YA), (const char*)(ws + WS_WBR) + (size_t)l * 3 * 1024 * 512 * 2, S, E, F.wv);
}
PHASE_FN void ph_ctx_sum(Ctx cx) {
    Frame F = mkframe(cx); REFRESH(F); GAS unsigned char* ws = F.ws;
    const bf16* cp = (const bf16*)(ws + WS_CPART); bf16* mb = (bf16*)(ws + WS_MBF) + (size_t)MLAT * DM;
    for (int i = F.bid * NTHREADS + F.tid; i < MCTX * DM / 8; i += F.G * NTHREADS) {
        const u32x4 a0 = *(const u32x4*)(cp + (size_t)i * 8), a1 = *(const u32x4*)(cp + (size_t)MCTX * DM + (size_t)i * 8), a2 = *(const u32x4*)(cp + (size_t)2 * MCTX * DM + (size_t)i * 8); u32x4 w;
        w.x = pk2(bflo(a0.x) + bflo(a1.x) + bflo(a2.x), bfhi(a0.x) + bfhi(a1.x) + bfhi(a2.x)); w.y = pk2(bflo(a0.y) + bflo(a1.y) + bflo(a2.y), bfhi(a0.y) + bfhi(a1.y) + bfhi(a2.y));
        w.z = pk2(bflo(a0.z) + bflo(a1.z) + bflo(a2.z), bfhi(a0.z) + bfhi(a1.z) + bfhi(a2.z)); w.w = pk2(bflo(a0.w) + bflo(a1.w) + bflo(a2.w), bfhi(a0.w) + bfhi(a1.w) + bfhi(a2.w));
        *(u32x4*)(mb + (size_t)i * 8) = w; }
}
PHASE_FN void ph_gemm_wout(Ctx cx, int l_) {
    Frame F = mkframe(cx); const int l = rfl(l_); GAS unsigned char* ws = F.ws;
    StaticOrder S{MLAT / 256, 4, F.G, F.bid, 1024}; EpiWout E{(bf16*)(ws + WS_T)};
    pg8::gemm_phase<EpiWout, StaticOrder>(F.lds, 1024, (const char*)(ws + WS_MBF), (const char*)(ws + WS_WOUT) + (size_t)l * 1024 * 1024 * 2, S, E, F.wv);
}
PHASE_FN void ph_gemm_wout_ctx(Ctx cx, int l_) {
    Frame F = mkframe(cx); const int l = rfl(l_); GAS unsigned char* ws = F.ws;
    WoutCtxOrder S{F.G, F.bid}; EpiWoutCtx E{(bf16*)(ws + WS_DQ)};
    int Kq = 256; asm volatile("" : "+s"(Kq));
    pg8::gemm_phase<EpiWoutCtx, WoutCtxOrder>(F.lds, Kq, (const char*)(ws + WS_MBF), (const char*)(ws + WS_WOUT) + (size_t)l * 1024 * 1024 * 2, S, E, F.wv, nullptr, 1024);
}
PHASE_FN void ph_gemm_moe1(Ctx cx, int l_) {
    Frame F = mkframe(cx); const int l = rfl(l_); GAS unsigned char* ws = F.ws; const ArgsP a = F.ap;
    moe_tables(F, l, 8);
    MoeOrder S{(const volatile LAS int*)(F.lds + TAB_OFF), 1}; EpiAct E{AIN(I_B1) + (size_t)l * 32 * 2048, (bf16*)(ws + WS_ACT)};
    pg8::gemm_phase<EpiAct, MoeOrder, true, true, true>(F.lds, 1024, (const char*)(ws + WS_HX), (const char*)(ws + WS_W1) + (size_t)l * 32 * 2048 * 1024 * 2, S, E, F.wv, (const int*)(ws + WS_ROWTOK));
}
PHASE_FN void ph_gemm_moe2(Ctx cx, int l_) {
    Frame F = mkframe(cx); const int l = rfl(l_); GAS unsigned char* ws = F.ws; const ArgsP a = F.ap;
    moe_tables(F, l, 4);
    MoeOrder S{(const volatile LAS int*)(F.lds + TAB_OFF), 0}; EpiY E{AIN(I_B2) + (size_t)l * 32 * 1024, (bf16*)(ws + WS_Y)};
    pg8::gemm_phase<EpiY, MoeOrder>(F.lds, 1024, (const char*)(ws + WS_ACT), (const char*)(ws + WS_W2) + (size_t)l * 32 * 1024 * 1024 * 2, S, E, F.wv);
}
constexpr int NPH_LAYER = 12, NPHASES = 2 + DEPTH * NPH_LAYER;
__global__ void __launch_bounds__(NTHREADS, 2) fwd_kernel(Args args) {
    extern __shared__ __attribute__((aligned(16))) unsigned char lds_raw[];
    LAS unsigned char* lds = (LAS unsigned char*)lds_raw;
    const int tid = threadIdx.x;
    volatile LAS unsigned* MISC = (volatile LAS unsigned*)(lds + MISC_OFF);
    for (int u = tid; u < (LDS_BYTES - LDSCTL_OFF) / 4; u += NTHREADS) ((LAS unsigned*)(lds + LDSCTL_OFF))[u] = 0u;
    __syncthreads();
    const int lo = args.ph_lo, hi = args.ph_hi;
    const bool multi = (hi - lo) > 1;
    unsigned* ctl = (unsigned*)(args.ws + WS_CTL);
    XcdBarrier bar; bar.bar = ctl + CW_BAR; bar.x = 0; bar.st = nullptr;
    if (multi) bar = xcd_barrier_post(ctl + CW_BAR, MISC + 8);
    Ctx cx; cx.lds = lds; cx.ws = args.ws; cx.ap = (ArgsP)__builtin_amdgcn_kernarg_segment_ptr(); cx.G = gridDim.x; cx.bid = blockIdx.x; cx.wv = __builtin_amdgcn_readfirstlane(tid >> 6);
#ifndef ONLYP
#define ONLYP -1
#endif
#define ENP(k) (ONLYP < 0 || ONLYP == (k))
#ifndef TSCALE
#define TSCALE 1.0f
#endif
#ifndef TIMEK
#define TIMEK -1
#endif
#ifndef DUPK
#define DUPK -1
#endif
#define DUP(k, call) do { if (DUPK == (k)) { call; } } while (0)
#define IN(k) (lo <= (k) && (k) < hi)
#ifdef DUPBAR
#define SEAM(k) do { if (IN(k) && IN((k) + 1)) { xcd_barrier(bar); xcd_barrier(bar); } } while (0)
#else
#define SEAM(k) do { if (IN(k) && IN((k) + 1)) xcd_barrier(bar); } while (0)
#endif
    unsigned long long tacc = 0, tst = 0;
#define TBEG(k) do { if (TIMEK == (k)) tst = __builtin_amdgcn_s_memrealtime(); } while (0)
#define TEND(k) do { if (TIMEK == (k)) tacc += __builtin_amdgcn_s_memrealtime() - tst; } while (0)
    TBEG(100); TBEG(102);
    if (IN(0)) { if (ENP(100)) p0_prologue(cx); DUP(100, p0_prologue(cx)); SEAM(0); }
    TEND(100); TBEG(101);
    if (IN(1)) { if (ENP(101)) ph_lnmod0(cx); SEAM(1); }
    TEND(101);
    for (int l = 0; l < DEPTH; ++l) {
        const int pb = 2 + l * NPH_LAYER;
        if (IN(pb + 0)) { TBEG(0); if (ENP(0)) ph_gemm_win(cx, l); DUP(0, ph_gemm_win(cx, l)); SEAM(pb + 0); TEND(0); }
        if (IN(pb + 1)) { TBEG(1); if (ENP(1)) ph_prepq(cx, l); if (IN(pb + 1) && IN(pb + 3)) xcd_barrier(bar); TEND(1); }
        if (IN(pb + 3)) { TBEG(3); if (ENP(3)) ph_mixers(cx, l); DUP(3, ph_mixers(cx, l)); SEAM(pb + 3); TEND(3); }
        if (IN(pb + 4)) { TBEG(4); if (ENP(13)) ph_combine(cx, l); SEAM(pb + 4); TEND(4); }
        if (IN(pb + 5)) { TBEG(5); if (ENP(5)) ph_gemm_merge(cx, l); DUP(5, ph_gemm_merge(cx, l));
            if (l < DEPTH - 1 && IN(pb + 6)) { xcd_barrier(bar); ph_ctx_sum(cx); }
            SEAM(pb + 5); TEND(5); }
        if (IN(pb + 6)) { TBEG(6); if (ENP(6)) { ph_gemm_wout(cx, l); if (l < DEPTH - 1) ph_gemm_wout_ctx(cx, l); } DUP(6, ph_gemm_wout(cx, l)); SEAM(pb + 6); TEND(6); }
        if (IN(pb + 7)) { TBEG(7); if (ENP(7)) ph_ln1_router(cx, l); SEAM(pb + 7); TEND(7); }
        if (IN(pb + 8)) { TBEG(8); if (ENP(8)) ph_moe_gather(cx, l); DUP(8, ph_moe_gather(cx, l)); SEAM(pb + 8); TEND(8); }
        if (IN(pb + 9)) { TBEG(9); if (ENP(9)) ph_gemm_moe1(cx, l); DUP(9, ph_gemm_moe1(cx, l)); SEAM(pb + 9); TEND(9); }
        if (IN(pb + 10)) { TBEG(10); if (ENP(10)) ph_gemm_moe2(cx, l); DUP(10, ph_gemm_moe2(cx, l)); SEAM(pb + 10); TEND(10); }
        if (IN(pb + 11)) { TBEG(11); if (ENP(14)) ph_ln2(cx, l); SEAM(pb + 11); TEND(11); }
    }
    TEND(102);
    if (TIMEK >= 0 && blockIdx.x == 0) { __syncthreads(); if (tid == 0) { if (TIMEK == 99) tacc = *(unsigned long long*)(ctl + 30000); const float us = (float)tacc * 0.01f * TSCALE; args.out[0] += sqrtf(16.777f * us); } }
#undef IN
#undef SEAM
}

#ifndef MK_PER_PHASE
#define MK_PER_PHASE 0
#endif
extern "C" void kernel_launch(void* const* d_in, const int* in_sizes, int n_in, void* d_out, int out_size, void* d_ws, size_t ws_size, hipStream_t stream) {
    static int grid = 0;
    if (grid == 0) {
        if (n_in != 24 || out_size != MLAT * DM || ws_size < WS_END) { fprintf(stderr, "kernel_launch: unexpected shapes (n_in %d out %d ws %zu need %zu)\n", n_in, out_size, ws_size, (size_t)WS_END); grid = -1; return; }
        int dev = 0, cus = 0, per_cu = 0;
        if (hipGetDevice(&dev) != hipSuccess || hipDeviceGetAttribute(&cus, hipDeviceAttributeMultiprocessorCount, dev) != hipSuccess) { grid = -1; return; }
        if (hipFuncSetAttribute((const void*)fwd_kernel, hipFuncAttributeMaxDynamicSharedMemorySize, LDS_BYTES) != hipSuccess) { fprintf(stderr, "kernel_launch: hipFuncSetAttribute failed\n"); grid = -1; return; }
        if (hipOccupancyMaxActiveBlocksPerMultiprocessor(&per_cu, (const void*)fwd_kernel, NTHREADS, LDS_BYTES) != hipSuccess || per_cu < 1) { fprintf(stderr, "kernel_launch: occupancy query says %d\n", per_cu); }
        (void)hipGetLastError();
        grid = cus;
    }
    if (grid < 0) return;
    (void)hipMemsetAsync((char*)d_ws + WS_CTL, 0, CTL_ZERO_BYTES, stream);
    Args a{};
    for (int i = 0; i < 24; ++i) a.in[i] = (const float*)d_in[i];
    a.out = (float*)d_out; a.ws = (unsigned char*)d_ws;
#if MK_PER_PHASE
    for (int p = 0; p < NPHASES; ++p) { a.ph_lo = p; a.ph_hi = p + 1; hipLaunchKernelGGL(fwd_kernel, dim3(grid), dim3(NTHREADS), LDS_BYTES, stream, a); }
#else
    a.ph_lo = 0; a.ph_hi = NPHASES; hipLaunchKernelGGL(fwd_kernel, dim3(grid), dim3(NTHREADS), LDS_BYTES, stream, a);
#endif
    const hipError_t le = hipPeekAtLastError();
    if (le != hipSuccess) fprintf(stderr, "kernel_launch: launch failed: %s\n", hipGetErrorName(le));
}
```

```cpp
#include <hip/hip_runtime.h>
#include <cstdio>
#include <cstdint>
#include <cmath>

#define GAS __attribute__((address_space(1)))
#define LAS __attribute__((address_space(3)))
typedef unsigned short bf16;
typedef float f32x4 __attribute__((ext_vector_type(4)));
typedef float f32x2 __attribute__((ext_vector_type(2)));
typedef unsigned u32x4 __attribute__((ext_vector_type(4)));
typedef unsigned u32x2 __attribute__((ext_vector_type(2)));
typedef short bf16x8 __attribute__((ext_vector_type(8)));

namespace pg8 {
#define PG8_LAS __attribute__((address_space(3)))
constexpr int BM = 256, BK = 64, HALF = 128, HTB = HALF * BK * 2, STAGE_BYTES = 8 * HTB, NXCD = 8, WGM = 8;
__host__ __device__ __forceinline__ int lds_byte(int r, int c) { const int st = (r >> 4) * 2 + (c >> 5), rr = r & 15, cc = c & 31, ob = rr * 64 + cc * 2; return st * 1024 + (ob ^ (((ob >> 9) & 1) << 5)); }
__host__ __device__ __forceinline__ void stage_rc(int b, int& R, int& C) { const int st = b / 1024, sb = b % 1024, swz = sb ^ (((sb >> 9) & 1) << 5); R = (st >> 1) * 16 + swz / 64; C = (st & 1) * 32 + (swz % 64) / 2; }
__host__ __device__ __forceinline__ int perm32(int rho) { const int n = rho >> 4, i = rho & 15; return 8 * (i >> 2) + 4 * n + (i & 3); }

struct Unit { int pm, pn, aux; unsigned aoff, boff; };

typedef float cvt_f32x2_t __attribute__((ext_vector_type(2))); typedef __bf16 cvt_bf16x2_t __attribute__((ext_vector_type(2)));
__device__ __forceinline__ unsigned cvt_pk_bf16(float lo, float hi) { cvt_f32x2_t v = {lo, hi}; cvt_bf16x2_t b = __builtin_convertvector(v, cvt_bf16x2_t); return __builtin_bit_cast(unsigned, b); }

template <class Epi, class Sched, bool ALIGN_EPI = true, bool SP2 = true, bool GATHER = false>
__device__ __forceinline__ void gemm_phase(PG8_LAS unsigned char* lds, const int K, const char* Abase, const char* Bbase, const Sched& S, const Epi& E, const int wv, const int* rowtok = nullptr, const int pitch_ = 0) {
    int lane_; asm volatile("v_mbcnt_lo_u32_b32 %0, -1, 0\n\tv_mbcnt_hi_u32_b32 %0, -1, %0" : "=v"(lane_));
    const int wid = wv, lane = lane_, tid = wv * 64 + lane_, wr = wid >> 2, wc = wid & 3, fr = lane & 15, fq = lane >> 4;
    const int nt = K / BK, PT = pitch_ ? pitch_ : K;
    unsigned voffA[2], voffB[2]; int gR[2]; unsigned gC[2]; unsigned cvA[2][2], nvA[2][2];
#pragma unroll
    for (int i = 0; i < 2; ++i) { int R, C; stage_rc(tid * 16 + i * 8192, R, C); const int Rb = ((R & ~31) + perm32(R & 31));
        voffA[i] = (unsigned)(R * PT + C) * 2u; voffB[i] = (unsigned)(Rb * PT + C) * 2u; gR[i] = R; gC[i] = (unsigned)C * 2u; }
    const size_t kstep = (size_t)(BK * 2);
    const size_t hstep = (size_t)HALF * PT * 2;
    const unsigned ldsw = (unsigned)wid * 1024u;
    const int aoff = lds_byte(wr * 64 + fr, fq * 8), boff = lds_byte(wc * 32 + fr, fq * 8);
#define PG8_SA(b, h) (((b) * 2 + (h)) * HTB)
#define PG8_SB(b, h) ((4 + (b) * 2 + (h)) * HTB)
#define PG8_STAGE(bufoff, gbase, voff) do { _Pragma("unroll") for (int _i = 0; _i < 2; ++_i) \
        __builtin_amdgcn_global_load_lds((const GAS unsigned*)((const char*)(gbase) + (voff)[_i]), (PG8_LAS unsigned*)(lds + (bufoff) + ldsw + _i * 8192), 16, 0, 0); } while (0)
#define PG8_STAGEA(bufoff, gbase, H, NX) do { _Pragma("unroll") for (int _i = 0; _i < 2; ++_i) { \
        const unsigned vo_ = GATHER ? ((NX) ? nvA[H][_i] : cvA[H][_i]) : voffA[_i]; const char* gb_ = GATHER ? (const char*)(gbase) : (const char*)(gbase) + ((H) ? hstep : (size_t)0); \
        __builtin_amdgcn_global_load_lds((const GAS unsigned*)(gb_ + vo_), (PG8_LAS unsigned*)(lds + (bufoff) + ldsw + _i * 8192), 16, 0, 0); } } while (0)
#define PG8_GLOAD(dst, pm_) do { if constexpr (GATHER) { _Pragma("unroll") for (int _h = 0; _h < 2; ++_h) _Pragma("unroll") for (int _i = 0; _i < 2; ++_i) dst[_h][_i] = (unsigned)rowtok[(pm_) * 256 + 128 * _h + gR[_i]] + gC[_i]; } } while (0)
#define PG8_LDA(dst, b, h) do { _Pragma("unroll") for (int m = 0; m < 4; ++m) _Pragma("unroll") for (int k = 0; k < 2; ++k) dst[m][k] = *(const PG8_LAS bf16x8*)(lds + PG8_SA(b, h) + aoff + m * 2048 + k * 1024); } while (0)
#define PG8_LDB(dst, b, h) do { _Pragma("unroll") for (int n = 0; n < 2; ++n) _Pragma("unroll") for (int k = 0; k < 2; ++k) dst[n][k] = *(const PG8_LAS bf16x8*)(lds + PG8_SB(b, h) + boff + n * 2048 + k * 1024); } while (0)
#define PG8_MMA(ai, bj, At, Bt) do { __builtin_amdgcn_s_setprio(1); _Pragma("unroll") for (int m = 0; m < 4; ++m) _Pragma("unroll") for (int n = 0; n < 2; ++n) _Pragma("unroll") for (int k = 0; k < 2; ++k) \
        acc[ai][bj][m][n] = __builtin_amdgcn_mfma_f32_16x16x32_bf16(Bt[n][k], At[m][k], acc[ai][bj][m][n], 0, 0, 0); __builtin_amdgcn_s_setprio(0); } while (0)
#define PG8_WAIT_V(n) asm volatile("s_waitcnt vmcnt(" #n ")" ::: "memory")
#define PG8_WAIT_L(n) asm volatile("s_waitcnt lgkmcnt(" #n ")" ::: "memory")
#define PG8_BAR __builtin_amdgcn_s_barrier()
#define PG8_SCHED __builtin_amdgcn_sched_barrier(0)
    Unit cur, nxt; int ui = 0;
    if (!S.next(0, cur)) return;
    f32x4 acc[2][2][4][2];
#pragma unroll
    for (int a = 0; a < 2; ++a)
#pragma unroll
        for (int b = 0; b < 2; ++b)
#pragma unroll
            for (int m = 0; m < 4; ++m)
#pragma unroll
                for (int n = 0; n < 2; ++n) acc[a][b][m][n] = (f32x4){0.f, 0.f, 0.f, 0.f};
    bf16x8 At[4][2], B0[2][2], B1[2][2];
    const char* cA = Abase + cur.aoff; const char* cB = Bbase + cur.boff;
    PG8_GLOAD(cvA, cur.pm);
    if constexpr (SP2) {
        PG8_STAGE(PG8_SB(0, 0), cB, voffB); PG8_STAGE(PG8_SB(0, 1), cB + hstep, voffB); PG8_STAGEA(PG8_SA(0, 0), cA, 0, false); PG8_STAGEA(PG8_SA(0, 1), cA, 1, false);
        if (wr == 1) PG8_BAR;
        PG8_WAIT_V(2); PG8_BAR;
        PG8_STAGE(PG8_SB(1, 0), cB + kstep, voffB); PG8_STAGEA(PG8_SA(1, 0), cA + kstep, 0, false); PG8_STAGE(PG8_SB(1, 1), cB + hstep + kstep, voffB);
        PG8_WAIT_V(6); PG8_BAR;
    } else {
        PG8_STAGE(PG8_SB(0, 0), cB, voffB); PG8_STAGEA(PG8_SA(0, 0), cA, 0, false); PG8_STAGE(PG8_SB(0, 1), cB + hstep, voffB); PG8_STAGEA(PG8_SA(0, 1), cA, 1, false);
        if (wr == 1) PG8_BAR;
        PG8_WAIT_V(4); PG8_BAR;
        PG8_STAGE(PG8_SB(1, 0), cB + kstep, voffB); PG8_STAGEA(PG8_SA(1, 0), cA + kstep, 0, false); PG8_STAGE(PG8_SB(1, 1), cB + hstep + kstep, voffB);
        PG8_WAIT_V(6); PG8_BAR;
    }
    for (;;) {
        const bool has_next = S.next(ui + 1, nxt);
        if constexpr (GATHER) { if (has_next) { PG8_GLOAD(nvA, nxt.pm); } else { _Pragma("unroll") for (int _h = 0; _h < 2; ++_h) _Pragma("unroll") for (int _i = 0; _i < 2; ++_i) nvA[_h][_i] = cvA[_h][_i]; } }
        const char* nA = has_next ? Abase + nxt.aoff : cA; const char* nB = has_next ? Bbase + nxt.boff : cB;
        for (int t = 0; t < nt; t += 2) {
            const bool last = (t == nt - 2);
            const char* a1 = cA + (size_t)(t + 1) * kstep;
            const char* a2 = last ? nA : cA + (size_t)(t + 2) * kstep; const char* b2 = last ? nB : cB + (size_t)(t + 2) * kstep;
            const char* a3 = a2 + kstep; const char* b3 = b2 + kstep;
            if constexpr (SP2) {
            PG8_LDB(B0, 0, 0); PG8_LDB(B1, 0, 1); PG8_SCHED; PG8_LDA(At, 0, 0); PG8_STAGEA(PG8_SA(1, 1), a1, 1, false);
            PG8_WAIT_V(8); PG8_WAIT_L(0); PG8_BAR; PG8_MMA(0, 0, At, B0); PG8_MMA(0, 1, At, B1); PG8_BAR; PG8_SCHED;
            PG8_LDA(At, 0, 1); PG8_STAGE(PG8_SB(0, 0), b2, voffB); PG8_STAGE(PG8_SB(0, 1), b2 + hstep, voffB); PG8_STAGEA(PG8_SA(0, 0), a2, 0, last);
            PG8_WAIT_V(8); PG8_WAIT_L(0); PG8_BAR; PG8_MMA(1, 0, At, B0); PG8_MMA(1, 1, At, B1); PG8_BAR; PG8_SCHED;
            PG8_LDB(B0, 1, 0); PG8_LDB(B1, 1, 1); PG8_SCHED; PG8_LDA(At, 1, 0); PG8_STAGEA(PG8_SA(0, 1), a2, 1, last);
            PG8_WAIT_V(8); PG8_WAIT_L(0); PG8_BAR; PG8_MMA(0, 0, At, B0); PG8_MMA(0, 1, At, B1); PG8_BAR; PG8_SCHED;
            PG8_LDA(At, 1, 1); PG8_STAGE(PG8_SB(1, 0), b3, voffB); PG8_STAGE(PG8_SB(1, 1), b3 + hstep, voffB); PG8_STAGEA(PG8_SA(1, 0), a3, 0, last);
            PG8_WAIT_V(8); PG8_WAIT_L(0); PG8_BAR; PG8_MMA(1, 0, At, B0); PG8_MMA(1, 1, At, B1); PG8_BAR; PG8_SCHED;
            } else {
            PG8_LDB(B0, 0, 0); PG8_SCHED; PG8_LDA(At, 0, 0); PG8_STAGEA(PG8_SA(1, 1), a1, 1, false);
            PG8_WAIT_L(8); PG8_BAR; PG8_WAIT_L(0); PG8_MMA(0, 0, At, B0); PG8_BAR; PG8_SCHED;
            PG8_LDB(B1, 0, 1); PG8_STAGE(PG8_SB(0, 0), b2, voffB);
            PG8_BAR; PG8_WAIT_L(0); PG8_MMA(0, 1, At, B1); PG8_BAR;
            PG8_LDA(At, 0, 1); PG8_STAGEA(PG8_SA(0, 0), a2, 0, last);
            PG8_BAR; PG8_WAIT_L(0); PG8_MMA(1, 0, At, B0); PG8_BAR; PG8_SCHED;
            PG8_STAGE(PG8_SB(0, 1), b2 + hstep, voffB);
            PG8_WAIT_V(6); PG8_BAR; PG8_MMA(1, 1, At, B1); PG8_BAR;
            PG8_LDB(B0, 1, 0); PG8_SCHED; PG8_LDA(At, 1, 0); PG8_STAGEA(PG8_SA(0, 1), a2, 1, last);
            PG8_WAIT_L(8); PG8_BAR; PG8_WAIT_L(0); PG8_MMA(0, 0, At, B0); PG8_BAR; PG8_SCHED;
            PG8_LDB(B1, 1, 1); PG8_STAGE(PG8_SB(1, 0), b3, voffB);
            PG8_BAR; PG8_WAIT_L(0); PG8_MMA(0, 1, At, B1); PG8_BAR;
            PG8_LDA(At, 1, 1); PG8_STAGEA(PG8_SA(1, 0), a3, 0, last);
            PG8_BAR; PG8_WAIT_L(0); PG8_MMA(1, 0, At, B0); PG8_BAR; PG8_SCHED;
            PG8_STAGE(PG8_SB(1, 1), b3 + hstep, voffB);
            PG8_WAIT_V(6); PG8_BAR; PG8_MMA(1, 1, At, B1); PG8_BAR;
            }
        }
        if constexpr (ALIGN_EPI) { if (wr == 0) PG8_BAR; }
        E(acc, cur, wr, wc, fr, fq);
        if (!has_next) break;
#pragma unroll
        for (int a = 0; a < 2; ++a)
#pragma unroll
            for (int b = 0; b < 2; ++b)
#pragma unroll
                for (int m = 0; m < 4; ++m)
#pragma unroll
                    for (int n = 0; n < 2; ++n) acc[a][b][m][n] = (f32x4){0.f, 0.f, 0.f, 0.f};
        cur = nxt; cA = nA; cB = nB; ++ui;
        if constexpr (GATHER) { _Pragma("unroll") for (int _h = 0; _h < 2; ++_h) _Pragma("unroll") for (int _i = 0; _i < 2; ++_i) cvA[_h][_i] = nvA[_h][_i]; }
        if constexpr (ALIGN_EPI) { if (wr == 1) PG8_BAR; }
    }
    PG8_WAIT_V(0);
    if constexpr (!ALIGN_EPI) { if (wr == 0) PG8_BAR; }
    PG8_BAR;
#undef PG8_SA
#undef PG8_SB
#undef PG8_STAGE
#undef PG8_STAGEA
#undef PG8_GLOAD
#undef PG8_LDA
#undef PG8_LDB
#undef PG8_MMA
#undef PG8_WAIT_V
#undef PG8_WAIT_L
#undef PG8_BAR
#undef PG8_SCHED
}
}
#ifndef USE_NA_MFMA
#define USE_NA_MFMA 1
#endif
#ifndef USE_GDN_FAST
#define USE_GDN_FAST 1
#endif
#ifndef USE_DIFF_MFMA
#define USE_DIFF_MFMA 1
#endif
constexpr int DM = 1024, BATCH = 2, SEQ = 8192, DEPTH = 4, CTXL = 256, GRIDW = 64;
constexpr int MLAT = BATCH * SEQ, MCTX = BATCH * CTXL, MT = MLAT + MCTX;
constexpr int NP = 8192;
constexpr int PC_GQ = 0, PC_GK = 512, PC_GV = 1024, PC_GZ = 1536, PC_DQ = 2048, PC_DK = 2560, PC_DV = 3072, PC_NQ = 3584, PC_NK = 4096, PC_NV = 4608, PC_GATE = 5120;
constexpr int D_IN = 8208, NEXP = 32, TOPK = 4, DEXP = 1024;
constexpr float LN_EPS = 1e-5f, RMS_EPS = 1e-6f;
constexpr float DN_ALPHA = 1.6817928305074292f;
constexpr int NWAVES = 8, NTHREADS = 512;
constexpr int RG_ROWS = 66, NRG = MT / RG_ROWS;
__device__ __forceinline__ int rg_row(int rg, int i) { return i < 64 ? rg * 64 + i : MLAT + rg * 2 + (i - 64); }
__device__ __forceinline__ int rg_of(int row) { return row < MLAT ? row >> 6 : (row - MLAT) >> 1; }
static_assert(NRG * 64 == MLAT && NRG * 2 == MCTX, "row groups");
constexpr int RPAD = MT * TOPK + NEXP * 256;
constexpr int MAXTILES = RPAD / 256;

constexpr size_t MiB = 1u << 20;
constexpr size_t al256(size_t x) { return (x + 255) / 256 * 256; }
constexpr size_t WS_CTL = 0, CTL_ZERO_BYTES = 1 * MiB;
constexpr size_t WS_MOD = WS_CTL + CTL_ZERO_BYTES;
constexpr size_t WS_LAM = WS_MOD + al256((size_t)DEPTH * 3 * 6144 * 4);
constexpr size_t WS_WDEC = WS_LAM + 256;
constexpr size_t WS_WRT = WS_WDEC + (size_t)DEPTH * 16 * 1024 * 4;
constexpr size_t WS_WIN = WS_WRT + (size_t)DEPTH * 32 * 1024 * 4;
constexpr size_t WS_WBR = WS_WIN + (size_t)DEPTH * 8192 * 1024 * 2;
constexpr size_t WS_WOUT = WS_WBR + (size_t)DEPTH * 3 * 1024 * 512 * 2;
constexpr size_t WS_W1 = WS_WOUT + (size_t)DEPTH * 1024 * 1024 * 2;
constexpr size_t WS_W2 = WS_W1 + (size_t)DEPTH * 32 * 2048 * 1024 * 2;
constexpr size_t WS_X = WS_W2 + (size_t)DEPTH * 32 * 1024 * 1024 * 2;
constexpr size_t WS_HX = WS_X + (size_t)MT * DM * 4;
constexpr size_t WS_P = WS_HX + (size_t)MT * DM * 2;
constexpr size_t WS_DEC = WS_P + (size_t)MT * NP * 2;
constexpr size_t WS_QN = WS_DEC + (size_t)MT * 16 * 4;
constexpr size_t WS_KN = WS_QN + (size_t)MT * 512 * 4;
constexpr size_t WS_VV = WS_KN + (size_t)MT * 512 * 4;
constexpr size_t WS_OG = WS_VV + (size_t)MT * 512 * 4;
constexpr size_t WS_OD = WS_OG + (size_t)2 * MT * 512 * 4;
constexpr size_t WS_YA = WS_OD + (size_t)2 * MT * 512 * 4;
constexpr size_t WS_YB = WS_YA + (size_t)MT * 512 * 2;
constexpr size_t WS_YC = WS_YB + (size_t)MT * 512 * 2;
constexpr size_t WS_MACC = WS_YC + (size_t)MT * 512 * 2;
constexpr size_t WS_MBF = WS_MACC + (size_t)MT * DM * 4;
constexpr size_t WS_T = WS_MBF + (size_t)MT * DM * 2;
constexpr size_t WS_TOPE = WS_T + (size_t)MT * DM * 4;
constexpr size_t WS_TOPR = WS_TOPE + (size_t)MT * 4 * 4;
constexpr size_t WS_TOPG = WS_TOPR + (size_t)MT * 4 * 4;
constexpr size_t WS_SLOT = WS_TOPG + (size_t)MT * 4 * 4;
constexpr size_t WS_BLKB = WS_SLOT + (size_t)MT * 4 * 4;
constexpr size_t WS_HP = WS_BLKB + (size_t)NRG * 32 * 4;
constexpr size_t WS_ACT = WS_HP + (size_t)RPAD * 1024 * 2;
constexpr size_t WS_Y = WS_ACT + (size_t)RPAD * 1024 * 2;
constexpr size_t WS_REC = WS_Y + (size_t)RPAD * 1024 * 2;
constexpr size_t WS_U = WS_REC + (size_t)2 * 4 * 2 * 132 * 57344;
constexpr size_t WS_GL = WS_U + (size_t)2 * 4 * 2 * 132 * 16384;
constexpr size_t WS_VT = WS_GL + (size_t)2 * 4 * 2 * 132 * 4 + 256;
constexpr size_t WS_ROWTOK = WS_VT + (size_t)2 * 8 * 64 * 8448 * 2;
constexpr size_t WS_CPART = WS_ROWTOK + (size_t)RPAD * 4;
constexpr size_t WS_DQ = WS_CPART + (size_t)3 * MCTX * DM * 2;
constexpr size_t WS_END = WS_DQ + (size_t)4 * MCTX * DM * 2;
constexpr int CW_BAR = 4096;
constexpr int CW_CNT = 16384;
constexpr int CW_Q = 20480;

constexpr int RING_BYTES = 131072;
constexpr int LDSCTL_OFF = RING_BYTES, MISC_OFF = LDSCTL_OFF + 2048;
constexpr int LDS_BYTES = 147456;

#define RLX_AGENT __ATOMIC_RELAXED, __HIP_MEMORY_SCOPE_AGENT
#define LDS_WAIT() asm volatile("s_waitcnt lgkmcnt(0)" ::: "memory")
#define VM_WAIT() asm volatile("s_waitcnt vmcnt(0)" ::: "memory")
__device__ __forceinline__ float bf2f(unsigned b) { return __uint_as_float(b << 16); }
__device__ __forceinline__ float bflo(unsigned w) { return __uint_as_float(w << 16); }
__device__ __forceinline__ float bfhi(unsigned w) { return __uint_as_float(w & 0xffff0000u); }
__device__ __forceinline__ unsigned f2bf(float f) { unsigned u = __float_as_uint(f); return (u + 0x7fffu + ((u >> 16) & 1u)) >> 16; }
__device__ __forceinline__ unsigned pk2(float lo, float hi) { return pg8::cvt_pk_bf16(lo, hi); }
__device__ __forceinline__ float siluf(float x) { return x / (1.f + __expf(-x)); }
__device__ __forceinline__ float sigmf(float x) { return 1.f / (1.f + __expf(-x)); }

#define XB_TMO      128
#define XB_XCNT(j)  (256  + 64 * (j))
#define XB_XSUB(j)  (1280 + 64 * (j))
#define XB_XGEN(j)  (2304 + 64 * (j))
#define XB_TOP      3328
#define XB_TOPGEN   3392
#define XCD_BAR_WORDS 3456
#define XB_SPIN_CAP (1u << 22)
__device__ __forceinline__ unsigned xb_ld(unsigned* p)              { return __hip_atomic_load(p, __ATOMIC_RELAXED, __HIP_MEMORY_SCOPE_AGENT); }
__device__ __forceinline__ unsigned xb_add(unsigned* p, unsigned v) { return __hip_atomic_fetch_add(p, v, __ATOMIC_RELAXED, __HIP_MEMORY_SCOPE_AGENT); }
__device__ __forceinline__ unsigned xb_xcc_id() { return (unsigned)__builtin_amdgcn_s_getreg((3 << 11) | 20) & 0xFu; }
#define XB_SPIN(cond, bar) do { unsigned _sp = 0; while (cond) { __builtin_amdgcn_s_sleep(1); \
    if ((++_sp & 255u) == 0u) { if (xb_ld(&(bar)[XB_TMO])) break; if (_sp > XB_SPIN_CAP) { atomicAdd(&(bar)[XB_TMO], 1u); break; } } } } while (0)
struct XcdBarrier { unsigned* bar; unsigned x; volatile LAS unsigned* st; };
__device__ __forceinline__ XcdBarrier xcd_barrier_post(unsigned* bar, volatile LAS unsigned* st) {
    XcdBarrier b; b.bar = bar; b.x = xb_xcc_id(); b.st = st;
    if (threadIdx.x == 0) (void)xb_add(&bar[XB_XCNT(b.x)], 1u);
    return b;
}
__device__ __forceinline__ void xcd_barrier_complete(unsigned* bar, unsigned x, unsigned& nloc, unsigned& nx) {
    const unsigned G = gridDim.x * gridDim.y * gridDim.z;
    unsigned sum, cnt, mine, sp = 0u;
    for (;;) {
        sum = 0u; cnt = 0u; mine = 0u;
#pragma unroll
        for (unsigned j = 0; j < 16; ++j) { const unsigned c = xb_ld(&bar[XB_XCNT(j)]); sum += c; cnt += (c > 0u) ? 1u : 0u; mine = (j == x) ? c : mine; }
        if (sum == G) break;
        __builtin_amdgcn_s_sleep(1);
        if ((++sp & 255u) == 0u) { if (xb_ld(&bar[XB_TMO])) break; if (sp > XB_SPIN_CAP) { atomicAdd(&bar[XB_TMO], 1u); break; } }
    }
    nloc = mine > 0u ? mine : 1u; nx = cnt > 0u ? cnt : 1u;
}
__device__ __forceinline__ void xcd_barrier(const XcdBarrier& b) {
#ifdef BAR_BRUTE
    __builtin_amdgcn_fence(__ATOMIC_RELEASE, "agent");
#endif
    asm volatile("s_waitcnt vmcnt(0)" ::: "memory");
    __syncthreads();
    if (threadIdx.x == 0) {
        unsigned* bar = b.bar;
        __builtin_amdgcn_s_waitcnt(0);
        unsigned nloc = b.st[0], nx = b.st[1];
        if (nloc == 0u) { xcd_barrier_complete(bar, b.x, nloc, nx); b.st[0] = nloc; b.st[1] = nx; }
        const unsigned old = xb_add(&bar[XB_XSUB(b.x)], 1u);
        const unsigned gen = old / nloc;
        if (old + 1u == (gen + 1u) * nloc) {
            __builtin_amdgcn_fence(__ATOMIC_RELEASE, "agent");
            asm volatile("s_waitcnt vmcnt(0)" ::: "memory");
            const unsigned og = xb_add(&bar[XB_TOP], 1u);
            const unsigned tg = og / nx;
            if (og + 1u == (tg + 1u) * nx) xb_add(&bar[XB_TOPGEN], 1u);
            else XB_SPIN(xb_ld(&bar[XB_TOPGEN]) == tg, bar);
            __builtin_amdgcn_fence(__ATOMIC_ACQUIRE, "agent");
            xb_add(&bar[XB_XGEN(b.x)], 1u);
            asm volatile("s_waitcnt vmcnt(0)" ::: "memory");
        } else {
            XB_SPIN(xb_ld(&bar[XB_XGEN(b.x)]) == gen, bar);
            __builtin_amdgcn_fence(__ATOMIC_ACQUIRE, "agent");
            asm volatile("s_waitcnt vmcnt(0)" ::: "memory");
        }
    }
    __syncthreads();
#ifdef BAR_BRUTE
    __builtin_amdgcn_fence(__ATOMIC_ACQUIRE, "agent");
    asm volatile("s_waitcnt vmcnt(0)" ::: "memory");
    __syncthreads();
#endif
}

struct Args { const float* in[24]; float* out; unsigned char* ws; int ph_lo, ph_hi; };
enum { I_X = 0, I_C, I_CTX, I_CCTX, I_WADA, I_BADA, I_WIN, I_CONVW, I_ALOG, I_DTB, I_GNW, I_DLAM, I_DNW, I_RPB, I_WBR, I_WOUT, I_LNG, I_LNB, I_WR, I_BR, I_W1, I_B1, I_W2, I_B2 };
typedef const __attribute__((address_space(4))) Args* ArgsP;
struct Ctx { LAS unsigned char* lds; unsigned char* ws; ArgsP ap; int G, bid, wv; };
#define AIN(i) ((const float*)(const GAS float*)(a->in[i]))
#define AOUT ((float*)(GAS float*)(a->out))
#define XROW0(row) ((row) < MLAT ? AIN(I_X) + (size_t)(row) * DM : AIN(I_CTX) + (size_t)((row) - MLAT) * DM)
#define PHASE_FN __device__ __forceinline__
__device__ __forceinline__ int rfl(int v) { return __builtin_amdgcn_readfirstlane(v); }
struct Frame {
    ArgsP ap;
    LAS unsigned char* lds;
    unsigned* ctl;
    GAS unsigned char* ws;
    int tid, lane, wave, G, bid, wv;
};
#define REFRESH(F) do { int l_; asm volatile("v_mbcnt_lo_u32_b32 %0, -1, 0\n\tv_mbcnt_hi_u32_b32 %0, -1, %0" : "=v"(l_)); (F).lane = l_; (F).wave = (F).wv; (F).tid = (F).wv * 64 + l_; } while (0)
__device__ __forceinline__ Frame mkframe(const Ctx& c) {
    Frame F;
    F.lds = (LAS unsigned char*)(size_t)(unsigned)rfl((int)(unsigned)(size_t)c.lds);
    { const unsigned long long w = (unsigned long long)c.ws; F.ws = (GAS unsigned char*)(((unsigned long long)(unsigned)rfl((int)(unsigned)(w >> 32)) << 32) | (unsigned)rfl((int)(unsigned)w)); }
    { const unsigned long long w = (unsigned long long)c.ap; F.ap = (ArgsP)(((unsigned long long)(unsigned)rfl((int)(unsigned)(w >> 32)) << 32) | (unsigned)rfl((int)(unsigned)w)); }
    F.ctl = (unsigned*)(GAS unsigned*)F.ws; F.G = rfl(c.G); F.bid = rfl(c.bid); F.wv = rfl(c.wv); F.wave = F.wv; F.lane = 0; F.tid = 0;
    return F;
}
__device__ __forceinline__ int lane_id() { return (int)__builtin_amdgcn_mbcnt_hi(~0u, __builtin_amdgcn_mbcnt_lo(~0u, 0u)); }
template <int CTRL> __device__ __forceinline__ float dppf(float v) { return __builtin_bit_cast(float, __builtin_amdgcn_update_dpp(0, __builtin_bit_cast(int, v), CTRL, 0xF, 0xF, true)); }
template <int K> __device__ __forceinline__ float xorl(float v) {
    if constexpr (K == 1) return dppf<0xB1>(v);
    else if constexpr (K == 2) return dppf<0x4E>(v);
    else if constexpr (K == 4 || K == 8) { const float up = dppf<0x100 + K>(v), dn = dppf<0x110 + K>(v); return (lane_id() & K) ? dn : up; }
    else if constexpr (K == 16) { const auto r = __builtin_amdgcn_permlane16_swap(__float_as_uint(v), __float_as_uint(v), false, false); return (lane_id() & 16) ? __uint_as_float(r[0]) : __uint_as_float(r[1]); }
    else { const auto r = __builtin_amdgcn_permlane32_swap(__float_as_uint(v), __float_as_uint(v), false, false); return (lane_id() & 32) ? __uint_as_float(r[0]) : __uint_as_float(r[1]); }
}
__device__ __forceinline__ float wave_sum(float v) {
    v += xorl<1>(v); v += xorl<2>(v); v += xorl<4>(v); v += xorl<8>(v);
    { const auto r = __builtin_amdgcn_permlane16_swap(__float_as_uint(v), __float_as_uint(v), false, false); v = __uint_as_float(r[0]) + __uint_as_float(r[1]); }
    { const auto r = __builtin_amdgcn_permlane32_swap(__float_as_uint(v), __float_as_uint(v), false, false); v = __uint_as_float(r[0]) + __uint_as_float(r[1]); }
    return v;
}
__device__ __forceinline__ float wave_max(float v) {
    v = fmaxf(v, xorl<1>(v)); v = fmaxf(v, xorl<2>(v)); v = fmaxf(v, xorl<4>(v)); v = fmaxf(v, xorl<8>(v)); v = fmaxf(v, xorl<16>(v)); v = fmaxf(v, xorl<32>(v));
    return v;
}
__device__ __forceinline__ int mod_index(int row) { return row < MLAT ? (row >> 13) : 2; }
static_assert(WS_YB == WS_YA + (size_t)MT * 512 * 2 && WS_YC == WS_YB + (size_t)MT * 512 * 2, "YA|YB|YC contiguous");
struct ConvItem { const float* W; bf16* WT; int ldw, K, src_col0, dst_row0, k0; };
__device__ __forceinline__ void conv_load(const ConvItem& c, f32x4 (&wv)[8], int lane) {
#pragma unroll
    for (int i = 0; i < 8; ++i) { const int kk = 8 * i + (lane >> 3); wv[i] = __builtin_nontemporal_load((const f32x4*)(c.W + (size_t)(c.k0 + kk) * c.ldw + c.src_col0 + 4 * (lane & 7))); }
}
__device__ __forceinline__ void conv_finish(const ConvItem& cI, const f32x4 (&wv)[8], LAS float* scr, int lane) {
#pragma unroll
    for (int i = 0; i < 8; ++i) { const int kk = 8 * i + (lane >> 3); LAS float* d = scr + kk * 33 + 4 * (lane & 7); d[0] = wv[i].x; d[1] = wv[i].y; d[2] = wv[i].z; d[3] = wv[i].w; }
    LDS_WAIT(); asm volatile("" ::: "memory");
    const int c = lane & 7;
#pragma unroll
    for (int j = 0; j < 4; ++j) { const int n = (lane >> 3) + 8 * j; const LAS float* s = scr + (8 * c) * 33 + n;
        u32x4 o; o.x = pk2(s[0 * 33], s[1 * 33]); o.y = pk2(s[2 * 33], s[3 * 33]); o.z = pk2(s[4 * 33], s[5 * 33]); o.w = pk2(s[6 * 33], s[7 * 33]);
        __builtin_nontemporal_store(o, (u32x4*)(cI.WT + (size_t)(cI.dst_row0 + n) * cI.K + cI.k0 + 8 * c)); }
    LDS_WAIT(); asm volatile("" ::: "memory");
}
constexpr int ITL_WIN = 16 * 256, ITL_WBR = 3 * 8 * 32, ITL_WOUT = 16 * 32, ITL_W1 = 32 * 16 * 64, ITL_W2 = 32 * 16 * 32, ITL_ALL = ITL_WIN + ITL_WBR + ITL_WOUT + ITL_W1 + ITL_W2, ITL_PRE = ITL_WIN + ITL_WBR + ITL_WOUT;
__device__ __forceinline__ ConvItem conv_decode(const Frame& F, const ArgsP a, int l, int it) {
    GAS unsigned char* ws = F.ws; int r = it; ConvItem c;
    if (r < ITL_WIN) { const int kb = r / 256, nb = r % 256, d0 = 32 * nb, s0 = d0 + (d0 >= 2048 ? 16 : 0);
        c.W = AIN(I_WIN) + (size_t)l * 1024 * D_IN; c.ldw = D_IN; c.K = 1024; c.src_col0 = s0; c.WT = (bf16*)(ws + WS_WIN) + (size_t)l * 8192 * 1024; c.dst_row0 = d0; c.k0 = 64 * kb; return c; }
    r -= ITL_WIN;
    if (r < ITL_WBR) { const int mi = l * 3 + r / 256, q = r % 256, kb = q / 32, nb = q % 32;
        c.W = AIN(I_WBR) + (size_t)mi * 512 * 1024; c.ldw = 1024; c.K = 512; c.src_col0 = 32 * nb; c.WT = (bf16*)(ws + WS_WBR) + (size_t)mi * 1024 * 512; c.dst_row0 = 32 * nb; c.k0 = 64 * kb; return c; }
    r -= ITL_WBR;
    if (r < ITL_WOUT) { const int kb = r / 32, nb = r % 32;
        c.W = AIN(I_WOUT) + (size_t)l * 1024 * 1024; c.ldw = 1024; c.K = 1024; c.src_col0 = 32 * nb; c.WT = (bf16*)(ws + WS_WOUT) + (size_t)l * 1024 * 1024; c.dst_row0 = 32 * nb; c.k0 = 64 * kb; return c; }
    r -= ITL_WOUT;
    if (r < ITL_W1) { const int mi = l * 32 + r / 1024, q = r % 1024, kb = q / 64, nb = q % 64, d0 = 32 * nb, pn = d0 >> 8, bj = (d0 >> 7) & 1, j = d0 & 127, s0 = 1024 * bj + 128 * pn + j;
        c.W = AIN(I_W1) + (size_t)mi * 1024 * 2048; c.ldw = 2048; c.K = 1024; c.src_col0 = s0; c.WT = (bf16*)(ws + WS_W1) + (size_t)mi * 2048 * 1024; c.dst_row0 = d0; c.k0 = 64 * kb; return c; }
    r -= ITL_W1;
    { const int mi = l * 32 + r / 512, q = r % 512, kb = q / 32, nb = q % 32;
        c.W = AIN(I_W2) + (size_t)mi * 1024 * 1024; c.ldw = 1024; c.K = 1024; c.src_col0 = 32 * nb; c.WT = (bf16*)(ws + WS_W2) + (size_t)mi * 1024 * 1024; c.dst_row0 = 32 * nb; c.k0 = 64 * kb; return c; }
}
__device__ __forceinline__ void conv_run(const Frame& F, const ArgsP a, int l, int it0, int stride, int count, LAS float* scr) {
    f32x4 wA[8], wB[8], wC[8], wD[8];
    ConvItem cA = conv_decode(F, a, l, it0), cB = cA, cC = cA, cD = cA; conv_load(cA, wA, F.lane);
    if (1 < count) { cB = conv_decode(F, a, l, it0 + stride); conv_load(cB, wB, F.lane); }
    if (2 < count) { cC = conv_decode(F, a, l, it0 + 2 * stride); conv_load(cC, wC, F.lane); }
    if (3 < count) { cD = conv_decode(F, a, l, it0 + 3 * stride); conv_load(cD, wD, F.lane); }
#pragma unroll 1
    for (int n = 0; n < count; n += 4) {
        conv_finish(cA, wA, scr, F.lane);
        if (n + 4 < count) { cA = conv_decode(F, a, l, it0 + (n + 4) * stride); conv_load(cA, wA, F.lane); }
        if (n + 1 < count) { conv_finish(cB, wB, scr, F.lane);
            if (n + 5 < count) { cB = conv_decode(F, a, l, it0 + (n + 5) * stride); conv_load(cB, wB, F.lane); } }
        if (n + 2 < count) { conv_finish(cC, wC, scr, F.lane);
            if (n + 6 < count) { cC = conv_decode(F, a, l, it0 + (n + 6) * stride); conv_load(cC, wC, F.lane); } }
        if (n + 3 < count) { conv_finish(cD, wD, scr, F.lane);
            if (n + 7 < count) { cD = conv_decode(F, a, l, it0 + (n + 7) * stride); conv_load(cD, wD, F.lane); } }
    }
}

PHASE_FN void p0_prologue(Ctx cx) {
    Frame F = mkframe(cx); const ArgsP a = F.ap;
    REFRESH(F);
    GAS unsigned char* ws = F.ws;
    LAS float* scr = (LAS float*)(F.lds + F.wave * 16384);
    const int gw = F.bid * NWAVES + F.wave, NGW = F.G * NWAVES;
    if (gw < ITL_PRE) conv_run(F, a, 0, gw, NGW, (ITL_PRE - gw + NGW - 1) / NGW, scr);
    const size_t gt = (size_t)F.bid * NTHREADS + F.tid, NGT = (size_t)F.G * NTHREADS;
    { float* wd = (float*)(ws + WS_WDEC);
      for (size_t i = gt; i < (size_t)DEPTH * 16 * 1024; i += NGT) { const int l = (int)(i >> 14), c = (int)(i >> 10) & 15, k = (int)i & 1023; wd[i] = AIN(I_WIN)[((size_t)l * 1024 + k) * D_IN + 2048 + c]; }
      float* wr = (float*)(ws + WS_WRT);
      for (size_t i = gt; i < (size_t)DEPTH * 32 * 1024; i += NGT) { const int l = (int)(i >> 15), e = (int)(i >> 10) & 31, k = (int)i & 1023; wr[i] = AIN(I_WR)[((size_t)l * 1024 + k) * 32 + e]; } }
    if (F.bid == 0 && F.wave < DEPTH) { const int l = F.wave; const float* lv = AIN(I_DLAM) + l * 256;
        const float s1 = wave_sum(lv[F.lane] * lv[64 + F.lane]), s2 = wave_sum(lv[128 + F.lane] * lv[192 + F.lane]);
        if (F.lane == 0) ((float*)(ws + WS_LAM))[l] = expf(s1) - expf(s2) + (0.8f - 0.6f * expf(-0.3f * (float)l)); }
    { LAS float* sc = (LAS float*)(F.lds);
      LAS float* red = sc + 3072;
      float* MOD = (float*)(ws + WS_MOD);
      __syncthreads();
      for (int i = F.tid; i < 3072; i += NTHREADS) sc[i] = siluf(i < 2048 ? AIN(I_C)[i] : AIN(I_CCTX)[i - 2048]);
      __syncthreads();
      for (int it = F.bid; it < DEPTH * 48; it += F.G) {
        const int l = it / 48, n0 = (it % 48) * 128; const float* wa = AIN(I_WADA) + (size_t)l * 1024 * 6144 + n0 + 2 * F.lane;
        f32x2 a0 = {0.f, 0.f}, a1 = {0.f, 0.f}, a2 = {0.f, 0.f};
#pragma unroll 32
        for (int k = F.wave * 128; k < F.wave * 128 + 128; ++k) { const f32x2 w = __builtin_nontemporal_load((const f32x2*)(wa + (size_t)k * 6144));
            const float s0 = sc[k], s1 = sc[1024 + k], s2 = sc[2048 + k]; a0 += w * s0; a1 += w * s1; a2 += w * s2; }
        *(LAS f32x2*)(red + (F.wave * 3 + 0) * 128 + 2 * F.lane) = a0; *(LAS f32x2*)(red + (F.wave * 3 + 1) * 128 + 2 * F.lane) = a1; *(LAS f32x2*)(red + (F.wave * 3 + 2) * 128 + 2 * F.lane) = a2;
        __syncthreads();
        if (F.tid < 384) { const int i = F.tid >> 7, c = F.tid & 127; float s = 0.f;
#pragma unroll
            for (int w = 0; w < 8; ++w) s += red[(w * 3 + i) * 128 + c];
            MOD[((size_t)l * 3 + i) * 6144 + n0 + c] = s + AIN(I_BADA)[l * 6144 + n0 + c]; }
        __syncthreads();
      } }
}

__device__ __forceinline__ void ln_inplace(f32x4 (&v)[4]) {
    float s = 0.f;
#pragma unroll
    for (int j = 0; j < 4; ++j) s += (v[j].x + v[j].y) + (v[j].z + v[j].w);
    const float mean = wave_sum(s) * (1.f / DM); float s2 = 0.f;
#pragma unroll
    for (int j = 0; j < 4; ++j) { v[j] = v[j] - mean; s2 += (v[j].x * v[j].x + v[j].y * v[j].y) + (v[j].z * v[j].z + v[j].w * v[j].w); }
    const float rstd = 1.f / sqrtf(wave_sum(s2) * (1.f / DM) + LN_EPS);
#pragma unroll
    for (int j = 0; j < 4; ++j) v[j] = v[j] * rstd;
}
__device__ __forceinline__ void modulate_store(const Frame& F, int l, int which, int row, f32x4 (&v)[4]) {
    ln_inplace(v);
    const float* mod = (const float*)(F.ws + WS_MOD) + ((size_t)l * 3 + mod_index(row)) * 6144 + which * 3072;
    bf16* hx = (bf16*)(F.ws + WS_HX) + (size_t)row * DM;
#pragma unroll
    for (int j = 0; j < 4; ++j) { const int c = 4 * F.lane + 256 * j; const f32x4 sh = *(const f32x4*)(mod + c), sc = *(const f32x4*)(mod + 1024 + c);
        v[j] = v[j] * (sc + 1.f) + sh;
        u32x2 o; o.x = pk2(v[j].x, v[j].y); o.y = pk2(v[j].z, v[j].w); *(u32x2*)(hx + c) = o; }
}
__device__ __forceinline__ void stage_wdec(const Frame& F, int l) {
    const f32x4* src = (const f32x4*)((const float*)(F.ws + WS_WDEC) + (size_t)l * 16 * 1024); LAS f32x4* dst = (LAS f32x4*)F.lds;
    __syncthreads();
    for (int i = F.tid; i < 16 * 256; i += NTHREADS) dst[i] = src[i];
    __syncthreads();
}
__device__ __forceinline__ void decay_cols(const Frame& F, int l, int row, const f32x4 (&h)[4]) {
    const LAS float* wd = (const LAS float*)F.lds; float* dec = (float*)(F.ws + WS_DEC) + (size_t)row * 16;
    float p[16];
#pragma unroll
    for (int i = 0; i < 16; ++i) { float s = 0.f;
#pragma unroll
        for (int j = 0; j < 4; ++j) { const f32x4 w = *(const LAS f32x4*)(wd + i * 1024 + 4 * F.lane + 256 * j); s += (h[j].x * w.x + h[j].y * w.y) + (h[j].z * w.z + h[j].w * w.w); }
        p[i] = s; if ((i & 7) == 7) asm volatile("" ::: "memory"); }
#pragma unroll
    for (int i2 = 0; i2 < 8; ++i2) { const bool up = (F.lane & 32) != 0; const float send = up ? p[i2] : p[i2 + 8], keep = up ? p[i2 + 8] : p[i2]; p[i2] = keep + xorl<32>(send); }
#pragma unroll
    for (int i2 = 0; i2 < 4; ++i2) { const bool up = (F.lane & 16) != 0; const float send = up ? p[i2] : p[i2 + 4], keep = up ? p[i2 + 4] : p[i2]; p[i2] = keep + xorl<16>(send); }
#pragma unroll
    for (int i2 = 0; i2 < 2; ++i2) { const bool up = (F.lane & 8) != 0; const float send = up ? p[i2] : p[i2 + 2], keep = up ? p[i2 + 2] : p[i2]; p[i2] = keep + xorl<8>(send); }
    { const bool up = (F.lane & 4) != 0; const float send = up ? p[0] : p[1], keep = up ? p[1] : p[0]; p[0] = keep + xorl<4>(send); }
    p[0] += xorl<2>(p[0]); p[0] += xorl<1>(p[0]);
    if ((F.lane & 3) == 0) dec[F.lane >> 2] = p[0];
}

__device__ __forceinline__ void decay_cols2(const Frame& F, int rowA, const f32x4 (&hA)[4], int rowB, const f32x4 (&hB)[4]) {
    const LAS float* wd = (const LAS float*)F.lds;
    float p[16], q[16];
#pragma unroll
    for (int i = 0; i < 16; ++i) { f32x2 s = {0.f, 0.f}, t = {0.f, 0.f};
#pragma unroll
        for (int j = 0; j < 4; ++j) { const f32x4 w = *(const LAS f32x4*)(wd + i * 1024 + 4 * F.lane + 256 * j); const f32x2 wl = {w.x, w.y}, wh = {w.z, w.w};
            s += (f32x2){hA[j].x, hA[j].y} * wl; s += (f32x2){hA[j].z, hA[j].w} * wh; t += (f32x2){hB[j].x, hB[j].y} * wl; t += (f32x2){hB[j].z, hB[j].w} * wh; }
        p[i] = s.x + s.y; q[i] = t.x + t.y; if ((i & 7) == 7) asm volatile("" ::: "memory"); }
#define DEC_BFLY(p) do { \
    _Pragma("unroll") for (int i2 = 0; i2 < 8; ++i2) { const bool up = (F.lane & 32) != 0; const float send = up ? p[i2] : p[i2 + 8], keep = up ? p[i2 + 8] : p[i2]; p[i2] = keep + xorl<32>(send); } \
    _Pragma("unroll") for (int i2 = 0; i2 < 4; ++i2) { const bool up = (F.lane & 16) != 0; const float send = up ? p[i2] : p[i2 + 4], keep = up ? p[i2 + 4] : p[i2]; p[i2] = keep + xorl<16>(send); } \
    _Pragma("unroll") for (int i2 = 0; i2 < 2; ++i2) { const bool up = (F.lane & 8) != 0; const float send = up ? p[i2] : p[i2 + 2], keep = up ? p[i2 + 2] : p[i2]; p[i2] = keep + xorl<8>(send); } \
    { const bool up = (F.lane & 4) != 0; const float send = up ? p[0] : p[1], keep = up ? p[1] : p[0]; p[0] = keep + xorl<4>(send); } \
    p[0] += xorl<2>(p[0]); p[0] += xorl<1>(p[0]); } while (0)
    DEC_BFLY(p); DEC_BFLY(q);
#undef DEC_BFLY
    if ((F.lane & 3) == 0) { ((float*)(F.ws + WS_DEC) + (size_t)rowA * 16)[F.lane >> 2] = p[0]; ((float*)(F.ws + WS_DEC) + (size_t)rowB * 16)[F.lane >> 2] = q[0]; }
}

PHASE_FN void ph_lnmod0(Ctx cx) {
    Frame F = mkframe(cx);
    REFRESH(F);
    const int gw = F.bid * NWAVES + F.wave, NGW = F.G * NWAVES;
    stage_wdec(F, 0);
    const ArgsP a = F.ap;
    f32x4 nv[4], pv[4]; bool havep = false; int prow = 0;
#pragma unroll
    for (int j = 0; j < 4; ++j) pv[j] = (f32x4){0.f, 0.f, 0.f, 0.f};
    if (gw < MT) { const f32x4* xr = (const f32x4*)XROW0(gw) + F.lane;
#pragma unroll
        for (int j = 0; j < 4; ++j) nv[j] = xr[64 * j]; }
    for (int row = gw; row < MT; row += NGW) { f32x4 v[4];
#pragma unroll
        for (int j = 0; j < 4; ++j) v[j] = nv[j];
        if (row + NGW < MT) { const f32x4* xr = (const f32x4*)XROW0(row + NGW) + F.lane;
#pragma unroll
            for (int j = 0; j < 4; ++j) nv[j] = xr[64 * j]; }
        modulate_store(F, 0, 0, row, v);
        if (havep) { decay_cols2(F, prow, pv, row, v); havep = false; }
        else { havep = true; prow = row;
#pragma unroll
            for (int j = 0; j < 4; ++j) pv[j] = v[j]; } }
    if (havep) decay_cols(F, 0, prow, pv);
}

struct TileMap {
    __device__ static __forceinline__ bool map(int i, int G, int c, int nM, int nN, int& pm, int& pn) {
        const int nwg = nM * nN; const long L = (long)i * G + c; if (L >= nwg) return false;
        int wgid = (int)L; { const int q = nwg / 8, r = nwg % 8, xcd = wgid % 8, off = wgid / 8; wgid = (xcd < r ? xcd * (q + 1) : r * (q + 1) + (xcd - r) * q) + off; }
        const int nig = 8 * nN, gid = wgid / nig, fm = gid * 8, gsz = (nM - fm) < 8 ? (nM - fm) : 8;
        pm = fm + ((wgid % nig) % gsz); pn = (wgid % nig) / gsz; return true; }
};
struct StaticOrder { int nM, nN, G, c, K;
    __device__ __forceinline__ bool next(int i, pg8::Unit& u) const { if (!TileMap::map(i, G, c, nM, nN, u.pm, u.pn)) return false; u.aux = 0;
        u.aoff = (unsigned)u.pm * 256u * (unsigned)K * 2u; u.boff = (unsigned)u.pn * 256u * (unsigned)K * 2u; return true; } };
struct MergeOrder { int G, c, nctx;
    __device__ __forceinline__ bool next(int i, pg8::Unit& u) const {
        const int nlat = c < 256 ? (256 - c + G - 1) / G : 0;
        if (i < 3 * nlat) { const int br = i % 3; TileMap::map(i / 3, G, c, MLAT / 256, 4, u.pm, u.pn); u.aux = br;
            u.aoff = (unsigned)br * (unsigned)(MT * 512 * 2) + (unsigned)u.pm * (256u * 512u * 2u); u.boff = ((unsigned)br * 1024u + (unsigned)u.pn * 256u) * (512u * 2u); return true; }
        const int v = c + (i - 3 * nlat) * G; if (v >= nctx) return false;
        const int ct = v / 3, br = v % 3; u.pm = MLAT / 256 + (ct >> 2); u.pn = ct & 3; u.aux = 4 + br;
        u.aoff = (unsigned)br * (unsigned)(MT * 512 * 2) + (unsigned)u.pm * (256u * 512u * 2u); u.boff = ((unsigned)br * 1024u + (unsigned)u.pn * 256u) * (512u * 2u); return true; } };
struct MoeOrder { const volatile LAS int* tab; int gather;
    __device__ __forceinline__ bool next(int i, pg8::Unit& u) const { const int w = tab[416 + i]; if (w < 0) return false; u.pm = w & 0xfff; u.pn = (w >> 12) & 0xf; u.aux = (w >> 16) & 0xff; const int nN = (w >> 24) & 0xf;
        u.aoff = gather ? 0u : (unsigned)u.pm * (256u * 1024u * 2u); u.boff = (unsigned)((u.aux * nN + u.pn) * 256) * (1024u * 2u); return true; } };

struct EpiWin { bf16* P;
    __device__ __forceinline__ void operator()(const f32x4 (&acc)[2][2][4][2], const pg8::Unit& u, int wr, int wc, int fr, int fq) const {
        const int row0 = u.pm * 256 + wr * 64 + fr, col0 = u.pn * 256 + wc * 32 + 8 * fq; const bool sg = u.pn >= 20;
#pragma unroll
        for (int ai = 0; ai < 2; ++ai)
#pragma unroll
            for (int m = 0; m < 4; ++m) { bf16* rowp = P + (size_t)(row0 + ai * 128 + m * 16) * NP + col0;
#pragma unroll
                for (int bj = 0; bj < 2; ++bj) { f32x4 v0 = acc[ai][bj][m][0], v1 = acc[ai][bj][m][1];
                    if (sg) {
#pragma unroll
                        for (int q = 0; q < 4; ++q) { v0[q] = sigmf(v0[q]); v1[q] = sigmf(v1[q]); } }
                    u32x4 w; w.x = pk2(v0[0], v0[1]); w.y = pk2(v0[2], v0[3]); w.z = pk2(v1[0], v1[1]); w.w = pk2(v1[2], v1[3]);
                    *(u32x4*)(rowp + bj * 128) = w; } }
    } };
struct EpiMerge { const bf16* P; bf16* MACC; bf16* MBF; bf16* CPART;
    __device__ __forceinline__ void operator()(const f32x4 (&acc)[2][2][4][2], const pg8::Unit& u, int wr, int wc, int fr, int fq) const {
        const int row0 = u.pm * 256 + wr * 64 + fr, col0 = u.pn * 256 + wc * 32 + 8 * fq; const bool isctx = u.aux >= 4; const int br = u.aux & 3;
        bf16* dstb = isctx ? CPART + (size_t)br * MCTX * DM - (size_t)MLAT * DM : (br < 2 ? MACC : MBF);
#pragma unroll
        for (int ai = 0; ai < 2; ++ai) {
            u32x4 g[4][2], mc[4][2];
#pragma unroll
            for (int m = 0; m < 4; ++m)
#pragma unroll
                for (int bj = 0; bj < 2; ++bj) { const size_t row = (size_t)(row0 + ai * 128 + m * 16); const int col = col0 + bj * 128;
                    g[m][bj] = *(const u32x4*)(P + row * NP + PC_GATE + 1024 * br + col);
                    if (br > 0 && !isctx) mc[m][bj] = *(const u32x4*)(MACC + row * DM + col); else mc[m][bj] = (u32x4){0u, 0u, 0u, 0u}; }
#pragma unroll
            for (int m = 0; m < 4; ++m)
#pragma unroll
                for (int bj = 0; bj < 2; ++bj) { const size_t row = (size_t)(row0 + ai * 128 + m * 16); const int col = col0 + bj * 128; const u32x4 gg = g[m][bj], mm = mc[m][bj];
                    const f32x4 v0 = acc[ai][bj][m][0], v1 = acc[ai][bj][m][1]; u32x4 w;
                    w.x = pk2(v0[0] * bflo(gg.x) + bflo(mm.x), v0[1] * bfhi(gg.x) + bfhi(mm.x)); w.y = pk2(v0[2] * bflo(gg.y) + bflo(mm.y), v0[3] * bfhi(gg.y) + bfhi(mm.y));
                    w.z = pk2(v1[0] * bflo(gg.z) + bflo(mm.z), v1[1] * bfhi(gg.z) + bfhi(mm.z)); w.w = pk2(v1[2] * bflo(gg.w) + bflo(mm.w), v1[3] * bfhi(gg.w) + bfhi(mm.w));
                    *(u32x4*)(dstb + row * DM + col) = w; }
            asm volatile("" ::: "memory");
        }
    } };
struct EpiWout { bf16* Dm;
    __device__ __forceinline__ void operator()(const f32x4 (&acc)[2][2][4][2], const pg8::Unit& u, int wr, int wc, int fr, int fq) const {
        const int row0 = u.pm * 256 + wr * 64 + fr, col0 = u.pn * 256 + wc * 32 + 8 * fq;
#pragma unroll
        for (int ai = 0; ai < 2; ++ai)
#pragma unroll
            for (int m = 0; m < 4; ++m) { bf16* rowp = Dm + (size_t)(row0 + ai * 128 + m * 16) * DM + col0;
#pragma unroll
                for (int bj = 0; bj < 2; ++bj) { const f32x4 v0 = acc[ai][bj][m][0], v1 = acc[ai][bj][m][1];
                    u32x4 w; w.x = pk2(v0[0], v0[1]); w.y = pk2(v0[2], v0[3]); w.z = pk2(v1[0], v1[1]); w.w = pk2(v1[2], v1[3]); *(u32x4*)(rowp + bj * 128) = w; } }
    } };
struct WoutCtxOrder { int G, c;
    __device__ __forceinline__ bool next(int i, pg8::Unit& u) const { const int v = c + i * G; if (v >= 32) return false; const int ct = v >> 2, kq = v & 3;
        u.pm = MLAT / 256 + (ct >> 2); u.pn = ct & 3; u.aux = kq; u.aoff = (unsigned)u.pm * (256u * 1024u * 2u) + (unsigned)kq * 512u; u.boff = (unsigned)u.pn * (256u * 1024u * 2u) + (unsigned)kq * 512u; return true; } };
struct EpiWoutCtx { bf16* Dq;
    __device__ __forceinline__ void operator()(const f32x4 (&acc)[2][2][4][2], const pg8::Unit& u, int wr, int wc, int fr, int fq) const {
        const int row0 = (u.pm - MLAT / 256) * 256 + wr * 64 + fr, col0 = u.pn * 256 + wc * 32 + 8 * fq; bf16* base = Dq + (size_t)u.aux * MCTX * DM;
#pragma unroll
        for (int ai = 0; ai < 2; ++ai)
#pragma unroll
            for (int m = 0; m < 4; ++m) { bf16* rowp = base + (size_t)(row0 + ai * 128 + m * 16) * DM + col0;
#pragma unroll
                for (int bj = 0; bj < 2; ++bj) { const f32x4 v0 = acc[ai][bj][m][0], v1 = acc[ai][bj][m][1];
                    u32x4 w; w.x = pk2(v0[0], v0[1]); w.y = pk2(v0[2], v0[3]); w.z = pk2(v1[0], v1[1]); w.w = pk2(v1[2], v1[3]); *(u32x4*)(rowp + bj * 128) = w; } }
    } };
struct EpiAct { const float* B1; bf16* ACT;
    __device__ __forceinline__ void operator()(const f32x4 (&acc)[2][2][4][2], const pg8::Unit& u, int wr, int wc, int fr, int fq) const {
        const int row0 = u.pm * 256 + wr * 64 + fr, cc = u.pn * 128 + wc * 32 + 8 * fq; const float* b = B1 + (size_t)u.aux * 2048;
        const f32x4 bg0 = *(const f32x4*)(b + cc), bg1 = *(const f32x4*)(b + cc + 4), bl0 = *(const f32x4*)(b + 1024 + cc), bl1 = *(const f32x4*)(b + 1024 + cc + 4);
#pragma unroll
        for (int ai = 0; ai < 2; ++ai)
#pragma unroll
            for (int m = 0; m < 4; ++m) { const size_t row = (size_t)(row0 + ai * 128 + m * 16);
                f32x4 g0 = acc[ai][0][m][0] + bg0, g1 = acc[ai][0][m][1] + bg1, l0 = acc[ai][1][m][0] + bl0, l1 = acc[ai][1][m][1] + bl1; float r[8];
#pragma unroll
                for (int q = 0; q < 4; ++q) { const float xg = fminf(g0[q], 7.f), xl = fminf(fmaxf(l0[q], -7.f), 7.f); r[q] = xg * sigmf(1.702f * xg) * (xl + 1.f);
                    const float yg = fminf(g1[q], 7.f), yl = fminf(fmaxf(l1[q], -7.f), 7.f); r[4 + q] = yg * sigmf(1.702f * yg) * (yl + 1.f); }
                u32x4 w; w.x = pk2(r[0], r[1]); w.y = pk2(r[2], r[3]); w.z = pk2(r[4], r[5]); w.w = pk2(r[6], r[7]);
                *(u32x4*)(ACT + row * 1024 + cc) = w; }
    } };
struct EpiY { const float* B2; bf16* Y;
    __device__ __forceinline__ void operator()(const f32x4 (&acc)[2][2][4][2], const pg8::Unit& u, int wr, int wc, int fr, int fq) const {
        const int row0 = u.pm * 256 + wr * 64 + fr, col0 = u.pn * 256 + wc * 32 + 8 * fq; const float* b = B2 + (size_t)u.aux * 1024;
#pragma unroll
        for (int bj = 0; bj < 2; ++bj) { const int col = col0 + bj * 128; const f32x4 ba = *(const f32x4*)(b + col), bb = *(const f32x4*)(b + col + 4);
#pragma unroll
            for (int ai = 0; ai < 2; ++ai)
#pragma unroll
                for (int m = 0; m < 4; ++m) { const size_t row = (size_t)(row0 + ai * 128 + m * 16); const f32x4 v0 = acc[ai][bj][m][0] + ba, v1 = acc[ai][bj][m][1] + bb;
                    u32x4 w; w.x = pk2(v0[0], v0[1]); w.y = pk2(v0[2], v0[3]); w.z = pk2(v1[0], v1[1]); w.w = pk2(v1[2], v1[3]); *(u32x4*)(Y + row * 1024 + col) = w; } }
    } };
PHASE_FN void ph_prep(Ctx cx, int l_) {
    Frame F = mkframe(cx); const ArgsP a = F.ap; const int l = rfl(l_);
    REFRESH(F);
    const int gw = F.bid * NWAVES + F.wave, NGW = F.G * NWAVES;
    bf16* P = (bf16*)(F.ws + WS_P);
    { const int blk = F.lane >> 2, j8 = F.lane & 3; float inv[8];
#pragma unroll
      for (int i = 0; i < 8; ++i) inv[i] = exp2f(-(float)(8 * (j8 & 1) + i) * (13.287712379549449f / 16.f)) * 0.15915494309189535f;
      for (int row = gw; row < MLAT; row += NGW) {
        const int t = row & (SEQ - 1); const float pos = (float)(j8 < 2 ? (t >> 6) : (t & 63));
        bf16* p = P + (size_t)row * NP + PC_DQ + blk * 64 + 8 * j8;
        const u32x4 w1 = *(const u32x4*)p, w2 = *(const u32x4*)(p + 32);
        float x1[8] = {bflo(w1.x), bfhi(w1.x), bflo(w1.y), bfhi(w1.y), bflo(w1.z), bfhi(w1.z), bflo(w1.w), bfhi(w1.w)};
        float x2[8] = {bflo(w2.x), bfhi(w2.x), bflo(w2.y), bfhi(w2.y), bflo(w2.z), bfhi(w2.z), bflo(w2.w), bfhi(w2.w)};
        float y1[8], y2[8];
#pragma unroll
        for (int i = 0; i < 8; ++i) { const float rev = pos * inv[i], fr = rev - floorf(rev), cs = __builtin_amdgcn_cosf(fr), sn = __builtin_amdgcn_sinf(fr);
            y1[i] = x1[i] * cs - x2[i] * sn; y2[i] = x2[i] * cs + x1[i] * sn; }
        *(u32x4*)p = (u32x4){pk2(y1[0], y1[1]), pk2(y1[2], y1[3]), pk2(y1[4], y1[5]), pk2(y1[6], y1[7])};
        *(u32x4*)(p + 32) = (u32x4){pk2(y2[0], y2[1]), pk2(y2[2], y2[3]), pk2(y2[4], y2[5]), pk2(y2[6], y2[7])};
      } }
#if !USE_GDN_FAST
    float* QN = (float*)(F.ws + WS_QN); float* KN = (float*)(F.ws + WS_KN); float* VV = (float*)(F.ws + WS_VV);
    const float* cw = AIN(I_CONVW) + (size_t)l * 3 * 1536;
    for (int row = gw; row < MT; row += NGW) {
        const bool lat = row < MLAT; const int t = lat ? (row & (SEQ - 1)) : ((row - MLAT) & (CTXL - 1)), L = lat ? SEQ : CTXL; const bool hm = t > 0, hp = t < L - 1;
        const bf16* p0 = P + (size_t)row * NP;
#pragma unroll
        for (int wh = 0; wh < 3; ++wh)
#pragma unroll
            for (int h = 0; h < 4; ++h) { const int c = wh * 512 + h * 128 + 2 * F.lane;
                const unsigned x0 = *(const unsigned*)(p0 + c), xm = hm ? *(const unsigned*)(p0 - NP + c) : 0u, xp = hp ? *(const unsigned*)(p0 + NP + c) : 0u;
                const f32x2 w0 = *(const f32x2*)(cw + c), w1 = *(const f32x2*)(cw + 1536 + c), w2 = *(const f32x2*)(cw + 3072 + c);
                float y0 = bflo(xm) * w0.x + bflo(x0) * w1.x + bflo(xp) * w2.x, y1 = bfhi(xm) * w0.y + bfhi(x0) * w1.y + bfhi(xp) * w2.y;
                y0 = siluf(y0); y1 = siluf(y1);
                if (wh < 2) { const float ss = wave_sum(y0 * y0 + y1 * y1), sc = (1.f / sqrtf(ss + RMS_EPS)) * (wh == 0 ? 0.08838834764831845f : 1.f); y0 *= sc; y1 *= sc; }
                float* o = (wh == 0 ? QN : wh == 1 ? KN : VV) + (size_t)row * 512 + h * 128 + 2 * F.lane; *(f32x2*)o = (f32x2){y0, y1}; }
    }
#endif
}

PHASE_FN void ph_gdn_chain_naive(Ctx cx, int l_) {
    Frame F = mkframe(cx); const ArgsP a = F.ap; const int l = rfl(l_);
    REFRESH(F);
    LAS float* kq = (LAS float*)F.lds;
    const float* QN = (const float*)(F.ws + WS_QN); const float* KN = (const float*)(F.ws + WS_KN); const float* VV = (const float*)(F.ws + WS_VV);
    const float* DEC = (const float*)(F.ws + WS_DEC); float* OG = (float*)(F.ws + WS_OG);
    for (int it = F.bid; it < 16; it += F.G) {
        const int b = it >> 3, h = (it >> 1) & 3, d = it & 1, v = (F.tid >> 1) & 127, hf = F.tid & 1;
        const float al = expf(AIN(I_ALOG)[(l * 2 + d) * 4 + h]), dtb = AIN(I_DTB)[(l * 2 + d) * 4 + h];
        float S[64];
#pragma unroll
        for (int k = 0; k < 64; ++k) S[k] = 0.f;
        __syncthreads();
        for (int step = 0; step < CTXL + SEQ; ++step) {
            int row; if (step < CTXL) { const int pos = d ? CTXL - 1 - step : step; row = MLAT + b * CTXL + pos; } else { const int tt = step - CTXL, pos = d ? SEQ - 1 - tt : tt; row = b * SEQ + pos; }
            LAS float* buf = kq + (step & 1) * 256;
            if (F.tid >= 256) { if (F.tid < 384) buf[F.tid - 256] = KN[(size_t)row * 512 + h * 128 + F.tid - 256]; else buf[F.tid - 256] = QN[(size_t)row * 512 + h * 128 + F.tid - 384]; }
            __syncthreads();
            if (F.tid < 256) {
                const float av = DEC[(size_t)row * 16 + 8 * d + h] + dtb, bb = DEC[(size_t)row * 16 + 8 * d + 4 + h];
                const float sp = av > 20.f ? av : log1pf(expf(av)); const float eg = expf(-al * sp), beta = sigmf(bb);
                const float vt = VV[(size_t)row * 512 + h * 128 + v];
                const LAS float* kb = buf + 64 * hf; const LAS float* qb = buf + 128 + 64 * hf;
                float kS = 0.f;
#pragma unroll
                for (int k4 = 0; k4 < 16; ++k4) { const f32x4 kk = *(const LAS f32x4*)(kb + 4 * k4); kS += (kk.x * S[4 * k4] + kk.y * S[4 * k4 + 1]) + (kk.z * S[4 * k4 + 2] + kk.w * S[4 * k4 + 3]); }
                kS += xorl<1>(kS);
                const float vn = beta * (vt - eg * kS); float o = 0.f;
#pragma unroll
                for (int k4 = 0; k4 < 16; ++k4) { const f32x4 kk = *(const LAS f32x4*)(kb + 4 * k4), qq = *(const LAS f32x4*)(qb + 4 * k4);
                    S[4 * k4] = eg * S[4 * k4] + kk.x * vn; S[4 * k4 + 1] = eg * S[4 * k4 + 1] + kk.y * vn; S[4 * k4 + 2] = eg * S[4 * k4 + 2] + kk.z * vn; S[4 * k4 + 3] = eg * S[4 * k4 + 3] + kk.w * vn;
                    o += (qq.x * S[4 * k4] + qq.y * S[4 * k4 + 1]) + (qq.z * S[4 * k4 + 2] + qq.w * S[4 * k4 + 3]); }
                o += xorl<1>(o);
                if (hf == 0) OG[((size_t)d * MT + row) * 512 + h * 128 + v] = o;
            }
        }
        __syncthreads();
    }
}

PHASE_FN void ph_diff_naive(Ctx cx, int l_) {
    Frame F = mkframe(cx); const int l = rfl(l_);
    REFRESH(F);
    LAS float* Kf = (LAS float*)F.lds;
    LAS float* Vf = (LAS float*)(F.lds + 16384);
    const bf16* P = (const bf16*)(F.ws + WS_P); float* OD = (float*)(F.ws + WS_OD);
    for (int it = F.bid; it < 512 + 16; it += F.G) {
        int b, h, m, q0, t0, t1;
        if (it < 512) { b = it >> 8; h = (it >> 6) & 3; m = (it >> 5) & 1; q0 = b * SEQ + (it & 31) * 256; t0 = 0; t1 = 132; }
        else { const int j = it - 512; b = j >> 3; h = (j >> 1) & 3; m = j & 1; q0 = MLAT + b * CTXL; t0 = 128; t1 = 132; }
        const int qi = F.tid & 255, eh = F.tid >> 8;
        float q[64], o[64];
        { const bf16* qp = P + (size_t)(q0 + qi) * NP + PC_DQ + h * 128 + m * 64;
#pragma unroll
          for (int d8 = 0; d8 < 8; ++d8) { const u32x4 w = *(const u32x4*)(qp + 8 * d8); q[8 * d8] = bflo(w.x) * 0.125f; q[8 * d8 + 1] = bfhi(w.x) * 0.125f; q[8 * d8 + 2] = bflo(w.y) * 0.125f; q[8 * d8 + 3] = bfhi(w.y) * 0.125f;
              q[8 * d8 + 4] = bflo(w.z) * 0.125f; q[8 * d8 + 5] = bfhi(w.z) * 0.125f; q[8 * d8 + 6] = bflo(w.w) * 0.125f; q[8 * d8 + 7] = bfhi(w.w) * 0.125f; } }
#pragma unroll
        for (int e = 0; e < 64; ++e) o[e] = 0.f;
        float mx = -1e30f, ls = 0.f;
        for (int t = t0; t < t1; ++t) {
            const int krow0 = t < 128 ? b * SEQ + 64 * t : MLAT + b * CTXL + 64 * (t - 128);
            __syncthreads();
            { const int key = F.tid >> 3, c8 = (F.tid & 7) * 8; const bf16* kp = P + (size_t)(krow0 + key) * NP + PC_DK + h * 128 + m * 64 + c8; const u32x4 w = *(const u32x4*)kp;
              LAS float* kd = Kf + key * 64 + c8; *(LAS f32x4*)kd = (f32x4){bflo(w.x), bfhi(w.x), bflo(w.y), bfhi(w.y)}; *(LAS f32x4*)(kd + 4) = (f32x4){bflo(w.z), bfhi(w.z), bflo(w.w), bfhi(w.w)};
              const int c16 = (F.tid & 7) * 16; const bf16* vp = P + (size_t)(krow0 + key) * NP + PC_DV + h * 128 + c16; const u32x4 w0 = *(const u32x4*)vp, w1 = *(const u32x4*)(vp + 8);
              LAS float* vd = Vf + key * 128 + c16; *(LAS f32x4*)vd = (f32x4){bflo(w0.x), bfhi(w0.x), bflo(w0.y), bfhi(w0.y)}; *(LAS f32x4*)(vd + 4) = (f32x4){bflo(w0.z), bfhi(w0.z), bflo(w0.w), bfhi(w0.w)};
              *(LAS f32x4*)(vd + 8) = (f32x4){bflo(w1.x), bfhi(w1.x), bflo(w1.y), bfhi(w1.y)}; *(LAS f32x4*)(vd + 12) = (f32x4){bflo(w1.z), bfhi(w1.z), bflo(w1.w), bfhi(w1.w)}; }
            __syncthreads();
            for (int kk = 0; kk < 64; ++kk) {
                float s = 0.f;
#pragma unroll
                for (int d4 = 0; d4 < 16; ++d4) { const f32x4 kv = *(const LAS f32x4*)(Kf + kk * 64 + 4 * d4); s += (q[4 * d4] * kv.x + q[4 * d4 + 1] * kv.y) + (q[4 * d4 + 2] * kv.z + q[4 * d4 + 3] * kv.w); }
                const float mn = fmaxf(mx, s), corr = __expf(mx - mn), p = __expf(s - mn); mx = mn; ls = ls * corr + p;
#pragma unroll
                for (int e4 = 0; e4 < 16; ++e4) { const f32x4 vv = *(const LAS f32x4*)(Vf + kk * 128 + eh * 64 + 4 * e4);
                    o[4 * e4] = o[4 * e4] * corr + p * vv.x; o[4 * e4 + 1] = o[4 * e4 + 1] * corr + p * vv.y; o[4 * e4 + 2] = o[4 * e4 + 2] * corr + p * vv.z; o[4 * e4 + 3] = o[4 * e4 + 3] * corr + p * vv.w; }
            }
        }
        const float il = 1.f / ls; float* op = OD + ((size_t)m * MT + q0 + qi) * 512 + h * 128 + eh * 64;
#pragma unroll
        for (int e4 = 0; e4 < 16; ++e4) *(f32x4*)(op + 4 * e4) = (f32x4){o[4 * e4] * il, o[4 * e4 + 1] * il, o[4 * e4 + 2] * il, o[4 * e4 + 3] * il};
    }
    __syncthreads();
}

__device__ __forceinline__ void na_key(const bf16* kp, const bf16* vp, const float (&q)[64], float bias, float& mx, float& ls, float (&o)[64]) {
    float s = 0.f;
#pragma unroll
    for (int d8 = 0; d8 < 8; ++d8) { const u32x4 w = *(const u32x4*)(kp + 8 * d8);
        s += (q[8 * d8] * bflo(w.x) + q[8 * d8 + 1] * bfhi(w.x)) + (q[8 * d8 + 2] * bflo(w.y) + q[8 * d8 + 3] * bfhi(w.y)) + (q[8 * d8 + 4] * bflo(w.z) + q[8 * d8 + 5] * bfhi(w.z)) + (q[8 * d8 + 6] * bflo(w.w) + q[8 * d8 + 7] * bfhi(w.w)); }
    s += bias;
    const float mn = fmaxf(mx, s), corr = __expf(mx - mn), p = __expf(s - mn); mx = mn; ls = ls * corr + p;
#pragma unroll
    for (int d8 = 0; d8 < 8; ++d8) { const u32x4 w = *(const u32x4*)(vp + 8 * d8);
        o[8 * d8] = o[8 * d8] * corr + p * bflo(w.x); o[8 * d8 + 1] = o[8 * d8 + 1] * corr + p * bfhi(w.x); o[8 * d8 + 2] = o[8 * d8 + 2] * corr + p * bflo(w.y); o[8 * d8 + 3] = o[8 * d8 + 3] * corr + p * bfhi(w.y);
        o[8 * d8 + 4] = o[8 * d8 + 4] * corr + p * bflo(w.z); o[8 * d8 + 5] = o[8 * d8 + 5] * corr + p * bfhi(w.z); o[8 * d8 + 6] = o[8 * d8 + 6] * corr + p * bflo(w.w); o[8 * d8 + 7] = o[8 * d8 + 7] * corr + p * bfhi(w.w); }
}
PHASE_FN void ph_na_naive(Ctx cx, int l_) {
    Frame F = mkframe(cx); const ArgsP a = F.ap; const int l = rfl(l_);
    REFRESH(F);
    const bf16* P = (const bf16*)(F.ws + WS_P); bf16* YC = (bf16*)(F.ws + WS_YC);
    const int gt = F.bid * NTHREADS + F.tid, NGT = F.G * NTHREADS;
    for (int idx = gt; idx < 8 * MT; idx += NGT) {
        int b, h, qrow, t; bool lat = idx < 8 * MLAT;
        if (lat) { b = idx >> 16; h = (idx >> 13) & 7; t = idx & (SEQ - 1); qrow = b * SEQ + t; } else { const int j = idx - 8 * MLAT; b = j >> 11; h = (j >> 8) & 7; t = j & 255; qrow = MLAT + b * CTXL + t; }
        float q[64], o[64];
        { const bf16* qp = P + (size_t)qrow * NP + PC_NQ + h * 64;
#pragma unroll
          for (int d8 = 0; d8 < 8; ++d8) { const u32x4 w = *(const u32x4*)(qp + 8 * d8); q[8 * d8] = bflo(w.x) * 0.125f; q[8 * d8 + 1] = bfhi(w.x) * 0.125f; q[8 * d8 + 2] = bflo(w.y) * 0.125f; q[8 * d8 + 3] = bfhi(w.y) * 0.125f;
              q[8 * d8 + 4] = bflo(w.z) * 0.125f; q[8 * d8 + 5] = bfhi(w.z) * 0.125f; q[8 * d8 + 6] = bflo(w.w) * 0.125f; q[8 * d8 + 7] = bfhi(w.w) * 0.125f; } }
#pragma unroll
        for (int e = 0; e < 64; ++e) o[e] = 0.f;
        float mx = -1e30f, ls = 0.f;
        if (lat) { const int r = t >> 6, c = t & 63; const int r0 = min(max(r - 4, 0), 120), c0 = min(max(c - 8, 0), 48);
            const float* rp = AIN(I_RPB) + ((size_t)l * 8 + h) * 15 * 31;
            for (int kr = 0; kr < 8; ++kr) for (int kc = 0; kc < 16; ++kc) { const int krow = b * SEQ + (r0 + kr) * 64 + c0 + kc;
                const float bias = rp[(r0 + kr - r + 7) * 31 + (c0 + kc - c + 15)];
                na_key(P + (size_t)krow * NP + PC_NK + h * 64, P + (size_t)krow * NP + PC_NV + h * 64, q, bias, mx, ls, o); } }
        for (int j = 0; j < CTXL; ++j) { const int krow = MLAT + b * CTXL + j; na_key(P + (size_t)krow * NP + PC_NK + h * 64, P + (size_t)krow * NP + PC_NV + h * 64, q, 0.f, mx, ls, o); }
        const float il = 1.f / ls; bf16* op = YC + (size_t)qrow * 512 + h * 64;
#pragma unroll
        for (int d8 = 0; d8 < 8; ++d8) { u32x4 w; w.x = pk2(o[8 * d8] * il, o[8 * d8 + 1] * il); w.y = pk2(o[8 * d8 + 2] * il, o[8 * d8 + 3] * il); w.z = pk2(o[8 * d8 + 4] * il, o[8 * d8 + 5] * il); w.w = pk2(o[8 * d8 + 6] * il, o[8 * d8 + 7] * il);
            *(u32x4*)(op + 8 * d8) = w; }
    }
}

__device__ __forceinline__ float grp16_sum(float v) { v += xorl<1>(v); v += xorl<2>(v); v += xorl<4>(v); v += xorl<8>(v); return v; }
PHASE_FN void ph_combine(Ctx cx, int l_) {
    Frame F = mkframe(cx); const ArgsP a = F.ap; const int l = rfl(l_);
    REFRESH(F);
    const int gw = F.bid * NWAVES + F.wave, NGW = F.G * NWAVES;
    const float* OG = (const float*)(F.ws + WS_OG); const float* OD = (const float*)(F.ws + WS_OD); const bf16* P = (const bf16*)(F.ws + WS_P);
    bf16* YA = (bf16*)(F.ws + WS_YA); bf16* YB = (bf16*)(F.ws + WS_YB);
    const float lam = ((const float*)(F.ws + WS_LAM))[l], omli = 1.f - (0.8f - 0.6f * expf(-0.3f * (float)l));
    const float* gnw = AIN(I_GNW) + l * 128; const float* dnw = AIN(I_DNW) + l * 128;
    const int MR = l == DEPTH - 1 ? MLAT : MT;
    const int c = 8 * F.lane, ch = c & 127;
    const f32x4 w0 = *(const f32x4*)(gnw + ch), w1 = *(const f32x4*)(gnw + ch + 4);
    f32x4 nf0 = {0.f, 0.f, 0.f, 0.f}, nf1 = nf0, nb0 = nf0, nb1 = nf0; u32x4 nz = {0u, 0u, 0u, 0u};
#define CMB_LOAD(r) do { const float* p0 = OG + (size_t)(r) * 512 + c; const float* p1 = p0 + (size_t)MT * 512; nf0 = __builtin_nontemporal_load((const f32x4*)p0); nf1 = __builtin_nontemporal_load((const f32x4*)(p0 + 4)); nb0 = __builtin_nontemporal_load((const f32x4*)p1); nb1 = __builtin_nontemporal_load((const f32x4*)(p1 + 4)); \
        nz = __builtin_nontemporal_load((const u32x4*)(P + (size_t)(r) * NP + PC_GZ + c)); } while (0)
    if (gw < MR) CMB_LOAD(gw);
    for (int row = gw; row < MR; row += NGW) {
        { const f32x4 a0 = nf0 + nb0, a1 = nf1 + nb1; const u32x4 z = nz;
          if (row + NGW < MR) CMB_LOAD(row + NGW);
          float ss = (a0.x * a0.x + a0.y * a0.y) + (a0.z * a0.z + a0.w * a0.w) + (a1.x * a1.x + a1.y * a1.y) + (a1.z * a1.z + a1.w * a1.w);
          const float rs = 1.f / sqrtf(grp16_sum(ss) * (1.f / 128.f) + RMS_EPS);
          u32x4 o; o.x = pk2(a0.x * rs * w0.x * siluf(bflo(z.x)), a0.y * rs * w0.y * siluf(bfhi(z.x))); o.y = pk2(a0.z * rs * w0.z * siluf(bflo(z.y)), a0.w * rs * w0.w * siluf(bfhi(z.y)));
          o.z = pk2(a1.x * rs * w1.x * siluf(bflo(z.z)), a1.y * rs * w1.y * siluf(bfhi(z.z))); o.w = pk2(a1.z * rs * w1.z * siluf(bflo(z.w)), a1.w * rs * w1.w * siluf(bfhi(z.w)));
          *(u32x4*)(YA + (size_t)row * 512 + c) = o; }
#if !USE_DIFF_MFMA
        { const float* p0 = OD + (size_t)row * 512 + c; const float* p1 = p0 + (size_t)MT * 512;
          const f32x4 a0 = *(const f32x4*)p0 - *(const f32x4*)p1 * lam, a1 = *(const f32x4*)(p0 + 4) - *(const f32x4*)(p1 + 4) * lam;
          float ss = (a0.x * a0.x + a0.y * a0.y) + (a0.z * a0.z + a0.w * a0.w) + (a1.x * a1.x + a1.y * a1.y) + (a1.z * a1.z + a1.w * a1.w);
          const float rs = (1.f / sqrtf(grp16_sum(ss) * (1.f / 128.f) + RMS_EPS)) * omli;
          const f32x4 w0 = *(const f32x4*)(dnw + ch), w1 = *(const f32x4*)(dnw + ch + 4);
          u32x4 o; o.x = pk2(a0.x * rs * w0.x, a0.y * rs * w0.y); o.y = pk2(a0.z * rs * w0.z, a0.w * rs * w0.w); o.z = pk2(a1.x * rs * w1.x, a1.y * rs * w1.y); o.w = pk2(a1.z * rs * w1.z, a1.w * rs * w1.w);
          *(u32x4*)(YB + (size_t)row * 512 + c) = o; }
#endif
    }
#undef CMB_LOAD
}
namespace dattn {
using s16x4  = __attribute__((ext_vector_type(4))) short;
using f32x16 = __attribute__((ext_vector_type(16))) float;
constexpr int KVBLK = 64;
constexpr float SCALE = 0.125f, THR = 8.f;
constexpr int SHM_V = KVBLK * 128 * 2, SHM_K = KVBLK * 128 * 2, SHM_ATTN = 2 * SHM_V + 2 * SHM_K + 8 * 64 * 4;
#define DA_KSWZ(row, colB) ((row) * 256 + ((colB) ^ (((row) & 7) << 4)))
#define DA_SBAR() __builtin_amdgcn_sched_barrier(0)
__device__ __forceinline__ int crow(int r, int hi) { return (r & 3) + 8 * (r >> 2) + 4 * hi; }
__device__ __forceinline__ unsigned cvtpk(float lo, float hi) { return pg8::cvt_pk_bf16(lo, hi); }
__device__ __forceinline__ void partialSM(f32x16& p0, f32x16& p1, float& m_reg, float& mn, float& alpha) {
  constexpr float C = SCALE * 1.4426950408889634f;
  float pmax = p0[0];
#pragma unroll
  for (int r = 1; r < 16; ++r) pmax = fmaxf(pmax, p0[r]);
#pragma unroll
  for (int r = 0; r < 16; ++r) pmax = fmaxf(pmax, p1[r]);
  { auto rr = __builtin_amdgcn_permlane32_swap(__float_as_uint(pmax), __float_as_uint(pmax), false, false);
    pmax = fmaxf(__uint_as_float(rr[0]), __uint_as_float(rr[1])); }
  if (__builtin_expect(__all(pmax - m_reg <= THR / SCALE), 1)) { mn = m_reg; alpha = 1.f; }
  else { mn = fmaxf(m_reg, pmax); alpha = __builtin_amdgcn_exp2f((m_reg - mn) * C); m_reg = mn; }
  const float mnC = -mn * C;
#pragma unroll
  for (int r = 0; r < 16; ++r) p0[r] = fmaf(p0[r], C, mnC);
#pragma unroll
  for (int r = 0; r < 16; ++r) p1[r] = fmaf(p1[r], C, mnC);
#pragma unroll
  for (int r = 0; r < 16; ++r) p0[r] = __builtin_amdgcn_exp2f(p0[r]);
}
__device__ __forceinline__ void finishSM(f32x16& p0, f32x16& p1, float alpha, float& l_reg, bf16x8& pa0, bf16x8& pa1, bf16x8& pa2, bf16x8& pa3) {
#pragma unroll
  for (int r = 0; r < 16; ++r) p1[r] = __builtin_amdgcn_exp2f(p1[r]);
  float ps = 0;
#pragma unroll
  for (int r = 0; r < 16; ++r) ps += p0[r];
#pragma unroll
  for (int r = 0; r < 16; ++r) ps += p1[r];
  { auto rr = __builtin_amdgcn_permlane32_swap(__float_as_uint(ps), __float_as_uint(ps), false, false);
    ps = __uint_as_float(rr[0]) + __uint_as_float(rr[1]); }
  l_reg = l_reg * alpha + ps;
#define DA_PK4(P, BASE, OUT) do { unsigned a0 = cvtpk(P[BASE + 0], P[BASE + 1]), a1 = cvtpk(P[BASE + 2], P[BASE + 3]);   \
    unsigned b0 = cvtpk(P[BASE + 4], P[BASE + 5]), b1 = cvtpk(P[BASE + 6], P[BASE + 7]);                              \
    auto r0 = __builtin_amdgcn_permlane32_swap(a0, b0, false, false); auto r1 = __builtin_amdgcn_permlane32_swap(a1, b1, false, false); \
    u32x4 w = {r0[0], r1[0], r0[1], r1[1]}; OUT = *reinterpret_cast<bf16x8*>(&w); } while (0)
  DA_PK4(p0, 0, pa0); DA_PK4(p0, 8, pa1); DA_PK4(p1, 0, pa2); DA_PK4(p1, 8, pa3);
#undef DA_PK4
}
__device__ __forceinline__ void qkt(f32x16& p0, f32x16& p1, const LAS char* Ks, const bf16x8* qr, int r32, int hi, int m) {
  p0 = f32x16{}; p1 = f32x16{};
#pragma unroll
  for (int d0 = 0; d0 < 4; ++d0) { const int cb = (m * 64 + d0 * 16 + hi * 8) * 2;
    const bf16x8 b0 = *reinterpret_cast<const LAS bf16x8*>(Ks + DA_KSWZ(r32, cb));
    const bf16x8 b1 = *reinterpret_cast<const LAS bf16x8*>(Ks + DA_KSWZ(32 + r32, cb));
    p0 = __builtin_amdgcn_mfma_f32_32x32x16_bf16(b0, qr[d0], p0, 0, 0, 0);
    p1 = __builtin_amdgcn_mfma_f32_32x32x16_bf16(b1, qr[d0], p1, 0, 0, 0); }
}
__device__ __forceinline__ int v_st(int k, int c) { const int kk = (k & ~0xC) | ((k & 4) << 1) | ((k & 8) >> 1); return ((kk >> 3) * 4 + (c >> 5)) * 512 + ((kk & 7) * 32 + (c & 31)) * 2; }
__device__ __forceinline__ int v_rd_base(int lane) { return ((lane & 3) << 3) | (((lane >> 2) & 3) << 6) | (((lane >> 4) & 1) << 5) | (((lane >> 5) & 1) << 8); }
constexpr int v_rd_off(int d0, int ks, int half) { return d0 * 512 + ks * 4096 + half * 2048; }
template <int OFF> __device__ __forceinline__ s16x4 tr_read(int vb) { s16x4 r; asm volatile("ds_read_b64_tr_b16 %0, %1 offset:%2" : "=&v"(r) : "v"(vb), "i"(OFF) : "memory"); return r; }
template <int D0> __device__ __forceinline__ void pv_one(f32x16& od, int vb, bf16x8 pa0, bf16x8 pa1, bf16x8 pa2, bf16x8 pa3) {
  const s16x4 l0 = tr_read<v_rd_off(D0, 0, 0)>(vb), h0 = tr_read<v_rd_off(D0, 0, 1)>(vb), l1 = tr_read<v_rd_off(D0, 1, 0)>(vb), h1 = tr_read<v_rd_off(D0, 1, 1)>(vb);
  const s16x4 l2 = tr_read<v_rd_off(D0, 2, 0)>(vb), h2 = tr_read<v_rd_off(D0, 2, 1)>(vb), l3 = tr_read<v_rd_off(D0, 3, 0)>(vb), h3 = tr_read<v_rd_off(D0, 3, 1)>(vb);
  asm volatile("s_waitcnt lgkmcnt(0)" ::: "memory"); DA_SBAR();
#define DA_PK(L, H) (bf16x8){L[0], L[1], L[2], L[3], H[0], H[1], H[2], H[3]}
  od = __builtin_amdgcn_mfma_f32_32x32x16_bf16(pa0, DA_PK(l0, h0), od, 0, 0, 0);
  od = __builtin_amdgcn_mfma_f32_32x32x16_bf16(pa1, DA_PK(l1, h1), od, 0, 0, 0);
  od = __builtin_amdgcn_mfma_f32_32x32x16_bf16(pa2, DA_PK(l2, h2), od, 0, 0, 0);
  od = __builtin_amdgcn_mfma_f32_32x32x16_bf16(pa3, DA_PK(l3, h3), od, 0, 0, 0);
#undef DA_PK
}
__device__ __forceinline__ void pv_d0(f32x16* o, int vb, bf16x8 pa0, bf16x8 pa1, bf16x8 pa2, bf16x8 pa3) {
  pv_one<0>(o[0], vb, pa0, pa1, pa2, pa3); pv_one<1>(o[1], vb, pa0, pa1, pa2, pa3); pv_one<2>(o[2], vb, pa0, pa1, pa2, pa3); pv_one<3>(o[3], vb, pa0, pa1, pa2, pa3);
}

__device__ __forceinline__ void unit(const bf16* __restrict__ P, bf16* __restrict__ YB, const float* __restrict__ nw, float lam, float omli,
                                     int b, int h, int qrow0, int t0, int NT, LAS char* lds, int wid, int lane) {
  const int tid = wid * 64 + lane, r32 = lane & 31, hi = lane >> 5, m = wid >> 2, wq = wid & 3;
  LAS char* V_lds = lds; LAS char* K_lds = lds + 2 * SHM_V;
  LAS float* ws = (LAS float*)(lds + 2 * SHM_V + 2 * SHM_K) + wid * 64; LAS float* li_l = ws; LAS float* al_l = ws + 32;
  float m_reg = -1e30f, l_reg = 0; f32x16 o[4] = {}; bf16x8 qr[4];
  { const bf16* Qw = P + (size_t)(qrow0 + wq * 32 + r32) * NP + PC_DQ + h * 128 + m * 64 + hi * 8;
#pragma unroll
    for (int d0 = 0; d0 < 4; ++d0) qr[d0] = *reinterpret_cast<const bf16x8*>(Qw + d0 * 16); }
  const int sr = tid >> 4, sc = (tid & 15) * 8, vst0 = v_st(sr, sc), vst1 = v_st(32 + sr, sc);
  const int vb0 = (int)(uintptr_t)V_lds + v_rd_base(lane);
  const bf16* Kcol = P + PC_DK + h * 128 + sc; const bf16* Vcol = P + PC_DV + h * 128 + sc;
  bf16x8 vsE0, vsE1, ksE0, ksE1, vsO0, vsO1, ksO0, ksO1;
#define DA_KROW(j) ((size_t)(((j) + t0) < 128 ? b * SEQ + 64 * ((j) + t0) : MLAT + b * CTXL + 64 * ((j) + t0 - 128)))
#define DA_SLOAD(S, j) do { const size_t k0_ = DA_KROW(j); vs##S##0 = *reinterpret_cast<const bf16x8*>(Vcol + (k0_ + sr) * NP); vs##S##1 = *reinterpret_cast<const bf16x8*>(Vcol + (k0_ + 32 + sr) * NP); \
    ks##S##0 = *reinterpret_cast<const bf16x8*>(Kcol + (k0_ + sr) * NP); ks##S##1 = *reinterpret_cast<const bf16x8*>(Kcol + (k0_ + 32 + sr) * NP); } while (0)
#define DA_SWRITE(bb, S) do { *(LAS bf16x8*)(V_lds + (bb) * SHM_V + vst0) = vs##S##0; *(LAS bf16x8*)(V_lds + (bb) * SHM_V + vst1) = vs##S##1; const int kc = sc * 2; \
    *(LAS bf16x8*)(K_lds + (bb) * SHM_K + DA_KSWZ(sr, kc)) = ks##S##0; *(LAS bf16x8*)(K_lds + (bb) * SHM_K + DA_KSWZ(32 + sr, kc)) = ks##S##1; } while (0)
#define DA_SWAIT() asm volatile("s_waitcnt vmcnt(4)" ::: "memory")
#define DA_RESC(a) do { if (__any((a) < 1.f)) { if (hi == 0) al_l[r32] = (a); asm volatile("s_waitcnt lgkmcnt(0)" ::: "memory"); \
    _Pragma("unroll") for (int d = 0; d < 4; ++d) _Pragma("unroll") for (int r = 0; r < 16; ++r) o[d][r] *= al_l[crow(r, hi)]; } } while (0)
  f32x16 pA0, pA1, pB0, pB1; float mnA, mnB, alA, alB; bf16x8 pa0, pa1, pa2, pa3;
  DA_SLOAD(E, 0); asm volatile("s_waitcnt vmcnt(0)" ::: "memory"); DA_SWRITE(0, E); __syncthreads();
  qkt(pA0, pA1, K_lds, qr, r32, hi, m); partialSM(pA0, pA1, m_reg, mnA, alA);
  DA_SLOAD(O, 1); if (2 < NT) DA_SLOAD(E, 2);
  DA_SWAIT(); DA_SWRITE(1, O); __syncthreads();
  for (int j = 1; j + 1 < NT; j += 2) {
    DA_SBAR(); qkt(pB0, pB1, K_lds + SHM_K, qr, r32, hi, m);
    finishSM(pA0, pA1, alA, l_reg, pa0, pa1, pa2, pa3); DA_SBAR();
    DA_SLOAD(O, j + 2); DA_SBAR();
    pv_d0(o, vb0, pa0, pa1, pa2, pa3); partialSM(pB0, pB1, m_reg, mnB, alB);
    __syncthreads(); DA_SWAIT(); DA_SWRITE(0, E);
    DA_RESC(alB); __syncthreads();
    DA_SBAR(); qkt(pA0, pA1, K_lds, qr, r32, hi, m);
    finishSM(pB0, pB1, alB, l_reg, pa0, pa1, pa2, pa3); DA_SBAR();
    if (j + 3 < NT) DA_SLOAD(E, j + 3); DA_SBAR();
    pv_d0(o, vb0 + SHM_V, pa0, pa1, pa2, pa3); partialSM(pA0, pA1, m_reg, mnA, alA);
    __syncthreads(); DA_SWAIT(); DA_SWRITE(1, O);
    DA_RESC(alA); __syncthreads();
  }
  DA_SBAR(); qkt(pB0, pB1, K_lds + SHM_K, qr, r32, hi, m);
  finishSM(pA0, pA1, alA, l_reg, pa0, pa1, pa2, pa3); DA_SBAR();
  pv_d0(o, vb0, pa0, pa1, pa2, pa3); partialSM(pB0, pB1, m_reg, mnB, alB);
  __syncthreads(); DA_RESC(alB);
  finishSM(pB0, pB1, alB, l_reg, pa0, pa1, pa2, pa3); DA_SBAR();
  pv_d0(o, vb0 + SHM_V, pa0, pa1, pa2, pa3);
  if (hi == 0) li_l[r32] = l_reg; asm volatile("s_waitcnt lgkmcnt(0)" ::: "memory");
  float rli[16];
#pragma unroll
  for (int r = 0; r < 16; ++r) rli[r] = __builtin_amdgcn_rcpf(li_l[crow(r, hi)]);
  __syncthreads();
  LAS float* X = (LAS float*)lds;
  if (m == 1) {
#pragma unroll
    for (int r = 0; r < 16; ++r) { const int row = wq * 32 + crow(r, hi);
#pragma unroll
      for (int d0 = 0; d0 < 4; ++d0) X[row * 132 + d0 * 32 + r32] = o[d0][r] * rli[r]; } }
  __syncthreads();
  if (m == 0) {
#pragma unroll
    for (int r = 0; r < 16; ++r) { const int row = wq * 32 + crow(r, hi);
#pragma unroll
      for (int d0 = 0; d0 < 4; ++d0) { LAS float* p = X + row * 132 + d0 * 32 + r32; *p = o[d0][r] * rli[r] - lam * *p; } }
    asm volatile("s_waitcnt lgkmcnt(0)" ::: "memory");
    const int row = wq * 32 + (lane >> 1), hf = lane & 1; const LAS float* xr = X + row * 132 + hf * 64;
    f32x4 v[16]; float ss = 0.f;
#pragma unroll
    for (int i = 0; i < 16; ++i) { v[i] = *(const LAS f32x4*)(xr + 4 * i); ss += (v[i].x * v[i].x + v[i].y * v[i].y) + (v[i].z * v[i].z + v[i].w * v[i].w); }
    ss += xorl<1>(ss);
    const float rs = (1.f / sqrtf(ss * (1.f / 128.f) + RMS_EPS)) * omli;
    bf16* op = YB + (size_t)(qrow0 + row) * 512 + h * 128 + hf * 64; const float* wp = nw + hf * 64;
#pragma unroll
    for (int i = 0; i < 8; ++i) { const f32x4 w0 = *(const f32x4*)(wp + 8 * i), w1 = *(const f32x4*)(wp + 8 * i + 4); const f32x4 a0 = v[2 * i] * rs * w0, a1 = v[2 * i + 1] * rs * w1;
      u32x4 w; w.x = cvtpk(a0.x, a0.y); w.y = cvtpk(a0.z, a0.w); w.z = cvtpk(a1.x, a1.y); w.w = cvtpk(a1.z, a1.w); *(u32x4*)(op + 8 * i) = w; }
  }
  __syncthreads();
#undef DA_KROW
#undef DA_SLOAD
#undef DA_SWRITE
#undef DA_SWAIT
#undef DA_RESC
}
__device__ __forceinline__ void unit3(const bf16* __restrict__ P, bf16* __restrict__ YB, const float* __restrict__ nw, float lam, float omli,
                                     int b, int h, int qrow0, int t0, int NT, LAS char* lds, int wid, int lane) {
  const int tid = wid * 64 + lane, r32 = lane & 31, hi = lane >> 5, m = wid >> 2, wq = wid & 3;
  LAS char* V_lds = lds; LAS char* K_lds = lds + 3 * SHM_V;
  LAS float* ws = (LAS float*)(lds + 3 * SHM_V + 3 * SHM_K) + wid * 64; LAS float* li_l = ws; LAS float* al_l = ws + 32;
  float m_reg = -1e30f, l_reg = 0; f32x16 o[4] = {}; bf16x8 qr[4];
  { const bf16* Qw = P + (size_t)(qrow0 + wq * 32 + r32) * NP + PC_DQ + h * 128 + m * 64 + hi * 8;
#pragma unroll
    for (int d0 = 0; d0 < 4; ++d0) qr[d0] = *reinterpret_cast<const bf16x8*>(Qw + d0 * 16); }
  const int sr = tid >> 4, sc = (tid & 15) * 8, vst0 = v_st(sr, sc), vst1 = v_st(32 + sr, sc);
  const int vb0 = (int)(uintptr_t)V_lds + v_rd_base(lane);
  const bf16* Kcol = P + PC_DK + h * 128 + sc; const bf16* Vcol = P + PC_DV + h * 128 + sc;
  bf16x8 vsE0, vsE1, ksE0, ksE1, vsO0, vsO1, ksO0, ksO1;
#define DA_KROW(j) ((size_t)(((j) + t0) < 128 ? b * SEQ + 64 * ((j) + t0) : MLAT + b * CTXL + 64 * ((j) + t0 - 128)))
#define DA_SLOAD(S, j) do { const size_t k0_ = DA_KROW(j); vs##S##0 = *reinterpret_cast<const bf16x8*>(Vcol + (k0_ + sr) * NP); vs##S##1 = *reinterpret_cast<const bf16x8*>(Vcol + (k0_ + 32 + sr) * NP); \
    ks##S##0 = *reinterpret_cast<const bf16x8*>(Kcol + (k0_ + sr) * NP); ks##S##1 = *reinterpret_cast<const bf16x8*>(Kcol + (k0_ + 32 + sr) * NP); } while (0)
#define DA_SWRITE(bb, S) do { *(LAS bf16x8*)(V_lds + (bb) * SHM_V + vst0) = vs##S##0; *(LAS bf16x8*)(V_lds + (bb) * SHM_V + vst1) = vs##S##1; const int kc = sc * 2; \
    *(LAS bf16x8*)(K_lds + (bb) * SHM_K + DA_KSWZ(sr, kc)) = ks##S##0; *(LAS bf16x8*)(K_lds + (bb) * SHM_K + DA_KSWZ(32 + sr, kc)) = ks##S##1; } while (0)
#define DA_SWRITE3(so, S) do { *(LAS bf16x8*)(V_lds + (so) + vst0) = vs##S##0; *(LAS bf16x8*)(V_lds + (so) + vst1) = vs##S##1; const int kc = sc * 2; \
    *(LAS bf16x8*)(K_lds + (so) + DA_KSWZ(sr, kc)) = ks##S##0; *(LAS bf16x8*)(K_lds + (so) + DA_KSWZ(32 + sr, kc)) = ks##S##1; } while (0)
#define DA_SWAIT() asm volatile("s_waitcnt vmcnt(4)" ::: "memory")
#define DA_RESC(a) do { if (__any((a) < 1.f)) { if (hi == 0) al_l[r32] = (a); asm volatile("s_waitcnt lgkmcnt(0)" ::: "memory"); \
    _Pragma("unroll") for (int d = 0; d < 4; ++d) _Pragma("unroll") for (int r = 0; r < 16; ++r) o[d][r] *= al_l[crow(r, hi)]; } } while (0)
  f32x16 pA0, pA1, pB0, pB1; float mnA, mnB, alA, alB; bf16x8 pa0, pa1, pa2, pa3;
  int sl_prev = 0, sl_cur = SHM_V, sl_next = 2 * SHM_V;
#define DA_ROT() do { const int t_ = sl_prev; sl_prev = sl_cur; sl_cur = sl_next; sl_next = t_; } while (0)
  DA_SLOAD(E, 0); asm volatile("s_waitcnt vmcnt(0)" ::: "memory"); DA_SWRITE(0, E); __syncthreads();
  qkt(pA0, pA1, K_lds, qr, r32, hi, m); partialSM(pA0, pA1, m_reg, mnA, alA);
  DA_SLOAD(O, 1); if (2 < NT) DA_SLOAD(E, 2);
  DA_SWAIT(); DA_SWRITE3(SHM_V, O); __syncthreads();
  for (int j = 1; j + 1 < NT; j += 2) {
    DA_SBAR(); qkt(pB0, pB1, K_lds + sl_cur, qr, r32, hi, m);
    finishSM(pA0, pA1, alA, l_reg, pa0, pa1, pa2, pa3); DA_SBAR();
    DA_SLOAD(O, j + 2); DA_SBAR();
    pv_d0(o, vb0 + sl_prev, pa0, pa1, pa2, pa3); partialSM(pB0, pB1, m_reg, mnB, alB);
    DA_SWAIT(); DA_SWRITE3(sl_next, E);
    DA_RESC(alB); __syncthreads(); DA_ROT();
    DA_SBAR(); qkt(pA0, pA1, K_lds + sl_cur, qr, r32, hi, m);
    finishSM(pB0, pB1, alB, l_reg, pa0, pa1, pa2, pa3); DA_SBAR();
    if (j + 3 < NT) DA_SLOAD(E, j + 3); DA_SBAR();
    pv_d0(o, vb0 + sl_prev, pa0, pa1, pa2, pa3); partialSM(pA0, pA1, m_reg, mnA, alA);
    DA_SWAIT(); DA_SWRITE3(sl_next, O);
    DA_RESC(alA); __syncthreads(); DA_ROT();
  }
  DA_SBAR(); qkt(pB0, pB1, K_lds + sl_cur, qr, r32, hi, m);
  finishSM(pA0, pA1, alA, l_reg, pa0, pa1, pa2, pa3); DA_SBAR();
  pv_d0(o, vb0 + sl_prev, pa0, pa1, pa2, pa3); partialSM(pB0, pB1, m_reg, mnB, alB);
  DA_RESC(alB);
  finishSM(pB0, pB1, alB, l_reg, pa0, pa1, pa2, pa3); DA_SBAR();
  pv_d0(o, vb0 + sl_cur, pa0, pa1, pa2, pa3);
#undef DA_ROT
  if (hi == 0) li_l[r32] = l_reg; asm volatile("s_waitcnt lgkmcnt(0)" ::: "memory");
  float rli[16];
#pragma unroll
  for (int r = 0; r < 16; ++r) rli[r] = __builtin_amdgcn_rcpf(li_l[crow(r, hi)]);
  __syncthreads();
  LAS float* X = (LAS float*)lds;
  if (m == 1) {
#pragma unroll
    for (int r = 0; r < 16; ++r) { const int row = wq * 32 + crow(r, hi);
#pragma unroll
      for (int d0 = 0; d0 < 4; ++d0) X[row * 132 + d0 * 32 + r32] = o[d0][r] * rli[r]; } }
  __syncthreads();
  if (m == 0) {
#pragma unroll
    for (int r = 0; r < 16; ++r) { const int row = wq * 32 + crow(r, hi);
#pragma unroll
      for (int d0 = 0; d0 < 4; ++d0) { LAS float* p = X + row * 132 + d0 * 32 + r32; *p = o[d0][r] * rli[r] - lam * *p; } }
    asm volatile("s_waitcnt lgkmcnt(0)" ::: "memory");
    const int row = wq * 32 + (lane >> 1), hf = lane & 1; const LAS float* xr = X + row * 132 + hf * 64;
    f32x4 v[16]; float ss = 0.f;
#pragma unroll
    for (int i = 0; i < 16; ++i) { v[i] = *(const LAS f32x4*)(xr + 4 * i); ss += (v[i].x * v[i].x + v[i].y * v[i].y) + (v[i].z * v[i].z + v[i].w * v[i].w); }
    ss += xorl<1>(ss);
    const float rs = (1.f / sqrtf(ss * (1.f / 128.f) + RMS_EPS)) * omli;
    bf16* op = YB + (size_t)(qrow0 + row) * 512 + h * 128 + hf * 64; const float* wp = nw + hf * 64;
#pragma unroll
    for (int i = 0; i < 8; ++i) { const f32x4 w0 = *(const f32x4*)(wp + 8 * i), w1 = *(const f32x4*)(wp + 8 * i + 4); const f32x4 a0 = v[2 * i] * rs * w0, a1 = v[2 * i + 1] * rs * w1;
      u32x4 w; w.x = cvtpk(a0.x, a0.y); w.y = cvtpk(a0.z, a0.w); w.z = cvtpk(a1.x, a1.y); w.w = cvtpk(a1.z, a1.w); *(u32x4*)(op + 8 * i) = w; }
  }
  __syncthreads();
#undef DA_KROW
#undef DA_SLOAD
#undef DA_SWRITE
#undef DA_SWAIT
#undef DA_SWRITE3
#undef DA_RESC
}
__device__ __forceinline__ void unit64(const bf16* __restrict__ P, bf16* __restrict__ YB, const float* __restrict__ nw, float lam, float omli,
                                       int b, int h, int qrow0, int t0, int NT, LAS char* lds, int wid, int lane) {
  const int tid = wid * 64 + lane, r32 = lane & 31, hi = lane >> 5, kp = wid >> 2, m = (wid >> 1) & 1, rb = wid & 1, NS = NT >> 1;
  LAS char* Vw = lds + kp * 16384; LAS char* Kw = lds + 32768 + kp * 16384;
  LAS float* ws = (LAS float*)(lds + 131072 + 4096) + wid * 64; LAS float* li_l = ws; LAS float* al_l = ws + 32;
  float m_reg = -1e30f, l_reg = 0; f32x16 o[4] = {}; bf16x8 qr[4];
  { const bf16* Qw = P + (size_t)(qrow0 + rb * 32 + r32) * NP + PC_DQ + h * 128 + m * 64 + hi * 8;
#pragma unroll
    for (int d0 = 0; d0 < 4; ++d0) qr[d0] = *reinterpret_cast<const bf16x8*>(Qw + d0 * 16); }
  const int sr = tid >> 4, sc = (tid & 15) * 8, vst0 = v_st(sr, sc), vst1 = v_st(32 + sr, sc);
  const int vb0 = (int)(uintptr_t)Vw + v_rd_base(lane);
  const bf16* Kcol = P + PC_DK + h * 128 + sc; const bf16* Vcol = P + PC_DV + h * 128 + sc;
  bf16x8 vsa0, vsa1, ksa0, ksa1, vsb0, vsb1, ksb0, ksb1;
#define DA_KROW(t) ((size_t)(((t) + t0) < 128 ? b * SEQ + 64 * ((t) + t0) : MLAT + b * CTXL + 64 * ((t) + t0 - 128)))
#define DA_SLOAD(j) do { const size_t ka_ = DA_KROW(2 * (j)), kb_ = DA_KROW(2 * (j) + 1); \
    vsa0 = *reinterpret_cast<const bf16x8*>(Vcol + (ka_ + sr) * NP); vsa1 = *reinterpret_cast<const bf16x8*>(Vcol + (ka_ + 32 + sr) * NP); ksa0 = *reinterpret_cast<const bf16x8*>(Kcol + (ka_ + sr) * NP); ksa1 = *reinterpret_cast<const bf16x8*>(Kcol + (ka_ + 32 + sr) * NP); \
    vsb0 = *reinterpret_cast<const bf16x8*>(Vcol + (kb_ + sr) * NP); vsb1 = *reinterpret_cast<const bf16x8*>(Vcol + (kb_ + 32 + sr) * NP); ksb0 = *reinterpret_cast<const bf16x8*>(Kcol + (kb_ + sr) * NP); ksb1 = *reinterpret_cast<const bf16x8*>(Kcol + (kb_ + 32 + sr) * NP); } while (0)
#define DA_SWRITE(bb) do { LAS char* B_ = lds + (bb) * 65536; const int kc = sc * 2; \
    *(LAS bf16x8*)(B_ + vst0) = vsa0; *(LAS bf16x8*)(B_ + vst1) = vsa1; *(LAS bf16x8*)(B_ + 16384 + vst0) = vsb0; *(LAS bf16x8*)(B_ + 16384 + vst1) = vsb1; \
    *(LAS bf16x8*)(B_ + 32768 + DA_KSWZ(sr, kc)) = ksa0; *(LAS bf16x8*)(B_ + 32768 + DA_KSWZ(32 + sr, kc)) = ksa1; *(LAS bf16x8*)(B_ + 49152 + DA_KSWZ(sr, kc)) = ksb0; *(LAS bf16x8*)(B_ + 49152 + DA_KSWZ(32 + sr, kc)) = ksb1; } while (0)
#define DA_RESC(a) do { if (__any((a) < 1.f)) { if (hi == 0) al_l[r32] = (a); asm volatile("s_waitcnt lgkmcnt(0)" ::: "memory"); \
    _Pragma("unroll") for (int d = 0; d < 4; ++d) _Pragma("unroll") for (int r = 0; r < 16; ++r) o[d][r] *= al_l[crow(r, hi)]; } } while (0)
  f32x16 pA0, pA1, pB0, pB1; float mnA, mnB, alA, alB; bf16x8 pa0, pa1, pa2, pa3;
  DA_SLOAD(0); asm volatile("s_waitcnt vmcnt(0)" ::: "memory"); DA_SWRITE(0); __syncthreads();
  qkt(pA0, pA1, Kw, qr, r32, hi, m); partialSM(pA0, pA1, m_reg, mnA, alA);
  DA_SLOAD(1);
  asm volatile("s_waitcnt vmcnt(0)" ::: "memory"); DA_SWRITE(1); __syncthreads();
  for (int j = 1; j + 1 < NS; j += 2) {
    DA_SBAR(); qkt(pB0, pB1, Kw + 65536, qr, r32, hi, m);
    finishSM(pA0, pA1, alA, l_reg, pa0, pa1, pa2, pa3); DA_SBAR();
    DA_SLOAD(j + 1); DA_SBAR();
    pv_d0(o, vb0, pa0, pa1, pa2, pa3); partialSM(pB0, pB1, m_reg, mnB, alB);
    __syncthreads(); asm volatile("s_waitcnt vmcnt(0)" ::: "memory"); DA_SWRITE(0);
    DA_RESC(alB); __syncthreads();
    DA_SBAR(); qkt(pA0, pA1, Kw, qr, r32, hi, m);
    finishSM(pB0, pB1, alB, l_reg, pa0, pa1, pa2, pa3); DA_SBAR();
    DA_SLOAD(j + 2); DA_SBAR();
    pv_d0(o, vb0 + 65536, pa0, pa1, pa2, pa3); partialSM(pA0, pA1, m_reg, mnA, alA);
    __syncthreads(); asm volatile("s_waitcnt vmcnt(0)" ::: "memory"); DA_SWRITE(1);
    DA_RESC(alA); __syncthreads();
  }
  DA_SBAR(); qkt(pB0, pB1, Kw + 65536, qr, r32, hi, m);
  finishSM(pA0, pA1, alA, l_reg, pa0, pa1, pa2, pa3); DA_SBAR();
  pv_d0(o, vb0, pa0, pa1, pa2, pa3); partialSM(pB0, pB1, m_reg, mnB, alB);
  __syncthreads(); DA_RESC(alB);
  finishSM(pB0, pB1, alB, l_reg, pa0, pa1, pa2, pa3); DA_SBAR();
  pv_d0(o, vb0 + 65536, pa0, pa1, pa2, pa3);
  __syncthreads();
  LAS float* XP = (LAS float*)lds + (wid & 3) * 4096;
  LAS float* MLP = (LAS float*)(lds + 65536) + (wid & 3) * 64;
  if (kp == 1) {
#pragma unroll
    for (int d0 = 0; d0 < 4; ++d0)
#pragma unroll
      for (int r = 0; r < 16; ++r) XP[(d0 * 16 + r) * 64 + lane] = o[d0][r];
    if (hi == 0) { MLP[2 * r32] = m_reg; MLP[2 * r32 + 1] = l_reg; } }
  __syncthreads();
  float rli[16];
  if (kp == 0) {
    constexpr float C = SCALE * 1.4426950408889634f;
    const float m1 = MLP[2 * r32], l1 = MLP[2 * r32 + 1], ms = fmaxf(m_reg, m1), a0 = __builtin_amdgcn_exp2f((m_reg - ms) * C), a1 = __builtin_amdgcn_exp2f((m1 - ms) * C);
    l_reg = l_reg * a0 + l1 * a1;
    if (hi == 0) { al_l[r32] = a0; li_l[r32] = a1; } asm volatile("s_waitcnt lgkmcnt(0)" ::: "memory");
#pragma unroll
    for (int r = 0; r < 16; ++r) { const float f0 = al_l[crow(r, hi)], f1 = li_l[crow(r, hi)];
#pragma unroll
      for (int d0 = 0; d0 < 4; ++d0) o[d0][r] = o[d0][r] * f0 + XP[(d0 * 16 + r) * 64 + lane] * f1; }
    asm volatile("s_waitcnt lgkmcnt(0)" ::: "memory");
    if (hi == 0) li_l[r32] = l_reg; asm volatile("s_waitcnt lgkmcnt(0)" ::: "memory");
#pragma unroll
    for (int r = 0; r < 16; ++r) rli[r] = __builtin_amdgcn_rcpf(li_l[crow(r, hi)]); }
  __syncthreads();
  LAS float* X = (LAS float*)lds;
  if (kp == 0 && m == 1) {
#pragma unroll
    for (int r = 0; r < 16; ++r) { const int row = rb * 32 + crow(r, hi);
#pragma unroll
      for (int d0 = 0; d0 < 4; ++d0) X[row * 132 + d0 * 32 + r32] = o[d0][r] * rli[r]; } }
  __syncthreads();
  if (kp == 0 && m == 0) {
#pragma unroll
    for (int r = 0; r < 16; ++r) { const int row = rb * 32 + crow(r, hi);
#pragma unroll
      for (int d0 = 0; d0 < 4; ++d0) { LAS float* p = X + row * 132 + d0 * 32 + r32; *p = o[d0][r] * rli[r] - lam * *p; } }
    asm volatile("s_waitcnt lgkmcnt(0)" ::: "memory");
    const int row = rb * 32 + (lane >> 1), hf = lane & 1; const LAS float* xr = X + row * 132 + hf * 64;
    f32x4 v[16]; float ss = 0.f;
#pragma unroll
    for (int i = 0; i < 16; ++i) { v[i] = *(const LAS f32x4*)(xr + 4 * i); ss += (v[i].x * v[i].x + v[i].y * v[i].y) + (v[i].z * v[i].z + v[i].w * v[i].w); }
    ss += xorl<1>(ss);
    const float rs = (1.f / sqrtf(ss * (1.f / 128.f) + RMS_EPS)) * omli;
    bf16* op = YB + (size_t)(qrow0 + row) * 512 + h * 128 + hf * 64; const float* wp = nw + hf * 64;
#pragma unroll
    for (int i = 0; i < 8; ++i) { const f32x4 w0 = *(const f32x4*)(wp + 8 * i), w1 = *(const f32x4*)(wp + 8 * i + 4); const f32x4 a0 = v[2 * i] * rs * w0, a1 = v[2 * i + 1] * rs * w1;
      u32x4 w; w.x = cvtpk(a0.x, a0.y); w.y = cvtpk(a0.z, a0.w); w.z = cvtpk(a1.x, a1.y); w.w = cvtpk(a1.z, a1.w); *(u32x4*)(op + 8 * i) = w; }
  }
  __syncthreads();
#undef DA_KROW
#undef DA_SLOAD
#undef DA_SWRITE
#undef DA_RESC
}
#undef DA_KSWZ
#undef DA_SBAR
}

PHASE_FN void ph_diff_mfma(Ctx cx, int l_) {
    Frame F = mkframe(cx); const ArgsP a = F.ap; const int l = rfl(l_);
    REFRESH(F);
    const bf16* P = (const bf16*)(F.ws + WS_P); bf16* YB = (bf16*)(F.ws + WS_YB);
    const float lam = ((const float*)(F.ws + WS_LAM))[l], omli = 1.f - (0.8f - 0.6f * expf(-0.3f * (float)l));
    const float* nw = AIN(I_DNW) + l * 128;
    for (int it = F.bid; it < 512 + 16; it += F.G) {
        int b, h, q0, t0, NT;
        if (it < 512) { b = it >> 8; h = (it >> 6) & 3; q0 = b * SEQ + (it & 63) * 128; t0 = 0; NT = 132; }
        else { const int j = it - 512; b = j >> 3; h = (j >> 1) & 3; q0 = MLAT + b * CTXL + (j & 1) * 128; t0 = 128; NT = 4; }
        dattn::unit(P, YB, nw, lam, omli, b, h, q0, t0, NT, (LAS char*)F.lds, F.wave, F.lane);
    }
}
namespace gdn {
using f32x16 = __attribute__((ext_vector_type(16))) float;
constexpr int REC_BYTES = 57344, U_BYTES = 16384, OFF_NEGW = 0, OFF_QG = 16384, OFF_KT = 32768, OFF_QK = 49152, NSTEP = 132;
constexpr int QS = 0, KS = 17408, VS = 34816, L0 = 52224, A0 = 84992, AP = 68, ASZ = 64 * AP * 4, SC = A0 + 2 * ASZ;
constexpr int XWP = 132, XWSZ = 64 * XWP * 2;
__device__ __forceinline__ unsigned pk(float lo, float hi) { return pg8::cvt_pk_bf16(lo, hi); }
__device__ __forceinline__ float ldbf(const LAS unsigned short* p) { return __uint_as_float(((unsigned)*p) << 16); }

__device__ __forceinline__ void prep_item(const Frame& F, const ArgsP a, int l, int item) {
    const int b = item / (NSTEP * 4), rem = item % (NSTEP * 4), cn = rem >> 2, h = rem & 3;
    const bool isctx = cn < 4; const int row0 = isctx ? MLAT + b * CTXL + 64 * cn : b * SEQ + 64 * (cn - 4), t0 = isctx ? 64 * cn : 64 * (cn - 4), L = isctx ? CTXL : SEQ;
    const bf16* P = (const bf16*)(F.ws + WS_P); const float* DEC = (const float*)(F.ws + WS_DEC);
    LAS unsigned char* lds = F.lds; const int lane = F.lane, wave = F.wave, tid = F.tid;
    LAS unsigned short* Qs = (LAS unsigned short*)(lds + QS); LAS unsigned short* Ks = (LAS unsigned short*)(lds + KS); LAS unsigned short* Vs = (LAS unsigned short*)(lds + VS);
    LAS float* GC = (LAS float*)(lds + SC); LAS float* BE = GC + 128; LAS float* EG = GC + 256; LAS float* ET = GC + 384;
    { const float* cw = AIN(I_CONVW) + (size_t)l * 3 * 1536;
      unsigned xr[3][10];
#pragma unroll
      for (int wh = 0; wh < 3; ++wh) { const int c = wh * 512 + h * 128 + 2 * lane;
#pragma unroll
        for (int q = 0; q < 10; ++q) { const int i = wave * 8 + q - 1, t = t0 + i; xr[wh][q] = (t >= 0 && t < L) ? __builtin_nontemporal_load((const unsigned*)(P + (size_t)(row0 + i) * NP + c)) : 0u; } }
#pragma unroll
      for (int wh = 0; wh < 3; ++wh) { const int c = wh * 512 + h * 128 + 2 * lane;
        const f32x2 w0 = *(const f32x2*)(cw + c), w1 = *(const f32x2*)(cw + 1536 + c), w2 = *(const f32x2*)(cw + 3072 + c);
#pragma unroll
        for (int ii = 0; ii < 8; ++ii) { const int i = wave * 8 + ii;
            float y0 = bflo(xr[wh][ii]) * w0.x + bflo(xr[wh][ii + 1]) * w1.x + bflo(xr[wh][ii + 2]) * w2.x, y1 = bfhi(xr[wh][ii]) * w0.y + bfhi(xr[wh][ii + 1]) * w1.y + bfhi(xr[wh][ii + 2]) * w2.y;
            y0 = siluf(y0); y1 = siluf(y1);
            if (wh < 2) { const float ss = wave_sum(y0 * y0 + y1 * y1), sc = (1.f / sqrtf(ss + RMS_EPS)) * (wh == 0 ? 0.08838834764831845f : 1.f); y0 *= sc; y1 *= sc; }
            LAS unsigned short* dst = (wh == 0 ? Qs : wh == 1 ? Ks : Vs) + i * 136 + 2 * lane; *(LAS unsigned*)dst = pk(y0, y1); } } }
    if (wave < 2) { const int d = wave, t = d ? 63 - lane : lane; const size_t row = (size_t)(row0 + t);
        const float al = expf(AIN(I_ALOG)[(l * 2 + d) * 4 + h]), av = DEC[row * 16 + 8 * d + h] + AIN(I_DTB)[(l * 2 + d) * 4 + h], bb = DEC[row * 16 + 8 * d + 4 + h];
        const float ye = __expf(fminf(av, 20.f)), sp = av > 20.f ? av : (ye < 1e-2f ? ye * (1.f - ye * (0.5f - ye * 0.33333334f)) : __logf(1.f + ye)); float gc = -al * sp;
#pragma unroll
        for (int o = 1; o < 64; o <<= 1) { const float v = __shfl_up(gc, o); if (lane >= o) gc += v; }
        const float gl = __shfl(gc, 63);
        GC[d * 64 + lane] = gc; BE[d * 64 + lane] = sigmf(bb); EG[d * 64 + lane] = expf(gc); ET[d * 64 + lane] = expf(gl - gc);
        if (lane == 63) { const int step = d ? (cn < 4 ? 3 - cn : 135 - cn) : cn; ((float*)(F.ws + WS_GL))[((b * 4 + h) * 2 + d) * NSTEP + step] = expf(gl); } }
    __syncthreads();
    { const int mat = wave >> 2, mi = wave & 3, fr = lane & 15, fq = lane >> 4; const LAS unsigned short* As = mat ? Qs : Ks;
#pragma unroll 1
      for (int nj = 0; nj < 4; ++nj) { f32x4 acc = {0.f, 0.f, 0.f, 0.f};
#pragma unroll
        for (int ks = 0; ks < 4; ++ks) { const bf16x8 af = *(const LAS bf16x8*)(As + (16 * mi + fr) * 136 + 32 * ks + 8 * fq), bfr = *(const LAS bf16x8*)(Ks + (16 * nj + fr) * 136 + 32 * ks + 8 * fq);
            acc = __builtin_amdgcn_mfma_f32_16x16x32_bf16(af, bfr, acc, 0, 0, 0); }
#pragma unroll
        for (int r = 0; r < 4; ++r) { const int ti = 16 * mi + 4 * fq + r, tj = 16 * nj + fr;
#pragma unroll
            for (int d = 0; d < 2; ++d) { const int i = d ? 63 - ti : ti, j = d ? 63 - tj : tj; const bool keep = mat ? (i >= j) : (i > j);
                float v = 0.f; if (keep) { v = acc[r] * __expf(fminf(GC[d * 64 + i] - GC[d * 64 + j], 0.f)); if (!mat) v *= BE[d * 64 + i]; }
                if (mat) ((LAS float*)(lds + A0 + d * ASZ))[i * AP + j] = v; else ((LAS float*)(lds + L0 + d * 16384))[i * 64 + j] = v; } } } }
    __syncthreads();
    const int d = __builtin_amdgcn_readfirstlane(tid >> 8), c = tid & 255, cc = c & 127; const bool isw = __builtin_amdgcn_readfirstlane(c >> 7) != 0;
    float x[64];
    { const LAS float* Ld = (const LAS float*)(lds + L0 + d * 16384); const LAS unsigned short* src = (isw ? Ks : Vs) + cc;
#pragma unroll
      for (int i = 0; i < 64; ++i) x[i] = 0.f;
#pragma unroll
      for (int i = 0; i < 64; ++i) { const int t = d ? 63 - i : i; float acc = ldbf(src + t * 136) * BE[d * 64 + i] * (isw ? EG[d * 64 + i] : 1.f);
#pragma unroll
          for (int j4 = 0; j4 < (i + 3) / 4; ++j4) { const f32x4 lv = *(const LAS f32x4*)(Ld + i * 64 + 4 * j4);
              acc -= lv.x * x[4 * j4]; if (4 * j4 + 1 < i) acc -= lv.y * x[4 * j4 + 1]; if (4 * j4 + 2 < i) acc -= lv.z * x[4 * j4 + 2]; if (4 * j4 + 3 < i) acc -= lv.w * x[4 * j4 + 3]; }
          asm volatile("" : "+v"(acc) :: "memory"); x[i] = acc; } }
    const int step = d ? (cn < 4 ? 3 - cn : 135 - cn) : cn; const size_t ridx = (size_t)((b * 4 + h) * 2 + d) * NSTEP + step;
    unsigned char* rec = (unsigned char*)(F.ws + WS_REC + ridx * REC_BYTES);
    if (!isw) {
        unsigned char* ub = (unsigned char*)(F.ws + WS_U + ridx * U_BYTES); const int nt = cc >> 5, col = cc & 31;
#pragma unroll
        for (int mt = 0; mt < 2; ++mt)
#pragma unroll
            for (int hi = 0; hi < 2; ++hi) { u32x4 w0, w1; const int ib = 32 * mt + 4 * hi;
                w0.x = pk(x[ib + 0], x[ib + 1]); w0.y = pk(x[ib + 2], x[ib + 3]); w0.z = pk(x[ib + 8], x[ib + 9]); w0.w = pk(x[ib + 10], x[ib + 11]);
                w1.x = pk(x[ib + 16], x[ib + 17]); w1.y = pk(x[ib + 18], x[ib + 19]); w1.z = pk(x[ib + 24], x[ib + 25]); w1.w = pk(x[ib + 26], x[ib + 27]);
                u32x4* dst = (u32x4*)(ub + (size_t)(((mt * 4 + nt) * 64 + hi * 32 + col) * 32)); dst[0] = w0; dst[1] = w1; } }
    __syncthreads();
    LAS unsigned short* Xw = (LAS unsigned short*)(lds + VS + d * XWSZ);
    if (isw) {
#pragma unroll
        for (int i = 0; i < 64; ++i) Xw[i * XWP + cc] = (unsigned short)(pk(-x[i], 0.f) & 0xffffu); }
    __syncthreads();
    { const int u2 = tid & 255; const LAS float* Ad = (const LAS float*)(lds + A0 + d * ASZ);
#pragma unroll
      for (int q = 0; q < 4; ++q) { const int s = u2 + 256 * q, f = s >> 6, ln = s & 63, r32 = ln & 31, hi = ln >> 5;
          { const int mt = f >> 3, ks = f & 7, i = 32 * mt + r32, t = d ? 63 - i : i, k0 = 16 * ks + 4 * hi;
            const u32x2 wa = *(const LAS u32x2*)(Xw + i * XWP + k0), wb = *(const LAS u32x2*)(Xw + i * XWP + k0 + 8);
            *(u32x4*)(rec + OFF_NEGW + s * 16) = (u32x4){wa.x, wa.y, wb.x, wb.y};
            const float eg = EG[d * 64 + i]; const u32x2 qa = *(const LAS u32x2*)(Qs + t * 136 + k0), qb = *(const LAS u32x2*)(Qs + t * 136 + k0 + 8);
            *(u32x4*)(rec + OFF_QG + s * 16) = (u32x4){pk(bflo(qa.x) * eg, bfhi(qa.x) * eg), pk(bflo(qa.y) * eg, bfhi(qa.y) * eg), pk(bflo(qb.x) * eg, bfhi(qb.x) * eg), pk(bflo(qb.y) * eg, bfhi(qb.y) * eg)}; }
          { const int mtS = f >> 2, ks = f & 3, dk = 32 * mtS + r32; float kv[8];
#pragma unroll
            for (int j = 0; j < 8; ++j) { const int i = 16 * ks + 8 * (j >> 2) + 4 * hi + (j & 3), t = d ? 63 - i : i; kv[j] = ldbf(Ks + t * 136 + dk) * ET[d * 64 + i]; }
            *(u32x4*)(rec + OFF_KT + s * 16) = (u32x4){pk(kv[0], kv[1]), pk(kv[2], kv[3]), pk(kv[4], kv[5]), pk(kv[6], kv[7])}; } }
#pragma unroll
      for (int q = 0; q < 2; ++q) { const int s = u2 + 256 * q, f = s >> 6, ln = s & 63, r32 = ln & 31, hi = ln >> 5, mt = f >> 2, ks = f & 3, i = 32 * mt + r32, j0 = 16 * ks + 4 * hi;
          const f32x4 va = *(const LAS f32x4*)(Ad + i * AP + j0), vb = *(const LAS f32x4*)(Ad + i * AP + j0 + 8);
          *(u32x4*)(rec + OFF_QK + s * 16) = (u32x4){pk(va.x, va.y), pk(va.z, va.w), pk(vb.x, vb.y), pk(vb.z, vb.w)}; } }
    __syncthreads();
}

__device__ __forceinline__ bf16x8 pack8(const f32x16& v, int s) {
    u32x4 p; p.x = pk(v[8 * s], v[8 * s + 1]); p.y = pk(v[8 * s + 2], v[8 * s + 3]); p.z = pk(v[8 * s + 4], v[8 * s + 5]); p.w = pk(v[8 * s + 6], v[8 * s + 7]); return __builtin_bit_cast(bf16x8, p); }
#define GDN_MFMA(a, b, c) __builtin_amdgcn_mfma_f32_32x32x16_bf16((a), (b), (c), 0, 0, 0)
#define GDN_FRAG(buf, off, f) (*(const LAS bf16x8*)((buf) + (off) + (f) * 1024 + lane * 16))
__device__ __forceinline__ void chain(const Frame& F, int b, int h, int d) {
    const int lane = F.lane, wave = F.wave, r32 = lane & 31, hi = lane >> 5, nt = wave & 3; const bool comp = wave < 4;
    LAS unsigned char* lds = F.lds;
    const size_t rbase = (size_t)((b * 4 + h) * 2 + d) * NSTEP;
    const unsigned char* recs = (const unsigned char*)(F.ws + WS_REC + rbase * REC_BYTES); const unsigned char* us = (const unsigned char*)(F.ws + WS_U + rbase * U_BYTES); const float* gls = (const float*)(F.ws + WS_GL) + rbase;
    float* OGu = (float*)(F.ws + WS_OG) + (size_t)d * MT * 512 + h * 128 + nt * 32;
    const int olane = (d ? -2048 * hi : 2048 * hi) + r32;
    f32x16 S[4]; bf16x8 Sb[8];
#pragma unroll
    for (int i = 0; i < 4; ++i) S[i] = f32x16{};
#pragma unroll
    for (int i = 0; i < 8; ++i) Sb[i] = bf16x8{};
#define GDN_DMA(step, bufi) do { const unsigned char* src_ = recs + (size_t)(step) * REC_BYTES + lane * 16; LAS unsigned char* dst_ = lds + (bufi) * REC_BYTES; \
        _Pragma("unroll") for (int p_ = 0; p_ < 14; ++p_) __builtin_amdgcn_global_load_lds((const GAS unsigned*)(src_ + ((wave - 4) * 14 + p_) * 1024), (LAS unsigned*)(dst_ + ((wave - 4) * 14 + p_) * 1024), 16, 0, 2); } while (0)
#define GDN_ULOAD(step) do { _Pragma("unroll") for (int mt_ = 0; mt_ < 2; ++mt_) { const u32x4* up_ = (const u32x4*)(us + (size_t)(step) * U_BYTES + (size_t)(((mt_ * 4 + nt) * 64 + lane) * 32)); un[2 * mt_] = __builtin_nontemporal_load(up_); un[2 * mt_ + 1] = __builtin_nontemporal_load(up_ + 1); } } while (0)
    u32x4 un[4];
#pragma unroll
    for (int i = 0; i < 4; ++i) un[i] = (u32x4){0u, 0u, 0u, 0u};
    float egn = 0.f;
    if (comp) { GDN_ULOAD(0); egn = gls[0]; } else { GDN_DMA(0, 0); asm volatile("s_waitcnt vmcnt(0)" ::: "memory"); }
    __syncthreads();
#pragma unroll 1
    for (int step = 0; step < NSTEP; ++step) {
        const LAS unsigned char* buf = lds + (step & 1) * REC_BYTES;
        if (!comp) { if (step + 1 < NSTEP) GDN_DMA(step + 1, (step + 1) & 1); }
        else {
            const float egl = egn;
            f32x16 Vp[2];
#pragma unroll
            for (int mt = 0; mt < 2; ++mt) { const u32x4 w0 = un[2 * mt], w1 = un[2 * mt + 1];
                Vp[mt] = (f32x16){bflo(w0.x), bfhi(w0.x), bflo(w0.y), bfhi(w0.y), bflo(w0.z), bfhi(w0.z), bflo(w0.w), bfhi(w0.w), bflo(w1.x), bfhi(w1.x), bflo(w1.y), bfhi(w1.y), bflo(w1.z), bfhi(w1.z), bflo(w1.w), bfhi(w1.w)}; }
#pragma unroll
            for (int mtS = 0; mtS < 4; ++mtS)
#pragma unroll
                for (int r = 0; r < 16; ++r) S[mtS][r] *= egl;
            asm volatile("" : "+v"(Vp[0]), "+v"(Vp[1]), "+v"(S[0]), "+v"(S[1]), "+v"(S[2]), "+v"(S[3]) :: "memory");
            if (step + 1 < NSTEP) { GDN_ULOAD(step + 1); egn = gls[step + 1]; }
#pragma unroll
            for (int ks = 0; ks < 8; ++ks) {
#pragma unroll
                for (int mt = 0; mt < 2; ++mt) Vp[mt] = GDN_MFMA(GDN_FRAG(buf, OFF_NEGW, mt * 8 + ks), Sb[ks], Vp[mt]);
                if ((ks & 3) == 3) asm volatile("" ::: "memory"); }
            bf16x8 Vb[4];
            Vb[0] = pack8(Vp[0], 0); Vb[1] = pack8(Vp[0], 1); Vb[2] = pack8(Vp[1], 0); Vb[3] = pack8(Vp[1], 1);
            const int cn = d ? (step < 4 ? 3 - step : 135 - step) : step; const size_t orow0 = cn < 4 ? (size_t)(MLAT + b * CTXL + 64 * cn) : (size_t)(b * SEQ + 64 * (cn - 4));
#pragma unroll
            for (int mt = 0; mt < 2; ++mt) { f32x16 O = f32x16{};
#pragma unroll
                for (int ks = 0; ks < 8; ++ks) { O = GDN_MFMA(GDN_FRAG(buf, OFF_QG, mt * 8 + ks), Sb[ks], O); if ((ks & 3) == 3) asm volatile("" ::: "memory"); }
#pragma unroll
                for (int ks = 0; ks < 4; ++ks) O = GDN_MFMA(GDN_FRAG(buf, OFF_QK, mt * 4 + ks), Vb[ks], O);
#pragma unroll
                for (int r = 0; r < 16; ++r) { const int iu = 32 * mt + (r & 3) + 8 * (r >> 2), tu = d ? 63 - iu : iu; (OGu + (orow0 + tu) * 512)[olane] = O[r]; } }
#pragma unroll
            for (int mtS = 0; mtS < 4; ++mtS) {
#pragma unroll
                for (int ks = 0; ks < 4; ++ks) S[mtS] = GDN_MFMA(GDN_FRAG(buf, OFF_KT, mtS * 4 + ks), Vb[ks], S[mtS]);
                Sb[2 * mtS] = pack8(S[mtS], 0); Sb[2 * mtS + 1] = pack8(S[mtS], 1); asm volatile("" ::: "memory"); }
        }
        if (!comp) asm volatile("s_waitcnt vmcnt(0)" ::: "memory");
        asm volatile("s_waitcnt lgkmcnt(0)" ::: "memory"); __builtin_amdgcn_s_barrier(); asm volatile("" ::: "memory");
    }
    __syncthreads();
#undef GDN_DMA
#undef GDN_ULOAD
}
#undef GDN_MFMA
#undef GDN_FRAG
}

PHASE_FN void ph_gdn_prep(Ctx cx, int l_) {
    Frame F = mkframe(cx); const ArgsP a = F.ap; const int l = rfl(l_);
    REFRESH(F);
    for (int it = F.bid; it < BATCH * gdn::NSTEP * 4; it += F.G) { REFRESH(F); gdn::prep_item(F, a, l, it); }
}
PHASE_FN void ph_gdn_chain(Ctx cx, int l_) {
    Frame F = mkframe(cx); const int l = rfl(l_);
    REFRESH(F);
    for (int it = F.bid; it < 16; it += F.G) gdn::chain(F, it >> 3, (it >> 1) & 3, it & 1);
}
namespace na {
constexpr int VTL = SEQ + CTXL;
constexpr float C2 = 0.125f * 1.4426950408889634f, L2E = 1.4426950408889634f;
struct KV { bf16x8 k[4]; bf16x8 v[4]; };
__device__ __forceinline__ KV load_group(const bf16* kp0, const bf16* vt, int lane) {
    const int m = lane & 15, kq = lane >> 4; KV r;
    const bf16* ka = kp0 + (size_t)(8 * (m >> 2) + (m & 3)) * NP + 8 * kq;
    r.k[0] = *(const bf16x8*)ka; r.k[1] = *(const bf16x8*)(ka + 4 * NP); r.k[2] = *(const bf16x8*)(ka + 32); r.k[3] = *(const bf16x8*)(ka + 4 * NP + 32);
    const bf16* va = vt + (size_t)m * VTL + 8 * kq;
#pragma unroll
    for (int dt = 0; dt < 4; ++dt) r.v[dt] = *(const bf16x8*)(va + (size_t)(16 * dt) * VTL);
    return r;
}
constexpr int NA_LK = 4096, NA_LV = NA_LK + 256 * 144;
__device__ __forceinline__ KV load_group_lds(const LAS unsigned char* lds, int g, int lane) {
    const int m = lane & 15, kq = lane >> 4; KV r;
    const LAS unsigned char* ka = lds + NA_LK + (32 * g + 8 * (m >> 2) + (m & 3)) * 144 + 16 * kq;
    r.k[0] = *(const LAS bf16x8*)ka; r.k[1] = *(const LAS bf16x8*)(ka + 4 * 144); r.k[2] = *(const LAS bf16x8*)(ka + 64); r.k[3] = *(const LAS bf16x8*)(ka + 4 * 144 + 64);
    const LAS unsigned char* va = lds + NA_LV + m * 528 + (32 * g + 8 * kq) * 2;
#pragma unroll
    for (int dt = 0; dt < 4; ++dt) r.v[dt] = *(const LAS bf16x8*)(va + 16 * dt * 528);
    return r;
}
__device__ __forceinline__ void group(const KV& kv, const bf16x8 (&qf)[2], bool local, const LAS float* rprow, int cmin, int cq, int kc0, int lane, float& mrun, float& lrun, f32x4 (&o)[4]) {
    const int kq = lane >> 4;
    f32x4 sa = {0.f, 0.f, 0.f, 0.f}, sb = {0.f, 0.f, 0.f, 0.f};
    sa = __builtin_amdgcn_mfma_f32_16x16x32_bf16(kv.k[0], qf[0], sa, 0, 0, 0); sb = __builtin_amdgcn_mfma_f32_16x16x32_bf16(kv.k[1], qf[0], sb, 0, 0, 0);
    sa = __builtin_amdgcn_mfma_f32_16x16x32_bf16(kv.k[2], qf[1], sa, 0, 0, 0); sb = __builtin_amdgcn_mfma_f32_16x16x32_bf16(kv.k[3], qf[1], sb, 0, 0, 0);
    float t[8];
#pragma unroll
    for (int j = 0; j < 4; ++j) { t[j] = sa[j] * C2; t[4 + j] = sb[j] * C2; }
    if (local) {
#pragma unroll
        for (int j = 0; j < 8; ++j) { const int kc = kc0 + 8 * kq + j; const bool ok = (kc >= cmin) && (kc < cmin + 16); const int bi = min(max(kc - cq + 15, 0), 30);
            t[j] = ok ? t[j] + rprow[bi] * L2E : -1e30f; } }
    float gm = fmaxf(fmaxf(fmaxf(t[0], t[1]), fmaxf(t[2], t[3])), fmaxf(fmaxf(t[4], t[5]), fmaxf(t[6], t[7])));
    gm = fmaxf(gm, xorl<16>(gm)); gm = fmaxf(gm, xorl<32>(gm));
    const float mn = fmaxf(mrun, gm), corr = __builtin_amdgcn_exp2f(mrun - mn); mrun = mn;
    float ps = 0.f;
#pragma unroll
    for (int j = 0; j < 8; ++j) { t[j] = __builtin_amdgcn_exp2f(t[j] - mn); ps += t[j]; }
    ps += xorl<16>(ps); ps += xorl<32>(ps);
    lrun = lrun * corr + ps;
    u32x4 pw; pw.x = pg8::cvt_pk_bf16(t[0], t[1]); pw.y = pg8::cvt_pk_bf16(t[2], t[3]); pw.z = pg8::cvt_pk_bf16(t[4], t[5]); pw.w = pg8::cvt_pk_bf16(t[6], t[7]);
    const bf16x8 pf = __builtin_bit_cast(bf16x8, pw);
#pragma unroll
    for (int dt = 0; dt < 4; ++dt) { o[dt] = o[dt] * corr; o[dt] = __builtin_amdgcn_mfma_f32_16x16x32_bf16(kv.v[dt], pf, o[dt], 0, 0, 0); }
}
}

__device__ __forceinline__ void vt_item(const Frame& F, int it) {
    const bf16* P = (const bf16*)(F.ws + WS_P); bf16* VT = (bf16*)(F.ws + WS_VT);
    LAS unsigned char* tile = F.lds + F.wave * 9216; const int lane = F.lane;
    const int b = it / (8 * 132), rem = it % (8 * 132), h = rem / 132, tb = rem % 132;
    const size_t row0 = tb < 128 ? (size_t)(b * SEQ + 64 * tb) : (size_t)(MLAT + b * CTXL + 64 * (tb - 128));
    const bf16* src = P + (row0 + lane) * NP + PC_NV + h * 64;
#pragma unroll
    for (int c = 0; c < 8; ++c) *(LAS u32x4*)(tile + lane * 144 + 16 * c) = __builtin_nontemporal_load((const u32x4*)(src + 8 * c));
    LDS_WAIT(); asm volatile("" ::: "memory");
    bf16* dst = VT + ((size_t)((b * 8 + h) * 64 + lane)) * na::VTL + 64 * tb;
#pragma unroll
    for (int c = 0; c < 8; ++c) { unsigned w[4];
#pragma unroll
        for (int q = 0; q < 4; ++q) { const unsigned lo = *(const LAS unsigned short*)(tile + (8 * c + 2 * q) * 144 + 2 * lane), hi = *(const LAS unsigned short*)(tile + (8 * c + 2 * q + 1) * 144 + 2 * lane); w[q] = lo | (hi << 16); }
        *(u32x4*)(dst + 8 * c) = (u32x4){w[0], w[1], w[2], w[3]}; }
    LDS_WAIT(); asm volatile("" ::: "memory");
}
__device__ __forceinline__ void rope_row(const Frame& F, int row) {
    const int blk = F.lane >> 2, j8 = F.lane & 3; bf16* P = (bf16*)(F.ws + WS_P);
    const int t = row & (SEQ - 1); const float pos = (float)(j8 < 2 ? (t >> 6) : (t & 63));
    bf16* p = P + (size_t)row * NP + PC_DQ + blk * 64 + 8 * j8;
    const u32x4 w1 = *(const u32x4*)p, w2 = *(const u32x4*)(p + 32);
    float x1[8] = {bflo(w1.x), bfhi(w1.x), bflo(w1.y), bfhi(w1.y), bflo(w1.z), bfhi(w1.z), bflo(w1.w), bfhi(w1.w)};
    float x2[8] = {bflo(w2.x), bfhi(w2.x), bflo(w2.y), bfhi(w2.y), bflo(w2.z), bfhi(w2.z), bflo(w2.w), bfhi(w2.w)};
    float y1[8], y2[8];
#pragma unroll
    for (int i = 0; i < 8; ++i) { const float inv = exp2f(-(float)(8 * (j8 & 1) + i) * (13.287712379549449f / 16.f)) * 0.15915494309189535f;
        const float rev = pos * inv, fr = rev - floorf(rev), cs = __builtin_amdgcn_cosf(fr), sn = __builtin_amdgcn_sinf(fr);
        y1[i] = x1[i] * cs - x2[i] * sn; y2[i] = x2[i] * cs + x1[i] * sn; }
    *(u32x4*)p = (u32x4){pk2(y1[0], y1[1]), pk2(y1[2], y1[3]), pk2(y1[4], y1[5]), pk2(y1[6], y1[7])};
    *(u32x4*)(p + 32) = (u32x4){pk2(y2[0], y2[1]), pk2(y2[2], y2[3]), pk2(y2[4], y2[5]), pk2(y2[6], y2[7])};
}
__device__ __forceinline__ void rope_rows4(const Frame& F, int r0) {
    const int blk = F.lane >> 2, j8 = F.lane & 3; bf16* P = (bf16*)(F.ws + WS_P);
    u32x4 w1[4], w2[4];
#pragma unroll
    for (int q = 0; q < 4; ++q) { const bf16* p = P + (size_t)(r0 + q) * NP + PC_DQ + blk * 64 + 8 * j8; w1[q] = *(const u32x4*)p; w2[q] = *(const u32x4*)(p + 32); }
    asm volatile("" ::: "memory");
    float inv[8];
#pragma unroll
    for (int i = 0; i < 8; ++i) inv[i] = exp2f(-(float)(8 * (j8 & 1) + i) * (13.287712379549449f / 16.f)) * 0.15915494309189535f;
#pragma unroll
    for (int q = 0; q < 4; ++q) { const int row = r0 + q, t = row & (SEQ - 1); const float pos = (float)(j8 < 2 ? (t >> 6) : (t & 63));
        bf16* p = P + (size_t)row * NP + PC_DQ + blk * 64 + 8 * j8;
        const float x1[8] = {bflo(w1[q].x), bfhi(w1[q].x), bflo(w1[q].y), bfhi(w1[q].y), bflo(w1[q].z), bfhi(w1[q].z), bflo(w1[q].w), bfhi(w1[q].w)};
        const float x2[8] = {bflo(w2[q].x), bfhi(w2[q].x), bflo(w2[q].y), bfhi(w2[q].y), bflo(w2[q].z), bfhi(w2[q].z), bflo(w2[q].w), bfhi(w2[q].w)};
        float y1[8], y2[8];
#pragma unroll
        for (int i = 0; i < 8; ++i) { const float rev = pos * inv[i], fr = rev - floorf(rev), cs = __builtin_amdgcn_cosf(fr), sn = __builtin_amdgcn_sinf(fr);
            y1[i] = x1[i] * cs - x2[i] * sn; y2[i] = x2[i] * cs + x1[i] * sn; }
        *(u32x4*)p = (u32x4){pk2(y1[0], y1[1]), pk2(y1[2], y1[3]), pk2(y1[4], y1[5]), pk2(y1[6], y1[7])};
        *(u32x4*)(p + 32) = (u32x4){pk2(y2[0], y2[1]), pk2(y2[2], y2[3]), pk2(y2[4], y2[5]), pk2(y2[6], y2[7])}; }
}
PHASE_FN void ph_prepq(Ctx cx, int l_) {
    Frame F = mkframe(cx); const ArgsP a = F.ap; const int l = rfl(l_);
    volatile LAS int* qw = (volatile LAS int*)(F.lds + MISC_OFF + 64);
    constexpr int N_G = BATCH * gdn::NSTEP * 4, N_R = MLAT / 32, N_V = BATCH * 8 * 132 / 8, N_ALL = N_G + N_R + N_V;
    for (;;) {
        REFRESH(F);
        __syncthreads();
        if (F.tid == 0) *qw = (int)__hip_atomic_fetch_add(F.ctl + CW_Q + 64 * (8 + l), 1u, __ATOMIC_RELAXED, __HIP_MEMORY_SCOPE_AGENT);
        __syncthreads();
        const int idx = rfl(*qw);
        if (idx >= N_ALL) break;
        if (idx < N_G) gdn::prep_item(F, a, l, idx);
        else if (idx < N_G + N_R) rope_rows4(F, (idx - N_G) * 32 + F.wave * 4);
        else vt_item(F, (idx - N_G - N_R) * 8 + F.wave);
    }
}

constexpr int NA_NLAT = BATCH * 8 * 128 * 4, NA_NCTX = BATCH * 8 * 16, NA_ITEMS = NA_NLAT + NA_NCTX;
__device__ __forceinline__ void na_wave_item(const Frame& F, const LAS float* rp, int it) {
    const bf16* P = (const bf16*)(F.ws + WS_P); const bf16* VT = (const bf16*)(F.ws + WS_VT); bf16* YC = (bf16*)(F.ws + WS_YC);
    const int lane = F.lane, qi = lane & 15, kq = lane >> 4;
    const bool lat = it < NA_NLAT; int b, h, r = 0, n = 0, qrow;
    if (lat) { b = it >> 12; h = (it >> 9) & 7; r = (it >> 2) & 127; n = it & 3; qrow = b * SEQ + r * 64 + 16 * n + qi; }
    else { const int j = it - NA_NLAT; b = j >> 7; h = (j >> 4) & 7; qrow = MLAT + b * CTXL + 16 * (j & 15) + qi; }
    bf16x8 qf[2];
    { const bf16* qp = P + (size_t)qrow * NP + PC_NQ + h * 64 + 8 * kq; qf[0] = *(const bf16x8*)qp; qf[1] = *(const bf16x8*)(qp + 32); }
    f32x4 o[4];
#pragma unroll
    for (int dt = 0; dt < 4; ++dt) o[dt] = (f32x4){0.f, 0.f, 0.f, 0.f};
    float mrun = -1e30f, lrun = 0.f;
    const bf16* Kb = P + PC_NK + h * 64; const bf16* VTh = VT + (size_t)((b * 8 + h) * 64) * na::VTL;
    const int r0 = min(max(r - 4, 0), 120), kc0 = min(max(16 * n - 8, 0), 32), cq = 16 * n + qi, cmin = min(max(cq - 8, 0), 48);
#define NA_KP(g) ((g) < 8 ? Kb + (size_t)(b * SEQ + (r0 + (g)) * 64 + kc0) * NP : Kb + (size_t)(MLAT + b * CTXL + 32 * ((g) - 8)) * NP)
#define NA_VP(g) ((g) < 8 ? VTh + (r0 + (g)) * 64 + kc0 : VTh + SEQ + 32 * ((g) - 8))
    const LAS unsigned char* ldsb = (const LAS unsigned char*)F.lds;
    if (lat) {
        na::KV w0 = na::load_group(NA_KP(0), NA_VP(0), lane), w1 = na::load_group(NA_KP(1), NA_VP(1), lane), w2 = na::load_group(NA_KP(2), NA_VP(2), lane);
#pragma unroll
        for (int g = 0; g < 8; ++g) {
            na::KV nw = w2;
            if (g + 3 < 8) nw = na::load_group(NA_KP(g + 3), NA_VP(g + 3), lane);
            na::group(w0, qf, true, rp + (r0 + g - r + 7) * 31, cmin, cq, kc0, lane, mrun, lrun, o);
            w0 = w1; w1 = w2; w2 = nw;
            asm volatile("" ::: "memory");
        }
    }
#pragma unroll 2
    for (int g = 0; g < 8; ++g) { const na::KV w = na::load_group_lds(ldsb, g, lane); na::group(w, qf, false, rp, cmin, cq, kc0, lane, mrun, lrun, o); }
#undef NA_KP
#undef NA_VP
    const float il = 1.f / lrun; bf16* op = YC + (size_t)qrow * 512 + h * 64 + 4 * kq;
#pragma unroll
    for (int dt = 0; dt < 4; ++dt) { u32x2 w; w.x = pg8::cvt_pk_bf16(o[dt][0] * il, o[dt][1] * il); w.y = pg8::cvt_pk_bf16(o[dt][2] * il, o[dt][3] * il); *(u32x2*)(op + 16 * dt) = w; }
}
PHASE_FN void ph_mixers(Ctx cx, int l_) {
    Frame F = mkframe(cx); const ArgsP a = F.ap; const int l = rfl(l_);
    volatile LAS int* qw = (volatile LAS int*)(F.lds + MISC_OFF + 64);
#ifndef NA_REP
#define NA_REP 1
#endif
    constexpr int N_FULL = 480, N_HALF = 2 * (512 - N_FULL), N_CH = 16, N_DF = N_FULL + N_HALF + 16, N_NA = (NA_ITEMS + 7) / 8, N_CV = ITL_ALL / 64, N_WORK = N_CH + N_DF + NA_REP * N_NA;
    constexpr int CV_START = N_FULL;
    constexpr int N_CV0 = (ITL_ALL - ITL_PRE) / 64;
    const int ncv = (l < DEPTH - 1 ? N_CV : 0) + (l == 0 ? N_CV0 : 0), N_ALL = N_WORK + ncv;
    const int cvs = l == 0 ? 0 : CV_START, nwk = N_WORK - N_CH - cvs, pairs = ncv < nwk ? ncv : nwk;
    const float lam = ((const float*)(F.ws + WS_LAM))[l], omli = 1.f - (0.8f - 0.6f * expf(-0.3f * (float)l));
    int staged = -1;
#ifdef TCLS
    unsigned long long tc0_ = __builtin_amdgcn_s_memrealtime(), tcacc_ = 0; int tcls_ = -1;
#endif
    for (;;) {
        REFRESH(F);
        __syncthreads();
        if (F.tid == 0) *qw = (int)__hip_atomic_fetch_add(F.ctl + CW_Q + 64 * l, 1u, __ATOMIC_RELAXED, __HIP_MEMORY_SCOPE_AGENT);
        __syncthreads();
        int idx = rfl(*qw);
#ifdef TCLS
        { const unsigned long long tn_ = __builtin_amdgcn_s_memrealtime(); if (tcls_ == TCLS) tcacc_ += tn_ - tc0_; tc0_ = tn_; tcls_ = -1; }
#endif
        if (idx >= N_ALL) break;
        { const int p = idx - N_CH - cvs; if (p >= 0) { int ck = -1;
              if (p < 2 * pairs) { if (p & 1) ck = p >> 1; else idx = N_CH + cvs + (p >> 1); }
              else if (ncv > nwk) ck = p - pairs; else idx = N_CH + cvs + p - pairs;
              if (ck >= 0) { LAS float* scr = (LAS float*)(F.lds + F.wave * 16384);
#ifdef TCLS
                  tcls_ = 5;
#endif
                  const bool own = l == 0 && ck < N_CV0;
                  conv_run(F, a, own ? 0 : l + 1, (own ? ITL_PRE + ck * 64 : (ck - (l == 0 ? N_CV0 : 0)) * 64) + F.wave, 8, 8, scr); staged = -1;
                  continue; } } }
        if (idx < N_CH + N_DF) staged = -1;
#ifdef TCLS
        tcls_ = idx < N_CH ? 0 : idx < N_CH + N_FULL ? 1 : idx < N_CH + N_FULL + N_HALF ? 2 : idx < N_CH + N_DF ? 3 : 4;
#endif
#ifdef TCHAIN
        if (idx < N_CH) { const unsigned long long t0_ = __builtin_amdgcn_s_memrealtime(); gdn::chain(F, idx >> 3, (idx >> 1) & 3, idx & 1);
            if (idx == TCHAIN && F.tid == 0) *(unsigned long long*)(F.ctl + 30000) += __builtin_amdgcn_s_memrealtime() - t0_; }
#else
        if (idx < N_CH) gdn::chain(F, idx >> 3, (idx >> 1) & 3, idx & 1);
#endif
        else if (idx < N_CH + N_DF) { const int it = idx - N_CH;
            if (it < N_FULL) { const int b = it >> 8, h = (it >> 6) & 3, q0 = b * SEQ + (it & 63) * 128;
                dattn::unit3((const bf16*)(F.ws + WS_P), (bf16*)(F.ws + WS_YB), AIN(I_DNW) + l * 128, lam, omli, b, h, q0, 0, 132, (LAS char*)F.lds, F.wave, F.lane); }
            else if (it < N_FULL + N_HALF) { const int j = it - N_FULL, u = N_FULL + (j >> 1), b = u >> 8, h = (u >> 6) & 3, q0 = b * SEQ + (u & 63) * 128 + (j & 1) * 64;
                dattn::unit64((const bf16*)(F.ws + WS_P), (bf16*)(F.ws + WS_YB), AIN(I_DNW) + l * 128, lam, omli, b, h, q0, 0, 132, (LAS char*)F.lds, F.wave, F.lane); }
            else if (l < DEPTH - 1) { const int j = it - N_FULL - N_HALF, b = j >> 3, h = (j >> 1) & 3, q0 = MLAT + b * CTXL + (j & 1) * 128;
                dattn::unit((const bf16*)(F.ws + WS_P), (bf16*)(F.ws + WS_YB), AIN(I_DNW) + l * 128, lam, omli, b, h, q0, 128, 4, (LAS char*)F.lds, F.wave, F.lane); } }
        else { const int it0 = ((idx - N_CH - N_DF) % N_NA) * 8, it = it0 + F.wave; const int h = it0 < NA_NLAT ? (it0 >> 9) & 7 : ((it0 - NA_NLAT) >> 4) & 7;
            const int bq = it0 < NA_NLAT ? it0 >> 12 : (it0 - NA_NLAT) >> 7;
            LAS float* rpl = (LAS float*)F.lds;
            if (F.tid < 465) rpl[F.tid] = AIN(I_RPB)[((size_t)l * 8 + h) * 465 + F.tid];
            if (staged != bq * 8 + h) { staged = bq * 8 + h;
                const bf16* Pk = (const bf16*)(F.ws + WS_P) + (size_t)(MLAT + bq * CTXL) * NP + PC_NK + h * 64;
#pragma unroll
                for (int q = 0; q < 4; ++q) { const int e = F.tid + 512 * q, row = e >> 3, c = e & 7; *(LAS u32x4*)(F.lds + na::NA_LK + row * 144 + 16 * c) = *(const u32x4*)(Pk + (size_t)row * NP + 8 * c); }
                const bf16* Vt = (const bf16*)(F.ws + WS_VT) + (size_t)((bq * 8 + h) * 64) * na::VTL + SEQ;
#pragma unroll
                for (int q = 0; q < 4; ++q) { const int e = F.tid + 512 * q, d = e >> 5, c = e & 31; *(LAS u32x4*)(F.lds + na::NA_LV + d * 528 + 16 * c) = *(const u32x4*)(Vt + (size_t)d * na::VTL + 8 * c); } }
            __syncthreads();
            if (it < (l < DEPTH - 1 ? NA_ITEMS : NA_NLAT)) na_wave_item(F, rpl, it); }
    }
#ifdef TCLS
    if (F.tid == 0 && tcacc_) __hip_atomic_fetch_add((unsigned long long*)(F.ctl + 30000), tcacc_, __ATOMIC_RELAXED, __HIP_MEMORY_SCOPE_AGENT);
#endif
}
constexpr int TAB_OFF = LDSCTL_OFF;
PHASE_FN void ph_ln1_router(Ctx cx, int l_) {
    Frame F = mkframe(cx); const ArgsP a = F.ap; const int l = rfl(l_);
    REFRESH(F);
    volatile LAS int* tab = (volatile LAS int*)(F.lds + TAB_OFF);
    const bf16* Dm = (const bf16*)(F.ws + WS_T); bf16* X = (bf16*)(F.ws + WS_X);
    { const f32x4* src = (const f32x4*)((const float*)(F.ws + WS_WRT) + (size_t)l * 32 * 1024); LAS f32x4* dst = (LAS f32x4*)F.lds;
#ifdef TLN1
      const unsigned long long tl0_ = __builtin_amdgcn_s_memrealtime();
#endif
      __syncthreads(); for (int i = F.tid; i < 32 * 256; i += NTHREADS) dst[i] = src[i]; __syncthreads();
#ifdef TLN1
      if (TLN1 == 1 && F.bid == 0 && F.tid == 0) *(unsigned long long*)(F.ctl + 30000) += __builtin_amdgcn_s_memrealtime() - tl0_;
#endif
    }
#ifdef TLN1
    const unsigned long long tl1_ = __builtin_amdgcn_s_memrealtime();
#endif
    const LAS float* wrT = (const LAS float*)F.lds;
    const float* lng = AIN(I_LNG) + (size_t)(l * 2 + 0) * DM; const float* lnb = AIN(I_LNB) + (size_t)(l * 2 + 0) * DM;
    int* TOPE = (int*)(F.ws + WS_TOPE); int* TOPR = (int*)(F.ws + WS_TOPR); float* TOPG = (float*)(F.ws + WS_TOPG); int* BLKB = (int*)(F.ws + WS_BLKB);
    const int RGV = l == DEPTH - 1 ? 64 : RG_ROWS;
    { int* ROWTOK = (int*)(F.ws + WS_ROWTOK); for (int i = F.bid * NTHREADS + F.tid; i < RPAD; i += F.G * NTHREADS) ROWTOK[i] = 0; }
    for (int rg = F.bid; rg < NRG; rg += F.G) {
        if (F.tid < 32) tab[384 + F.tid] = 0;
        __syncthreads();
        f32x4 nv[4]; u32x2 nb[4], nd[4];
        { const int r0 = rg_row(rg, F.wave);
#pragma unroll
          for (int j = 0; j < 4; ++j) { nv[j] = (f32x4){0.f, 0.f, 0.f, 0.f}; nb[j] = (u32x2){0u, 0u};
              if (l == 0) nv[j] = *((const f32x4*)XROW0(r0) + F.lane + 64 * j); else nb[j] = __builtin_nontemporal_load((const u32x2*)(X + (size_t)r0 * DM + 4 * F.lane + 256 * j)); nd[j] = __builtin_nontemporal_load((const u32x2*)(Dm + (size_t)r0 * DM + 4 * F.lane + 256 * j)); } }
        const bf16* Dq = (const bf16*)(F.ws + WS_DQ);
        for (int i = F.wave; i < RGV; i += 2 * NWAVES) {
            const bool two = i + NWAVES < RGV;
            f32x4 v[4], u[4];
#pragma unroll
            for (int j = 0; j < 4; ++j) u[j] = (f32x4){0.f, 0.f, 0.f, 0.f};
#pragma unroll 1
            for (int rr = 0; rr < (two ? 2 : 1); ++rr) { const int row = rg_row(rg, i + rr * NWAVES);
                if (rr) {
#pragma unroll
                    for (int j = 0; j < 4; ++j) u[j] = v[j]; }
                const float* mrow = (const float*)(F.ws + WS_MOD) + ((size_t)l * 3 + mod_index(row)) * 6144;
                f32x4 ggv[4], lgv[4], lbv[4], shv[4], scv[4];
#pragma unroll
                for (int j = 0; j < 4; ++j) { const int c = 4 * F.lane + 256 * j; ggv[j] = *(const f32x4*)(mrow + 2048 + c); lgv[j] = *(const f32x4*)(lng + c); lbv[j] = *(const f32x4*)(lnb + c);
                    shv[j] = *(const f32x4*)(mrow + 3072 + c); scv[j] = *(const f32x4*)(mrow + 4096 + c); }
                asm volatile("" ::: "memory");
#pragma unroll
                for (int j = 0; j < 4; ++j) { const f32x4 gg = ggv[j]; const u32x2 w = nd[j];
                    f32x4 dd = (f32x4){bflo(w.x), bfhi(w.x), bflo(w.y), bfhi(w.y)};
                    if (row >= MLAT) { dd = (f32x4){0.f, 0.f, 0.f, 0.f};
#pragma unroll
                        for (int q = 0; q < 4; ++q) { const u32x2 pw = *(const u32x2*)(Dq + ((size_t)q * MCTX + (row - MLAT)) * DM + 4 * F.lane + 256 * j); dd += (f32x4){bflo(pw.x), bfhi(pw.x), bflo(pw.y), bfhi(pw.y)}; } }
                    const f32x4 xv = l == 0 ? nv[j] : (f32x4){bflo(nb[j].x), bfhi(nb[j].x), bflo(nb[j].y), bfhi(nb[j].y)};
                    v[j] = xv * DN_ALPHA + gg * dd; }
                if (i + (rr + 1) * NWAVES < RGV) { const int nr = rg_row(rg, i + (rr + 1) * NWAVES);
#pragma unroll
                    for (int j = 0; j < 4; ++j) { if (l == 0) nv[j] = *((const f32x4*)XROW0(nr) + F.lane + 64 * j); else nb[j] = __builtin_nontemporal_load((const u32x2*)(X + (size_t)nr * DM + 4 * F.lane + 256 * j)); nd[j] = __builtin_nontemporal_load((const u32x2*)(Dm + (size_t)nr * DM + 4 * F.lane + 256 * j)); } }
                ln_inplace(v);
#pragma unroll
                for (int j = 0; j < 4; ++j) { const int c = 4 * F.lane + 256 * j; v[j] = v[j] * lgv[j] + lbv[j]; *(u32x2*)(X + (size_t)row * DM + c) = (u32x2){pk2(v[j].x, v[j].y), pk2(v[j].z, v[j].w)}; }
                ln_inplace(v);
                { bf16* hx = (bf16*)(F.ws + WS_HX) + (size_t)row * DM;
#pragma unroll
                  for (int j = 0; j < 4; ++j) { const int c = 4 * F.lane + 256 * j; v[j] = v[j] * (scv[j] + 1.f) + shv[j]; *(u32x2*)(hx + c) = (u32x2){pk2(v[j].x, v[j].y), pk2(v[j].z, v[j].w)}; } }

            }
            if (two) {
#pragma unroll
                for (int j = 0; j < 4; ++j) { const f32x4 t = v[j]; v[j] = u[j]; u[j] = t; } }
            float p[32], q[32];
#pragma unroll
            for (int e = 0; e < 32; ++e) { f32x2 s = {0.f, 0.f}, t = {0.f, 0.f};
#pragma unroll
                for (int j = 0; j < 4; ++j) { const f32x4 w = *(const LAS f32x4*)(wrT + e * 1024 + 4 * F.lane + 256 * j); const f32x2 wl = {w.x, w.y}, wh = {w.z, w.w};
                    s += (f32x2){v[j].x, v[j].y} * wl; s += (f32x2){v[j].z, v[j].w} * wh; t += (f32x2){u[j].x, u[j].y} * wl; t += (f32x2){u[j].z, u[j].w} * wh; }
                p[e] = s.x + s.y; q[e] = t.x + t.y; if ((e & 7) == 7) asm volatile("" ::: "memory"); }
#define LN1_BFLY(p) do { \
            _Pragma("unroll") for (int i2 = 0; i2 < 16; ++i2) { const bool up = (F.lane & 32) != 0; const float send = up ? p[i2] : p[i2 + 16], keep = up ? p[i2 + 16] : p[i2]; p[i2] = keep + xorl<32>(send); } \
            _Pragma("unroll") for (int i2 = 0; i2 < 8; ++i2) { const bool up = (F.lane & 16) != 0; const float send = up ? p[i2] : p[i2 + 8], keep = up ? p[i2 + 8] : p[i2]; p[i2] = keep + xorl<16>(send); } \
            _Pragma("unroll") for (int i2 = 0; i2 < 4; ++i2) { const bool up = (F.lane & 8) != 0; const float send = up ? p[i2] : p[i2 + 4], keep = up ? p[i2 + 4] : p[i2]; p[i2] = keep + xorl<8>(send); } \
            _Pragma("unroll") for (int i2 = 0; i2 < 2; ++i2) { const bool up = (F.lane & 4) != 0; const float send = up ? p[i2] : p[i2 + 2], keep = up ? p[i2 + 2] : p[i2]; p[i2] = keep + xorl<4>(send); } \
            { const bool up = (F.lane & 2) != 0; const float send = up ? p[0] : p[1], keep = up ? p[1] : p[0]; p[0] = keep + xorl<2>(send); } \
            p[0] += xorl<1>(p[0]); } while (0)
            LN1_BFLY(p); LN1_BFLY(q);
#undef LN1_BFLY
#pragma unroll 1
            for (int rr = 0; rr < (two ? 2 : 1); ++rr) { const int row = rg_row(rg, i + rr * NWAVES);
            const int me = F.lane >> 1; float lg = (rr ? q[0] : p[0]) + AIN(I_BR)[l * 32 + me];
                int rank = 0;
#pragma unroll
                for (int e = 0; e < 32; ++e) { const float sv = __builtin_bit_cast(float, __builtin_amdgcn_readlane(__builtin_bit_cast(int, lg), 2 * e)); rank += (sv > lg || (sv == lg && e < me)) ? 1 : 0; }
                int te[4]; float tv[4];
#pragma unroll
                for (int k = 0; k < 4; ++k) { const unsigned long long mk = __ballot(rank == k); const int ln = (int)__builtin_ctzll(mk); te[k] = ln >> 1; tv[k] = __builtin_bit_cast(float, __builtin_amdgcn_readlane(__builtin_bit_cast(int, lg), ln)); }
                const float e1 = __expf(tv[1] - tv[0]), e2 = __expf(tv[2] - tv[0]), e3 = __expf(tv[3] - tv[0]), isum = 1.f / (1.f + e1 + e2 + e3);
                if (F.lane < 4) { const int k = F.lane; const int e = k == 0 ? te[0] : k == 1 ? te[1] : k == 2 ? te[2] : te[3]; const float g = (k == 0 ? 1.f : k == 1 ? e1 : k == 2 ? e2 : e3) * isum;
                    const int lr = __hip_atomic_fetch_add((LAS int*)&tab[384 + e], 1, __ATOMIC_RELAXED, __HIP_MEMORY_SCOPE_WORKGROUP);
                    TOPE[row * 4 + k] = e; TOPR[row * 4 + k] = lr; TOPG[row * 4 + k] = g; }
            }
        }
        __syncthreads();
        if (F.tid < 32) { const int n = tab[384 + F.tid]; const unsigned base = __hip_atomic_fetch_add(F.ctl + CW_CNT + l * 32 + F.tid, (unsigned)n, __ATOMIC_RELAXED, __HIP_MEMORY_SCOPE_AGENT); BLKB[rg * 32 + F.tid] = (int)base; }
        __syncthreads();
    }
#ifdef TLN1
    if (TLN1 == 2 && F.bid == 0 && F.tid == 0) *(unsigned long long*)(F.ctl + 30000) += __builtin_amdgcn_s_memrealtime() - tl1_;
#endif
}
__device__ __forceinline__ void moe_tables(Frame& F, int l, int nN) {
    REFRESH(F);
    volatile LAS int* tab = (volatile LAS int*)(F.lds + TAB_OFF);
    __syncthreads();
    if (F.wave == 0) {
        const int e = F.lane & 31; const int n = (int)__hip_atomic_load(F.ctl + CW_CNT + l * 32 + e, __ATOMIC_RELAXED, __HIP_MEMORY_SCOPE_AGENT), nt = F.lane < 32 ? (n + 255) >> 8 : 0;
        int inc = nt;
#pragma unroll
        for (int o = 1; o < 32; o <<= 1) { const int v = __shfl_up(inc, o); if (F.lane >= o) inc += v; }
        const int t = inc - nt;
        if (F.lane < 32) { tab[352 + e] = t * 256;
#pragma unroll 1
            for (int i = 0; i < nt; ++i) tab[t + i] = e; }
        if (F.lane == 31) tab[320] = inc; }
    __syncthreads();
    if (nN > 0 && F.tid < 16) { int pm, pn; const int T = tab[320]; int w = -1;
        if (TileMap::map(F.tid, F.G, F.bid, T, nN, pm, pn)) w = pm | (pn << 12) | (tab[pm] << 16) | (nN << 24);
        tab[416 + F.tid] = w; }
    __syncthreads();
}
PHASE_FN void ph_moe_gather(Ctx cx, int l_) {
    Frame F = mkframe(cx); const int l = rfl(l_);
    REFRESH(F);
    volatile LAS int* tab = (volatile LAS int*)(F.lds + TAB_OFF);
    moe_tables(F, l, 0);
    const int gw = F.bid * NWAVES + F.wave, NGW = F.G * NWAVES;
    const int* TOPE = (const int*)(F.ws + WS_TOPE); const int* TOPR = (const int*)(F.ws + WS_TOPR); const int* BLKB = (const int*)(F.ws + WS_BLKB); int* SLOT = (int*)(F.ws + WS_SLOT);
    const bf16* HX = (const bf16*)(F.ws + WS_HX); bf16* HP = (bf16*)(F.ws + WS_HP);
    const int MR = l == DEPTH - 1 ? MLAT : MT;
    int* ROWTOK = (int*)(F.ws + WS_ROWTOK);
    for (int e4 = (int)((size_t)F.bid * NTHREADS + F.tid); e4 < MR * 4; e4 += F.G * NTHREADS) { const int row = e4 >> 2, e = TOPE[e4];
        const int slot = tab[352 + e] + BLKB[rg_of(row) * 32 + e] + TOPR[e4]; SLOT[e4] = slot; ROWTOK[slot] = row * (DM * 2); }
}
PHASE_FN void ph_ln2(Ctx cx, int l_) {
    Frame F = mkframe(cx); const ArgsP a = F.ap; const int l = rfl(l_);
    REFRESH(F);
    const int gw = F.bid * NWAVES + F.wave, NGW = F.G * NWAVES;
    bf16* X = (bf16*)(F.ws + WS_X); const bf16* Y = (const bf16*)(F.ws + WS_Y);
    const int* SLOT = (const int*)(F.ws + WS_SLOT); const float* TOPG = (const float*)(F.ws + WS_TOPG);
    const float* lng = AIN(I_LNG) + (size_t)(l * 2 + 1) * DM; const float* lnb = AIN(I_LNB) + (size_t)(l * 2 + 1) * DM;
    if (l < DEPTH - 1) stage_wdec(F, l + 1);
    const bool poison = __hip_atomic_load(F.ctl + CW_BAR + XB_TMO, __ATOMIC_RELAXED, __HIP_MEMORY_SCOPE_AGENT) != 0u;
    const int MR = l == DEPTH - 1 ? MLAT : MT;
    u32x2 xr[4], nx[4]; u32x2 yw[4][4], ny[4][4]; float cg = 0.f, g1 = 0.f; int s1 = 0;
#pragma unroll
    for (int j = 0; j < 4; ++j) { xr[j] = (u32x2){0u, 0u}; nx[j] = xr[j];
#pragma unroll
        for (int k = 0; k < 4; ++k) { yw[k][j] = (u32x2){0u, 0u}; ny[k][j] = yw[k][j]; } }
    if (gw < MR) { const int s0 = SLOT[gw * 4 + (F.lane & 3)]; cg = TOPG[gw * 4 + (F.lane & 3)];
#pragma unroll
        for (int j = 0; j < 4; ++j) xr[j] = __builtin_nontemporal_load((const u32x2*)(X + (size_t)gw * DM + 4 * F.lane + 256 * j));
#pragma unroll
        for (int k = 0; k < 4; ++k) { const bf16* yr = Y + (size_t)__builtin_amdgcn_readlane(s0, k) * DM + 4 * F.lane;
#pragma unroll
            for (int j = 0; j < 4; ++j) yw[k][j] = __builtin_nontemporal_load((const u32x2*)(yr + 256 * j)); }
        if (gw + NGW < MR) { s1 = SLOT[(gw + NGW) * 4 + (F.lane & 3)]; g1 = TOPG[(gw + NGW) * 4 + (F.lane & 3)]; } }
    f32x4 pv[4]; bool havep = false; int prow = 0;
#pragma unroll
    for (int j = 0; j < 4; ++j) pv[j] = (f32x4){0.f, 0.f, 0.f, 0.f};
    for (int row = gw; row < MR; row += NGW) {
        const float* mrow = (const float*)(F.ws + WS_MOD) + ((size_t)l * 3 + mod_index(row)) * 6144; const float* mnext = mrow + (l < DEPTH - 1 ? 3 * 6144 : 0);
        f32x4 ggv[4], lgv[4], lbv[4], shv[4], scv[4];
#pragma unroll
        for (int j = 0; j < 4; ++j) { const int c = 4 * F.lane + 256 * j; ggv[j] = *(const f32x4*)(mrow + 5120 + c); lgv[j] = *(const f32x4*)(lng + c); lbv[j] = *(const f32x4*)(lnb + c);
            shv[j] = *(const f32x4*)(mnext + c); scv[j] = *(const f32x4*)(mnext + 1024 + c); }
        int s2 = 0; float g2n = 0.f;
        if (row + NGW < MR) { const int nr = row + NGW;
#pragma unroll
            for (int j = 0; j < 4; ++j) nx[j] = __builtin_nontemporal_load((const u32x2*)(X + (size_t)nr * DM + 4 * F.lane + 256 * j));
#pragma unroll
            for (int k = 0; k < 4; ++k) { const bf16* yr = Y + (size_t)__builtin_amdgcn_readlane(s1, k) * DM + 4 * F.lane;
#pragma unroll
                for (int j = 0; j < 4; ++j) ny[k][j] = __builtin_nontemporal_load((const u32x2*)(yr + 256 * j)); }
            if (nr + NGW < MR) { s2 = SLOT[(nr + NGW) * 4 + (F.lane & 3)]; g2n = TOPG[(nr + NGW) * 4 + (F.lane & 3)]; } }
        float gk[4];
#pragma unroll
        for (int k = 0; k < 4; ++k) gk[k] = __builtin_bit_cast(float, __builtin_amdgcn_readlane(__builtin_bit_cast(int, cg), k));
        f32x4 fx[4];
#pragma unroll
        for (int j = 0; j < 4; ++j) fx[j] = (f32x4){0.f, 0.f, 0.f, 0.f};
#pragma unroll
        for (int k = 0; k < 4; ++k)
#pragma unroll
            for (int j = 0; j < 4; ++j) { const u32x2 w = yw[k][j]; fx[j] += (f32x4){bflo(w.x), bfhi(w.x), bflo(w.y), bfhi(w.y)} * gk[k]; }
        f32x4 v[4];
#pragma unroll
        for (int j = 0; j < 4; ++j) { const int c = 4 * F.lane + 256 * j; v[j] = (f32x4){bflo(xr[j].x), bfhi(xr[j].x), bflo(xr[j].y), bfhi(xr[j].y)} * DN_ALPHA + ggv[j] * fx[j]; }
        ln_inplace(v);
#pragma unroll
        for (int j = 0; j < 4; ++j) v[j] = v[j] * lgv[j] + lbv[j];
        if (l == DEPTH - 1) { if (row < MLAT) {
            if (poison) { const float qn = __builtin_nanf("");
#pragma unroll
                for (int j = 0; j < 4; ++j) v[j] = (f32x4){qn, qn, qn, qn}; }
#pragma unroll
            for (int j = 0; j < 4; ++j) *((f32x4*)AOUT + (size_t)row * 256 + F.lane + 64 * j) = v[j]; } }
        else {
#pragma unroll
            for (int j = 0; j < 4; ++j) *(u32x2*)(X + (size_t)row * DM + 4 * F.lane + 256 * j) = (u32x2){pk2(v[j].x, v[j].y), pk2(v[j].z, v[j].w)};
            ln_inplace(v);
            { bf16* hx = (bf16*)(F.ws + WS_HX) + (size_t)row * DM;
#pragma unroll
              for (int j = 0; j < 4; ++j) { const int c = 4 * F.lane + 256 * j; v[j] = v[j] * (scv[j] + 1.f) + shv[j]; *(u32x2*)(hx + c) = (u32x2){pk2(v[j].x, v[j].y), pk2(v[j].z, v[j].w)}; } }
            if (havep) { decay_cols2(F, prow, pv, row, v); havep = false; }
            else { havep = true; prow = row;
#pragma unroll
                for (int j = 0; j < 4; ++j) pv[j] = v[j]; } }
#pragma unroll
        for (int j = 0; j < 4; ++j) { xr[j] = nx[j];
#pragma unroll
            for (int k = 0; k < 4; ++k) yw[k][j] = ny[k][j]; }
        cg = g1; s1 = s2; g1 = g2n;
    }
    if (havep) decay_cols(F, l + 1, prow, pv);
}

PHASE_FN void ph_gemm_win(Ctx cx, int l_) {
    Frame F = mkframe(cx); const int l = rfl(l_); GAS unsigned char* ws = F.ws;
    StaticOrder S{MT / 256, NP / 256, F.G, F.bid, 1024}; EpiWin E{(bf16*)(ws + WS_P)};
    pg8::gemm_phase<EpiWin, StaticOrder>(F.lds, 1024, (const char*)(ws + WS_HX), (const char*)(ws + WS_WIN) + (size_t)l * 8192 * 1024 * 2, S, E, F.wv);
}
PHASE_FN void ph_gemm_merge(Ctx cx, int l_) {
    Frame F = mkframe(cx); const int l = rfl(l_); GAS unsigned char* ws = F.ws;
    MergeOrder S{F.G, F.bid, l == DEPTH - 1 ? 0 : 24}; EpiMerge E{(const bf16*)(ws + WS_P), (bf16*)(ws + WS_MACC), (bf16*)(ws + WS_MBF), (bf16*)(ws + WS_CPART)};
    pg8::gemm_phase<EpiMerge, MergeOrder>(F.lds, 512, (const char*)(ws + WS_YA), (const char*)(ws + WS_WBR) + (size_t)l * 3 * 1024 * 512 * 2, S, E, F.wv);
}
PHASE_FN void ph_ctx_sum(Ctx cx) {
    Frame F = mkframe(cx); REFRESH(F); GAS unsigned char* ws = F.ws;
    const bf16* cp = (const bf16*)(ws + WS_CPART); bf16* mb = (bf16*)(ws + WS_MBF) + (size_t)MLAT * DM;
    for (int i = F.bid * NTHREADS + F.tid; i < MCTX * DM / 8; i += F.G * NTHREADS) {
        const u32x4 a0 = *(const u32x4*)(cp + (size_t)i * 8), a1 = *(const u32x4*)(cp + (size_t)MCTX * DM + (size_t)i * 8), a2 = *(const u32x4*)(cp + (size_t)2 * MCTX * DM + (size_t)i * 8); u32x4 w;
        w.x = pk2(bflo(a0.x) + bflo(a1.x) + bflo(a2.x), bfhi(a0.x) + bfhi(a1.x) + bfhi(a2.x)); w.y = pk2(bflo(a0.y) + bflo(a1.y) + bflo(a2.y), bfhi(a0.y) + bfhi(a1.y) + bfhi(a2.y));
        w.z = pk2(bflo(a0.z) + bflo(a1.z) + bflo(a2.z), bfhi(a0.z) + bfhi(a1.z) + bfhi(a2.z)); w.w = pk2(bflo(a0.w) + bflo(a1.w) + bflo(a2.w), bfhi(a0.w) + bfhi(a1.w) + bfhi(a2.w));
        *(u32x4*)(mb + (size_t)i * 8) = w; }
}
PHASE_FN void ph_gemm_wout(Ctx cx, int l_) {
    Frame F = mkframe(cx); const int l = rfl(l_); GAS unsigned char* ws = F.ws;
    StaticOrder S{MLAT / 256, 4, F.G, F.bid, 1024}; EpiWout E{(bf16*)(ws + WS_T)};
    pg8::gemm_phase<EpiWout, StaticOrder>(F.lds, 1024, (const char*)(ws + WS_MBF), (const char*)(ws + WS_WOUT) + (size_t)l * 1024 * 1024 * 2, S, E, F.wv);
}
PHASE_FN void ph_gemm_wout_ctx(Ctx cx, int l_) {
    Frame F = mkframe(cx); const int l = rfl(l_); GAS unsigned char* ws = F.ws;
    WoutCtxOrder S{F.G, F.bid}; EpiWoutCtx E{(bf16*)(ws + WS_DQ)};
    int Kq = 256; asm volatile("" : "+s"(Kq));
    pg8::gemm_phase<EpiWoutCtx, WoutCtxOrder>(F.lds, Kq, (const char*)(ws + WS_MBF), (const char*)(ws + WS_WOUT) + (size_t)l * 1024 * 1024 * 2, S, E, F.wv, nullptr, 1024);
}
PHASE_FN void ph_gemm_moe1(Ctx cx, int l_) {
    Frame F = mkframe(cx); const int l = rfl(l_); GAS unsigned char* ws = F.ws; const ArgsP a = F.ap;
    moe_tables(F, l, 8);
    MoeOrder S{(const volatile LAS int*)(F.lds + TAB_OFF), 1}; EpiAct E{AIN(I_B1) + (size_t)l * 32 * 2048, (bf16*)(ws + WS_ACT)};
    pg8::gemm_phase<EpiAct, MoeOrder, true, true, true>(F.lds, 1024, (const char*)(ws + WS_HX), (const char*)(ws + WS_W1) + (size_t)l * 32 * 2048 * 1024 * 2, S, E, F.wv, (const int*)(ws + WS_ROWTOK));
}
PHASE_FN void ph_gemm_moe2(Ctx cx, int l_) {
    Frame F = mkframe(cx); const int l = rfl(l_); GAS unsigned char* ws = F.ws; const ArgsP a = F.ap;
    moe_tables(F, l, 4);
    MoeOrder S{(const volatile LAS int*)(F.lds + TAB_OFF), 0}; EpiY E{AIN(I_B2) + (size_t)l * 32 * 1024, (bf16*)(ws + WS_Y)};
    pg8::gemm_phase<EpiY, MoeOrder>(F.lds, 1024, (const char*)(ws + WS_ACT), (const char*)(ws + WS_W2) + (size_t)l * 32 * 1024 * 1024 * 2, S, E, F.wv);
}
constexpr int NPH_LAYER = 12, NPHASES = 2 + DEPTH * NPH_LAYER;
__global__ void __launch_bounds__(NTHREADS, 2) fwd_kernel(Args args) {
    extern __shared__ __attribute__((aligned(16))) unsigned char lds_raw[];
    LAS unsigned char* lds = (LAS unsigned char*)lds_raw;
    const int tid = threadIdx.x;
    volatile LAS unsigned* MISC = (volatile LAS unsigned*)(lds + MISC_OFF);
    for (int u = tid; u < (LDS_BYTES - LDSCTL_OFF) / 4; u += NTHREADS) ((LAS unsigned*)(lds + LDSCTL_OFF))[u] = 0u;
    __syncthreads();
    const int lo = args.ph_lo, hi = args.ph_hi;
    const bool multi = (hi - lo) > 1;
    unsigned* ctl = (unsigned*)(args.ws + WS_CTL);
    XcdBarrier bar; bar.bar = ctl + CW_BAR; bar.x = 0; bar.st = nullptr;
    if (multi) bar = xcd_barrier_post(ctl + CW_BAR, MISC + 8);
    Ctx cx; cx.lds = lds; cx.ws = args.ws; cx.ap = (ArgsP)__builtin_amdgcn_kernarg_segment_ptr(); cx.G = gridDim.x; cx.bid = blockIdx.x; cx.wv = __builtin_amdgcn_readfirstlane(tid >> 6);
#ifndef ONLYP
#define ONLYP -1
#endif
#define ENP(k) (ONLYP < 0 || ONLYP == (k))
#ifndef TSCALE
#define TSCALE 1.0f
#endif
#ifndef TIMEK
#define TIMEK -1
#endif
#ifndef DUPK
#define DUPK -1
#endif
#define DUP(k, call) do { if (DUPK == (k)) { call; } } while (0)
#define IN(k) (lo <= (k) && (k) < hi)
#ifdef DUPBAR
#define SEAM(k) do { if (IN(k) && IN((k) + 1)) { xcd_barrier(bar); xcd_barrier(bar); } } while (0)
#else
#define SEAM(k) do { if (IN(k) && IN((k) + 1)) xcd_barrier(bar); } while (0)
#endif
    unsigned long long tacc = 0, tst = 0;
#define TBEG(k) do { if (TIMEK == (k)) tst = __builtin_amdgcn_s_memrealtime(); } while (0)
#define TEND(k) do { if (TIMEK == (k)) tacc += __builtin_amdgcn_s_memrealtime() - tst; } while (0)
    TBEG(100); TBEG(102);
    if (IN(0)) { if (ENP(100)) p0_prologue(cx); DUP(100, p0_prologue(cx)); SEAM(0); }
    TEND(100); TBEG(101);
    if (IN(1)) { if (ENP(101)) ph_lnmod0(cx); SEAM(1); }
    TEND(101);
    for (int l = 0; l < DEPTH; ++l) {
        const int pb = 2 + l * NPH_LAYER;
        if (IN(pb + 0)) { TBEG(0); if (ENP(0)) ph_gemm_win(cx, l); DUP(0, ph_gemm_win(cx, l)); SEAM(pb + 0); TEND(0); }
        if (IN(pb + 1)) { TBEG(1); if (ENP(1)) ph_prepq(cx, l); if (IN(pb + 1) && IN(pb + 3)) xcd_barrier(bar); TEND(1); }
        if (IN(pb + 3)) { TBEG(3); if (ENP(3)) ph_mixers(cx, l); DUP(3, ph_mixers(cx, l)); SEAM(pb + 3); TEND(3); }
        if (IN(pb + 4)) { TBEG(4); if (ENP(13)) ph_combine(cx, l); SEAM(pb + 4); TEND(4); }
        if (IN(pb + 5)) { TBEG(5); if (ENP(5)) ph_gemm_merge(cx, l); DUP(5, ph_gemm_merge(cx, l));
            if (l < DEPTH - 1 && IN(pb + 6)) { xcd_barrier(bar); ph_ctx_sum(cx); }
            SEAM(pb + 5); TEND(5); }
        if (IN(pb + 6)) { TBEG(6); if (ENP(6)) { ph_gemm_wout(cx, l); if (l < DEPTH - 1) ph_gemm_wout_ctx(cx, l); } DUP(6, ph_gemm_wout(cx, l)); SEAM(pb + 6); TEND(6); }
        if (IN(pb + 7)) { TBEG(7); if (ENP(7)) ph_ln1_router(cx, l); SEAM(pb + 7); TEND(7); }
        if (IN(pb + 8)) { TBEG(8); if (ENP(8)) ph_moe_gather(cx, l); DUP(8, ph_moe_gather(cx, l)); SEAM(pb + 8); TEND(8); }
        if (IN(pb + 9)) { TBEG(9); if (ENP(9)) ph_gemm_moe1(cx, l); DUP(9, ph_gemm_moe1(cx, l)); SEAM(pb + 9); TEND(9); }
        if (IN(pb + 10)) { TBEG(10); if (ENP(10)) ph_gemm_moe2(cx, l); DUP(10, ph_gemm_moe2(cx, l)); SEAM(pb + 10); TEND(10); }
        if (IN(pb + 11)) { TBEG(11); if (ENP(14)) ph_ln2(cx, l); SEAM(pb + 11); TEND(11); }
    }
    TEND(102);
    if (TIMEK >= 0 && blockIdx.x == 0) { __syncthreads(); if (tid == 0) { if (TIMEK == 99) tacc = *(unsigned long long*)(ctl + 30000); const float us = (float)tacc * 0.01f * TSCALE; args.out[0] += sqrtf(16.777f * us); } }
#undef IN
#undef SEAM
}

#ifndef MK_PER_PHASE
#define MK_PER_PHASE 0
#endif
extern "C" void kernel_launch(void* const* d_in, const int* in_sizes, int n_in, void* d_out, int out_size, void* d_ws, size_t ws_size, hipStream_t stream) {
    static int grid = 0;
    if (grid == 0) {
        if (n_in != 24 || out_size != MLAT * DM || ws_size < WS_END) { fprintf(stderr, "kernel_launch: unexpected shapes (n_in %d out %d ws %zu need %zu)\n", n_in, out_size, ws_size, (size_t)WS_END); grid = -1; return; }
        int dev = 0, cus = 0, per_cu = 0;
        if (hipGetDevice(&dev) != hipSuccess || hipDeviceGetAttribute(&cus, hipDeviceAttributeMultiprocessorCount, dev) != hipSuccess) { grid = -1; return; }
        if (hipFuncSetAttribute((const void*)fwd_kernel, hipFuncAttributeMaxDynamicSharedMemorySize, LDS_BYTES) != hipSuccess) { fprintf(stderr, "kernel_launch: hipFuncSetAttribute failed\n"); grid = -1; return; }
        if (hipOccupancyMaxActiveBlocksPerMultiprocessor(&per_cu, (const void*)fwd_kernel, NTHREADS, LDS_BYTES) != hipSuccess || per_cu < 1) { fprintf(stderr, "kernel_launch: occupancy query says %d\n", per_cu); }
        (void)hipGetLastError();
        grid = cus;
    }
    if (grid < 0) return;
    (void)hipMemsetAsync((char*)d_ws + WS_CTL, 0, CTL_ZERO_BYTES, stream);
    Args a{};
    for (int i = 0; i < 24; ++i) a.in[i] = (const float*)d_in[i];
    a.out = (float*)d_out; a.ws = (unsigned char*)d_ws;
#if MK_PER_PHASE
    for (int p = 0; p < NPHASES; ++p) { a.ph_lo = p; a.ph_hi = p + 1; hipLaunchKernelGGL(fwd_kernel, dim3(grid), dim3(NTHREADS), LDS_BYTES, stream, a); }
#else
    a.ph_lo = 0; a.ph_hi = NPHASES; hipLaunchKernelGGL(fwd_kernel, dim3(grid), dim3(NTHREADS), LDS_BYTES, stream, a);
#endif
    const hipError_t le = hipPeekAtLastError();
    if (le != hipSuccess) fprintf(stderr, "kernel_launch: launch failed: %s\n", hipGetErrorName(le));
}
```
